# Optimizing an MI355X kernel written in HIP

```python
import math
import jax, jax.numpy as jnp
from jax import lax
import numpy as np

D_MODEL = 4096
BATCH = 2
SEQ = 8192
DEPTH = 4

GRID_W = 64
CTX_LEN = 256
MIX_WIDTH = D_MODEL
HEAD_DIM = 128
NA_HEADS = (MIX_WIDTH // 2) // HEAD_DIM
NA_WIDTH = NA_HEADS * HEAD_DIM
HY_WIDTH = MIX_WIDTH - NA_WIDTH
WIN_H = 8
WIN_W = 16
HY_ORDER = 2
HY_SHORT = 3
HY_BANDS = 16
HY_EMB = 1 + 2 * HY_BANDS
HY_FILTER_HIDDEN = 64
HY_DECAY_TARGET = 1e-2
HY_FAST_DECAY = 0.3
HY_SLOW_DECAY = 1.5
GM_WIDTH = MIX_WIDTH
GM_GROUPS = GM_WIDTH // HEAD_DIM
CHUNK = 128
N_EXPERTS = 64
TOP_K = 8
EXPERT_DIM = 128
SHARED_DIM = TOP_K * EXPERT_DIM
ROUTED_SCALE = 2.5
ADA_RANK = 256
N_MOD = 6
EPS = 1e-6
N_EVEN = (DEPTH + 1) // 2
N_ODD = DEPTH // 2
EVEN_IN = 3 * NA_WIDTH + (HY_ORDER + 1) * HY_WIDTH
ODD_IN = 2 * GM_WIDTH

kernel_name = "hybrid_na_hyena_gmlp_moe_dit"


def rmsnorm(x, g):
    xf = x.astype(jnp.float32)
    y = xf * lax.rsqrt(jnp.mean(xf * xf, axis=-1, keepdims=True) + EPS)
    return (y * g.astype(jnp.float32)).astype(x.dtype)


def modulate(h, shift, scale):
    return h * (1.0 + scale) + shift


def ada_mod(cond, a, b, bias):
    m = (jax.nn.silu(cond) @ a) @ b + bias
    return m.reshape(cond.shape[:-1] + (N_MOD, D_MODEL))


def split_heads(t):
    return t.reshape(t.shape[:-1] + (NA_HEADS, HEAD_DIM))


def dense_attention(q, k, v):
    s = jnp.einsum('bqhd,bkhd->bhqk', q, k).astype(jnp.float32) * (HEAD_DIM ** -0.5)
    p = jax.nn.softmax(s, axis=-1).astype(v.dtype)
    return jnp.einsum('bhqk,bkhd->bqhd', p, v)


def neighborhood_attention(q, k, v, kc, vc, rpb):
    bsz, n, h, hd = q.shape
    rows = n // GRID_W
    kh = min(WIN_H, rows)
    scale = HEAD_DIM ** -0.5
    kg = k.reshape(bsz, rows, GRID_W, h, hd)
    vg = v.reshape(bsz, rows, GRID_W, h, hd)
    q_rows = jnp.moveaxis(q.reshape(bsz, rows, GRID_W, h, hd), 1, 0)
    r_idx = jnp.arange(rows, dtype=jnp.int32)
    r_start = jnp.clip(r_idx - kh // 2, 0, rows - kh)
    cols = jnp.arange(GRID_W, dtype=jnp.int32)
    c_start = jnp.clip(cols - WIN_W // 2, 0, GRID_W - WIN_W)
    c_idx = c_start[:, None] + jnp.arange(WIN_W, dtype=jnp.int32)
    col_off = c_idx - cols[:, None] + (WIN_W - 1)

    def one_row(args):
        q_row, r, rs = args
        k_band = lax.dynamic_slice_in_dim(kg, rs, kh, axis=1)
        v_band = lax.dynamic_slice_in_dim(vg, rs, kh, axis=1)
        k_win = k_band[:, :, c_idx]
        v_win = v_band[:, :, c_idx]
        row_off = rs + jnp.arange(kh, dtype=jnp.int32) - r + (WIN_H - 1)
        bias = rpb[:, row_off[None, :, None], col_off[:, None, :]]
        s_win = (jnp.einsum('bqhd,brqwhd->bhqrw', q_row, k_win).astype(jnp.float32) * scale
                 + bias.astype(jnp.float32))
        s_ctx = jnp.einsum('bqhd,bchd->bhqc', q_row, kc).astype(jnp.float32) * scale
        s = jnp.concatenate([s_win.reshape(bsz, h, GRID_W, kh * WIN_W), s_ctx], axis=-1)
        p = jax.nn.softmax(s, axis=-1).astype(v.dtype)
        p_win = p[..., :kh * WIN_W].reshape(bsz, h, GRID_W, kh, WIN_W)
        p_ctx = p[..., kh * WIN_W:]
        return (jnp.einsum('bhqrw,brqwhd->bqhd', p_win, v_win)
                + jnp.einsum('bhqc,bchd->bqhd', p_ctx, vc))

    out = lax.map(one_row, (q_rows, r_idx, r_start))
    return jnp.moveaxis(out, 0, 1).reshape(bsz, n, h, hd)


def short_conv(x, w, b):
    n = x.shape[1]
    pad = HY_SHORT // 2
    xp = jnp.pad(x, ((0, 0), (pad, HY_SHORT - 1 - pad), (0, 0)))
    out = b
    for i in range(HY_SHORT):
        out = out + xp[:, i:i + n] * w[i]
    return out


def hyena_filters(length, w1, b1, w2, b2, w3, b3, w4, freq):
    f32 = jnp.float32
    t_norm = jnp.linspace(0.0, 1.0, length, dtype=f32)[:, None]
    pos = jnp.arange(length, dtype=f32)[:, None]
    bands = jnp.linspace(1e-4, HY_BANDS - 1, HY_BANDS, dtype=f32)[None, :]
    ang = (2.0 * math.pi / length) * pos * bands
    feats = jnp.concatenate([t_norm, jnp.cos(ang), -jnp.sin(ang)], axis=-1)
    fr = freq.astype(f32)
    hdn = jnp.sin(fr[0] * (feats @ w1.astype(f32) + b1.astype(f32)))
    hdn = jnp.sin(fr[1] * (hdn @ w2.astype(f32) + b2.astype(f32)))
    hdn = jnp.sin(fr[2] * (hdn @ w3.astype(f32) + b3.astype(f32)))
    filt = (hdn @ w4.astype(f32)).reshape(length, 2, HY_ORDER, HY_WIDTH)
    deltas = jnp.abs(jnp.linspace(math.log(HY_DECAY_TARGET) / HY_FAST_DECAY,
                                  math.log(HY_DECAY_TARGET) / HY_SLOW_DECAY, HY_WIDTH, dtype=f32))
    filt = filt * jnp.exp(-t_norm * deltas)[:, None, None, :]
    fwd, bwd = filt[:, 0], filt[:, 1]
    kern = jnp.concatenate([fwd, jnp.zeros_like(fwd[:1]), bwd[:0:-1]], axis=0)
    return kern * lax.rsqrt(jnp.sum(kern * kern, axis=0, keepdims=True) + EPS)


def long_conv(z, kern, skip):
    n = z.shape[1]
    zf = z.astype(jnp.float32)
    zk = jnp.fft.rfft(zf, n=2 * n, axis=1) * jnp.fft.rfft(kern, axis=0)[None]
    y = jnp.fft.irfft(zk, n=2 * n, axis=1)[:, :n]
    return (y + zf * skip.astype(jnp.float32)).astype(z.dtype)


def hyena(p, conv_w, conv_b, w1, b1, w2, b2, w3, b3, w4, freq, skip):
    u = short_conv(p, conv_w, conv_b)
    parts = jnp.split(u, HY_ORDER + 1, axis=-1)
    gates, z = parts[:HY_ORDER], parts[HY_ORDER]
    kern = hyena_filters(p.shape[1], w1, b1, w2, b2, w3, b3, w4, freq)
    for o in range(HY_ORDER):
        z = gates[o] * long_conv(z, kern[:, o], skip[o])
    return z


def mixer_even(h_lat, h_ctx, w_in, q_gain, k_gain, rpb, hy_params, w_out, ctx_out):
    bsz, n, _ = h_lat.shape
    lc = h_ctx.shape[1]
    p_lat = h_lat @ w_in
    q, k, v = (split_heads(t) for t in jnp.split(p_lat[..., :3 * NA_WIDTH], 3, axis=-1))
    q, k = rmsnorm(q, q_gain), rmsnorm(k, k_gain)
    if ctx_out:
        p_ctx = h_ctx @ w_in
        qc, kc, vc = (split_heads(t) for t in jnp.split(p_ctx[..., :3 * NA_WIDTH], 3, axis=-1))
    else:
        kc, vc = (split_heads(t) for t in
                  jnp.split(h_ctx @ w_in[:, NA_WIDTH:3 * NA_WIDTH], 2, axis=-1))
    kc = rmsnorm(kc, k_gain)
    a_lat = neighborhood_attention(q, k, v, kc, vc, rpb).reshape(bsz, n, NA_WIDTH)
    o_lat = jnp.concatenate([a_lat, hyena(p_lat[..., 3 * NA_WIDTH:], *hy_params)], axis=-1) @ w_out
    if not ctx_out:
        return o_lat, None
    a_ctx = dense_attention(rmsnorm(qc, q_gain), kc, vc).reshape(bsz, lc, NA_WIDTH)
    o_ctx = jnp.concatenate([a_ctx, hyena(p_ctx[..., 3 * NA_WIDTH:], *hy_params)], axis=-1) @ w_out
    return o_lat, o_ctx


def gmlp(h, w_in, b_in, v_gain, w_s, b_s):
    bsz, n, _ = h.shape
    z = jax.nn.gelu(h @ w_in + b_in, approximate=False)
    u, v = jnp.split(z, 2, axis=-1)
    v = rmsnorm(v, v_gain)
    vb = v.reshape(bsz, n // CHUNK, CHUNK, GM_GROUPS, HEAD_DIM)
    s = jnp.einsum('gpq,bnqgc->bnpgc', w_s, vb) + b_s.T[:, :, None]
    return u * s.reshape(bsz, n, GM_WIDTH)


def moe(h, w_router, r_bias, w_gate, w_up, w_down, ws_gate, ws_up, ws_down):
    shp = h.shape
    t = h.reshape(-1, D_MODEL)
    scores = jax.nn.sigmoid((t @ w_router).astype(jnp.float32))
    _, idx = lax.top_k(scores + r_bias.astype(jnp.float32), TOP_K)
    sel = jnp.take_along_axis(scores, idx, axis=-1)
    g = sel / jnp.sum(sel, axis=-1, keepdims=True) * ROUTED_SCALE
    gates = jnp.einsum('tk,tke->te', g, jax.nn.one_hot(idx, N_EXPERTS, dtype=jnp.float32))
    hid = jax.nn.silu(jnp.einsum('td,edf->tef', t, w_gate)) * jnp.einsum('td,edf->tef', t, w_up)
    routed = jnp.einsum('tef,efd->td', hid * gates[..., None].astype(hid.dtype), w_down)
    shared = (jax.nn.silu(t @ ws_gate) * (t @ ws_up)) @ ws_down
    return (routed + shared).reshape(shp)


def setup_inputs(seed: int = 0) -> dict:
    key = jax.random.key(seed)
    ks = iter(jax.random.split(key, 64))

    def nrm(shape, scale):
        return jax.random.normal(next(ks), shape, jnp.float32) * scale

    def gain(shape):
        return 1.0 + nrm(shape, 0.05)

    d = D_MODEL
    fh = HY_FILTER_HIDDEN
    return {
        "x": nrm((BATCH, SEQ, d), 1.0),
        "c": nrm((BATCH, d), 1.0),
        "ctx": nrm((BATCH, CTX_LEN, d), 1.0),
        "c_ctx": nrm((d,), 1.0),
        "ada_a": nrm((DEPTH, d, ADA_RANK), d ** -0.5),
        "ada_b": nrm((DEPTH, ADA_RANK, N_MOD * d), 0.5 * ADA_RANK ** -0.5),
        "ada_bias": nrm((DEPTH, N_MOD * d), 0.02),
        "norm_mix": gain((DEPTH, d)),
        "norm_ffn": gain((DEPTH, d)),
        "even_w_in": nrm((N_EVEN, d, EVEN_IN), d ** -0.5),
        "na_q_gain": gain((N_EVEN, HEAD_DIM)),
        "na_k_gain": gain((N_EVEN, HEAD_DIM)),
        "na_rpb": nrm((N_EVEN, NA_HEADS, 2 * WIN_H - 1, 2 * WIN_W - 1), 0.1),
        "hy_conv_w": nrm((N_EVEN, HY_SHORT, (HY_ORDER + 1) * HY_WIDTH), HY_SHORT ** -0.5),
        "hy_conv_b": nrm((N_EVEN, (HY_ORDER + 1) * HY_WIDTH), 0.02),
        "hy_w1": nrm((N_EVEN, HY_EMB, fh), HY_EMB ** -0.5),
        "hy_b1": nrm((N_EVEN, fh), 0.1),
        "hy_w2": nrm((N_EVEN, fh, fh), fh ** -0.5),
        "hy_b2": nrm((N_EVEN, fh), 0.1),
        "hy_w3": nrm((N_EVEN, fh, fh), fh ** -0.5),
        "hy_b3": nrm((N_EVEN, fh), 0.1),
        "hy_w4": nrm((N_EVEN, fh, 2 * HY_ORDER * HY_WIDTH), fh ** -0.5),
        "hy_freq": 1.0 + nrm((N_EVEN, 3, fh), 0.1),
        "hy_skip": nrm((N_EVEN, HY_ORDER, HY_WIDTH), 0.5),
        "odd_w_in": nrm((N_ODD, d, ODD_IN), d ** -0.5),
        "odd_b_in": nrm((N_ODD, ODD_IN), 0.02),
        "gm_v_gain": gain((N_ODD, GM_WIDTH)),
        "gm_w_s": nrm((N_ODD, GM_GROUPS, CHUNK, CHUNK), CHUNK ** -0.5),
        "gm_b_s": 1.0 + nrm((N_ODD, GM_GROUPS, CHUNK), 0.02),
        "w_mix_out": nrm((DEPTH, MIX_WIDTH, d), MIX_WIDTH ** -0.5),
        "moe_router": nrm((DEPTH, d, N_EXPERTS), d ** -0.5),
        "moe_bias": nrm((DEPTH, N_EXPERTS), 0.01),
        "moe_w_gate": nrm((DEPTH, N_EXPERTS, d, EXPERT_DIM), d ** -0.5),
        "moe_w_up": nrm((DEPTH, N_EXPERTS, d, EXPERT_DIM), d ** -0.5),
        "moe_w_down": nrm((DEPTH, N_EXPERTS, EXPERT_DIM, d), EXPERT_DIM ** -0.5),
        "sh_w_gate": nrm((DEPTH, d, SHARED_DIM), d ** -0.5),
        "sh_w_up": nrm((DEPTH, d, SHARED_DIM), d ** -0.5),
        "sh_w_down": nrm((DEPTH, SHARED_DIM, d), SHARED_DIM ** -0.5),
    }


def reference(x, c, ctx, c_ctx, ada_a, ada_b, ada_bias, norm_mix, norm_ffn,
              even_w_in, na_q_gain, na_k_gain, na_rpb, hy_conv_w, hy_conv_b,
              hy_w1, hy_b1, hy_w2, hy_b2, hy_w3, hy_b3, hy_w4, hy_freq, hy_skip,
              odd_w_in, odd_b_in, gm_v_gain, gm_w_s, gm_b_s, w_mix_out,
              moe_router, moe_bias, moe_w_gate, moe_w_up, moe_w_down,
              sh_w_gate, sh_w_up, sh_w_down):
    lc = ctx.shape[1]
    lat, cx = x, ctx
    for layer in range(DEPTH):
        last = layer == DEPTH - 1
        is_even = layer % 2 == 0
        need_ctx = (not last) or is_even
        j = layer // 2
        m_lat = ada_mod(c, ada_a[layer], ada_b[layer], ada_bias[layer])[:, None]
        h_lat = modulate(rmsnorm(lat, norm_mix[layer]), m_lat[..., 0, :], m_lat[..., 1, :])
        if need_ctx:
            m_ctx = ada_mod(c_ctx, ada_a[layer], ada_b[layer], ada_bias[layer])[None, None]
            h_ctx = modulate(rmsnorm(cx, norm_mix[layer]), m_ctx[..., 0, :], m_ctx[..., 1, :])
        if is_even:
            hy_params = (hy_conv_w[j], hy_conv_b[j], hy_w1[j], hy_b1[j], hy_w2[j], hy_b2[j],
                         hy_w3[j], hy_b3[j], hy_w4[j], hy_freq[j], hy_skip[j])
            o_lat, o_ctx = mixer_even(h_lat, h_ctx, even_w_in[j], na_q_gain[j], na_k_gain[j],
                                      na_rpb[j], hy_params, w_mix_out[layer], not last)
        else:
            gm = (odd_w_in[j], odd_b_in[j], gm_v_gain[j], gm_w_s[j], gm_b_s[j])
            o_lat = gmlp(h_lat, *gm) @ w_mix_out[layer]
            o_ctx = None if last else gmlp(h_ctx, *gm) @ w_mix_out[layer]
        lat = lat + m_lat[..., 2, :] * o_lat
        moe_params = (moe_router[layer], moe_bias[layer], moe_w_gate[layer], moe_w_up[layer],
                      moe_w_down[layer], sh_w_gate[layer], sh_w_up[layer], sh_w_down[layer])
        if last:
            f_in = modulate(rmsnorm(lat, norm_ffn[layer]), m_lat[..., 3, :], m_lat[..., 4, :])
            lat = lat + m_lat[..., 5, :] * moe(f_in, *moe_params)
        else:
            cx = cx + m_ctx[..., 2, :] * o_ctx
            f_in = jnp.concatenate(
                [modulate(rmsnorm(cx, norm_ffn[layer]), m_ctx[..., 3, :], m_ctx[..., 4, :]),
                 modulate(rmsnorm(lat, norm_ffn[layer]), m_lat[..., 3, :], m_lat[..., 4, :])], axis=1)
            f = moe(f_in, *moe_params)
            cx = cx + m_ctx[..., 5, :] * f[:, :lc]
            lat = lat + m_lat[..., 5, :] * f[:, lc:]
    return lat
```

```cpp
#include <hip/hip_runtime.h>
#include <cstdio>
#include <cstdint>

#ifndef MK_PER_PHASE
#define MK_PER_PHASE 0
#endif

#ifndef PROBE_DUP
#define PROBE_DUP 0
#endif

constexpr int D = 4096, SEQ = 8192, NLAT = 16384, LC = 256, NCTX = 512, T = NLAT + NCTX;
constexpr int EVEN_IN = 12288, ODD_IN = 8192, NE = 64, ED = 128, SHD = 1024, RANK = 256;
constexpr int GU_N = (NE * ED + SHD) * 2;
constexpr int DN_K = NE * ED + SHD;
constexpr float EPS = 1e-6f;

namespace pg8 {
#define PG8_LAS __attribute__((address_space(3)))
typedef unsigned short bf16_t;
typedef short bf16x8 __attribute__((ext_vector_type(8)));
typedef float f32x4 __attribute__((ext_vector_type(4)));
typedef unsigned u32x4 __attribute__((ext_vector_type(4)));
constexpr int BM = 256, BK = 64, HALF = 128, HTB = HALF * BK * 2  , STAGE_BYTES = 8 * HTB, NXCD = 8, WGM = 8;

__host__ __device__ __forceinline__ int lds_byte(int r, int c) { const int st = (r >> 4) * 2 + (c >> 5), rr = r & 15, cc = c & 31, ob = rr * 64 + cc * 2; return st * 1024 + (ob ^ (((ob >> 9) & 1) << 5)); }
__host__ __device__ __forceinline__ void stage_rc(int b, int& R, int& C) { const int st = b / 1024, sb = b % 1024, swz = sb ^ (((sb >> 9) & 1) << 5); R = (st >> 1) * 16 + swz / 64; C = (st & 1) * 32 + (swz % 64) / 2; }
__host__ __device__ __forceinline__ int perm32(int rho) { const int n = rho >> 4, i = rho & 15; return 8 * (i >> 2) + 4 * n + (i & 3); }

struct Unit { int pm, pn; };
struct Gemm { const bf16_t* A; const bf16_t* Bt; int M, N, K; };

struct StaticOrder {
    int nM, nN, nwg, G, c;
    __host__ __device__ void init(int M, int N, int G_, int c_) { nM = M / BM; nN = N / BM; nwg = nM * nN; G = G_; c = c_; }
    __host__ __device__ bool next(int i, Unit& u) const {
        const long L = (long)i * G + c; if (L >= nwg) return false;
        int wgid = (int)L; { const int q = nwg / NXCD, r = nwg % NXCD, xcd = wgid % NXCD, off = wgid / NXCD; wgid = (xcd < r ? xcd * (q + 1) : r * (q + 1) + (xcd - r) * q) + off; }
        const int nig = WGM * nN, gid = wgid / nig, fm = gid * WGM, gsz = (nM - fm) < WGM ? (nM - fm) : WGM;
        u.pm = fm + ((wgid % nig) % gsz); u.pn = (wgid % nig) / gsz; return true;
    }
    __device__ __forceinline__ void a_ready(const Unit&) const {}
    __device__ __forceinline__ void done(const Unit&) const {}
};

__device__ __forceinline__ unsigned cvt_pk_bf16(float lo, float hi) { unsigned r; asm volatile("v_cvt_pk_bf16_f32 %0, %1, %2" : "=v"(r) : "v"(lo), "v"(hi)); return r; }
typedef float f32x2 __attribute__((ext_vector_type(2)));
__device__ __forceinline__ f32x2 gelu_pk(f32x2 v) {
    const f32x2 av = __builtin_elementwise_abs(v), d = av * 0.2316418882f + 1.0f;
    f32x2 t; t.x = __builtin_amdgcn_rcpf(d.x); t.y = __builtin_amdgcn_rcpf(d.y);
    f32x2 q = t * 0.5307027145f + (-0.7265760135f); q = q * t + 0.7107068705f; q = q * t + (-0.142248368f); q = q * t + 0.127414796f; q = q * t;
    const f32x2 s = (v * v) * (-0.72134752044f);
    f32x2 e; e.x = __builtin_amdgcn_exp2f(s.x); e.y = __builtin_amdgcn_exp2f(s.y);
    const f32x2 m = v * (q * e), r = v - m;
    f32x2 o; o.x = v.x < 0.f ? m.x : r.x; o.y = v.y < 0.f ? m.y : r.y; return o;
}

template <int ACT  > struct EpiBf16 {
    static constexpr bool PERM = true, AFTER_DRAIN = false; static_assert(ACT == 0 || ACT == 1, "EpiBf16: ACT is 0 (none) or 1 (gelu_pk)");
    bf16_t* O; int ldc; const float* bias; int split_cols; size_t split_stride; float scale0;
    __device__ __forceinline__ void operator()(const f32x4 (&acc)[2][2][4][2], const Unit& u, int wr, int wc, int fr, int fq) const {
        const int row0 = u.pm * BM + wr * 64 + fr; int colt = u.pn * BM; bf16_t* base = O;
        float sc = 1.f; if (split_cols) { const int t = colt / split_cols; base += (size_t)t * split_stride; colt -= t * split_cols; if (t == 0) sc = scale0; }
        const int col0 = colt + wc * 32 + 8 * fq, bcol0 = u.pn * BM + wc * 32 + 8 * fq;
        f32x4 bv[2][2];
#pragma unroll
        for (int bj = 0; bj < 2; ++bj)
#pragma unroll
            for (int n = 0; n < 2; ++n) bv[bj][n] = bias ? *(const f32x4*)(bias + bcol0 + bj * HALF + 4 * n) : (f32x4){0.f, 0.f, 0.f, 0.f};
#pragma unroll
        for (int ai = 0; ai < 2; ++ai)
#pragma unroll
            for (int m = 0; m < 4; ++m) { bf16_t* rowp = base + (size_t)(row0 + ai * HALF + m * 16) * ldc + col0;
#pragma unroll
                for (int bj = 0; bj < 2; ++bj) { f32x4 v0 = acc[ai][bj][m][0] + bv[bj][0], v1 = acc[ai][bj][m][1] + bv[bj][1];
                    if (ACT == 1) { f32x2 a = gelu_pk((f32x2){v0[0], v0[1]}), b = gelu_pk((f32x2){v0[2], v0[3]}), c = gelu_pk((f32x2){v1[0], v1[1]}), d = gelu_pk((f32x2){v1[2], v1[3]});
                        v0 = (f32x4){a.x, a.y, b.x, b.y}; v1 = (f32x4){c.x, c.y, d.x, d.y}; }
                    v0 = v0 * sc; v1 = v1 * sc; u32x4 w; w.x = cvt_pk_bf16(v0[0], v0[1]); w.y = cvt_pk_bf16(v0[2], v0[3]); w.z = cvt_pk_bf16(v1[0], v1[1]); w.w = cvt_pk_bf16(v1[2], v1[3]);
                    *(u32x4*)(rowp + bj * HALF) = w; } }
    }
};

struct EpiResid {
    static constexpr bool PERM = false, AFTER_DRAIN = false;
    const float* lat_src; const float* cx_src; float* lat_dst; float* cx_dst; const float* gate;
    __device__ __forceinline__ void operator()(const f32x4 (&acc)[2][2][4][2], const Unit& u, int wr, int wc, int fr, int fq) const {
        const int rowt = u.pm * BM; int c, rbase; const float* src; float* dst;
        if (rowt < NLAT) { c = rowt < SEQ ? 0 : 1; src = lat_src; dst = lat_dst; rbase = 0; } else { c = 2; src = cx_src; dst = cx_dst; rbase = NLAT; }
        const float* gv = gate + (size_t)c * 6 * D;
        const int row0 = rowt - rbase + wr * 64 + fr, col0 = u.pn * BM + wc * 32 + 4 * fq;
        f32x4 g[2][2];
#pragma unroll
        for (int bj = 0; bj < 2; ++bj)
#pragma unroll
            for (int n = 0; n < 2; ++n) g[bj][n] = *(const f32x4*)(gv + col0 + bj * HALF + n * 16);
#pragma unroll
        for (int ai = 0; ai < 2; ++ai)
#pragma unroll
            for (int m = 0; m < 4; ++m) { const size_t off = (size_t)(row0 + ai * HALF + m * 16) * D + col0;
#pragma unroll
                for (int bj = 0; bj < 2; ++bj)
#pragma unroll
                    for (int n = 0; n < 2; ++n) { const f32x4 s = *(const f32x4*)(src + off + bj * HALF + n * 16); *(f32x4*)(dst + off + bj * HALF + n * 16) = s + g[bj][n] * acc[ai][bj][m][n]; } }
    }
};
struct EpiSwiglu {
    static constexpr bool PERM = true, AFTER_DRAIN = false;
    bf16_t* H; const float* gates;
    __device__ __forceinline__ void operator()(const f32x4 (&acc)[2][2][4][2], const Unit& u, int wr, int wc, int fr, int fq) const {
        const int row0 = u.pm * BM + wr * 64 + fr, hc0 = u.pn * 128 + wc * 16 + 4 * fq;
#pragma unroll
        for (int ai = 0; ai < 2; ++ai)
#pragma unroll
            for (int m = 0; m < 4; ++m) { const int row = row0 + ai * HALF + m * 16; const float gt = (u.pn < NE) ? gates[(size_t)row * NE + u.pn] : 1.f;
#pragma unroll
                for (int bj = 0; bj < 2; ++bj) { const f32x4 v0 = acc[ai][bj][m][0], v1 = acc[ai][bj][m][1];
                    const float h0 = v0[0] / (1.f + __expf(-v0[0])) * v0[1] * gt, h1 = v0[2] / (1.f + __expf(-v0[2])) * v0[3] * gt;
                    const float h2 = v1[0] / (1.f + __expf(-v1[0])) * v1[1] * gt, h3 = v1[2] / (1.f + __expf(-v1[2])) * v1[3] * gt;
                    typedef unsigned u32x2v __attribute__((ext_vector_type(2))); u32x2v w; w.x = cvt_pk_bf16(h0, h1); w.y = cvt_pk_bf16(h2, h3);
                    *(u32x2v*)(H + (size_t)row * DN_K + hc0 + bj * 64) = w; } }
    }
};

template <class Epi, class Sched, bool ALIGN_EPI = false, bool SP2 = false>
__device__ __forceinline__ void gemm_phase(PG8_LAS unsigned char* lds, const Gemm g, const Sched& S, const Epi& E) {
    int tid_o = threadIdx.x; asm volatile("" : "+v"(tid_o));
    const int tid = tid_o, wid = __builtin_amdgcn_readfirstlane(tid >> 6), lane = tid & 63, wr = wid >> 2, wc = wid & 3, fr = lane & 15, fq = lane >> 4;
    const int K = g.K, nt = K / BK;
    unsigned voffA[2], voffB[2];
#pragma unroll
    for (int i = 0; i < 2; ++i) { int R, C; stage_rc(tid * 16 + i * 8192, R, C); const int Rb = Epi::PERM ? ((R & ~31) + perm32(R & 31)) : R;
        voffA[i] = (unsigned)(R * K + C) * 2u; voffB[i] = (unsigned)(Rb * K + C) * 2u; }
    const size_t kstep = (size_t)(BK * 2);
    const size_t hstep = (size_t)HALF * K * 2;
    const size_t tstep = 2 * hstep;
    const unsigned ldsw = (unsigned)wid * 1024u;
    const int aoff = lds_byte(wr * 64 + fr, fq * 8), boff = lds_byte(wc * 32 + fr, fq * 8);
#define PG8_SA(b, h) (((b) * 2 + (h)) * HTB)
#define PG8_SB(b, h) ((4 + (b) * 2 + (h)) * HTB)
#define PG8_STAGE(bufoff, gbase, voff) do { _Pragma("unroll") for (int _i = 0; _i < 2; ++_i) \
        __builtin_amdgcn_global_load_lds((const unsigned*)((const char*)(gbase) + (voff)[_i]), (PG8_LAS unsigned*)(lds + (bufoff) + ldsw + _i * 8192), 16, 0, 0); } while (0)
#define PG8_LDA(dst, b, h) do { _Pragma("unroll") for (int m = 0; m < 4; ++m) _Pragma("unroll") for (int k = 0; k < 2; ++k) dst[m][k] = *(const PG8_LAS bf16x8*)(lds + PG8_SA(b, h) + aoff + m * 2048 + k * 1024); } while (0)
#define PG8_LDB(dst, b, h) do { _Pragma("unroll") for (int n = 0; n < 2; ++n) _Pragma("unroll") for (int k = 0; k < 2; ++k) dst[n][k] = *(const PG8_LAS bf16x8*)(lds + PG8_SB(b, h) + boff + n * 2048 + k * 1024); } while (0)
#define PG8_MMA(ai, bj, At, Bt) do { __builtin_amdgcn_s_setprio(1); _Pragma("unroll") for (int m = 0; m < 4; ++m) _Pragma("unroll") for (int n = 0; n < 2; ++n) _Pragma("unroll") for (int k = 0; k < 2; ++k) \
        acc[ai][bj][m][n] = __builtin_amdgcn_mfma_f32_16x16x32_bf16(Bt[n][k], At[m][k], acc[ai][bj][m][n], 0, 0, 0); __builtin_amdgcn_s_setprio(0); } while (0)
#define PG8_WAIT_V(n) asm volatile("s_waitcnt vmcnt(" #n ")" ::: "memory")
#define PG8_WAIT_L(n) asm volatile("s_waitcnt lgkmcnt(" #n ")" ::: "memory")
#define PG8_BAR __builtin_amdgcn_s_barrier()
#define PG8_SCHED __builtin_amdgcn_sched_barrier(0)
    Unit cur, nxt; int ui = 0;
    if (!S.next(0, cur)) return;
    f32x4 acc[2][2][4][2];
#pragma unroll
    for (int a = 0; a < 2; ++a)
#pragma unroll
        for (int b = 0; b < 2; ++b)
#pragma unroll
            for (int m = 0; m < 4; ++m)
#pragma unroll
                for (int n = 0; n < 2; ++n) acc[a][b][m][n] = (f32x4){0.f, 0.f, 0.f, 0.f};
    bf16x8 At[4][2], B0[2][2], B1[2][2];
    const char* cA = (const char*)g.A + (size_t)cur.pm * tstep; const char* cB = (const char*)g.Bt + (size_t)cur.pn * tstep;
    S.a_ready(cur);
    if constexpr (SP2) {
        PG8_STAGE(PG8_SB(0, 0), cB, voffB); PG8_STAGE(PG8_SB(0, 1), cB + hstep, voffB); PG8_STAGE(PG8_SA(0, 0), cA, voffA); PG8_STAGE(PG8_SA(0, 1), cA + hstep, voffA);
        if (wr == 1) PG8_BAR;
        PG8_WAIT_V(2); PG8_BAR;
        PG8_STAGE(PG8_SB(1, 0), cB + kstep, voffB); PG8_STAGE(PG8_SA(1, 0), cA + kstep, voffA); PG8_STAGE(PG8_SB(1, 1), cB + hstep + kstep, voffB);
        PG8_WAIT_V(6); PG8_BAR;
    } else {
        PG8_STAGE(PG8_SB(0, 0), cB, voffB); PG8_STAGE(PG8_SA(0, 0), cA, voffA); PG8_STAGE(PG8_SB(0, 1), cB + hstep, voffB); PG8_STAGE(PG8_SA(0, 1), cA + hstep, voffA);
        if (wr == 1) PG8_BAR;
        PG8_WAIT_V(4); PG8_BAR;
        PG8_STAGE(PG8_SB(1, 0), cB + kstep, voffB); PG8_STAGE(PG8_SA(1, 0), cA + kstep, voffA); PG8_STAGE(PG8_SB(1, 1), cB + hstep + kstep, voffB);
        PG8_WAIT_V(6); PG8_BAR;
    }
    for (;;) {
        const bool has_next = S.next(ui + 1, nxt);
        const char* nA = has_next ? (const char*)g.A + (size_t)nxt.pm * tstep : cA; const char* nB = has_next ? (const char*)g.Bt + (size_t)nxt.pn * tstep : cB;
        for (int t = 0; t < nt; t += 2) {
            const bool last = (t == nt - 2);
            const char* a1 = cA + (size_t)(t + 1) * kstep;
            const char* a2 = last ? nA : cA + (size_t)(t + 2) * kstep; const char* b2 = last ? nB : cB + (size_t)(t + 2) * kstep;
            const char* a3 = a2 + kstep; const char* b3 = b2 + kstep;
            if (last && has_next) S.a_ready(nxt);
            if constexpr (SP2) {
            PG8_LDB(B0, 0, 0); PG8_LDB(B1, 0, 1); PG8_SCHED; PG8_LDA(At, 0, 0); PG8_STAGE(PG8_SA(1, 1), a1 + hstep, voffA);
            PG8_WAIT_V(8); PG8_WAIT_L(0); PG8_BAR; PG8_MMA(0, 0, At, B0); PG8_MMA(0, 1, At, B1); PG8_BAR; PG8_SCHED;
            PG8_LDA(At, 0, 1); PG8_STAGE(PG8_SB(0, 0), b2, voffB); PG8_STAGE(PG8_SB(0, 1), b2 + hstep, voffB); PG8_STAGE(PG8_SA(0, 0), a2, voffA);
            PG8_WAIT_V(8); PG8_WAIT_L(0); PG8_BAR; PG8_MMA(1, 0, At, B0); PG8_MMA(1, 1, At, B1); PG8_BAR; PG8_SCHED;
            PG8_LDB(B0, 1, 0); PG8_LDB(B1, 1, 1); PG8_SCHED; PG8_LDA(At, 1, 0); PG8_STAGE(PG8_SA(0, 1), a2 + hstep, voffA);
            PG8_WAIT_V(8); PG8_WAIT_L(0); PG8_BAR; PG8_MMA(0, 0, At, B0); PG8_MMA(0, 1, At, B1); PG8_BAR; PG8_SCHED;
            PG8_LDA(At, 1, 1); PG8_STAGE(PG8_SB(1, 0), b3, voffB); PG8_STAGE(PG8_SB(1, 1), b3 + hstep, voffB); PG8_STAGE(PG8_SA(1, 0), a3, voffA);
            PG8_WAIT_V(8); PG8_WAIT_L(0); PG8_BAR; PG8_MMA(1, 0, At, B0); PG8_MMA(1, 1, At, B1); PG8_BAR; PG8_SCHED;
            } else {
            PG8_LDB(B0, 0, 0); PG8_SCHED; PG8_LDA(At, 0, 0); PG8_STAGE(PG8_SA(1, 1), a1 + hstep, voffA);
            PG8_WAIT_L(8); PG8_BAR; PG8_WAIT_L(0); PG8_MMA(0, 0, At, B0); PG8_BAR; PG8_SCHED;
            PG8_LDB(B1, 0, 1); PG8_STAGE(PG8_SB(0, 0), b2, voffB);
            PG8_BAR; PG8_WAIT_L(0); PG8_MMA(0, 1, At, B1); PG8_BAR;
            PG8_LDA(At, 0, 1); PG8_STAGE(PG8_SA(0, 0), a2, voffA);
            PG8_BAR; PG8_WAIT_L(0); PG8_MMA(1, 0, At, B0); PG8_BAR; PG8_SCHED;
            PG8_STAGE(PG8_SB(0, 1), b2 + hstep, voffB);
            PG8_WAIT_V(6); PG8_BAR; PG8_MMA(1, 1, At, B1); PG8_BAR;
            PG8_LDB(B0, 1, 0); PG8_SCHED; PG8_LDA(At, 1, 0); PG8_STAGE(PG8_SA(0, 1), a2 + hstep, voffA);
            PG8_WAIT_L(8); PG8_BAR; PG8_WAIT_L(0); PG8_MMA(0, 0, At, B0); PG8_BAR; PG8_SCHED;
            PG8_LDB(B1, 1, 1); PG8_STAGE(PG8_SB(1, 0), b3, voffB);
            PG8_BAR; PG8_WAIT_L(0); PG8_MMA(0, 1, At, B1); PG8_BAR;
            PG8_LDA(At, 1, 1); PG8_STAGE(PG8_SA(1, 0), a3, voffA);
            PG8_BAR; PG8_WAIT_L(0); PG8_MMA(1, 0, At, B0); PG8_BAR; PG8_SCHED;
            PG8_STAGE(PG8_SB(1, 1), b3 + hstep, voffB);
            PG8_WAIT_V(6); PG8_BAR; PG8_MMA(1, 1, At, B1); PG8_BAR;
            }
        }
        if constexpr (ALIGN_EPI) { if (wr == 0) PG8_BAR; }
        if constexpr (!Epi::AFTER_DRAIN) { E(acc, cur, wr, wc, fr, fq); S.done(cur); }
        if (!has_next) break;
#pragma unroll
        for (int a = 0; a < 2; ++a)
#pragma unroll
            for (int b = 0; b < 2; ++b)
#pragma unroll
                for (int m = 0; m < 4; ++m)
#pragma unroll
                    for (int n = 0; n < 2; ++n) acc[a][b][m][n] = (f32x4){0.f, 0.f, 0.f, 0.f};
        cur = nxt; cA = nA; cB = nB; ++ui;
        if constexpr (ALIGN_EPI) { if (wr == 1) PG8_BAR; }
    }
    PG8_WAIT_V(0);
    if constexpr (!ALIGN_EPI) { if (wr == 0) PG8_BAR; }
    PG8_BAR;
    if constexpr (Epi::AFTER_DRAIN) { E.fused(acc, cur, wr, wc, fr, fq, lds, wid, lane); S.done(cur); }
#undef PG8_SA
#undef PG8_SB
#undef PG8_STAGE
#undef PG8_LDA
#undef PG8_LDB
#undef PG8_MMA
#undef PG8_WAIT_V
#undef PG8_WAIT_L
#undef PG8_BAR
#undef PG8_SCHED
}

struct UnitX { int pm, pn, e, nrows, k0, nt; };
typedef int i32x4 __attribute__((ext_vector_type(4)));
typedef int i32x8 __attribute__((ext_vector_type(8)));
template <class Epi, class Sched, class RowMap, bool F8 = false>
__device__ __forceinline__ void gemm_phase_x(PG8_LAS unsigned char* lds, const Gemm g, const Sched& S, const Epi& E, const RowMap& RM) {
    int tid_o = threadIdx.x; asm volatile("" : "+v"(tid_o));
    const int tid = tid_o, wid = __builtin_amdgcn_readfirstlane(tid >> 6), lane = tid & 63, wr = wid >> 2, wc = wid & 3, fr = lane & 15, fq = lane >> 4;
    const int K = g.K;
    int R_[2], C_[2]; unsigned voffB[2];
#pragma unroll
    for (int i = 0; i < 2; ++i) { stage_rc(tid * 16 + i * 8192, R_[i], C_[i]); const int Rb = Epi::PERM ? ((R_[i] & ~31) + perm32(R_[i] & 31)) : R_[i]; voffB[i] = (unsigned)(Rb * K + C_[i]) * 2u; }
    const size_t kstep = (size_t)(BK * 2);
    const size_t hstep = (size_t)HALF * K * 2;
    const size_t tstep = 2 * hstep;
    const unsigned ldsw = (unsigned)wid * 1024u;
    const int aoff = lds_byte(wr * 64 + fr, fq * 8), boff = lds_byte(wc * 32 + fr, fq * 8);
#define PG8_SA(b, h) (((b) * 2 + (h)) * HTB)
#define PG8_SB(b, h) ((4 + (b) * 2 + (h)) * HTB)
#define PG8_STAGE(bufoff, gbase, voff) do { _Pragma("unroll") for (int _i = 0; _i < 2; ++_i) \
        __builtin_amdgcn_global_load_lds((const unsigned*)((const char*)(gbase) + (voff)[_i]), (PG8_LAS unsigned*)(lds + (bufoff) + ldsw + _i * 8192), 16, 0, 0); } while (0)
#define PG8_LD8(dst, addr) do { const i32x4 _lo = *(const PG8_LAS i32x4*)(addr), _hi = *(const PG8_LAS i32x4*)((addr) + 1024); dst = __builtin_shufflevector(_lo, _hi, 0, 1, 2, 3, 4, 5, 6, 7); } while (0)
#define PG8_LDA(dst, b, h) do { _Pragma("unroll") for (int m = 0; m < 4; ++m) PG8_LD8(dst[m], lds + PG8_SA(b, h) + aoff + m * 2048); } while (0)
#define PG8_LDB(dst, b, h) do { _Pragma("unroll") for (int n = 0; n < 2; ++n) PG8_LD8(dst[n], lds + PG8_SB(b, h) + boff + n * 2048); } while (0)
#define PG8_LOH(v) __builtin_bit_cast(bf16x8, __builtin_shufflevector(v, v, 0, 1, 2, 3))
#define PG8_HIH(v) __builtin_bit_cast(bf16x8, __builtin_shufflevector(v, v, 4, 5, 6, 7))
#define PG8_MMA(ai, bj, At, Bt) do { __builtin_amdgcn_s_setprio(1); _Pragma("unroll") for (int m = 0; m < 4; ++m) _Pragma("unroll") for (int n = 0; n < 2; ++n) { \
        if constexpr (F8) asm volatile("v_mfma_scale_f32_16x16x128_f8f6f4 %0, %1, %2, %0, %3, %3 op_sel_hi:[0,0,0]" : "+v"(acc[ai][bj][m][n]) : "v"(Bt[n]), "v"(At[m]), "v"(sc8)); \
        else { acc[ai][bj][m][n] = __builtin_amdgcn_mfma_f32_16x16x32_bf16(PG8_LOH(Bt[n]), PG8_LOH(At[m]), acc[ai][bj][m][n], 0, 0, 0); \
               acc[ai][bj][m][n] = __builtin_amdgcn_mfma_f32_16x16x32_bf16(PG8_HIH(Bt[n]), PG8_HIH(At[m]), acc[ai][bj][m][n], 0, 0, 0); } } \
        __builtin_amdgcn_s_setprio(0); } while (0)
#define PG8_WAIT_V(n) asm volatile("s_waitcnt vmcnt(" #n ")" ::: "memory")
#define PG8_WAIT_L(n) asm volatile("s_waitcnt lgkmcnt(" #n ")" ::: "memory")
#define PG8_BAR __builtin_amdgcn_s_barrier()
#define PG8_SCHED __builtin_amdgcn_sched_barrier(0)
#define PG8_ROWOFF(dst, u) do { _Pragma("unroll") for (int _h = 0; _h < 2; ++_h) _Pragma("unroll") for (int _i = 0; _i < 2; ++_i) \
        dst[_h][_i] = (RM.row(u, _h * HALF + R_[_i]) * (unsigned)K + (unsigned)C_[_i]) * 2u; } while (0)
#define PG8_ABASE(u) ((const char*)g.A + ((size_t)RM.base(u) * K + (size_t)(u).k0) * 2)
    UnitX cur, nxt; int ui = 0;
    if (!S.next(0, cur)) return;
    f32x4 acc[2][2][4][2];
#pragma unroll
    for (int a = 0; a < 2; ++a)
#pragma unroll
        for (int b = 0; b < 2; ++b)
#pragma unroll
            for (int m = 0; m < 4; ++m)
#pragma unroll
                for (int n = 0; n < 2; ++n) acc[a][b][m][n] = (f32x4){0.f, 0.f, 0.f, 0.f};
    i32x8 At[4], B0[2], B1[2];
    const int sc8 = 0x7f7f7f7f;
    unsigned vc[2][2], vn[2][2];
    PG8_ROWOFF(vc, cur);
    const char* A0 = PG8_ABASE(cur);
    const char* cB = (const char*)g.Bt + (size_t)cur.pn * tstep + (size_t)cur.k0 * 2;
    PG8_STAGE(PG8_SB(0, 0), cB, voffB); PG8_STAGE(PG8_SB(0, 1), cB + hstep, voffB); PG8_STAGE(PG8_SA(0, 0), A0, vc[0]); PG8_STAGE(PG8_SA(0, 1), A0, vc[1]);
    if (wr == 1) PG8_BAR;
    PG8_WAIT_V(2); PG8_BAR;
    PG8_STAGE(PG8_SB(1, 0), cB + kstep, voffB); PG8_STAGE(PG8_SA(1, 0), A0 + kstep, vc[0]); PG8_STAGE(PG8_SB(1, 1), cB + hstep + kstep, voffB);
    PG8_WAIT_V(6); PG8_BAR;
    for (;;) {
        const bool has_next = S.next(ui + 1, nxt);
        if constexpr (!RowMap::IDENT) { if (has_next) { PG8_ROWOFF(vn, nxt); } else {
#pragma unroll
            for (int _h = 0; _h < 2; ++_h)
#pragma unroll
                for (int _i = 0; _i < 2; ++_i) vn[_h][_i] = vc[_h][_i]; } }
        const char* nB = has_next ? (const char*)g.Bt + (size_t)nxt.pn * tstep + (size_t)nxt.k0 * 2 : cB;
        const char* nA = has_next ? PG8_ABASE(nxt) : A0;
        const int nt = cur.nt;
        for (int t = 0; t < nt; t += 2) {
            const bool last = (t == nt - 2);
            const char* a1 = A0 + (size_t)(t + 1) * kstep;
            const char* a2 = last ? nA : A0 + (size_t)(t + 2) * kstep; const char* b2 = last ? nB : cB + (size_t)(t + 2) * kstep;
            const char* a3 = a2 + kstep; const char* b3 = b2 + kstep;
            unsigned v2h0[2], v2h1[2];
#pragma unroll
            for (int _i = 0; _i < 2; ++_i) { if constexpr (RowMap::IDENT) { v2h0[_i] = vc[0][_i]; v2h1[_i] = vc[1][_i]; } else { v2h0[_i] = last ? vn[0][_i] : vc[0][_i]; v2h1[_i] = last ? vn[1][_i] : vc[1][_i]; } }
            PG8_LDB(B0, 0, 0); PG8_LDB(B1, 0, 1); PG8_SCHED; PG8_LDA(At, 0, 0); PG8_STAGE(PG8_SA(1, 1), a1, vc[1]);
            PG8_WAIT_V(8); PG8_WAIT_L(0); PG8_BAR; PG8_MMA(0, 0, At, B0); PG8_MMA(0, 1, At, B1); PG8_BAR; PG8_SCHED;
            PG8_LDA(At, 0, 1); PG8_STAGE(PG8_SB(0, 0), b2, voffB); PG8_STAGE(PG8_SB(0, 1), b2 + hstep, voffB); PG8_STAGE(PG8_SA(0, 0), a2, v2h0);
            PG8_WAIT_V(8); PG8_WAIT_L(0); PG8_BAR; PG8_MMA(1, 0, At, B0); PG8_MMA(1, 1, At, B1); PG8_BAR; PG8_SCHED;
            PG8_LDB(B0, 1, 0); PG8_LDB(B1, 1, 1); PG8_SCHED; PG8_LDA(At, 1, 0); PG8_STAGE(PG8_SA(0, 1), a2, v2h1);
            PG8_WAIT_V(8); PG8_WAIT_L(0); PG8_BAR; PG8_MMA(0, 0, At, B0); PG8_MMA(0, 1, At, B1); PG8_BAR; PG8_SCHED;
            PG8_LDA(At, 1, 1); PG8_STAGE(PG8_SB(1, 0), b3, voffB); PG8_STAGE(PG8_SB(1, 1), b3 + hstep, voffB); PG8_STAGE(PG8_SA(1, 0), a3, v2h0);
            PG8_WAIT_V(8); PG8_WAIT_L(0); PG8_BAR; PG8_MMA(1, 0, At, B0); PG8_MMA(1, 1, At, B1); PG8_BAR; PG8_SCHED;
        }
        if constexpr (F8) asm volatile("s_nop 7\n\ts_nop 7\n\ts_nop 7" ::: "memory");
        if (wr == 0) PG8_BAR;
        E(acc, cur, wr, wc, fr, fq);
        if (!has_next) break;
#pragma unroll
        for (int a = 0; a < 2; ++a)
#pragma unroll
            for (int b = 0; b < 2; ++b)
#pragma unroll
                for (int m = 0; m < 4; ++m)
#pragma unroll
                    for (int n = 0; n < 2; ++n) acc[a][b][m][n] = (f32x4){0.f, 0.f, 0.f, 0.f};
        cur = nxt; cB = nB; A0 = nA; ++ui;
        if constexpr (!RowMap::IDENT) {
#pragma unroll
        for (int _h = 0; _h < 2; ++_h)
#pragma unroll
            for (int _i = 0; _i < 2; ++_i) vc[_h][_i] = vn[_h][_i]; }
        if (wr == 1) PG8_BAR;
    }
    PG8_WAIT_V(0);
    PG8_BAR;
#undef PG8_SA
#undef PG8_SB
#undef PG8_STAGE
#undef PG8_LDA
#undef PG8_LDB
#undef PG8_LD8
#undef PG8_LOH
#undef PG8_HIH
#undef PG8_MMA
#undef PG8_WAIT_V
#undef PG8_WAIT_L
#undef PG8_BAR
#undef PG8_SCHED
#undef PG8_ROWOFF
#undef PG8_ABASE
}

struct MoeOrder {
    const PG8_LAS int* tab; const PG8_LAS int* cnt; int Ur, nSh, G, c, ntk;
    __device__ __forceinline__ bool next(int i, UnitX& u) const {
        int L = i * G + c; u.k0 = 0; u.nt = ntk;
        if (L < Ur) { const int v = tab[L]; u.e = v & 255; u.pm = v >> 8; u.pn = u.e; u.nrows = cnt[u.e]; return true; }
        L -= Ur;
        if (L < nSh) { u.e = -1; u.pm = L >> 3; u.pn = NE + (L & 7); u.nrows = 0; return true; }
        return false;
    }
};
struct RowList {
    const int* list;
    static constexpr bool IDENT = false;
    __device__ __forceinline__ unsigned base(const UnitX&) const { return 0u; }
    __device__ __forceinline__ unsigned row(const UnitX& u, int r) const {
        if (u.e < 0) return (unsigned)(u.pm * BM + r);
        int i = u.pm * BM + r; i = i < u.nrows ? i : u.nrows - 1;
        return (unsigned)list[(size_t)u.e * T + i];
    }
};
struct EpiSwigluX {
    static constexpr bool PERM = true, AFTER_DRAIN = false;
    unsigned char* H; const float* gates; const int* list; float oscale;
    __device__ __forceinline__ void operator()(const f32x4 (&acc)[2][2][4][2], const UnitX& u, int wr, int wc, int fr, int fq) const {
        const int hc0 = u.pn * 128 + wc * 16 + 4 * fq;
#pragma unroll
        for (int ai = 0; ai < 2; ++ai)
#pragma unroll
            for (int m = 0; m < 4; ++m) { const int rloc = u.pm * BM + wr * 64 + fr + ai * HALF + m * 16; int tok = rloc; float gt = 1.f; bool ok = true;
                if (u.e >= 0) { ok = rloc < u.nrows; tok = ok ? list[(size_t)u.e * T + rloc] : 0; gt = ok ? gates[(size_t)tok * NE + u.e] : 0.f; }
                if (ok) {
#pragma unroll
                for (int bj = 0; bj < 2; ++bj) { const f32x4 v0 = acc[ai][bj][m][0] * oscale, v1 = acc[ai][bj][m][1] * oscale;
                    const float h0 = v0[0] / (1.f + __expf(-v0[0])) * v0[1] * gt, h1 = v0[2] / (1.f + __expf(-v0[2])) * v0[3] * gt;
                    const float h2 = v1[0] / (1.f + __expf(-v1[0])) * v1[1] * gt, h3 = v1[2] / (1.f + __expf(-v1[2])) * v1[3] * gt;
                    int w = __builtin_amdgcn_cvt_pk_fp8_f32(__builtin_amdgcn_fmed3f(h0, -448.f, 448.f), __builtin_amdgcn_fmed3f(h1, -448.f, 448.f), 0, false); w = __builtin_amdgcn_cvt_pk_fp8_f32(__builtin_amdgcn_fmed3f(h2, -448.f, 448.f), __builtin_amdgcn_fmed3f(h3, -448.f, 448.f), w, true);
                    *(int*)(H + (size_t)tok * DN_K + hc0 + bj * 64) = w; } } }
    }
};

struct SplitCtxOrder {
    int nN, G, c, ntk, nlat, nsub, nsplit;
    __device__ __forceinline__ void init(int M, int N, int K, int G_, int c_, int nsplit_) { nN = N / BM; G = G_; c = c_; ntk = K / BK; nsplit = nsplit_; nlat = (NLAT / BM) * nN; nsub = (M > NLAT) ? ((M - NLAT) / BM) * nN * nsplit : 0; }
    __device__ __forceinline__ bool next(int i, UnitX& u) const {
        int L = i * G + c; u.e = -1; u.nrows = 0;
        if (L < nlat) { int wgid = L; { const int q = nlat / NXCD, xcd = wgid % NXCD, off = wgid / NXCD; wgid = xcd * q + off; }
            const int nig = WGM * nN, gid = wgid / nig, fm = gid * WGM; u.pm = fm + ((wgid % nig) % WGM); u.pn = (wgid % nig) / WGM; u.k0 = 0; u.nt = ntk; return true; }
        L -= nlat;
        if (L < nsub) { const int tile = L / nsplit, s = L % nsplit; u.pm = NLAT / BM + tile / nN; u.pn = tile % nN; u.nt = ntk / nsplit; u.k0 = s * (ntk / nsplit) * BK; u.e = -2 - s; return true; }
        return false;
    }
};
struct RowIdent { static constexpr bool IDENT = true;
                  __device__ __forceinline__ unsigned base(const UnitX& u) const { return (unsigned)(u.pm * BM); }
                  __device__ __forceinline__ unsigned row(const UnitX&, int r) const { return (unsigned)r; } };
struct EpiResidX {
    static constexpr bool PERM = false, AFTER_DRAIN = false;
    const float* lat_src; float* lat_dst; const float* gate; float* part; float oscale;
    __device__ __forceinline__ void operator()(const f32x4 (&acc)[2][2][4][2], const UnitX& u, int wr, int wc, int fr, int fq) const {
        const int rowt = u.pm * BM, col0 = u.pn * BM + wc * 32 + 4 * fq;
        if (u.e <= -2) {
            float* pp = part + (size_t)(-2 - u.e) * NCTX * D; const int row0 = rowt - NLAT + wr * 64 + fr;
#pragma unroll
            for (int ai = 0; ai < 2; ++ai)
#pragma unroll
                for (int m = 0; m < 4; ++m) { const size_t off = (size_t)(row0 + ai * HALF + m * 16) * D + col0;
#pragma unroll
                    for (int bj = 0; bj < 2; ++bj)
#pragma unroll
                        for (int n = 0; n < 2; ++n) *(f32x4*)(pp + off + bj * HALF + n * 16) = acc[ai][bj][m][n] * oscale; }
            return; }
        const int c = rowt < SEQ ? 0 : 1; const float* gv = gate + (size_t)c * 6 * D; const int row0 = rowt + wr * 64 + fr;
        f32x4 g[2][2];
#pragma unroll
        for (int bj = 0; bj < 2; ++bj)
#pragma unroll
            for (int n = 0; n < 2; ++n) g[bj][n] = *(const f32x4*)(gv + col0 + bj * HALF + n * 16) * oscale;
#pragma unroll
        for (int ai = 0; ai < 2; ++ai)
#pragma unroll
            for (int m = 0; m < 4; ++m) { const size_t off = (size_t)(row0 + ai * HALF + m * 16) * D + col0;
#pragma unroll
                for (int bj = 0; bj < 2; ++bj)
#pragma unroll
                    for (int n = 0; n < 2; ++n) { const f32x4 s = *(const f32x4*)(lat_src + off + bj * HALF + n * 16); *(f32x4*)(lat_dst + off + bj * HALF + n * 16) = s + g[bj][n] * acc[ai][bj][m][n]; } }
    }
};

struct StaticOrderX {
    int nM, nN, nwg, G, c, ntk;
    __device__ __forceinline__ void init(int M, int N, int K, int G_, int c_) { nM = M / BM; nN = N / BM; nwg = nM * nN; G = G_; c = c_; ntk = K / BK; }
    __device__ __forceinline__ bool next(int i, UnitX& u) const {
        const long L = (long)i * G + c; if (L >= nwg) return false;
        int wgid = (int)L; { const int q = nwg / NXCD, r = nwg % NXCD, xcd = wgid % NXCD, off = wgid / NXCD; wgid = (xcd < r ? xcd * (q + 1) : r * (q + 1) + (xcd - r) * q) + off; }
        const int nig = WGM * nN, gid = wgid / nig, fm = gid * WGM, gsz = (nM - fm) < WGM ? (nM - fm) : WGM;
        u.pm = fm + ((wgid % nig) % gsz); u.pn = (wgid % nig) / gsz; u.e = -1; u.nrows = 0; u.k0 = 0; u.nt = ntk; return true;
    }
};
template <int ACT> struct EpiBf16X {
    static constexpr bool PERM = true, AFTER_DRAIN = false;
    bf16_t* O; int ldc; const float* bias; float oscale;
    __device__ __forceinline__ void operator()(const f32x4 (&acc)[2][2][4][2], const UnitX& u, int wr, int wc, int fr, int fq) const {
        const int row0 = u.pm * BM + wr * 64 + fr, col0 = u.pn * BM + wc * 32 + 8 * fq;
        f32x4 bv[2][2];
#pragma unroll
        for (int bj = 0; bj < 2; ++bj)
#pragma unroll
            for (int n = 0; n < 2; ++n) bv[bj][n] = bias ? *(const f32x4*)(bias + col0 + bj * HALF + 4 * n) : (f32x4){0.f, 0.f, 0.f, 0.f};
#pragma unroll
        for (int ai = 0; ai < 2; ++ai)
#pragma unroll
            for (int m = 0; m < 4; ++m) { bf16_t* rowp = O + (size_t)(row0 + ai * HALF + m * 16) * ldc + col0;
#pragma unroll
                for (int bj = 0; bj < 2; ++bj) { f32x4 v0 = acc[ai][bj][m][0] * oscale + bv[bj][0], v1 = acc[ai][bj][m][1] * oscale + bv[bj][1];
                    if (ACT == 1) { f32x2 a = gelu_pk((f32x2){v0[0], v0[1]}), b = gelu_pk((f32x2){v0[2], v0[3]}), c = gelu_pk((f32x2){v1[0], v1[1]}), d = gelu_pk((f32x2){v1[2], v1[3]});
                        v0 = (f32x4){a.x, a.y, b.x, b.y}; v1 = (f32x4){c.x, c.y, d.x, d.y}; }
                    u32x4 w; w.x = cvt_pk_bf16(v0[0], v0[1]); w.y = cvt_pk_bf16(v0[2], v0[3]); w.z = cvt_pk_bf16(v1[0], v1[1]); w.w = cvt_pk_bf16(v1[2], v1[3]);
                    *(u32x4*)(rowp + bj * HALF) = w; } }
    }
};
}

#ifndef PG8_SP2
#define PG8_SP2 true
#endif
#ifndef PG8_ALIGN
#define PG8_ALIGN true
#endif

#define LAS __attribute__((address_space(3)))
typedef unsigned short bf16_t;
typedef float f32x4 __attribute__((ext_vector_type(4)));
typedef unsigned u32x4 __attribute__((ext_vector_type(4)));
typedef unsigned u32x2 __attribute__((ext_vector_type(2)));

constexpr size_t MiB = 1u << 20;
constexpr size_t WS_CTL = 0, CTL_ZERO_BYTES = 1 * MiB;
constexpr size_t WS_MODS = 1 * MiB;
constexpr size_t WS_RPART = 3 * MiB;
constexpr size_t WS_WR = 4 * MiB;
constexpr size_t WS_RB = 16 * MiB;
constexpr size_t WS_RSTDV = 16 * MiB + 65536;
constexpr size_t WS_GATES = 17 * MiB;
constexpr size_t WS_CX = 22 * MiB;
constexpr size_t WS_WIN = 30 * MiB;
constexpr size_t WS_WOUT = WS_WIN + 96 * MiB;
constexpr size_t WS_WGU = WS_WOUT + 32 * MiB;
constexpr size_t WS_WD = WS_WGU + 144 * MiB;
constexpr size_t WS_H = WS_WD + 72 * MiB;
constexpr size_t WS_P = WS_H + 132 * MiB;
constexpr size_t WS_MIX = WS_P + 396 * MiB;
constexpr size_t WS_UT = WS_MIX + 132 * MiB;
constexpr size_t WS_FILT = WS_UT + 384 * MiB;
constexpr size_t WS_FILTC = WS_FILT + 256 * MiB;
constexpr size_t WS_Z2T = WS_FILTC + 8 * MiB;
constexpr size_t WS_END = WS_Z2T + 128 * MiB;
constexpr size_t WS_WSET2 = WS_END;
constexpr size_t WSET_BYTES = 344 * MiB;
constexpr size_t WS_PART = WS_WSET2 + WSET_BYTES;
constexpr size_t WS_ELIST = WS_PART + 64 * MiB;
constexpr size_t WS_H8E = WS_ELIST + 5 * MiB;
constexpr size_t WS_END2 = WS_H8E + 66 * MiB;
constexpr int CW_BAR = 4096;
constexpr int CW_ECNT = 8192;
constexpr int CW_WQ = 8704;
constexpr int CW_ARR = 8768;
constexpr int TAB_OFF = 131072;

constexpr int LDS_BYTES = 147456;
constexpr int MISC_OFF = 147200;

#define XB_TMO      128
#define XB_XCNT(j)  (256  + 64 * (j))
#define XB_XSUB(j)  (1280 + 64 * (j))
#define XB_XGEN(j)  (2304 + 64 * (j))
#define XB_TOP      3328
#define XB_TOPGEN   3392
#define XCD_BAR_WORDS 3456
#define XB_SPIN_CAP (1u << 21)

__device__ __forceinline__ unsigned xb_ld(unsigned* p)              { return __hip_atomic_load(p, __ATOMIC_RELAXED, __HIP_MEMORY_SCOPE_AGENT); }
__device__ __forceinline__ unsigned xb_add(unsigned* p, unsigned v) { return __hip_atomic_fetch_add(p, v, __ATOMIC_RELAXED, __HIP_MEMORY_SCOPE_AGENT); }
__device__ __forceinline__ unsigned xb_xcc_id() { return (unsigned)__builtin_amdgcn_s_getreg((3 << 11) | 20) & 0xFu; }
#define XB_SPIN(cond, bar) do { unsigned _sp = 0; while (cond) { __builtin_amdgcn_s_sleep(1); \
    if ((++_sp & 255u) == 0u) { if (xb_ld(&(bar)[XB_TMO])) break; if (_sp > XB_SPIN_CAP) { atomicAdd(&(bar)[XB_TMO], 1u); break; } } } } while (0)

struct XcdBarrier { unsigned* bar; unsigned x; volatile LAS unsigned* st; };

__device__ __forceinline__ XcdBarrier xcd_barrier_post(unsigned* bar, volatile LAS unsigned* st) {
    XcdBarrier b; b.bar = bar; b.x = xb_xcc_id(); b.st = st;
    if (threadIdx.x == 0) (void)xb_add(&bar[XB_XCNT(b.x)], 1u);
    return b;
}
__device__ __forceinline__ void xcd_barrier_complete(unsigned* bar, unsigned x, unsigned& nloc, unsigned& nx) {
    const unsigned G = gridDim.x * gridDim.y * gridDim.z;
    unsigned sum, cnt, mine, sp = 0u;
    for (;;) {
        sum = 0u; cnt = 0u; mine = 0u;
#pragma unroll
        for (unsigned j = 0; j < 16; ++j) { const unsigned c = xb_ld(&bar[XB_XCNT(j)]); sum += c; cnt += (c > 0u) ? 1u : 0u; mine = (j == x) ? c : mine; }
        if (sum == G) break;
        __builtin_amdgcn_s_sleep(1);
        if ((++sp & 255u) == 0u) { if (xb_ld(&bar[XB_TMO])) break; if (sp > XB_SPIN_CAP) { atomicAdd(&bar[XB_TMO], 1u); break; } }
    }
    nloc = mine > 0u ? mine : 1u; nx = cnt > 0u ? cnt : 1u;
}
__device__ __forceinline__ void xcd_barrier(const XcdBarrier& b) {
    asm volatile("s_waitcnt vmcnt(0)" ::: "memory");
    __syncthreads();
    if (threadIdx.x == 0) {
        unsigned* bar = b.bar;
        __builtin_amdgcn_s_waitcnt(0);
        unsigned nloc = b.st[0], nx = b.st[1];
        if (nloc == 0u) { xcd_barrier_complete(bar, b.x, nloc, nx); b.st[0] = nloc; b.st[1] = nx; }
        const unsigned old = xb_add(&bar[XB_XSUB(b.x)], 1u);
        const unsigned gen = old / nloc;
        if (old + 1u == (gen + 1u) * nloc) {
            __builtin_amdgcn_fence(__ATOMIC_RELEASE, "agent");
            asm volatile("s_waitcnt vmcnt(0)" ::: "memory");
            const unsigned og = xb_add(&bar[XB_TOP], 1u);
            const unsigned tg = og / nx;
            if (og + 1u == (tg + 1u) * nx) xb_add(&bar[XB_TOPGEN], 1u);
            else XB_SPIN(xb_ld(&bar[XB_TOPGEN]) == tg, bar);
            __builtin_amdgcn_fence(__ATOMIC_ACQUIRE, "agent");
            xb_add(&bar[XB_XGEN(b.x)], 1u);
            asm volatile("s_waitcnt vmcnt(0)" ::: "memory");
        } else {
            XB_SPIN(xb_ld(&bar[XB_XGEN(b.x)]) == gen, bar);
            __builtin_amdgcn_fence(__ATOMIC_ACQUIRE, "agent");
            asm volatile("s_waitcnt vmcnt(0)" ::: "memory");
        }
    }
    __syncthreads();
}

struct Args { const float* in[38]; float* out; unsigned char* ws; int ph_lo, ph_hi; };
enum { I_X = 0, I_C, I_CTX, I_CCTX, I_ADA_A, I_ADA_B, I_ADA_BIAS, I_NORM_MIX, I_NORM_FFN, I_EVEN_WIN, I_QGAIN, I_KGAIN, I_RPB, I_HY_CW, I_HY_CB,
       I_HY_W1, I_HY_B1, I_HY_W2, I_HY_B2, I_HY_W3, I_HY_B3, I_HY_W4, I_HY_FREQ, I_HY_SKIP, I_ODD_WIN, I_ODD_BIN, I_GM_VGAIN, I_GM_WS, I_GM_BS, I_WOUT,
       I_ROUTER, I_MOE_BIAS, I_MOE_WG, I_MOE_WU, I_MOE_WD, I_SH_WG, I_SH_WU, I_SH_WD };

struct Frame { LAS unsigned char* lds; int tid, lane, wave, G, gw, NGW; };

#define LDS_WAIT() asm volatile("s_waitcnt lgkmcnt(0)" ::: "memory")
__device__ __forceinline__ int opaque_zero() { int z; asm volatile("s_mov_b32 %0, 0" : "=s"(z)); return z; }
#define INP(i) (a.in[(i) + Z])
#define WSB(off) (a.ws + ((size_t)(off) + (size_t)Z))
#define AOUT (a.out + (size_t)Z)
#define WSETP(off, l_) ((bf16_t*)(a.ws + (((l_) & 1) ? (WS_WSET2 + ((off) - WS_WIN)) : (off)) + (size_t)Z))
__device__ __forceinline__ unsigned f2bf(float f) { unsigned u = __builtin_bit_cast(unsigned, f); return (u + 0x7fffu + ((u >> 16) & 1u)) >> 16; }
__device__ __forceinline__ unsigned pk2(float lo, float hi) { return f2bf(lo) | (f2bf(hi) << 16); }
__device__ __forceinline__ float sat8(float v) { return __builtin_amdgcn_fmed3f(v, -448.f, 448.f); }
__device__ __forceinline__ unsigned pk4f8(float a0, float a1, float a2, float a3) { a0 = sat8(a0); a1 = sat8(a1); a2 = sat8(a2); a3 = sat8(a3); int w = __builtin_amdgcn_cvt_pk_fp8_f32(a0, a1, 0, false); w = __builtin_amdgcn_cvt_pk_fp8_f32(a2, a3, w, true); return (unsigned)w; }
__device__ __forceinline__ float bflo(unsigned u) { return __builtin_bit_cast(float, u << 16); }
__device__ __forceinline__ float bfhi(unsigned u) { return __builtin_bit_cast(float, u & 0xffff0000u); }
__device__ __forceinline__ float bf2f(bf16_t b) { return __builtin_bit_cast(float, ((unsigned)b) << 16); }
__device__ __forceinline__ float wave_sum(float v) {
#pragma unroll
    for (int o = 1; o < 64; o <<= 1) v += __shfl_xor(v, o);
    return v;
}
__device__ __forceinline__ float wave_max(float v) {
#pragma unroll
    for (int o = 1; o < 64; o <<= 1) v = fmaxf(v, __shfl_xor(v, o));
    return v;
}
__device__ __forceinline__ float* MODSP_(unsigned char* wsz, int l, int c, int i) { return (float*)(wsz + WS_MODS) + ((size_t)(l * 3 + c) * 6 + i) * D; }
#define MODSP(a_, l_, c_, i_) MODSP_(WSB(0), l_, c_, i_)

__device__ __forceinline__ void ph_mods1(const Args& a, const Frame& F) {
    const int Z = opaque_zero();
    LAS float* red = (LAS float*)F.lds;
    const float* c = INP(I_C); const float* cc = INP(I_CCTX); const float* A = INP(I_ADA_A);
    float* rpart = (float*)WSB(WS_RPART);
    for (int it = blockIdx.x; it < 4 * 64; it += F.G) {
        const int l = it >> 6, kc = it & 63, j = F.tid & 255, half = F.tid >> 8, k0 = kc * 64 + half * 32;
        float s0 = 0.f, s1 = 0.f, s2 = 0.f;
        const float* Ap = A + ((size_t)l * D + k0) * RANK + j;
        for (int k = 0; k < 32; ++k) {
            const float w = Ap[(size_t)k * RANK]; const float x0 = c[k0 + k], x1 = c[D + k0 + k], x2 = cc[k0 + k];
            s0 += x0 / (1.f + expf(-x0)) * w; s1 += x1 / (1.f + expf(-x1)) * w; s2 += x2 / (1.f + expf(-x2)) * w;
        }
        if (half == 1) { red[j] = s0; red[256 + j] = s1; red[512 + j] = s2; }
        __syncthreads();
        if (half == 0) { float* o = rpart + (size_t)(l * 64 + kc) * 768; o[j] = s0 + red[j]; o[256 + j] = s1 + red[256 + j]; o[512 + j] = s2 + red[512 + j]; }
        __syncthreads();
    }
}
__device__ __forceinline__ void ph_mods2(const Args& a, const Frame& F) {
    const int Z = opaque_zero();
    LAS float* r = (LAS float*)F.lds;
    const float* rpart = (const float*)WSB(WS_RPART); const float* B = INP(I_ADA_B); const float* bias = INP(I_ADA_BIAS);
    for (int it = blockIdx.x; it < 4 * 48; it += F.G) {
        const int l = it / 48, nc = it % 48;
        for (int idx = F.tid; idx < 768; idx += 512) { float s = 0.f; for (int kc = 0; kc < 64; ++kc) s += rpart[(size_t)(l * 64 + kc) * 768 + idx]; r[idx] = s; }
        __syncthreads();
        const int n = nc * 512 + F.tid; const float* Bp = B + (size_t)l * RANK * 24576 + n;
        float s0 = bias[l * 24576 + n], s1 = s0, s2 = s0;
        for (int j = 0; j < RANK; ++j) { const float w = Bp[(size_t)j * 24576]; s0 += r[j] * w; s1 += r[256 + j] * w; s2 += r[512 + j] * w; }
        float* M = (float*)WSB(WS_MODS);
        M[(size_t)(l * 3 + 0) * 24576 + n] = s0; M[(size_t)(l * 3 + 1) * 24576 + n] = s1; M[(size_t)(l * 3 + 2) * 24576 + n] = s2;
        __syncthreads();
    }
}
__device__ __forceinline__ void ph_rprep(const Args& a, const Frame& F) {
    const int Z = opaque_zero();
    LAS float* tile = (LAS float*)F.lds;
    bf16_t* WRH = (bf16_t*)WSB(WS_WR); bf16_t* WRL = WRH + (size_t)4 * 3 * NE * D; float* RB = (float*)WSB(WS_RB);
    for (int it = blockIdx.x; it < 4 * 64; it += F.G) {
        const int l = it >> 6, kc = it & 63, k0 = kc * 64;
        const float* Wr = INP(I_ROUTER) + ((size_t)l * D + k0) * NE;
        for (int idx = F.tid; idx < 4096; idx += 512) tile[(idx >> 6) * 65 + (idx & 63)] = Wr[idx];
        __syncthreads();
        const float* g = INP(I_NORM_FFN) + (size_t)l * D;
        for (int c = 0; c < 3; ++c) {
            const float* sc = MODSP(a, l, c, 4); const size_t ob = (size_t)(l * 3 + c) * NE * D;
            for (int idx = F.tid; idx < 4096; idx += 512) { const int e = idx >> 6, kk = idx & 63, k = k0 + kk; const float v = tile[kk * 65 + e] * (g[k] * (1.f + sc[k]));
                const unsigned hb = __builtin_bit_cast(unsigned, v) & 0xffff0000u; const float lo = v - __builtin_bit_cast(float, hb);
                WRH[ob + (size_t)e * D + k] = (bf16_t)(hb >> 16); WRL[ob + (size_t)e * D + k] = (bf16_t)f2bf(lo); }
        }
        __syncthreads();
    }
    for (int task = F.gw; task < 4 * 3 * NE; task += F.NGW) {
        const int l = task / 192, c = (task / 64) % 3, e = task & 63;
        const float* sh = MODSP(a, l, c, 3); const float* Wr = INP(I_ROUTER) + (size_t)l * D * NE + e; float s = 0.f;
        for (int k = F.lane; k < D; k += 64) s += sh[k] * Wr[(size_t)k * NE];
        s = wave_sum(s); if (F.lane == 0) RB[task] = s;
    }
}

__device__ __forceinline__ void transpose_item(const float* W, int N, bf16_t* WT, int ldk, int row_off, int row_mul, int koff, LAS float* scr, int item, int lane) {
    const int nblk = N / 32, kb = item / nblk, nb = item % nblk, k0 = 64 * kb, n0 = 32 * nb;
#pragma unroll 8
    for (int i = 0; i < 32; ++i) { const int kk = 2 * i + (lane >> 5); scr[kk * 33 + (lane & 31)] = W[(size_t)(k0 + kk) * N + n0 + (lane & 31)]; }
    LDS_WAIT();
    const int c = lane & 7;
#pragma unroll
    for (int j = 0; j < 4; ++j) { const int n = (lane >> 3) + 8 * j; const LAS float* s = scr + (8 * c) * 33 + n;
        u32x4 o; o.x = pk2(s[0 * 33], s[1 * 33]); o.y = pk2(s[2 * 33], s[3 * 33]); o.z = pk2(s[4 * 33], s[5 * 33]); o.w = pk2(s[6 * 33], s[7 * 33]);
        *(u32x4*)(WT + (size_t)(row_off + (n0 + n) * row_mul) * ldk + koff + k0 + 8 * c) = o; }
    LDS_WAIT();
}
__device__ __forceinline__ void transpose_item_f8(const float* W, int N, unsigned char* WT, int ldk, int row_off, int row_mul, int koff, float scale, LAS float* scr, int item, int lane) {
    const int nblk = N / 32, kb = item / nblk, nb = item % nblk, k0 = 64 * kb, n0 = 32 * nb;
#pragma unroll 8
    for (int i = 0; i < 32; ++i) { const int kk = 2 * i + (lane >> 5); scr[kk * 33 + (lane & 31)] = W[(size_t)(k0 + kk) * N + n0 + (lane & 31)]; }
    LDS_WAIT();
    const int c = lane & 7;
#pragma unroll
    for (int j = 0; j < 4; ++j) { const int n = (lane >> 3) + 8 * j; const LAS float* s = scr + (8 * c) * 33 + n;
        int lo = __builtin_amdgcn_cvt_pk_fp8_f32(s[0 * 33] * scale, s[1 * 33] * scale, 0, false); lo = __builtin_amdgcn_cvt_pk_fp8_f32(s[2 * 33] * scale, s[3 * 33] * scale, lo, true);
        int hi = __builtin_amdgcn_cvt_pk_fp8_f32(s[4 * 33] * scale, s[5 * 33] * scale, 0, false); hi = __builtin_amdgcn_cvt_pk_fp8_f32(s[6 * 33] * scale, s[7 * 33] * scale, hi, true);
        u32x2 o; o.x = (unsigned)lo; o.y = (unsigned)hi;
        *(u32x2*)(WT + (size_t)(row_off + (n0 + n) * row_mul) * ldk + koff + k0 + 8 * c) = o; }
    LDS_WAIT();
}
constexpr float WD_SCALE = 16.f, WGU_SCALE = 64.f;
__device__ __forceinline__ void conv_mat(const Frame& F, const float* W, int K, int N, bf16_t* WT, int ldk, int row_off, int row_mul, int koff, LAS float* scr) {
    const int nitems = (K / 64) * (N / 32);
    for (int it = F.gw; it < nitems; it += F.NGW) transpose_item(W, N, WT, ldk, row_off, row_mul, koff, scr, it, F.lane);
}
constexpr int WQ_CHUNK = 8;
__device__ __forceinline__ int wq_nitems(int lt) { return (((lt & 1) == 0) ? 24576 : 16384) + 8192 + 16384 + 16384 + 2048 + 2048 + 16384 + 2048; }
__device__ __forceinline__ void wq_item(const Args& a, const Frame& F, int lt, int item, LAS float* scr, int Z) {
    const int j = lt >> 1; const int n0 = ((lt & 1) == 0) ? 24576 : 16384;
    bf16_t* WIN = WSETP(WS_WIN, lt); bf16_t* WOUT = WSETP(WS_WOUT, lt); bf16_t* WGU = WSETP(WS_WGU, lt); bf16_t* WD = WSETP(WS_WD, lt);
    int it = item;
    if (it < n0) { if ((lt & 1) == 0) { if ((it % (EVEN_IN / 32)) * 32 < 6144) transpose_item_f8(INP(I_EVEN_WIN) + (size_t)j * D * EVEN_IN, EVEN_IN, (unsigned char*)WIN, D, 0, 1, 0, WGU_SCALE, scr, it, F.lane);
                                        else transpose_item(INP(I_EVEN_WIN) + (size_t)j * D * EVEN_IN, EVEN_IN, WIN, D, 0, 1, 0, scr, it, F.lane); }
                   else transpose_item_f8(INP(I_ODD_WIN) + (size_t)j * D * ODD_IN, ODD_IN, (unsigned char*)WIN, D, 0, 1, 0, WGU_SCALE, scr, it, F.lane); return; }
    it -= n0;
    if (it < 8192) { if (lt & 1) transpose_item_f8(INP(I_WOUT) + (size_t)lt * D * D, D, (unsigned char*)WOUT, D, 0, 1, 0, WGU_SCALE, scr, it, F.lane);
                     else transpose_item(INP(I_WOUT) + (size_t)lt * D * D, D, WOUT, D, 0, 1, 0, scr, it, F.lane); return; }
    it -= 8192;
    if (it < 16384) { const int e = it >> 8, li = it & 255; transpose_item_f8(INP(I_MOE_WG) + ((size_t)lt * NE + e) * D * ED, ED, (unsigned char*)WGU, D, e * 256, 2, 0, WGU_SCALE, scr, li, F.lane); return; }
    it -= 16384;
    if (it < 16384) { const int e = it >> 8, li = it & 255; transpose_item_f8(INP(I_MOE_WU) + ((size_t)lt * NE + e) * D * ED, ED, (unsigned char*)WGU, D, e * 256 + 1, 2, 0, WGU_SCALE, scr, li, F.lane); return; }
    it -= 16384;
    if (it < 2048) { transpose_item_f8(INP(I_SH_WG) + (size_t)lt * D * SHD, SHD, (unsigned char*)WGU, D, NE * 256, 2, 0, WGU_SCALE, scr, it, F.lane); return; }
    it -= 2048;
    if (it < 2048) { transpose_item_f8(INP(I_SH_WU) + (size_t)lt * D * SHD, SHD, (unsigned char*)WGU, D, NE * 256 + 1, 2, 0, WGU_SCALE, scr, it, F.lane); return; }
    it -= 2048;
    if (it < 16384) { const int e = it >> 8, li = it & 255; transpose_item_f8(INP(I_MOE_WD) + ((size_t)lt * NE + e) * ED * D, D, (unsigned char*)WD, DN_K, 0, 1, e * ED, WD_SCALE, scr, li, F.lane); return; }
    it -= 16384;
    transpose_item_f8(INP(I_SH_WD) + (size_t)lt * SHD * D, D, (unsigned char*)WD, DN_K, 0, 1, NE * ED, WD_SCALE, scr, it, F.lane);
}
__device__ __forceinline__ void wq_pull(const Args& a, const Frame& F, int lt, int arr_word) {
    const int Z = opaque_zero();
    unsigned* ctl = (unsigned*)WSB(WS_CTL);
    volatile LAS unsigned* MISC = (volatile LAS unsigned*)(F.lds + MISC_OFF);
    LAS float* scr = (LAS float*)(F.lds + F.wave * 16384);
    const int nchunks = wq_nitems(lt) / WQ_CHUNK;
    __syncthreads();
    if (arr_word >= 0 && F.tid == 0) __hip_atomic_fetch_add(ctl + arr_word, 1u, __ATOMIC_RELAXED, __HIP_MEMORY_SCOPE_AGENT);
    for (;;) {
        if (F.tid == 0) {
            unsigned c = 0xffffffffu;
            const bool go = (arr_word < 0) || (__hip_atomic_load(ctl + arr_word, __ATOMIC_RELAXED, __HIP_MEMORY_SCOPE_AGENT) < (unsigned)F.G);
            if (go) c = __hip_atomic_fetch_add(ctl + CW_WQ + lt, 1u, __ATOMIC_RELAXED, __HIP_MEMORY_SCOPE_AGENT);
            MISC[16] = c;
        }
        __syncthreads();
        const unsigned c = MISC[16];
        __syncthreads();
        if (c >= (unsigned)nchunks) break;
#pragma unroll 1
        for (int q = 0; q < WQ_CHUNK / 8; ++q) wq_item(a, F, lt, (int)c * WQ_CHUNK + F.wave * (WQ_CHUNK / 8) + q, scr, Z);
    }
}

__device__ __forceinline__ void ph_norm(const Args& a, const Frame& F, int l, int which, int gw0, int ngw, bool zero_hall = false) {
    const int Z = opaque_zero();
    bf16_t* HA = (bf16_t*)WSB(WS_P); unsigned char* H8E = (unsigned char*)WSB(WS_H8E);
    const int M = which ? ((l >= 2) ? NLAT : T) : ((l == 3) ? NLAT : T);
    const float* lat_src = (l == 0 && which == 0) ? INP(I_X) : AOUT;
    const float* cx_src = (l == 0 && which == 0) ? INP(I_CTX) : (const float*)WSB(WS_CX);
    const float* g = (which ? INP(I_NORM_FFN) : INP(I_NORM_MIX)) + (size_t)l * D;
    bf16_t* H = (bf16_t*)WSB(WS_H);
    for (int row = gw0; row < M; row += ngw) {
        const float* src = row < NLAT ? lat_src + (size_t)row * D : cx_src + (size_t)(row - NLAT) * D;
        const int c = row < SEQ ? 0 : (row < NLAT ? 1 : 2);
        const float* sh = MODSP(a, l, c, which ? 3 : 0); const float* sc = MODSP(a, l, c, which ? 4 : 1);
        f32x4 v[16]; float ss = 0.f;
#pragma unroll
        for (int j = 0; j < 16; ++j) { v[j] = ((const f32x4*)src)[F.lane + 64 * j]; ss += (v[j].x * v[j].x + v[j].y * v[j].y) + (v[j].z * v[j].z + v[j].w * v[j].w); }
        ss = wave_sum(ss);
        const float rstd = 1.0f / sqrtf(ss * (1.0f / D) + EPS);
        u32x2* o = (u32x2*)(H + (size_t)row * D);
#pragma unroll
        for (int j = 0; j < 16; ++j) { const int idx = F.lane + 64 * j; const f32x4 gg = ((const f32x4*)g)[idx], s1 = ((const f32x4*)sc)[idx], s0 = ((const f32x4*)sh)[idx];
            const f32x4 y = (v[j] * rstd) * gg; const f32x4 hh = y * (1.f + s1) + s0;
            if (which || (l & 1)) { ((unsigned*)((unsigned char*)H + (size_t)row * D))[idx] = pk4f8(hh.x, hh.y, hh.z, hh.w); }
            else { ((unsigned*)(H8E + (size_t)row * D))[idx] = pk4f8(hh.x, hh.y, hh.z, hh.w);
                   u32x2 w; w.x = pk2(hh.x, hh.y); w.y = pk2(hh.z, hh.w); o[idx] = w; } }
        if (zero_hall) { u32x4* hr = (u32x4*)((unsigned char*)HA + (size_t)row * DN_K); const u32x4 z4 = (u32x4){0u, 0u, 0u, 0u};
#pragma unroll
            for (int q = 0; q < 8; ++q) hr[F.lane + 64 * q] = z4; }
    }
}

__device__ __forceinline__ void ph_e1(const Args& a, const Frame& F, int l, bool do_a = true) {
    const int Z = opaque_zero();
    const int j2 = l >> 1;
    bf16_t* P = (bf16_t*)WSB(WS_P);
    const float* qg = INP(I_QGAIN) + j2 * 128; const float* kg = INP(I_KGAIN) + j2 * 128;
    if (do_a) for (int row = F.gw; row < T; row += F.NGW) {
        u32x4* pr = (u32x4*)(P + (size_t)row * EVEN_IN);
#pragma unroll
        for (int j = 0; j < 8; ++j) {
            const int chunk = F.lane + 64 * j; const u32x4 raw = pr[chunk];
            float x[8] = { bflo(raw.x), bfhi(raw.x), bflo(raw.y), bfhi(raw.y), bflo(raw.z), bfhi(raw.z), bflo(raw.w), bfhi(raw.w) };
            float ss = 0.f;
#pragma unroll
            for (int i = 0; i < 8; ++i) ss += x[i] * x[i];
            ss += __shfl_xor(ss, 1); ss += __shfl_xor(ss, 2); ss += __shfl_xor(ss, 4); ss += __shfl_xor(ss, 8);
            const float rstd = 1.0f / sqrtf(ss * (1.0f / 128.f) + EPS);
            const float* gp = (j < 4 ? qg : kg) + (chunk & 15) * 8;
            u32x4 o; o.x = pk2(x[0] * rstd * gp[0], x[1] * rstd * gp[1]); o.y = pk2(x[2] * rstd * gp[2], x[3] * rstd * gp[3]);
            o.z = pk2(x[4] * rstd * gp[4], x[5] * rstd * gp[5]); o.w = pk2(x[6] * rstd * gp[6], x[7] * rstd * gp[7]);
            pr[chunk] = o;
        }
    }
    LAS float* Q = (LAS float*)F.lds;
    const float* cw = INP(I_HY_CW) + (size_t)j2 * 3 * 6144; const float* cb = INP(I_HY_CB) + (size_t)j2 * 6144;
    bf16_t* UT = (bf16_t*)WSB(WS_UT); float* Z2T = (float*)WSB(WS_Z2T); typedef float f32x2e __attribute__((ext_vector_type(2)));
    __syncthreads();
    for (int it = blockIdx.x; it < 2 * 128 * 24; it += F.G) {
        const int b = it / (128 * 24), rem = it % (128 * 24), t0 = (rem / 24) * 64, ch0 = (rem % 24) * 256;
        for (int idx = F.tid; idx < 66 * 32; idx += 512) { const int rr = idx >> 5, ck = idx & 31, t = t0 - 1 + rr; u32x4 raw = (u32x4){0u, 0u, 0u, 0u};
            if (t >= 0 && t < SEQ) raw = *(const u32x4*)(P + (size_t)(b * SEQ + t) * EVEN_IN + 6144 + ch0 + 8 * ck);
            LAS float* d = Q + (ck * 66 + rr) * 9; d[0] = bflo(raw.x); d[1] = bfhi(raw.x); d[2] = bflo(raw.y); d[3] = bfhi(raw.y); d[4] = bflo(raw.z); d[5] = bfhi(raw.z); d[6] = bflo(raw.w); d[7] = bfhi(raw.w); }
        __syncthreads();
        for (int idx = F.tid; idx < 256 * 32; idx += 512) { const int ch = idx >> 5, t = (idx & 31) * 2, chg = ch0 + ch; const float w0 = cw[chg], w1 = cw[6144 + chg], w2 = cw[2 * 6144 + chg], bb = cb[chg];
            const LAS float* q = Q + ((ch >> 3) * 66 + t) * 9 + (ch & 7); const float p0 = q[0], p1 = q[9], p2 = q[18], p3 = q[27];
            const float v0 = bb + p0 * w0 + p1 * w1 + p2 * w2, v1 = bb + p1 * w0 + p2 * w1 + p3 * w2;
            if (chg < 4096) *(unsigned*)(UT + ((size_t)b * 4096 + chg) * SEQ + t0 + t) = pk2(v0, v1);
            else { f32x2e o2; o2.x = v0; o2.y = v1; *(f32x2e*)(Z2T + ((size_t)b * 2048 + (chg - 4096)) * SEQ + t0 + t) = o2; } }
        __syncthreads();
    }
}

__device__ __forceinline__ void ph_hyf(const Args& a, const Frame& F, int l) {
    const int Z = opaque_zero();
    const int j2 = l >> 1;
    const float* w1 = INP(I_HY_W1) + (size_t)j2 * 33 * 64; const float* b1 = INP(I_HY_B1) + j2 * 64;
    const float* w2 = INP(I_HY_W2) + (size_t)j2 * 4096; const float* b2 = INP(I_HY_B2) + j2 * 64;
    const float* w3 = INP(I_HY_W3) + (size_t)j2 * 4096; const float* b3 = INP(I_HY_B3) + j2 * 64;
    const float* w4 = INP(I_HY_W4) + (size_t)j2 * 64 * 8192; const float* fq = INP(I_HY_FREQ) + j2 * 192;
    float* FILT = (float*)WSB(WS_FILT); float* FILTC = (float*)WSB(WS_FILTC);
    LAS float* feats = (LAS float*)F.lds; LAS float* ha = feats + 1056; LAS float* hb = ha + 2048; LAS float* hT = hb + 2048; LAS float* tn = hT + 2048;
    const float dstart = -15.350567286626969f, dstop = -3.0701134573253945f, dstep = (dstop - dstart) / 2047.f;
    __syncthreads();
    for (int it = blockIdx.x; it < 256 + 128; it += F.G) {
        const int L = it < 256 ? SEQ : LC, t0 = (it < 256 ? it : ((it - 256) >> 4)) * 32;
        const int i_lo = it < 256 ? 0 : ((it - 256) & 15), i_hi = it < 256 ? 16 : i_lo + 1;
        const float c2pi = (float)(6.283185307179586 / (double)L), invLm1 = 1.0f / (float)(L - 1);
        for (int idx = F.tid; idx < 1056; idx += 512) { const int p = idx / 33, f = idx % 33; const float pos = (float)(t0 + p); float val;
            if (f == 0) { val = pos * invLm1; tn[p] = val; }
            else { const int bi = (f - 1) & 15; const float band = 1e-4f + (float)bi * ((15.f - 1e-4f) / 15.f); const float ang = (c2pi * pos) * band; val = (f <= 16) ? cosf(ang) : -sinf(ang); }
            feats[idx] = val; }
        __syncthreads();
        const int p = F.tid >> 4, ug = F.tid & 15;
#pragma unroll 1
        for (int q = 0; q < 4; ++q) { const int u = ug * 4 + q; float s = b1[u];
#pragma unroll 3
            for (int f = 0; f < 33; ++f) s += feats[p * 33 + f] * w1[f * 64 + u];
            ha[p * 64 + u] = sinf(fq[u] * s); }
        __syncthreads();
#pragma unroll 1
        for (int q = 0; q < 4; ++q) { const int u = ug * 4 + q; float s = b2[u];
#pragma unroll 4
            for (int m = 0; m < 64; ++m) s += ha[p * 64 + m] * w2[m * 64 + u];
            hb[p * 64 + u] = sinf(fq[64 + u] * s); }
        __syncthreads();
#pragma unroll 1
        for (int q = 0; q < 4; ++q) { const int u = ug * 4 + q; float s = b3[u];
#pragma unroll 4
            for (int m = 0; m < 64; ++m) s += hb[p * 64 + m] * w3[m * 64 + u];
            hT[(u >> 2) * 128 + (p >> 4) * 64 + (u & 3) * 16 + (p & 15)] = sinf(fq[128 + u] * s); }
        __syncthreads();
        {   const int j = F.lane & 15, kq = F.lane >> 4; const int cb_lo = i_lo * 32, cb_hi = i_hi * 32;
            const float rstep = -invLm1;
            float bvn[16];
            { const float* wp = w4 + (size_t)kq * 8192 + (cb_lo + F.wave) * 16 + j;
#pragma unroll
              for (int sk = 0; sk < 16; ++sk) bvn[sk] = wp[(size_t)sk * 4 * 8192]; }
#pragma unroll 1
            for (int cb = cb_lo + F.wave; cb < cb_hi; cb += 8) {
                const int n = cb * 16 + j;
                float bv[16];
#pragma unroll
                for (int sk = 0; sk < 16; ++sk) bv[sk] = bvn[sk];
                if (cb + 8 < cb_hi) { const float* wp = w4 + (size_t)kq * 8192 + (cb + 8) * 16 + j;
#pragma unroll
                    for (int sk = 0; sk < 16; ++sk) bvn[sk] = wp[(size_t)sk * 4 * 8192]; }
                f32x4 acc0 = (f32x4){0.f, 0.f, 0.f, 0.f}, acc1 = (f32x4){0.f, 0.f, 0.f, 0.f};
#pragma unroll
                for (int sk = 0; sk < 16; ++sk) { const float a0 = hT[sk * 128 + F.lane], a1 = hT[sk * 128 + 64 + F.lane];
                    acc0 = __builtin_amdgcn_mfma_f32_16x16x4f32(a0, bv[sk], acc0, 0, 0, 0); acc1 = __builtin_amdgcn_mfma_f32_16x16x4f32(a1, bv[sk], acc1, 0, 0, 0); }
                const int dir = n >> 12, o = (n >> 11) & 1, c = n & 2047; const float delta = fabsf(dstart + (float)c * dstep);
                const float ratio = expf(rstep * delta), e0 = expf(-tn[4 * kq] * delta), e1 = expf(-tn[16 + 4 * kq] * delta);
                float* dst = (L == SEQ) ? FILT + (((size_t)(c * 2 + o) * 2 + dir) * SEQ + t0) : FILTC + (((size_t)(c * 2 + o) * 2 + dir) * LC + t0);
                f32x4 v0, v1; float d0 = e0, d1 = e1;
                v0.x = acc0.x * d0; v1.x = acc1.x * d1; d0 *= ratio; d1 *= ratio; v0.y = acc0.y * d0; v1.y = acc1.y * d1; d0 *= ratio; d1 *= ratio;
                v0.z = acc0.z * d0; v1.z = acc1.z * d1; d0 *= ratio; d1 *= ratio; v0.w = acc0.w * d0; v1.w = acc1.w * d1;
                *(f32x4*)(dst + 4 * kq) = v0; *(f32x4*)(dst + 16 + 4 * kq) = v1;
            }
        }
        __syncthreads();
    }
}

typedef short bf16x8v __attribute__((ext_vector_type(8)));
#define GAS __attribute__((address_space(1)))
typedef const GAS char* gcp_t;
__device__ __forceinline__ float xmax16_32(float v) {
    const unsigned u = __builtin_bit_cast(unsigned, v);
    const auto r = __builtin_amdgcn_permlane32_swap(u, u, false, false);
    unsigned a0 = r[0], a1 = r[1]; asm volatile("" : "+v"(a0), "+v"(a1));
    const float m = fmaxf(__builtin_bit_cast(float, a0), __builtin_bit_cast(float, a1));
    const unsigned um = __builtin_bit_cast(unsigned, m);
    const auto r2 = __builtin_amdgcn_permlane16_swap(um, um, false, false);
    unsigned b0 = r2[0], b1 = r2[1]; asm volatile("" : "+v"(b0), "+v"(b1));
    return fmaxf(__builtin_bit_cast(float, b0), __builtin_bit_cast(float, b1));
}
__device__ __forceinline__ void ph_attn(const Args& a, const Frame& F, int l) {
    const int Z = opaque_zero();
    const int j2 = l >> 1;
    const bf16_t* P = (const bf16_t*)WSB(WS_P); bf16_t* MIX = (bf16_t*)WSB(WS_MIX);
    const int wv = __builtin_amdgcn_readfirstlane(F.wave);
    LAS unsigned char* KT = F.lds;
    LAS unsigned char* VT = F.lds + 32768;
    LAS float* rp = (LAS float*)(F.lds + 65536);
    const unsigned vt_addr = (unsigned)(size_t)VT;
    const int j = F.lane & 15, kq = F.lane >> 4;
    const float qscale = 0.08838834764831845f * 1.4426950408889634f;
    const unsigned koff = (unsigned)((j * EVEN_IN + 8 * kq) * 2);
    unsigned foff[2];
#pragma unroll
    for (int u = 0; u < 2; ++u) foff[u] = (unsigned)((8 * wv + 4 * u + kq) * (EVEN_IN * 2) + ((j ^ ((kq << 2) | ((2 * wv + u) & 3))) * 16));
    const bool fast = (F.G & 15) == 0;
    const int nst = 128 + (l == 0 ? 4 : 0);
    unsigned gs = 0;
#pragma unroll 1
    for (int h = fast ? ((int)blockIdx.x & 15) : 0; h < 16; h += (fast ? 16 : 1)) {
        const float* rpb = INP(I_RPB) + ((size_t)j2 * 16 + h) * 465;
        __syncthreads();
        for (int idx = F.tid; idx < 465; idx += 512) rp[idx] = rpb[idx] * 1.4426950408889634f;
        __syncthreads();
        const int w0 = fast ? ((int)blockIdx.x >> 4) : (int)blockIdx.x, nw = fast ? (F.G >> 4) : F.G;
#pragma unroll 1
        for (int st = w0; st < nst; st += nw) {
            int b, nwin, c0 = 0, ws_ = 0, rs = 0, r = 0, rsA = 0; size_t qrow0;
            if (st < 128) { const int r0 = (st & 63) * 2; b = st >> 6; r = r0 + (wv >> 2); c0 = (wv & 3) * 16; ws_ = min(max(c0 - 8, 0), 32); rs = min(max(r - 4, 0), 120);
                rsA = min(max(r0 - 4, 0), 120); nwin = min(max(r0 - 3, 0), 120) + 8 - rsA; qrow0 = (size_t)b * SEQ + r * 64 + c0; }
            else { const int t2 = st - 128; b = t2 >> 1; qrow0 = (size_t)NLAT + b * LC + ((t2 & 1) * 8 + wv) * 16; nwin = 0; }
            const int nsteps = nwin + 4;
            bf16x8v qf[4];
            { unsigned long long qbi = (unsigned long long)(P + qrow0 * EVEN_IN + h * 128); asm volatile("" : "+s"(qbi)); const gcp_t qb = (gcp_t)qbi;
              unsigned _ko = koff; asm volatile("" : "+v"(_ko));
#pragma unroll
              for (int s = 0; s < 4; ++s) qf[s] = *(const GAS bf16x8v*)(qb + 64 * s + _ko); }
            u32x4 fr[4];
#define ATT_FETCH(s_) do { const int _s = (s_); const size_t _tok0 = (_s < nwin) ? ((size_t)b * SEQ + (rsA + _s) * 64) : ((size_t)NLAT + b * LC + (_s - nwin) * 64); \
            unsigned long long _kbi = (unsigned long long)(P + _tok0 * EVEN_IN + 2048 + h * 128); asm volatile("" : "+s"(_kbi)); const gcp_t _kb = (gcp_t)_kbi; \
            _Pragma("unroll") for (int u = 0; u < 2; ++u) { unsigned _fo = foff[u]; asm volatile("" : "+v"(_fo)); \
                fr[u] = *(const GAS u32x4*)(_kb + _fo); fr[2 + u] = *(const GAS u32x4*)(_kb + 4096 + _fo); } } while (0)
#define ATT_PUT(bf_) do { _Pragma("unroll") for (int u = 0; u < 2; ++u) { \
                *(LAS u32x4*)(KT + (bf_) * 16384 + (2 * wv + u) * 1024 + F.lane * 16) = fr[u]; *(LAS u32x4*)(VT + (bf_) * 16384 + (2 * wv + u) * 1024 + F.lane * 16) = fr[2 + u]; } } while (0)
            ATT_FETCH(0);
            const int cq = c0 + j, cs = min(max(cq - 8, 0), 48);
            int dcv[8]; float madd[8];
#pragma unroll
            for (int e = 0; e < 8; ++e) { const int kcol = ws_ + 8 * kq + e; dcv[e] = min(max(kcol - cq + 15, 0), 30); madd[e] = ((unsigned)(kcol - cs) < 16u) ? 0.f : -1e30f; asm volatile("" : "+v"(madd[e])); }
            unsigned KBw[2], KBc[2], VBw[2], VBc[2];
#pragma unroll
            for (int t = 0; t < 2; ++t) {
                { const unsigned row = (unsigned)(ws_ + 8 * (j >> 2) + (j & 3) + 4 * t), y = (row >> 2) & 3u; KBw[t] = 256u * row + 16u * ((unsigned)kq ^ y) + 64u * (unsigned)(j & 3); }
                { const unsigned row = (unsigned)(8 * (j >> 2) + (j & 3) + 4 * t), y = (row >> 2) & 3u; KBc[t] = 256u * row + 16u * ((unsigned)kq ^ y) + 64u * (unsigned)(j & 3); }
                const unsigned q = (unsigned)j >> 2, p = (unsigned)j & 3u, bq = p >> 1;
                { const unsigned row = (unsigned)(ws_ + 8 * kq + 4 * t) + q, X = (q << 2) | ((row >> 2) & 3u); VBw[t] = 256u * row + 16u * (bq ^ X) + 8u * (p & 1u); }
                { const unsigned row = (unsigned)(8 * kq + 4 * t) + q, X = (q << 2) | ((row >> 2) & 3u); VBc[t] = 256u * row + 16u * (bq ^ X) + 8u * (p & 1u); }
            }
            f32x4 o[8];
#pragma unroll
            for (int d = 0; d < 8; ++d) o[d] = (f32x4){0.f, 0.f, 0.f, 0.f};
            float mrun = -1e30f, lsum = 0.f;
#define ATT_GROUP(KB0_, KB1_, VB0_, VB1_, XO_, WIN, brow_) do { \
            bf16x8v kf[8]; \
            _Pragma("unroll") for (int s = 0; s < 4; ++s) { kf[s] = *(const LAS bf16x8v*)(KT + (((KB0_) ^ (64u * s)) + (XO_))); kf[4 + s] = *(const LAS bf16x8v*)(KT + (((KB1_) ^ (64u * s)) + (XO_))); } \
            float bias[8]; \
            if (WIN) { const LAS float* rrow = rp + (brow_) * 31; \
                _Pragma("unroll") for (int e = 0; e < 8; ++e) bias[e] = rrow[dcv[e]]; } \
            f32x4 s0 = (f32x4){0.f, 0.f, 0.f, 0.f}, s1 = (f32x4){0.f, 0.f, 0.f, 0.f}; \
            __builtin_amdgcn_s_setprio(1);     \
            _Pragma("unroll") for (int s = 0; s < 4; ++s) { s0 = __builtin_amdgcn_mfma_f32_16x16x32_bf16(kf[s], qf[s], s0, 0, 0, 0); s1 = __builtin_amdgcn_mfma_f32_16x16x32_bf16(kf[4 + s], qf[s], s1, 0, 0, 0); } \
            __builtin_amdgcn_s_setprio(0); \
            if (WIN) asm volatile("" : "+v"(bias[0]), "+v"(bias[1]), "+v"(bias[2]), "+v"(bias[3]), "+v"(bias[4]), "+v"(bias[5]), "+v"(bias[6]), "+v"(bias[7]));     \
            else asm volatile("" : "+v"(s0), "+v"(s1)); \
            u32x2 tr[8][2]; unsigned rd[8][2]; \
            _Pragma("unroll") for (int d = 0; d < 8; ++d) { rd[d][0] = vt_addr + ((VB0_) ^ (32u * d)); rd[d][1] = vt_addr + ((VB1_) ^ (32u * d)); } \
            asm volatile("ds_read_b64_tr_b16 %0, %8 offset:%16\n\tds_read_b64_tr_b16 %1, %9 offset:%16\n\tds_read_b64_tr_b16 %2, %10 offset:%16\n\tds_read_b64_tr_b16 %3, %11 offset:%16\n\t" \
                         "ds_read_b64_tr_b16 %4, %12 offset:%16\n\tds_read_b64_tr_b16 %5, %13 offset:%16\n\tds_read_b64_tr_b16 %6, %14 offset:%16\n\tds_read_b64_tr_b16 %7, %15 offset:%16" \
                : "=&v"(tr[0][0]), "=&v"(tr[0][1]), "=&v"(tr[1][0]), "=&v"(tr[1][1]), "=&v"(tr[2][0]), "=&v"(tr[2][1]), "=&v"(tr[3][0]), "=&v"(tr[3][1]) \
                : "v"(rd[0][0]), "v"(rd[0][1]), "v"(rd[1][0]), "v"(rd[1][1]), "v"(rd[2][0]), "v"(rd[2][1]), "v"(rd[3][0]), "v"(rd[3][1]), "i"(XO_)); \
            asm volatile("ds_read_b64_tr_b16 %0, %8 offset:%16\n\tds_read_b64_tr_b16 %1, %9 offset:%16\n\tds_read_b64_tr_b16 %2, %10 offset:%16\n\tds_read_b64_tr_b16 %3, %11 offset:%16\n\t" \
                         "ds_read_b64_tr_b16 %4, %12 offset:%16\n\tds_read_b64_tr_b16 %5, %13 offset:%16\n\tds_read_b64_tr_b16 %6, %14 offset:%16\n\tds_read_b64_tr_b16 %7, %15 offset:%16" \
                : "=&v"(tr[4][0]), "=&v"(tr[4][1]), "=&v"(tr[5][0]), "=&v"(tr[5][1]), "=&v"(tr[6][0]), "=&v"(tr[6][1]), "=&v"(tr[7][0]), "=&v"(tr[7][1]) \
                : "v"(rd[4][0]), "v"(rd[4][1]), "v"(rd[5][0]), "v"(rd[5][1]), "v"(rd[6][0]), "v"(rd[6][1]), "v"(rd[7][0]), "v"(rd[7][1]), "i"(XO_)); \
            float sv[8]; \
            _Pragma("unroll") for (int e = 0; e < 8; ++e) sv[e] = WIN ? fmaf((e >> 2) ? s1[e & 3] : s0[e & 3], qscale, bias[e]) + madd[e] : ((e >> 2) ? s1[e & 3] : s0[e & 3]) * qscale; \
            float gmax = sv[0]; \
            _Pragma("unroll") for (int e = 1; e < 8; ++e) gmax = fmaxf(gmax, sv[e]); \
            gmax = xmax16_32(gmax); \
            const float mnew = fmaxf(mrun, gmax), alpha = __builtin_amdgcn_exp2f(mrun - mnew); \
            if (__builtin_amdgcn_ballot_w64(mnew > mrun) != 0ull) { _Pragma("unroll") for (int d = 0; d < 8; ++d) o[d] = o[d] * alpha; } \
            mrun = mnew; \
            float p[8], psum = 0.f; \
            _Pragma("unroll") for (int e = 0; e < 8; ++e) { p[e] = __builtin_amdgcn_exp2f(sv[e] - mnew); psum += p[e]; } \
            lsum = lsum * alpha + psum; \
            union { bf16x8v v; unsigned u[4]; } pf; \
            pf.u[0] = pk2(p[0], p[1]); pf.u[1] = pk2(p[2], p[3]); pf.u[2] = pk2(p[4], p[5]); pf.u[3] = pk2(p[6], p[7]); \
            asm volatile("s_waitcnt lgkmcnt(0)" : "+v"(tr[0][0]), "+v"(tr[0][1]), "+v"(tr[1][0]), "+v"(tr[1][1]), "+v"(tr[2][0]), "+v"(tr[2][1]), "+v"(tr[3][0]), "+v"(tr[3][1]), \
                                                  "+v"(tr[4][0]), "+v"(tr[4][1]), "+v"(tr[5][0]), "+v"(tr[5][1]), "+v"(tr[6][0]), "+v"(tr[6][1]), "+v"(tr[7][0]), "+v"(tr[7][1]) :: "memory"); \
            __builtin_amdgcn_s_setprio(1); \
            _Pragma("unroll") for (int d = 0; d < 8; ++d) { union { bf16x8v v; unsigned u[4]; } vf; vf.u[0] = tr[d][0].x; vf.u[1] = tr[d][0].y; vf.u[2] = tr[d][1].x; vf.u[3] = tr[d][1].y; \
                o[d] = __builtin_amdgcn_mfma_f32_16x16x32_bf16(vf.v, pf.v, o[d], 0, 0, 0); } \
            __builtin_amdgcn_s_setprio(0); } while (0)
#pragma unroll 1
            for (int step = 0; step < nsteps; ++step, ++gs) {
                ATT_PUT(gs & 1u);
                __syncthreads();
                if (step + 1 < nsteps) ATT_FETCH(step + 1);
                const unsigned bo = (gs & 1u) * 16384u;
                if (step < nwin) {
                    const int g = rsA + step - rs;
                    if ((unsigned)g < 8u) { const unsigned k0 = KBw[0] + bo, k1 = KBw[1] + bo, v0 = VBw[0] + bo, v1 = VBw[1] + bo; ATT_GROUP(k0, k1, v0, v1, 0, true, rs + g - r + 7); }
                } else {
                    const unsigned k0 = KBc[0] + bo, k1 = KBc[1] + bo, v0 = VBc[0] + bo, v1 = VBc[1] + bo;
                    ATT_GROUP(k0, k1, v0, v1, 0, false, 0);
                    ATT_GROUP(k0, k1, v0, v1, 8192, false, 0);
                }
            }
#undef ATT_FETCH
#undef ATT_PUT
#undef ATT_GROUP
            lsum += __shfl_xor(lsum, 16); lsum += __shfl_xor(lsum, 32);
            const float inv = 1.0f / lsum;
#pragma unroll
            for (int d = 0; d < 8; ++d) { u32x2 w; w.x = pk2(o[d].x * inv, o[d].y * inv); w.y = pk2(o[d].z * inv, o[d].w * inv);
                *(u32x2*)(MIX + (qrow0 + j) * D + h * 128 + 16 * d + 4 * kq) = w; }
        }
    }
    __syncthreads();
}

__device__ __forceinline__ float wave_sum_o(float v) {
    int ln = (int)__builtin_amdgcn_mbcnt_hi(~0u, __builtin_amdgcn_mbcnt_lo(~0u, 0u)); asm volatile("" : "+v"(ln));
#pragma unroll
    for (int o = 1; o < 64; o <<= 1) v += __builtin_bit_cast(float, __builtin_amdgcn_ds_bpermute((ln ^ o) << 2, __builtin_bit_cast(int, v)));
    return v;
}
__device__ __forceinline__ float block_sum(const Frame& F, float v, LAS float* red) {
    v = wave_sum_o(v);
    __syncthreads();
    if (F.lane == 0) red[F.wave] = v;
    __syncthreads();
    float s = 0.f;
#pragma unroll
    for (int w = 0; w < 8; ++w) s += red[w];
    return s;
}
typedef float f32x2 __attribute__((ext_vector_type(2)));
#define FP(idx) ((idx) + ((idx) >> 5))
__device__ constexpr int BR5[32] = {0,16,8,24,4,20,12,28,2,18,10,26,6,22,14,30,1,17,9,25,5,21,13,29,3,19,11,27,7,23,15,31};
__device__ constexpr int BR4[16] = {0,8,4,12,2,10,6,14,1,9,5,13,3,11,7,15};
#define brevn(s, bits) ((bits) == 5 ? BR5[(s)] : BR4[(s)])
__device__ __forceinline__ f32x2 cswap(f32x2 a) { f32x2 r; r.x = a.y; r.y = -a.x; return r; }
__device__ __forceinline__ f32x2 cmul(f32x2 a, f32x2 w) { f32x2 t; t.x = -a.y; t.y = a.x; return a * w.x + t * w.y; }
__device__ __forceinline__ f32x2 cmulc(f32x2 a, f32x2 w) { f32x2 t; t.x = a.y; t.y = -a.x; f32x2 r = a * w.x + t * w.y; r.y = -r.y; return r; }
template <int R> __device__ __forceinline__ void dif(f32x2 (&x)[R]) {
    constexpr float C32[16] = { 1.f, 0.98078528040323043f, 0.92387953251128674f, 0.83146961230254524f, 0.70710678118654752f, 0.55557023301960218f, 0.38268343236508978f, 0.19509032201612825f,
                                0.f, -0.19509032201612825f, -0.38268343236508978f, -0.55557023301960218f, -0.70710678118654752f, -0.83146961230254524f, -0.92387953251128674f, -0.98078528040323043f };
    constexpr float S32[16] = { 0.f, 0.19509032201612825f, 0.38268343236508978f, 0.55557023301960218f, 0.70710678118654752f, 0.83146961230254524f, 0.92387953251128674f, 0.98078528040323043f,
                                1.f, 0.98078528040323043f, 0.92387953251128674f, 0.83146961230254524f, 0.70710678118654752f, 0.55557023301960218f, 0.38268343236508978f, 0.19509032201612825f };
#pragma unroll
    for (int h = R / 2; h >= 1; h >>= 1) {
#pragma unroll
        for (int b = 0; b < R; b += 2 * h) {
#pragma unroll
            for (int k = 0; k < h; ++k) {
                const int i0 = b + k, i1 = b + k + h, ti = k * (16 / h);
                const f32x2 u = x[i0], v = x[i1];
                x[i0] = u + v;
                const f32x2 d = u - v;
                if (ti == 0) x[i1] = d;
                else if (ti == 8) x[i1] = cswap(d);
                else x[i1] = d * C32[ti] + cswap(d) * S32[ti];
            }
        }
    }
}
struct FftCtx { LAS f32x2* X; const LAS f32x2* TW; int tid; };
__device__ __forceinline__ void fft_fwd_A(const FftCtx& f, f32x2 (&x)[32]) {
    dif<32>(x);
    __builtin_amdgcn_sched_barrier(0);
    const int i = f.tid; const f32x2 w = f.TW[i]; f32x2 cw; cw.x = 1.f; cw.y = 0.f;
    __syncthreads();
    LAS f32x2* XA = f.X + (i + (i >> 5));
    XA[0] = x[0];
#pragma unroll
    for (int r = 1; r < 32; ++r) { __builtin_amdgcn_sched_barrier(0); cw = cmul(cw, w); XA[528 * r] = cmul(x[brevn(r, 5)], cw); }
    __syncthreads();
}
__device__ __forceinline__ void fft_fwd_BC(const FftCtx& f, f32x2 (&x)[32]) {
#pragma unroll 1
    for (int u = 0; u < 2; ++u) {
        const int q = f.tid + 512 * u, r = q >> 5, i2 = q & 31;
        f32x2 y[16]; LAS f32x2* XB = f.X + (528 * r + i2);
#pragma unroll
        for (int j2 = 0; j2 < 16; ++j2) y[j2] = XB[33 * j2];
        dif<16>(y);
        __builtin_amdgcn_sched_barrier(0);
        const f32x2 w = f.TW[32 * i2]; f32x2 cw; cw.x = 1.f; cw.y = 0.f;
        XB[0] = y[0];
#pragma unroll
        for (int r2 = 1; r2 < 16; ++r2) { __builtin_amdgcn_sched_barrier(0); cw = cmul(cw, w); XB[33 * r2] = cmul(y[brevn(r2, 4)], cw); }
    }
    __syncthreads();
    { const LAS f32x2* XC = f.X + 33 * f.tid;
#pragma unroll
      for (int m = 0; m < 32; ++m) x[m] = XC[m]; }
    dif<32>(x);
}
__device__ __forceinline__ void fft_inv(const FftCtx& f, f32x2 (&x)[32]) {
    {   f32x2 t[32];
#pragma unroll
        for (int k = 0; k < 32; ++k) { t[k] = x[brevn(k, 5)]; t[k].y = -t[k].y; }
        dif<32>(t);
        LAS f32x2* XC = f.X + 33 * f.tid;
#pragma unroll
        for (int s = 0; s < 32; ++s) { f32x2 v = t[s]; v.y = -v.y; XC[brevn(s, 5)] = v; }
    }
    __syncthreads();
#pragma unroll 1
    for (int u = 0; u < 2; ++u) {
        const int q = f.tid + 512 * u, r = q >> 5, i2 = q & 31;
        f32x2 y[16];
        const f32x2 w = f.TW[32 * i2]; f32x2 cw; cw.x = 1.f; cw.y = 0.f; LAS f32x2* XB = f.X + (528 * r + i2);
        { f32x2 v = XB[0]; v.y = -v.y; y[0] = v; }
#pragma unroll
        for (int r2 = 1; r2 < 16; ++r2) { __builtin_amdgcn_sched_barrier(0); cw = cmul(cw, w); f32x2 v = XB[33 * r2]; v.y = -v.y; y[r2] = cmul(v, cw); }
        dif<16>(y);
#pragma unroll
        for (int s = 0; s < 16; ++s) { f32x2 v = y[s]; v.y = -v.y; XB[33 * brevn(s, 4)] = v; }
    }
    __syncthreads();
    {   const int i = f.tid; const f32x2 w = f.TW[i]; f32x2 cw; cw.x = 1.f; cw.y = 0.f; const LAS f32x2* XA = f.X + (i + (i >> 5));
        { f32x2 v = XA[0]; v.y = -v.y; x[0] = v; }
#pragma unroll
        for (int r = 1; r < 32; ++r) { __builtin_amdgcn_sched_barrier(0); cw = cmul(cw, w); f32x2 v = XA[528 * r]; v.y = -v.y; x[r] = cmul(v, cw); }
        dif<32>(x);
#pragma unroll
        for (int s = 0; s < 32; ++s) x[s].y = -x[s].y;
    }
}
__device__ __forceinline__ void ph_hyc(const Args& a, const Frame& F, int l) {
    const int Z = opaque_zero();
    const int j2 = l >> 1;
    const float* FILT = (const float*)WSB(WS_FILT); const bf16_t* UT = (const bf16_t*)WSB(WS_UT); float* Z2T = (float*)WSB(WS_Z2T);
    const float* skip = INP(I_HY_SKIP) + (size_t)j2 * 2 * 2048;
    FftCtx f; f.X = (LAS f32x2*)F.lds; f.TW = (const LAS f32x2*)(F.lds + 135168); f.tid = F.tid;
    LAS float* red = (LAS float*)(F.lds + 135168 + 8192);
    { LAS f32x2* tw = (LAS f32x2*)(F.lds + 135168);
      for (int m = F.tid; m < 1024; m += 512) { float sn, cs; sincosf(-6.283185307179586f * (float)m * (1.0f / 16384.f), &sn, &cs); f32x2 v; v.x = cs; v.y = sn; tw[m] = v; } }
    __syncthreads();
    const unsigned tu = (unsigned)F.tid, trv = 511u - (unsigned)F.tid;
    for (int c = blockIdx.x; c < 2048; c += F.G) {
        f32x2 nd[16];
        { const float* z0p = Z2T + ((size_t)0 * 2048 + c) * SEQ; const float* z1p = Z2T + ((size_t)1 * 2048 + c) * SEQ;
#pragma unroll
          for (int j = 0; j < 16; ++j) { unsigned long long a0 = (unsigned long long)(z0p + 512 * j), a1 = (unsigned long long)(z1p + 512 * j); asm volatile("" : "+s"(a0), "+s"(a1)); nd[j].x = ((const GAS float*)a0)[tu]; nd[j].y = ((const GAS float*)a1)[tu]; } }
#pragma unroll 1
        for (int o = 0; o < 2; ++o) {
            const float* fwd = FILT + ((size_t)(c * 2 + o) * 2 + 0) * SEQ; const float* bwd = fwd + SEQ;
            f32x2 kx[32]; float ss = 0.f;
#pragma unroll
            for (int j = 0; j < 32; ++j) { float v;
                if (j < 16) v = (fwd + 512 * j)[tu]; else { v = (bwd + (SEQ - 512 * (j - 16) - 511))[trv]; if (j == 16 && F.tid == 0) v = 0.f; }
                kx[j].x = v; kx[j].y = 0.f; ss += v * v; }
            fft_fwd_A(f, kx); fft_fwd_BC(f, kx);
            const float tot = block_sum(F, ss, red);
            const float sc = (1.0f / sqrtf(tot + EPS)) * (1.0f / 16384.f);
            const float skn = skip[o * 2048 + c] * (1.0f / 16384.f);
#pragma unroll
            for (int s = 0; s < 32; ++s) { kx[s] = kx[s] * sc; kx[s].x += skn; }
            f32x2 dx[32];
#pragma unroll
            for (int j = 0; j < 32; ++j) { if (j < 16) dx[j] = nd[j]; else { dx[j].x = 0.f; dx[j].y = 0.f; } }
            fft_fwd_A(f, dx); fft_fwd_BC(f, dx);
#pragma unroll
            for (int s = 0; s < 32; ++s) dx[s] = cmul(dx[s], kx[s]);
            const bf16_t* g0p = UT + ((size_t)0 * 4096 + o * 2048 + c) * SEQ; const bf16_t* g1p = UT + ((size_t)1 * 4096 + o * 2048 + c) * SEQ;
            unsigned short gt0[16], gt1[16];
#pragma unroll
            for (int j = 0; j < 16; ++j) { unsigned long long a0 = (unsigned long long)(g0p + 512 * j), a1 = (unsigned long long)(g1p + 512 * j); asm volatile("" : "+s"(a0), "+s"(a1));
                gt0[j] = ((const GAS bf16_t*)a0)[tu]; gt1[j] = ((const GAS bf16_t*)a1)[tu]; }
            fft_inv(f, dx);
            float* o0p = Z2T + ((size_t)0 * 2048 + c) * SEQ; float* o1p = Z2T + ((size_t)1 * 2048 + c) * SEQ;
#pragma unroll
            for (int j = 0; j < 16; ++j) { const int s = brevn(j, 5);
                nd[j].x = bf2f(gt0[j]) * dx[s].x; nd[j].y = bf2f(gt1[j]) * dx[s].y; }
            if (o == 1) {
#pragma unroll
                for (int j = 0; j < 16; ++j) { unsigned long long b0 = (unsigned long long)(o0p + 512 * j), b1 = (unsigned long long)(o1p + 512 * j); asm volatile("" : "+s"(b0), "+s"(b1));
                    ((GAS float*)b0)[tu] = nd[j].x; ((GAS float*)b1)[tu] = nd[j].y; }
            }
        }
    }
}

__device__ __forceinline__ void ph_hyx(const Args& a, const Frame& F, int l) {
    const int Z = opaque_zero();
    const int j2 = l >> 1;
    const bf16_t* P = (const bf16_t*)WSB(WS_P); bf16_t* MIX = (bf16_t*)WSB(WS_MIX); const float* FILTC = (const float*)WSB(WS_FILTC);
    const float* cw = INP(I_HY_CW) + (size_t)j2 * 3 * 6144; const float* cb = INP(I_HY_CB) + (size_t)j2 * 6144; const float* skip = INP(I_HY_SKIP) + (size_t)j2 * 2 * 2048;
    LAS float* us = (LAS float*)F.lds;
    LAS float* Hh = us + 3 * 2 * 256 * 8;
    LAS float* red = Hh + 2 * 8 * 512;
    const int b = F.tid >> 8, t = F.tid & 255;
    for (int cg = blockIdx.x; cg < 256; cg += F.G) {
        const int c0 = cg * 8;
        __syncthreads();
#pragma unroll 1
        for (int part = 0; part < 3; ++part) { const int ch0 = part * 2048 + c0; float v[8];
#pragma unroll
            for (int k = 0; k < 8; ++k) v[k] = cb[ch0 + k];
#pragma unroll
            for (int i = 0; i < 3; ++i) { const int tt = t + i - 1; if (tt >= 0 && tt < LC) { const u32x4 raw = *(const u32x4*)(P + (size_t)(NLAT + b * LC + tt) * EVEN_IN + 6144 + ch0); const float* w = cw + i * 6144 + ch0;
                v[0] += bflo(raw.x) * w[0]; v[1] += bfhi(raw.x) * w[1]; v[2] += bflo(raw.y) * w[2]; v[3] += bfhi(raw.y) * w[3]; v[4] += bflo(raw.z) * w[4]; v[5] += bfhi(raw.z) * w[5]; v[6] += bflo(raw.w) * w[6]; v[7] += bfhi(raw.w) * w[7]; } }
            LAS f32x4* d = (LAS f32x4*)(us + ((part * 2 + b) * 256 + t) * 8); d[0] = (f32x4){v[0], v[1], v[2], v[3]}; d[1] = (f32x4){v[4], v[5], v[6], v[7]}; }
#pragma unroll 1
        for (int m = 0; m < 8; ++m) { const int idx = F.tid + 512 * m, ok = idx >> 8, d = idx & 255, o = ok >> 3, k = ok & 7;
            const float* fwd = FILTC + ((size_t)((c0 + k) * 2 + o) * 2 + 0) * LC; const float f = fwd[d]; float ss = f * f; Hh[ok * 512 + 256 + d] = f;
            if (d >= 1) { const float g = fwd[LC + d]; Hh[ok * 512 + 256 - d] = g; ss += g * g; } else Hh[ok * 512] = 0.f;
            ss = wave_sum_o(ss); if (F.lane == 0) red[ok * 4 + (F.wave & 3)] = ss; }
        __syncthreads();
#pragma unroll 1
        for (int o = 0; o < 2; ++o) {
            float acc[8];
#pragma unroll
            for (int k = 0; k < 8; ++k) acc[k] = 0.f;
            const LAS float* zb = us + (2 * 2 + b) * 256 * 8; const LAS float* hb = Hh + (o * 8) * 512 + 256 + t;
            for (int sidx = 0; sidx < LC; ++sidx) { const f32x4 z0 = *(const LAS f32x4*)(zb + sidx * 8), z1 = *(const LAS f32x4*)(zb + sidx * 8 + 4);
                acc[0] += hb[0 * 512 - sidx] * z0.x; acc[1] += hb[1 * 512 - sidx] * z0.y; acc[2] += hb[2 * 512 - sidx] * z0.z; acc[3] += hb[3 * 512 - sidx] * z0.w;
                acc[4] += hb[4 * 512 - sidx] * z1.x; acc[5] += hb[5 * 512 - sidx] * z1.y; acc[6] += hb[6 * 512 - sidx] * z1.z; acc[7] += hb[7 * 512 - sidx] * z1.w; }
            float zn[8];
#pragma unroll
            for (int k = 0; k < 8; ++k) { const int ok = o * 8 + k; const float fscale = 1.0f / sqrtf(red[ok * 4] + red[ok * 4 + 1] + red[ok * 4 + 2] + red[ok * 4 + 3] + EPS);
                const float y = acc[k] * fscale + zb[t * 8 + k] * skip[o * 2048 + c0 + k]; zn[k] = us[((o * 2 + b) * 256 + t) * 8 + k] * y; }
            __syncthreads();
            if (o == 0) { LAS f32x4* d = (LAS f32x4*)(us + ((2 * 2 + b) * 256 + t) * 8); d[0] = (f32x4){zn[0], zn[1], zn[2], zn[3]}; d[1] = (f32x4){zn[4], zn[5], zn[6], zn[7]}; __syncthreads(); }
            else { u32x4 w; w.x = pk2(zn[0], zn[1]); w.y = pk2(zn[2], zn[3]); w.z = pk2(zn[4], zn[5]); w.w = pk2(zn[6], zn[7]); *(u32x4*)(MIX + (size_t)(NLAT + b * LC + t) * D + 2048 + c0) = w; }
        }
    }
}
__device__ __forceinline__ void ph_hyt(const Args& a, const Frame& F) {
    const int Z = opaque_zero();
    const float* Z2T = (const float*)WSB(WS_Z2T); bf16_t* MIX = (bf16_t*)WSB(WS_MIX);
    LAS float* tile = (LAS float*)F.lds;
    for (int it = blockIdx.x; it < 2 * 128 * 32; it += F.G) {
        const int b = it >> 12, t0 = ((it >> 5) & 127) * 64, c0 = (it & 31) * 64;
        for (int idx = F.tid; idx < 4096; idx += 512) { const int cc = idx >> 6, tt = idx & 63; tile[cc * 65 + tt] = Z2T[((size_t)b * 2048 + c0 + cc) * SEQ + t0 + tt]; }
        __syncthreads();
        { const int tt = F.tid >> 3, ck = F.tid & 7; const LAS float* sp = tile + (8 * ck) * 65 + tt;
          u32x4 o; o.x = pk2(sp[0], sp[65]); o.y = pk2(sp[2 * 65], sp[3 * 65]); o.z = pk2(sp[4 * 65], sp[5 * 65]); o.w = pk2(sp[6 * 65], sp[7 * 65]);
          *(u32x4*)(MIX + (size_t)(b * SEQ + t0 + tt) * D + 2048 + c0 + 8 * ck) = o; }
        __syncthreads();
    }
}

__device__ __forceinline__ void ph_r1(const Args& a, const Frame& F, int l) {
    const int Z = opaque_zero();
    const int M = (l == 3) ? NLAT : T; const bf16_t* ZB = (const bf16_t*)WSB(WS_P); float* RS = (float*)WSB(WS_RSTDV);
    for (int row = F.gw; row < M; row += F.NGW) {
        const u32x4* vr = (const u32x4*)(ZB + (size_t)row * ODD_IN + 4096); float ss = 0.f;
#pragma unroll
        for (int j = 0; j < 8; ++j) { const u32x4 r = vr[F.lane + 64 * j];
            ss += bflo(r.x) * bflo(r.x) + bfhi(r.x) * bfhi(r.x) + bflo(r.y) * bflo(r.y) + bfhi(r.y) * bfhi(r.y) + bflo(r.z) * bflo(r.z) + bfhi(r.z) * bfhi(r.z) + bflo(r.w) * bflo(r.w) + bfhi(r.w) * bfhi(r.w); }
        ss = wave_sum(ss);
        if (F.lane == 0) RS[row] = 1.0f / sqrtf(ss * (1.0f / 4096.f) + EPS);
    }
}
__device__ __forceinline__ void ph_sg(const Args& a, const Frame& F, int l) {
    const int Z = opaque_zero();
    const int j2 = l >> 1, M = (l == 3) ? NLAT : T;
    const bf16_t* ZB = (const bf16_t*)WSB(WS_P); bf16_t* MIX = (bf16_t*)WSB(WS_MIX); const float* RS = (const float*)WSB(WS_RSTDV);
    const float* vgain = INP(I_GM_VGAIN) + (size_t)j2 * 4096; const float* ws = INP(I_GM_WS) + (size_t)j2 * 32 * 128 * 128; const float* bs = INP(I_GM_BS) + (size_t)j2 * 32 * 128;
    LAS unsigned char* VT = F.lds;
    const int nunits = (M / 128) * 32;
    const int jl = F.lane & 15, kq = F.lane >> 4;
    for (int un = blockIdx.x; un < nunits; un += F.G) {
        const int chunk = un >> 5, g = un & 31;
        __syncthreads();
#pragma unroll
        for (int it = 0; it < 4; ++it) { const int idx = F.tid + 512 * it, q = idx >> 4, c8 = (idx & 15) * 8; const int row = chunk * 128 + q;
            const u32x4 raw = *(const u32x4*)(ZB + (size_t)row * ODD_IN + 4096 + g * 128 + c8); const float rs = RS[row]; const float* gp = vgain + g * 128 + c8;
            const float v[8] = { bflo(raw.x), bfhi(raw.x), bflo(raw.y), bfhi(raw.y), bflo(raw.z), bfhi(raw.z), bflo(raw.w), bfhi(raw.w) };
#pragma unroll
            for (int i = 0; i < 8; ++i) *(LAS unsigned short*)(VT + (c8 + i) * 272 + q * 2) = (unsigned short)f2bf(v[i] * rs * gp[i]); }
        union { bf16x8v v; unsigned u[4]; } wf[4];
        { const float* wp = ws + (size_t)g * 16384 + (size_t)(16 * F.wave + jl) * 128 + 8 * kq;
#pragma unroll
          for (int s4 = 0; s4 < 4; ++s4) { const f32x4 w0 = *(const f32x4*)(wp + 32 * s4), w1 = *(const f32x4*)(wp + 32 * s4 + 4);
              wf[s4].u[0] = pk2(w0.x, w0.y); wf[s4].u[1] = pk2(w0.z, w0.w); wf[s4].u[2] = pk2(w1.x, w1.y); wf[s4].u[3] = pk2(w1.z, w1.w); } }
        __syncthreads();
        const int p = 16 * F.wave + jl, row = chunk * 128 + p; const float bsp = bs[g * 128 + p];
#pragma unroll
        for (int cb = 0; cb < 8; ++cb) {
            f32x4 acc = (f32x4){0.f, 0.f, 0.f, 0.f};
#pragma unroll
            for (int s4 = 0; s4 < 4; ++s4) { const bf16x8v af = *(const LAS bf16x8v*)(VT + (16 * cb + jl) * 272 + (32 * s4 + 8 * kq) * 2);
                acc = __builtin_amdgcn_mfma_f32_16x16x32_bf16(af, wf[s4].v, acc, 0, 0, 0); }
            const int c0 = g * 128 + 16 * cb + 4 * kq;
            const u32x2 ur = *(const u32x2*)(ZB + (size_t)row * ODD_IN + c0);
            *(unsigned*)((unsigned char*)MIX + (size_t)row * D + c0) = pk4f8(bflo(ur.x) * (acc.x + bsp), bfhi(ur.x) * (acc.y + bsp), bflo(ur.y) * (acc.z + bsp), bfhi(ur.y) * (acc.w + bsp));
        }
    }
}

__device__ __forceinline__ void ph_router(const Args& a, const Frame& F, int l) {
    const int Z = opaque_zero();
    const int M = (l >= 2) ? NLAT : T, ntask = M / 16;
    const bf16_t* WRH = (const bf16_t*)WSB(WS_WR); const bf16_t* WRL = WRH + (size_t)4 * 3 * NE * D; const float* RB = (const float*)WSB(WS_RB); float* GATES = (float*)WSB(WS_GATES);
    const float* CX = (const float*)WSB(WS_CX); const float* rbias = INP(I_MOE_BIAS) + l * NE;
    LAS float* S = (LAS float*)(F.lds + F.wave * 8192);
    unsigned* ECNT = (unsigned*)WSB(WS_CTL) + CW_ECNT; int* ELIST = (int*)WSB(WS_ELIST);
    for (int task = F.wave * F.G + (int)blockIdx.x; task < ntask; task += 4 * F.G) {
        const int t0 = task * 16, c = t0 < SEQ ? 0 : (t0 < NLAT ? 1 : 2), j = F.lane & 15, kq = F.lane >> 4, row = t0 + j;
        const float* xr = (row < NLAT ? AOUT + (size_t)row * D : CX + (size_t)(row - NLAT) * D) + 8 * kq;
        const bf16_t* wh = WRH + ((size_t)(l * 3 + c) * NE + j) * D + 8 * kq; const bf16_t* wl = WRL + ((size_t)(l * 3 + c) * NE + j) * D + 8 * kq;
        f32x4 acc[4]; float ss = 0.f;
#pragma unroll
        for (int blk = 0; blk < 4; ++blk) acc[blk] = (f32x4){0.f, 0.f, 0.f, 0.f};
#pragma unroll 2
        for (int k0 = 0; k0 < D; k0 += 32) {
            const f32x4 x0 = *(const f32x4*)(xr + k0), x1 = *(const f32x4*)(xr + k0 + 4);
            ss += (x0.x * x0.x + x0.y * x0.y) + (x0.z * x0.z + x0.w * x0.w) + (x1.x * x1.x + x1.y * x1.y) + (x1.z * x1.z + x1.w * x1.w);
            const float xs[8] = { x0.x, x0.y, x0.z, x0.w, x1.x, x1.y, x1.z, x1.w };
            union { bf16x8v v; unsigned u[4]; } xh, xl;
#pragma unroll
            for (int q = 0; q < 4; ++q) { const unsigned b0 = __builtin_bit_cast(unsigned, xs[2 * q]), b1 = __builtin_bit_cast(unsigned, xs[2 * q + 1]);
                xh.u[q] = (b0 >> 16) | (b1 & 0xffff0000u);
                xl.u[q] = pk2(xs[2 * q] - __builtin_bit_cast(float, b0 & 0xffff0000u), xs[2 * q + 1] - __builtin_bit_cast(float, b1 & 0xffff0000u)); }
#pragma unroll
            for (int blk = 0; blk < 4; ++blk) { const bf16x8v ah = *(const bf16x8v*)(wh + (size_t)blk * 16 * D + k0), al = *(const bf16x8v*)(wl + (size_t)blk * 16 * D + k0);
                acc[blk] = __builtin_amdgcn_mfma_f32_16x16x32_bf16(ah, xh.v, acc[blk], 0, 0, 0);
                acc[blk] = __builtin_amdgcn_mfma_f32_16x16x32_bf16(al, xh.v, acc[blk], 0, 0, 0);
                acc[blk] = __builtin_amdgcn_mfma_f32_16x16x32_bf16(ah, xl.v, acc[blk], 0, 0, 0); }
        }
        ss += __shfl_xor(ss, 16); ss += __shfl_xor(ss, 32);
        const float rstd = 1.0f / sqrtf(ss * (1.0f / D) + EPS);
        LDS_WAIT();
#pragma unroll
        for (int blk = 0; blk < 4; ++blk)
#pragma unroll
            for (int r = 0; r < 4; ++r) { const int e = 16 * blk + 4 * kq + r; const float logit = acc[blk][r] * rstd + RB[(l * 3 + c) * NE + e]; S[j * 65 + e] = 1.0f / (1.0f + expf(-logit)); }
        LDS_WAIT();
        unsigned mlo = 0u, mhi = 0u; float ssum = 1.f;
        if (F.lane < 16) {
            ssum = 0.f;
            for (int it = 0; it < 8; ++it) { float best = -1e30f; int bi = 0;
                for (int e = 0; e < NE; ++e) { const bool taken = e < 32 ? ((mlo >> e) & 1u) : ((mhi >> (e - 32)) & 1u); const float v = S[F.lane * 65 + e] + rbias[e]; if (!taken && v > best) { best = v; bi = e; } }
                if (bi < 32) mlo |= 1u << bi; else mhi |= 1u << (bi - 32);
                ssum += S[F.lane * 65 + bi]; }
        }
        unsigned selbits = 0u;
        for (int tok = 0; tok < 16; ++tok) { const unsigned lo = __shfl(mlo, tok), hi = __shfl(mhi, tok); const float sm = __shfl(ssum, tok);
            const bool sel = F.lane < 32 ? ((lo >> F.lane) & 1u) : ((hi >> (F.lane - 32)) & 1u);
            if (sel) selbits |= 1u << tok;
            GATES[(size_t)(t0 + tok) * NE + F.lane] = sel ? S[tok * 65 + F.lane] / sm * 2.5f : 0.f; }
        const int ne = __popc(selbits);
        if (ne) { int pos = (int)__hip_atomic_fetch_add(ECNT + l * NE + F.lane, (unsigned)ne, __ATOMIC_RELAXED, __HIP_MEMORY_SCOPE_AGENT);
            for (int tok = 0; tok < 16; ++tok) if ((selbits >> tok) & 1u) { ELIST[(size_t)F.lane * T + pos] = t0 + tok; ++pos; } }
    }
}

__device__ __forceinline__ void ph_cxfix(const Args& a, const Frame& F, const float* cx_src_in, int l, int gate_idx, int nsplit) {
    const int Z = opaque_zero();
    const float* cx_src = cx_src_in + Z; float* CX = (float*)WSB(WS_CX); const float* part = (const float*)WSB(WS_PART); const float* gv = MODSP(a, l, 2, gate_idx);
    for (int i = blockIdx.x * 512 + F.tid; i < NCTX * (D / 4); i += F.G * 512) {
        f32x4 s = ((const f32x4*)part)[i];
#pragma unroll
        for (int k = 1; k < 8; ++k) if (k < nsplit) s += ((const f32x4*)(part + (size_t)k * NCTX * D))[i];
        ((f32x4*)CX)[i] = ((const f32x4*)cx_src)[i] + ((const f32x4*)gv)[i & (D / 4 - 1)] * s;
    }
}
template <int l> __device__ __forceinline__ void layer_body(const Args& a, const Frame& F, const XcdBarrier& bar, const int lo, const int hi) {
#define IN(k) (lo <= (k) && (k) < hi)
#if (PROBE_DUP & 256)
#define SEAM(k) do { if (IN(k) && IN((k) + 1)) { xcd_barrier(bar); xcd_barrier(bar); } } while (0)
#else
#define SEAM(k) do { if (IN(k) && IN((k) + 1)) xcd_barrier(bar); } while (0)
#endif
        const int base = 3 + 9 * l; const bool even = (l & 1) == 0; const int M = (l == 3) ? NLAT : T; const int M2 = (l >= 2) ? NLAT : T;
        if (IN(base + 0)) { if (l >= 1 && l <= 2) { ph_cxfix(a, F, (const float*)(a.ws + WS_CX), l - 1, 5, 6); xcd_barrier(bar); }
            wq_pull(a, F, l, -1); ph_norm(a, F, l, 0, F.gw, F.NGW); }
        SEAM(base + 0);
        if (IN(base + 1)) {
            const int Z = opaque_zero(); bf16_t* H = (bf16_t*)WSB(WS_H); bf16_t* WIN = WSETP(WS_WIN, l); bf16_t* P = (bf16_t*)WSB(WS_P);
            if (even) { pg8::RowIdent RM;
                { pg8::Gemm g{(bf16_t*)WSB(WS_H8E), WIN, M, 6144, D / 2}; pg8::StaticOrderX S; S.init(M, 6144, D / 2, F.G, (int)blockIdx.x);
                  pg8::EpiBf16X<0> E{P, EVEN_IN, nullptr, 1.f / WGU_SCALE};
                  pg8::gemm_phase_x<pg8::EpiBf16X<0>, pg8::StaticOrderX, pg8::RowIdent, true>(F.lds, g, S, E, RM); }
                __syncthreads();
                { pg8::Gemm g{H, WIN + (size_t)6144 * D, M, 6144, D}; pg8::StaticOrderX S; S.init(M, 6144, D, F.G, F.G - 1 - (int)blockIdx.x);
                  pg8::EpiBf16X<0> E{P + 6144, EVEN_IN, nullptr, 1.f};
                  pg8::gemm_phase_x<pg8::EpiBf16X<0>, pg8::StaticOrderX, pg8::RowIdent, false>(F.lds, g, S, E, RM); } }
            else { pg8::Gemm g{H, WIN, M, ODD_IN, D / 2}; pg8::StaticOrderX S; S.init(M, ODD_IN, D / 2, F.G, (int)blockIdx.x); pg8::RowIdent RM;
                pg8::EpiBf16X<1> E{P, ODD_IN, INP(I_ODD_BIN) + (size_t)(l >> 1) * ODD_IN, 1.f / WGU_SCALE};
                pg8::gemm_phase_x<pg8::EpiBf16X<1>, pg8::StaticOrderX, pg8::RowIdent, true>(F.lds, g, S, E, RM); }
            if (l < 3) wq_pull(a, F, l + 1, CW_ARR + base + 1);
        }
        SEAM(base + 1);
        if (IN(base + 2)) { if (even) { ph_e1(a, F, l); ph_hyf(a, F, l); } else ph_r1(a, F, l);
#if (PROBE_DUP & 1024)
            __syncthreads(); if (even) { ph_hyf(a, F, l); }
#endif
#if (PROBE_DUP & 2)
            __syncthreads(); if (even) { ph_e1(a, F, l, false); ph_hyf(a, F, l); } else ph_r1(a, F, l);
#endif
        }
        SEAM(base + 2);
        if (IN(base + 3)) { if (even) { ph_attn(a, F, l); __syncthreads(); ph_hyc(a, F, l); __syncthreads(); if (l == 0) ph_hyx(a, F, l); } else ph_sg(a, F, l);
#if (PROBE_DUP & 4)
            __syncthreads(); if (even) { ph_attn(a, F, l); __syncthreads(); ph_hyc(a, F, l); __syncthreads(); ph_hyx(a, F, l); } else ph_sg(a, F, l);
#endif
#if (PROBE_DUP & 16)
            __syncthreads(); if (even) { ph_hyc(a, F, l); }
#endif
#if (PROBE_DUP & 32)
            __syncthreads(); if (even) { ph_attn(a, F, l); }
#endif
#if (PROBE_DUP & 64)
            __syncthreads(); if (!even) { ph_sg(a, F, l); }
#endif
        }
        SEAM(base + 3);
        if (IN(base + 4)) { if (even) ph_hyt(a, F);
#if (PROBE_DUP & 8)
            __syncthreads(); if (even) ph_hyt(a, F);
#endif
        }
        SEAM(base + 4);
        if (IN(base + 5)) {
            const int Z = opaque_zero(); bf16_t* MIX = (bf16_t*)WSB(WS_MIX); bf16_t* WOUT = WSETP(WS_WOUT, l); float* CX = (float*)WSB(WS_CX);
            pg8::RowIdent RM;
            if (even) { pg8::Gemm g{MIX, WOUT, M2, D, D}; pg8::SplitCtxOrder S; S.init(M2, D, D, F.G, (int)blockIdx.x, 8);
                pg8::EpiResidX E{l == 0 ? INP(I_X) : AOUT, AOUT, MODSP(a, l, 0, 2), (float*)WSB(WS_PART), 1.f};
                pg8::gemm_phase_x<pg8::EpiResidX, pg8::SplitCtxOrder, pg8::RowIdent>(F.lds, g, S, E, RM); }
            else { pg8::Gemm g{MIX, WOUT, M2, D, D / 2}; pg8::SplitCtxOrder S; S.init(M2, D, D / 2, F.G, (int)blockIdx.x, 8);
                pg8::EpiResidX E{AOUT, AOUT, MODSP(a, l, 0, 2), (float*)WSB(WS_PART), 1.f / WGU_SCALE};
                pg8::gemm_phase_x<pg8::EpiResidX, pg8::SplitCtxOrder, pg8::RowIdent, true>(F.lds, g, S, E, RM); }
            if (l < 3) wq_pull(a, F, l + 1, CW_ARR + base + 5);
        }
        SEAM(base + 5);
        if (IN(base + 6)) { if (M2 > NLAT) { ph_cxfix(a, F, l == 0 ? a.in[I_CTX] : (const float*)(a.ws + WS_CX), l, 2, 8); xcd_barrier(bar); }
            if (F.wave >= 4) ph_norm(a, F, l, 1, (int)blockIdx.x * 4 + F.wave - 4, F.G * 4, true); else ph_router(a, F, l);
#if (PROBE_DUP & 2048)
            __syncthreads(); if (F.wave >= 4) ph_norm(a, F, l, 1, (int)blockIdx.x * 4 + F.wave - 4, F.G * 4, true);
#endif
            }
        SEAM(base + 6);
        if (IN(base + 7)) {
            const int Z = opaque_zero(); bf16_t* H = (bf16_t*)WSB(WS_H); bf16_t* WGU = WSETP(WS_WGU, l); bf16_t* P = (bf16_t*)WSB(WS_P);
            LAS int* tab = (LAS int*)(F.lds + TAB_OFF); LAS int* cntl = tab + 640;
            const unsigned* ECNT = (const unsigned*)WSB(WS_CTL) + CW_ECNT + l * NE;
            if (F.tid < NE) cntl[F.tid] = (int)__hip_atomic_load(ECNT + F.tid, __ATOMIC_RELAXED, __HIP_MEMORY_SCOPE_AGENT);
            __syncthreads();
            if (F.tid == 0) { int n = 0; for (int e = 0; e < NE; ++e) { const int nt_ = (cntl[e] + 255) >> 8; for (int t = 0; t < nt_; ++t) tab[n++] = e | (t << 8); } cntl[NE] = n; }
            __syncthreads();
            pg8::Gemm g{H, WGU, M2, GU_N, D / 2};
            pg8::MoeOrder S{tab, cntl, cntl[NE], (M2 / 256) * 8, F.G, (int)blockIdx.x, D / 128};
            pg8::RowList RM{(const int*)WSB(WS_ELIST)};
            pg8::EpiSwigluX E{(unsigned char*)P, (const float*)WSB(WS_GATES), (const int*)WSB(WS_ELIST), 1.f / WGU_SCALE};
            pg8::gemm_phase_x<pg8::EpiSwigluX, pg8::MoeOrder, pg8::RowList, true>(F.lds, g, S, E, RM);
#if (PROBE_DUP & 512)
            __syncthreads(); pg8::gemm_phase_x<pg8::EpiSwigluX, pg8::MoeOrder, pg8::RowList, true>(F.lds, g, S, E, RM);
#endif
            if (l < 3) wq_pull(a, F, l + 1, CW_ARR + base + 7);
        }
        SEAM(base + 7);
        if (IN(base + 8)) {
            const int Z = opaque_zero(); bf16_t* P = (bf16_t*)WSB(WS_P); bf16_t* WD = WSETP(WS_WD, l); float* CX = (float*)WSB(WS_CX);
            pg8::Gemm g{P, WD, M2, D, DN_K / 2}; pg8::SplitCtxOrder S; S.init(M2, D, DN_K / 2, F.G, (int)blockIdx.x, 6);
            pg8::EpiResidX E{AOUT, AOUT, MODSP(a, l, 0, 5), (float*)WSB(WS_PART), 1.f / WD_SCALE}; pg8::RowIdent RM;
            pg8::gemm_phase_x<pg8::EpiResidX, pg8::SplitCtxOrder, pg8::RowIdent, true>(F.lds, g, S, E, RM);
            if (l < 3) wq_pull(a, F, l + 1, CW_ARR + base + 8);
        }
        if (l < 3) SEAM(base + 8);
#undef IN
#undef SEAM
}

__global__ void __launch_bounds__(512, 2) fwd_kernel(Args a) {
    extern __shared__ __attribute__((aligned(16))) unsigned char lds_raw[];
    Frame F; F.lds = (LAS unsigned char*)lds_raw; F.tid = threadIdx.x; F.lane = F.tid & 63; F.wave = __builtin_amdgcn_readfirstlane(F.tid >> 6);
    F.G = gridDim.x; F.gw = blockIdx.x * 8 + F.wave; F.NGW = F.G * 8;
    volatile LAS unsigned* MISC = (volatile LAS unsigned*)(F.lds + MISC_OFF);
    if (F.tid < 32) MISC[F.tid] = 0u;
    __syncthreads();
    const int lo = a.ph_lo, hi = a.ph_hi;
    unsigned* barw = (unsigned*)(a.ws) + CW_BAR;
    XcdBarrier bar; bar.bar = barw; bar.x = 0; bar.st = MISC + 8;
    if (hi - lo > 1) bar = xcd_barrier_post(barw, MISC + 8);
#define IN(k) (lo <= (k) && (k) < hi)
#if (PROBE_DUP & 256)
#define SEAM(k) do { if (IN(k) && IN((k) + 1)) { xcd_barrier(bar); xcd_barrier(bar); } } while (0)
#else
#define SEAM(k) do { if (IN(k) && IN((k) + 1)) xcd_barrier(bar); } while (0)
#endif

    if (IN(0)) ph_mods1(a, F);
    SEAM(0);
    if (IN(1)) ph_mods2(a, F);
    SEAM(1);
    if (IN(2)) ph_rprep(a, F);
    SEAM(2);
#if (PROBE_DUP & 4096)
    ph_mods1(a, F); xcd_barrier(bar); ph_mods2(a, F); xcd_barrier(bar); ph_rprep(a, F); xcd_barrier(bar);
#endif
    layer_body<0>(a, F, bar, lo, hi);
    layer_body<1>(a, F, bar, lo, hi);
    layer_body<2>(a, F, bar, lo, hi);
    layer_body<3>(a, F, bar, lo, hi);
#undef IN
#undef SEAM
}
constexpr int N_PHASES = 3 + 9 * 4;

extern "C" void kernel_launch(void* const* d_in, const int* in_sizes, int n_in, void* d_out, int out_size, void* d_ws, size_t ws_size, hipStream_t stream) {
    static int grid = 0;
    if (grid == 0) {
        if (n_in != 38 || out_size != NLAT * D || ws_size < WS_END2) { fprintf(stderr, "kernel_launch: unexpected sizes (n_in %d, out %d, ws %zu < %zu)\n", n_in, out_size, ws_size, (size_t)WS_END2); grid = -1; return; }
        int dev = 0, cus = 0, per_cu = 0;
        if (hipGetDevice(&dev) != hipSuccess || hipDeviceGetAttribute(&cus, hipDeviceAttributeMultiprocessorCount, dev) != hipSuccess) { grid = -1; return; }
        if (hipFuncSetAttribute((const void*)fwd_kernel, hipFuncAttributeMaxDynamicSharedMemorySize, LDS_BYTES) != hipSuccess) { fprintf(stderr, "kernel_launch: hipFuncSetAttribute failed\n"); grid = -1; return; }
        if (hipOccupancyMaxActiveBlocksPerMultiprocessor(&per_cu, (const void*)fwd_kernel, 512, LDS_BYTES) != hipSuccess || per_cu < 1) fprintf(stderr, "kernel_launch: occupancy query reports %d\n", per_cu);
        (void)hipGetLastError();
        grid = cus;
    }
    if (grid < 0) return;
    (void)hipMemsetAsync((char*)d_ws + WS_CTL, 0, CTL_ZERO_BYTES, stream);
    Args a{};
    for (int i = 0; i < 38; ++i) a.in[i] = (const float*)d_in[i];
    a.out = (float*)d_out; a.ws = (unsigned char*)d_ws;
#if MK_PER_PHASE
    for (int k = 0; k < N_PHASES; ++k) { a.ph_lo = k; a.ph_hi = k + 1; hipLaunchKernelGGL(fwd_kernel, dim3(grid), dim3(512), LDS_BYTES, stream, a); }
#else
    a.ph_lo = 0; a.ph_hi = N_PHASES;
    hipLaunchKernelGGL(fwd_kernel, dim3(grid), dim3(512), LDS_BYTES, stream, a);
#endif
}
```

```cpp
#include <hip/hip_runtime.h>
#include <cstdio>
#include <cstdint>

#ifndef MK_PER_PHASE
#define MK_PER_PHASE 0
#endif

#ifndef PROBE_DUP
#define PROBE_DUP 0
#endif

constexpr int D = 4096, SEQ = 8192, NLAT = 16384, LC = 256, NCTX = 512, T = NLAT + NCTX;
constexpr int EVEN_IN = 12288, ODD_IN = 8192, NE = 64, ED = 128, SHD = 1024, RANK = 256;
constexpr int GU_N = (NE * ED + SHD) * 2;
constexpr int DN_K = NE * ED + SHD;
constexpr float EPS = 1e-6f;

namespace pg8 {
#define PG8_LAS __attribute__((address_space(3)))
typedef unsigned short bf16_t;
typedef short bf16x8 __attribute__((ext_vector_type(8)));
typedef float f32x4 __attribute__((ext_vector_type(4)));
typedef unsigned u32x4 __attribute__((ext_vector_type(4)));
constexpr int BM = 256, BK = 64, HALF = 128, HTB = HALF * BK * 2  , STAGE_BYTES = 8 * HTB, NXCD = 8, WGM = 8;

__host__ __device__ __forceinline__ int lds_byte(int r, int c) { const int st = (r >> 4) * 2 + (c >> 5), rr = r & 15, cc = c & 31, ob = rr * 64 + cc * 2; return st * 1024 + (ob ^ (((ob >> 9) & 1) << 5)); }
__host__ __device__ __forceinline__ void stage_rc(int b, int& R, int& C) { const int st = b / 1024, sb = b % 1024, swz = sb ^ (((sb >> 9) & 1) << 5); R = (st >> 1) * 16 + swz / 64; C = (st & 1) * 32 + (swz % 64) / 2; }
__host__ __device__ __forceinline__ int perm32(int rho) { const int n = rho >> 4, i = rho & 15; return 8 * (i >> 2) + 4 * n + (i & 3); }

struct Unit { int pm, pn; };
struct Gemm { const bf16_t* A; const bf16_t* Bt; int M, N, K; };

struct StaticOrder {
    int nM, nN, nwg, G, c;
    __host__ __device__ void init(int M, int N, int G_, int c_) { nM = M / BM; nN = N / BM; nwg = nM * nN; G = G_; c = c_; }
    __host__ __device__ bool next(int i, Unit& u) const {
        const long L = (long)i * G + c; if (L >= nwg) return false;
        int wgid = (int)L; { const int q = nwg / NXCD, r = nwg % NXCD, xcd = wgid % NXCD, off = wgid / NXCD; wgid = (xcd < r ? xcd * (q + 1) : r * (q + 1) + (xcd - r) * q) + off; }
        const int nig = WGM * nN, gid = wgid / nig, fm = gid * WGM, gsz = (nM - fm) < WGM ? (nM - fm) : WGM;
        u.pm = fm + ((wgid % nig) % gsz); u.pn = (wgid % nig) / gsz; return true;
    }
    __device__ __forceinline__ void a_ready(const Unit&) const {}
    __device__ __forceinline__ void done(const Unit&) const {}
};

__device__ __forceinline__ unsigned cvt_pk_bf16(float lo, float hi) { unsigned r; asm volatile("v_cvt_pk_bf16_f32 %0, %1, %2" : "=v"(r) : "v"(lo), "v"(hi)); return r; }
typedef float f32x2 __attribute__((ext_vector_type(2)));
__device__ __forceinline__ f32x2 gelu_pk(f32x2 v) {
    const f32x2 av = __builtin_elementwise_abs(v), d = av * 0.2316418882f + 1.0f;
    f32x2 t; t.x = __builtin_amdgcn_rcpf(d.x); t.y = __builtin_amdgcn_rcpf(d.y);
    f32x2 q = t * 0.5307027145f + (-0.7265760135f); q = q * t + 0.7107068705f; q = q * t + (-0.142248368f); q = q * t + 0.127414796f; q = q * t;
    const f32x2 s = (v * v) * (-0.72134752044f);
    f32x2 e; e.x = __builtin_amdgcn_exp2f(s.x); e.y = __builtin_amdgcn_exp2f(s.y);
    const f32x2 m = v * (q * e), r = v - m;
    f32x2 o; o.x = v.x < 0.f ? m.x : r.x; o.y = v.y < 0.f ? m.y : r.y; return o;
}

template <int ACT  > struct EpiBf16 {
    static constexpr bool PERM = true, AFTER_DRAIN = false; static_assert(ACT == 0 || ACT == 1, "EpiBf16: ACT is 0 (none) or 1 (gelu_pk)");
    bf16_t* O; int ldc; const float* bias; int split_cols; size_t split_stride; float scale0;
    __device__ __forceinline__ void operator()(const f32x4 (&acc)[2][2][4][2], const Unit& u, int wr, int wc, int fr, int fq) const {
        const int row0 = u.pm * BM + wr * 64 + fr; int colt = u.pn * BM; bf16_t* base = O;
        float sc = 1.f; if (split_cols) { const int t = colt / split_cols; base += (size_t)t * split_stride; colt -= t * split_cols; if (t == 0) sc = scale0; }
        const int col0 = colt + wc * 32 + 8 * fq, bcol0 = u.pn * BM + wc * 32 + 8 * fq;
        f32x4 bv[2][2];
#pragma unroll
        for (int bj = 0; bj < 2; ++bj)
#pragma unroll
            for (int n = 0; n < 2; ++n) bv[bj][n] = bias ? *(const f32x4*)(bias + bcol0 + bj * HALF + 4 * n) : (f32x4){0.f, 0.f, 0.f, 0.f};
#pragma unroll
        for (int ai = 0; ai < 2; ++ai)
#pragma unroll
            for (int m = 0; m < 4; ++m) { bf16_t* rowp = base + (size_t)(row0 + ai * HALF + m * 16) * ldc + col0;
#pragma unroll
                for (int bj = 0; bj < 2; ++bj) { f32x4 v0 = acc[ai][bj][m][0] + bv[bj][0], v1 = acc[ai][bj][m][1] + bv[bj][1];
                    if (ACT == 1) { f32x2 a = gelu_pk((f32x2){v0[0], v0[1]}), b = gelu_pk((f32x2){v0[2], v0[3]}), c = gelu_pk((f32x2){v1[0], v1[1]}), d = gelu_pk((f32x2){v1[2], v1[3]});
                        v0 = (f32x4){a.x, a.y, b.x, b.y}; v1 = (f32x4){c.x, c.y, d.x, d.y}; }
                    v0 = v0 * sc; v1 = v1 * sc; u32x4 w; w.x = cvt_pk_bf16(v0[0], v0[1]); w.y = cvt_pk_bf16(v0[2], v0[3]); w.z = cvt_pk_bf16(v1[0], v1[1]); w.w = cvt_pk_bf16(v1[2], v1[3]);
                    *(u32x4*)(rowp + bj * HALF) = w; } }
    }
};

struct EpiResid {
    static constexpr bool PERM = false, AFTER_DRAIN = false;
    const float* lat_src; const float* cx_src; float* lat_dst; float* cx_dst; const float* gate;
    __device__ __forceinline__ void operator()(const f32x4 (&acc)[2][2][4][2], const Unit& u, int wr, int wc, int fr, int fq) const {
        const int rowt = u.pm * BM; int c, rbase; const float* src; float* dst;
        if (rowt < NLAT) { c = rowt < SEQ ? 0 : 1; src = lat_src; dst = lat_dst; rbase = 0; } else { c = 2; src = cx_src; dst = cx_dst; rbase = NLAT; }
        const float* gv = gate + (size_t)c * 6 * D;
        const int row0 = rowt - rbase + wr * 64 + fr, col0 = u.pn * BM + wc * 32 + 4 * fq;
        f32x4 g[2][2];
#pragma unroll
        for (int bj = 0; bj < 2; ++bj)
#pragma unroll
            for (int n = 0; n < 2; ++n) g[bj][n] = *(const f32x4*)(gv + col0 + bj * HALF + n * 16);
#pragma unroll
        for (int ai = 0; ai < 2; ++ai)
#pragma unroll
            for (int m = 0; m < 4; ++m) { const size_t off = (size_t)(row0 + ai * HALF + m * 16) * D + col0;
#pragma unroll
                for (int bj = 0; bj < 2; ++bj)
#pragma unroll
                    for (int n = 0; n < 2; ++n) { const f32x4 s = *(const f32x4*)(src + off + bj * HALF + n * 16); *(f32x4*)(dst + off + bj * HALF + n * 16) = s + g[bj][n] * acc[ai][bj][m][n]; } }
    }
};
struct EpiSwiglu {
    static constexpr bool PERM = true, AFTER_DRAIN = false;
    bf16_t* H; const float* gates;
    __device__ __forceinline__ void operator()(const f32x4 (&acc)[2][2][4][2], const Unit& u, int wr, int wc, int fr, int fq) const {
        const int row0 = u.pm * BM + wr * 64 + fr, hc0 = u.pn * 128 + wc * 16 + 4 * fq;
#pragma unroll
        for (int ai = 0; ai < 2; ++ai)
#pragma unroll
            for (int m = 0; m < 4; ++m) { const int row = row0 + ai * HALF + m * 16; const float gt = (u.pn < NE) ? gates[(size_t)row * NE + u.pn] : 1.f;
#pragma unroll
                for (int bj = 0; bj < 2; ++bj) { const f32x4 v0 = acc[ai][bj][m][0], v1 = acc[ai][bj][m][1];
                    const float h0 = v0[0] / (1.f + __expf(-v0[0])) * v0[1] * gt, h1 = v0[2] / (1.f + __expf(-v0[2])) * v0[3] * gt;
                    const float h2 = v1[0] / (1.f + __expf(-v1[0])) * v1[1] * gt, h3 = v1[2] / (1.f + __expf(-v1[2])) * v1[3] * gt;
                    typedef unsigned u32x2v __attribute__((ext_vector_type(2))); u32x2v w; w.x = cvt_pk_bf16(h0, h1); w.y = cvt_pk_bf16(h2, h3);
                    *(u32x2v*)(H + (size_t)row * DN_K + hc0 + bj * 64) = w; } }
    }
};

template <class Epi, class Sched, bool ALIGN_EPI = false, bool SP2 = false>
__device__ __forceinline__ void gemm_phase(PG8_LAS unsigned char* lds, const Gemm g, const Sched& S, const Epi& E) {
    int tid_o = threadIdx.x; asm volatile("" : "+v"(tid_o));
    const int tid = tid_o, wid = __builtin_amdgcn_readfirstlane(tid >> 6), lane = tid & 63, wr = wid >> 2, wc = wid & 3, fr = lane & 15, fq = lane >> 4;
    const int K = g.K, nt = K / BK;
    unsigned voffA[2], voffB[2];
#pragma unroll
    for (int i = 0; i < 2; ++i) { int R, C; stage_rc(tid * 16 + i * 8192, R, C); const int Rb = Epi::PERM ? ((R & ~31) + perm32(R & 31)) : R;
        voffA[i] = (unsigned)(R * K + C) * 2u; voffB[i] = (unsigned)(Rb * K + C) * 2u; }
    const size_t kstep = (size_t)(BK * 2);
    const size_t hstep = (size_t)HALF * K * 2;
    const size_t tstep = 2 * hstep;
    const unsigned ldsw = (unsigned)wid * 1024u;
    const int aoff = lds_byte(wr * 64 + fr, fq * 8), boff = lds_byte(wc * 32 + fr, fq * 8);
#define PG8_SA(b, h) (((b) * 2 + (h)) * HTB)
#define PG8_SB(b, h) ((4 + (b) * 2 + (h)) * HTB)
#define PG8_STAGE(bufoff, gbase, voff) do { _Pragma("unroll") for (int _i = 0; _i < 2; ++_i) \
        __builtin_amdgcn_global_load_lds((const unsigned*)((const char*)(gbase) + (voff)[_i]), (PG8_LAS unsigned*)(lds + (bufoff) + ldsw + _i * 8192), 16, 0, 0); } while (0)
#define PG8_LDA(dst, b, h) do { _Pragma("unroll") for (int m = 0; m < 4; ++m) _Pragma("unroll") for (int k = 0; k < 2; ++k) dst[m][k] = *(const PG8_LAS bf16x8*)(lds + PG8_SA(b, h) + aoff + m * 2048 + k * 1024); } while (0)
#define PG8_LDB(dst, b, h) do { _Pragma("unroll") for (int n = 0; n < 2; ++n) _Pragma("unroll") for (int k = 0; k < 2; ++k) dst[n][k] = *(const PG8_LAS bf16x8*)(lds + PG8_SB(b, h) + boff + n * 2048 + k * 1024); } while (0)
#define PG8_MMA(ai, bj, At, Bt) do { __builtin_amdgcn_s_setprio(1); _Pragma("unroll") for (int m = 0; m < 4; ++m) _Pragma("unroll") for (int n = 0; n < 2; ++n) _Pragma("unroll") for (int k = 0; k < 2; ++k) \
        acc[ai][bj][m][n] = __builtin_amdgcn_mfma_f32_16x16x32_bf16(Bt[n][k], At[m][k], acc[ai][bj][m][n], 0, 0, 0); __builtin_amdgcn_s_setprio(0); } while (0)
#define PG8_WAIT_V(n) asm volatile("s_waitcnt vmcnt(" #n ")" ::: "memory")
#define PG8_WAIT_L(n) asm volatile("s_waitcnt lgkmcnt(" #n ")" ::: "memory")
#define PG8_BAR __builtin_amdgcn_s_barrier()
#define PG8_SCHED __builtin_amdgcn_sched_barrier(0)
    Unit cur, nxt; int ui = 0;
    if (!S.next(0, cur)) return;
    f32x4 acc[2][2][4][2];
#pragma unroll
    for (int a = 0; a < 2; ++a)
#pragma unroll
        for (int b = 0; b < 2; ++b)
#pragma unroll
            for (int m = 0; m < 4; ++m)
#pragma unroll
                for (int n = 0; n < 2; ++n) acc[a][b][m][n] = (f32x4){0.f, 0.f, 0.f, 0.f};
    bf16x8 At[4][2], B0[2][2], B1[2][2];
    const char* cA = (const char*)g.A + (size_t)cur.pm * tstep; const char* cB = (const char*)g.Bt + (size_t)cur.pn * tstep;
    S.a_ready(cur);
    if constexpr (SP2) {
        PG8_STAGE(PG8_SB(0, 0), cB, voffB); PG8_STAGE(PG8_SB(0, 1), cB + hstep, voffB); PG8_STAGE(PG8_SA(0, 0), cA, voffA); PG8_STAGE(PG8_SA(0, 1), cA + hstep, voffA);
        if (wr == 1) PG8_BAR;
        PG8_WAIT_V(2); PG8_BAR;
        PG8_STAGE(PG8_SB(1, 0), cB + kstep, voffB); PG8_STAGE(PG8_SA(1, 0), cA + kstep, voffA); PG8_STAGE(PG8_SB(1, 1), cB + hstep + kstep, voffB);
        PG8_WAIT_V(6); PG8_BAR;
    } else {
        PG8_STAGE(PG8_SB(0, 0), cB, voffB); PG8_STAGE(PG8_SA(0, 0), cA, voffA); PG8_STAGE(PG8_SB(0, 1), cB + hstep, voffB); PG8_STAGE(PG8_SA(0, 1), cA + hstep, voffA);
        if (wr == 1) PG8_BAR;
        PG8_WAIT_V(4); PG8_BAR;
        PG8_STAGE(PG8_SB(1, 0), cB + kstep, voffB); PG8_STAGE(PG8_SA(1, 0), cA + kstep, voffA); PG8_STAGE(PG8_SB(1, 1), cB + hstep + kstep, voffB);
        PG8_WAIT_V(6); PG8_BAR;
    }
    for (;;) {
        const bool has_next = S.next(ui + 1, nxt);
        const char* nA = has_next ? (const char*)g.A + (size_t)nxt.pm * tstep : cA; const char* nB = has_next ? (const char*)g.Bt + (size_t)nxt.pn * tstep : cB;
        for (int t = 0; t < nt; t += 2) {
            const bool last = (t == nt - 2);
            const char* a1 = cA + (size_t)(t + 1) * kstep;
            const char* a2 = last ? nA : cA + (size_t)(t + 2) * kstep; const char* b2 = last ? nB : cB + (size_t)(t + 2) * kstep;
            const char* a3 = a2 + kstep; const char* b3 = b2 + kstep;
            if (last && has_next) S.a_ready(nxt);
            if constexpr (SP2) {
            PG8_LDB(B0, 0, 0); PG8_LDB(B1, 0, 1); PG8_SCHED; PG8_LDA(At, 0, 0); PG8_STAGE(PG8_SA(1, 1), a1 + hstep, voffA);
            PG8_WAIT_V(8); PG8_WAIT_L(0); PG8_BAR; PG8_MMA(0, 0, At, B0); PG8_MMA(0, 1, At, B1); PG8_BAR; PG8_SCHED;
            PG8_LDA(At, 0, 1); PG8_STAGE(PG8_SB(0, 0), b2, voffB); PG8_STAGE(PG8_SB(0, 1), b2 + hstep, voffB); PG8_STAGE(PG8_SA(0, 0), a2, voffA);
            PG8_WAIT_V(8); PG8_WAIT_L(0); PG8_BAR; PG8_MMA(1, 0, At, B0); PG8_MMA(1, 1, At, B1); PG8_BAR; PG8_SCHED;
            PG8_LDB(B0, 1, 0); PG8_LDB(B1, 1, 1); PG8_SCHED; PG8_LDA(At, 1, 0); PG8_STAGE(PG8_SA(0, 1), a2 + hstep, voffA);
            PG8_WAIT_V(8); PG8_WAIT_L(0); PG8_BAR; PG8_MMA(0, 0, At, B0); PG8_MMA(0, 1, At, B1); PG8_BAR; PG8_SCHED;
            PG8_LDA(At, 1, 1); PG8_STAGE(PG8_SB(1, 0), b3, voffB); PG8_STAGE(PG8_SB(1, 1), b3 + hstep, voffB); PG8_STAGE(PG8_SA(1, 0), a3, voffA);
            PG8_WAIT_V(8); PG8_WAIT_L(0); PG8_BAR; PG8_MMA(1, 0, At, B0); PG8_MMA(1, 1, At, B1); PG8_BAR; PG8_SCHED;
            } else {
            PG8_LDB(B0, 0, 0); PG8_SCHED; PG8_LDA(At, 0, 0); PG8_STAGE(PG8_SA(1, 1), a1 + hstep, voffA);
            PG8_WAIT_L(8); PG8_BAR; PG8_WAIT_L(0); PG8_MMA(0, 0, At, B0); PG8_BAR; PG8_SCHED;
            PG8_LDB(B1, 0, 1); PG8_STAGE(PG8_SB(0, 0), b2, voffB);
            PG8_BAR; PG8_WAIT_L(0); PG8_MMA(0, 1, At, B1); PG8_BAR;
            PG8_LDA(At, 0, 1); PG8_STAGE(PG8_SA(0, 0), a2, voffA);
            PG8_BAR; PG8_WAIT_L(0); PG8_MMA(1, 0, At, B0); PG8_BAR; PG8_SCHED;
            PG8_STAGE(PG8_SB(0, 1), b2 + hstep, voffB);
            PG8_WAIT_V(6); PG8_BAR; PG8_MMA(1, 1, At, B1); PG8_BAR;
            PG8_LDB(B0, 1, 0); PG8_SCHED; PG8_LDA(At, 1, 0); PG8_STAGE(PG8_SA(0, 1), a2 + hstep, voffA);
            PG8_WAIT_L(8); PG8_BAR; PG8_WAIT_L(0); PG8_MMA(0, 0, At, B0); PG8_BAR; PG8_SCHED;
            PG8_LDB(B1, 1, 1); PG8_STAGE(PG8_SB(1, 0), b3, voffB);
            PG8_BAR; PG8_WAIT_L(0); PG8_MMA(0, 1, At, B1); PG8_BAR;
            PG8_LDA(At, 1, 1); PG8_STAGE(PG8_SA(1, 0), a3, voffA);
            PG8_BAR; PG8_WAIT_L(0); PG8_MMA(1, 0, At, B0); PG8_BAR; PG8_SCHED;
            PG8_STAGE(PG8_SB(1, 1), b3 + hstep, voffB);
            PG8_WAIT_V(6); PG8_BAR; PG8_MMA(1, 1, At, B1); PG8_BAR;
            }
        }
        if constexpr (ALIGN_EPI) { if (wr == 0) PG8_BAR; }
        if constexpr (!Epi::AFTER_DRAIN) { E(acc, cur, wr, wc, fr, fq); S.done(cur); }
        if (!has_next) break;
#pragma unroll
        for (int a = 0; a < 2; ++a)
#pragma unroll
            for (int b = 0; b < 2; ++b)
#pragma unroll
                for (int m = 0; m < 4; ++m)
#pragma unroll
                    for (int n = 0; n < 2; ++n) acc[a][b][m][n] = (f32x4){0.f, 0.f, 0.f, 0.f};
        cur = nxt; cA = nA; cB = nB; ++ui;
        if constexpr (ALIGN_EPI) { if (wr == 1) PG8_BAR; }
    }
    PG8_WAIT_V(0);
    if constexpr (!ALIGN_EPI) { if (wr == 0) PG8_BAR; }
    PG8_BAR;
    if constexpr (Epi::AFTER_DRAIN) { E.fused(acc, cur, wr, wc, fr, fq, lds, wid, lane); S.done(cur); }
#undef PG8_SA
#undef PG8_SB
#undef PG8_STAGE
#undef PG8_LDA
#undef PG8_LDB
#undef PG8_MMA
#undef PG8_WAIT_V
#undef PG8_WAIT_L
#undef PG8_BAR
#undef PG8_SCHED
}

struct UnitX { int pm, pn, e, nrows, k0, nt; };
typedef int i32x4 __attribute__((ext_vector_type(4)));
typedef int i32x8 __attribute__((ext_vector_type(8)));
template <class Epi, class Sched, class RowMap, bool F8 = false>
__device__ __forceinline__ void gemm_phase_x(PG8_LAS unsigned char* lds, const Gemm g, const Sched& S, const Epi& E, const RowMap& RM) {
    int tid_o = threadIdx.x; asm volatile("" : "+v"(tid_o));
    const int tid = tid_o, wid = __builtin_amdgcn_readfirstlane(tid >> 6), lane = tid & 63, wr = wid >> 2, wc = wid & 3, fr = lane & 15, fq = lane >> 4;
    const int K = g.K;
    int R_[2], C_[2]; unsigned voffB[2];
#pragma unroll
    for (int i = 0; i < 2; ++i) { stage_rc(tid * 16 + i * 8192, R_[i], C_[i]); const int Rb = Epi::PERM ? ((R_[i] & ~31) + perm32(R_[i] & 31)) : R_[i]; voffB[i] = (unsigned)(Rb * K + C_[i]) * 2u; }
    const size_t kstep = (size_t)(BK * 2);
    const size_t hstep = (size_t)HALF * K * 2;
    const size_t tstep = 2 * hstep;
    const unsigned ldsw = (unsigned)wid * 1024u;
    const int aoff = lds_byte(wr * 64 + fr, fq * 8), boff = lds_byte(wc * 32 + fr, fq * 8);
#define PG8_SA(b, h) (((b) * 2 + (h)) * HTB)
#define PG8_SB(b, h) ((4 + (b) * 2 + (h)) * HTB)
#define PG8_STAGE(bufoff, gbase, voff) do { _Pragma("unroll") for (int _i = 0; _i < 2; ++_i) \
        __builtin_amdgcn_global_load_lds((const unsigned*)((const char*)(gbase) + (voff)[_i]), (PG8_LAS unsigned*)(lds + (bufoff) + ldsw + _i * 8192), 16, 0, 0); } while (0)
#define PG8_LD8(dst, addr) do { const i32x4 _lo = *(const PG8_LAS i32x4*)(addr), _hi = *(const PG8_LAS i32x4*)((addr) + 1024); dst = __builtin_shufflevector(_lo, _hi, 0, 1, 2, 3, 4, 5, 6, 7); } while (0)
#define PG8_LDA(dst, b, h) do { _Pragma("unroll") for (int m = 0; m < 4; ++m) PG8_LD8(dst[m], lds + PG8_SA(b, h) + aoff + m * 2048); } while (0)
#define PG8_LDB(dst, b, h) do { _Pragma("unroll") for (int n = 0; n < 2; ++n) PG8_LD8(dst[n], lds + PG8_SB(b, h) + boff + n * 2048); } while (0)
#define PG8_LOH(v) __builtin_bit_cast(bf16x8, __builtin_shufflevector(v, v, 0, 1, 2, 3))
#define PG8_HIH(v) __builtin_bit_cast(bf16x8, __builtin_shufflevector(v, v, 4, 5, 6, 7))
#define PG8_MMA(ai, bj, At, Bt) do { __builtin_amdgcn_s_setprio(1); _Pragma("unroll") for (int m = 0; m < 4; ++m) _Pragma("unroll") for (int n = 0; n < 2; ++n) { \
        if constexpr (F8) asm volatile("v_mfma_scale_f32_16x16x128_f8f6f4 %0, %1, %2, %0, %3, %3 op_sel_hi:[0,0,0]" : "+v"(acc[ai][bj][m][n]) : "v"(Bt[n]), "v"(At[m]), "v"(sc8)); \
        else { acc[ai][bj][m][n] = __builtin_amdgcn_mfma_f32_16x16x32_bf16(PG8_LOH(Bt[n]), PG8_LOH(At[m]), acc[ai][bj][m][n], 0, 0, 0); \
               acc[ai][bj][m][n] = __builtin_amdgcn_mfma_f32_16x16x32_bf16(PG8_HIH(Bt[n]), PG8_HIH(At[m]), acc[ai][bj][m][n], 0, 0, 0); } } \
        __builtin_amdgcn_s_setprio(0); } while (0)
#define PG8_WAIT_V(n) asm volatile("s_waitcnt vmcnt(" #n ")" ::: "memory")
#define PG8_WAIT_L(n) asm volatile("s_waitcnt lgkmcnt(" #n ")" ::: "memory")
#define PG8_BAR __builtin_amdgcn_s_barrier()
#define PG8_SCHED __builtin_amdgcn_sched_barrier(0)
#define PG8_ROWOFF(dst, u) do { _Pragma("unroll") for (int _h = 0; _h < 2; ++_h) _Pragma("unroll") for (int _i = 0; _i < 2; ++_i) \
        dst[_h][_i] = (RM.row(u, _h * HALF + R_[_i]) * (unsigned)K + (unsigned)C_[_i]) * 2u; } while (0)
#define PG8_ABASE(u) ((const char*)g.A + ((size_t)RM.base(u) * K + (size_t)(u).k0) * 2)
    UnitX cur, nxt; int ui = 0;
    if (!S.next(0, cur)) return;
    f32x4 acc[2][2][4][2];
#pragma unroll
    for (int a = 0; a < 2; ++a)
#pragma unroll
        for (int b = 0; b < 2; ++b)
#pragma unroll
            for (int m = 0; m < 4; ++m)
#pragma unroll
                for (int n = 0; n < 2; ++n) acc[a][b][m][n] = (f32x4){0.f, 0.f, 0.f, 0.f};
    i32x8 At[4], B0[2], B1[2];
    const int sc8 = 0x7f7f7f7f;
    unsigned vc[2][2], vn[2][2];
    PG8_ROWOFF(vc, cur);
    const char* A0 = PG8_ABASE(cur);
    const char* cB = (const char*)g.Bt + (size_t)cur.pn * tstep + (size_t)cur.k0 * 2;
    PG8_STAGE(PG8_SB(0, 0), cB, voffB); PG8_STAGE(PG8_SB(0, 1), cB + hstep, voffB); PG8_STAGE(PG8_SA(0, 0), A0, vc[0]); PG8_STAGE(PG8_SA(0, 1), A0, vc[1]);
    if (wr == 1) PG8_BAR;
    PG8_WAIT_V(2); PG8_BAR;
    PG8_STAGE(PG8_SB(1, 0), cB + kstep, voffB); PG8_STAGE(PG8_SA(1, 0), A0 + kstep, vc[0]); PG8_STAGE(PG8_SB(1, 1), cB + hstep + kstep, voffB);
    PG8_WAIT_V(6); PG8_BAR;
    for (;;) {
        const bool has_next = S.next(ui + 1, nxt);
        if constexpr (!RowMap::IDENT) { if (has_next) { PG8_ROWOFF(vn, nxt); } else {
#pragma unroll
            for (int _h = 0; _h < 2; ++_h)
#pragma unroll
                for (int _i = 0; _i < 2; ++_i) vn[_h][_i] = vc[_h][_i]; } }
        const char* nB = has_next ? (const char*)g.Bt + (size_t)nxt.pn * tstep + (size_t)nxt.k0 * 2 : cB;
        const char* nA = has_next ? PG8_ABASE(nxt) : A0;
        const int nt = cur.nt;
        for (int t = 0; t < nt; t += 2) {
            const bool last = (t == nt - 2);
            const char* a1 = A0 + (size_t)(t + 1) * kstep;
            const char* a2 = last ? nA : A0 + (size_t)(t + 2) * kstep; const char* b2 = last ? nB : cB + (size_t)(t + 2) * kstep;
            const char* a3 = a2 + kstep; const char* b3 = b2 + kstep;
            unsigned v2h0[2], v2h1[2];
#pragma unroll
            for (int _i = 0; _i < 2; ++_i) { if constexpr (RowMap::IDENT) { v2h0[_i] = vc[0][_i]; v2h1[_i] = vc[1][_i]; } else { v2h0[_i] = last ? vn[0][_i] : vc[0][_i]; v2h1[_i] = last ? vn[1][_i] : vc[1][_i]; } }
            PG8_LDB(B0, 0, 0); PG8_LDB(B1, 0, 1); PG8_SCHED; PG8_LDA(At, 0, 0); PG8_STAGE(PG8_SA(1, 1), a1, vc[1]);
            PG8_WAIT_V(8); PG8_WAIT_L(0); PG8_BAR; PG8_MMA(0, 0, At, B0); PG8_MMA(0, 1, At, B1); PG8_BAR; PG8_SCHED;
            PG8_LDA(At, 0, 1); PG8_STAGE(PG8_SB(0, 0), b2, voffB); PG8_STAGE(PG8_SB(0, 1), b2 + hstep, voffB); PG8_STAGE(PG8_SA(0, 0), a2, v2h0);
            PG8_WAIT_V(8); PG8_WAIT_L(0); PG8_BAR; PG8_MMA(1, 0, At, B0); PG8_MMA(1, 1, At, B1); PG8_BAR; PG8_SCHED;
            PG8_LDB(B0, 1, 0); PG8_LDB(B1, 1, 1); PG8_SCHED; PG8_LDA(At, 1, 0); PG8_STAGE(PG8_SA(0, 1), a2, v2h1);
            PG8_WAIT_V(8); PG8_WAIT_L(0); PG8_BAR; PG8_MMA(0, 0, At, B0); PG8_MMA(0, 1, At, B1); PG8_BAR; PG8_SCHED;
            PG8_LDA(At, 1, 1); PG8_STAGE(PG8_SB(1, 0), b3, voffB); PG8_STAGE(PG8_SB(1, 1), b3 + hstep, voffB); PG8_STAGE(PG8_SA(1, 0), a3, v2h0);
            PG8_WAIT_V(8); PG8_WAIT_L(0); PG8_BAR; PG8_MMA(1, 0, At, B0); PG8_MMA(1, 1, At, B1); PG8_BAR; PG8_SCHED;
        }
        if constexpr (F8) asm volatile("s_nop 7\n\ts_nop 7\n\ts_nop 7" ::: "memory");
        if (wr == 0) PG8_BAR;
        E(acc, cur, wr, wc, fr, fq);
        if (!has_next) break;
#pragma unroll
        for (int a = 0; a < 2; ++a)
#pragma unroll
            for (int b = 0; b < 2; ++b)
#pragma unroll
                for (int m = 0; m < 4; ++m)
#pragma unroll
                    for (int n = 0; n < 2; ++n) acc[a][b][m][n] = (f32x4){0.f, 0.f, 0.f, 0.f};
        cur = nxt; cB = nB; A0 = nA; ++ui;
        if constexpr (!RowMap::IDENT) {
#pragma unroll
        for (int _h = 0; _h < 2; ++_h)
#pragma unroll
            for (int _i = 0; _i < 2; ++_i) vc[_h][_i] = vn[_h][_i]; }
        if (wr == 1) PG8_BAR;
    }
    PG8_WAIT_V(0);
    PG8_BAR;
#undef PG8_SA
#undef PG8_SB
#undef PG8_STAGE
#undef PG8_LDA
#undef PG8_LDB
#undef PG8_LD8
#undef PG8_LOH
#undef PG8_HIH
#undef PG8_MMA
#undef PG8_WAIT_V
#undef PG8_WAIT_L
#undef PG8_BAR
#undef PG8_SCHED
#undef PG8_ROWOFF
#undef PG8_ABASE
}

struct MoeOrder {
    const PG8_LAS int* tab; const PG8_LAS int* cnt; int Ur, nSh, G, c, ntk;
    __device__ __forceinline__ bool next(int i, UnitX& u) const {
        int L = i * G + c; u.k0 = 0; u.nt = ntk;
        if (L < Ur) { const int v = tab[L]; u.e = v & 255; u.pm = v >> 8; u.pn = u.e; u.nrows = cnt[u.e]; return true; }
        L -= Ur;
        if (L < nSh) { u.e = -1; u.pm = L >> 3; u.pn = NE + (L & 7); u.nrows = 0; return true; }
        return false;
    }
};
struct RowList {
    const int* list;
    static constexpr bool IDENT = false;
    __device__ __forceinline__ unsigned base(const UnitX&) const { return 0u; }
    __device__ __forceinline__ unsigned row(const UnitX& u, int r) const {
        if (u.e < 0) return (unsigned)(u.pm * BM + r);
        int i = u.pm * BM + r; i = i < u.nrows ? i : u.nrows - 1;
        return (unsigned)list[(size_t)u.e * T + i];
    }
};
struct EpiSwigluX {
    static constexpr bool PERM = true, AFTER_DRAIN = false;
    unsigned char* H; const float* gates; const int* list; float oscale;
    __device__ __forceinline__ void operator()(const f32x4 (&acc)[2][2][4][2], const UnitX& u, int wr, int wc, int fr, int fq) const {
        const int hc0 = u.pn * 128 + wc * 16 + 4 * fq;
#pragma unroll
        for (int ai = 0; ai < 2; ++ai)
#pragma unroll
            for (int m = 0; m < 4; ++m) { const int rloc = u.pm * BM + wr * 64 + fr + ai * HALF + m * 16; int tok = rloc; float gt = 1.f; bool ok = true;
                if (u.e >= 0) { ok = rloc < u.nrows; tok = ok ? list[(size_t)u.e * T + rloc] : 0; gt = ok ? gates[(size_t)tok * NE + u.e] : 0.f; }
                if (ok) {
#pragma unroll
                for (int bj = 0; bj < 2; ++bj) { const f32x4 v0 = acc[ai][bj][m][0] * oscale, v1 = acc[ai][bj][m][1] * oscale;
                    const float h0 = v0[0] / (1.f + __expf(-v0[0])) * v0[1] * gt, h1 = v0[2] / (1.f + __expf(-v0[2])) * v0[3] * gt;
                    const float h2 = v1[0] / (1.f + __expf(-v1[0])) * v1[1] * gt, h3 = v1[2] / (1.f + __expf(-v1[2])) * v1[3] * gt;
                    int w = __builtin_amdgcn_cvt_pk_fp8_f32(__builtin_amdgcn_fmed3f(h0, -448.f, 448.f), __builtin_amdgcn_fmed3f(h1, -448.f, 448.f), 0, false); w = __builtin_amdgcn_cvt_pk_fp8_f32(__builtin_amdgcn_fmed3f(h2, -448.f, 448.f), __builtin_amdgcn_fmed3f(h3, -448.f, 448.f), w, true);
                    *(int*)(H + (size_t)tok * DN_K + hc0 + bj * 64) = w; } } }
    }
};

struct SplitCtxOrder {
    int nN, G, c, ntk, nlat, nsub, nsplit;
    __device__ __forceinline__ void init(int M, int N, int K, int G_, int c_, int nsplit_) { nN = N / BM; G = G_; c = c_; ntk = K / BK; nsplit = nsplit_; nlat = (NLAT / BM) * nN; nsub = (M > NLAT) ? ((M - NLAT) / BM) * nN * nsplit : 0; }
    __device__ __forceinline__ bool next(int i, UnitX& u) const {
        int L = i * G + c; u.e = -1; u.nrows = 0;
        if (L < nlat) { int wgid = L; { const int q = nlat / NXCD, xcd = wgid % NXCD, off = wgid / NXCD; wgid = xcd * q + off; }
            const int nig = WGM * nN, gid = wgid / nig, fm = gid * WGM; u.pm = fm + ((wgid % nig) % WGM); u.pn = (wgid % nig) / WGM; u.k0 = 0; u.nt = ntk; return true; }
        L -= nlat;
        if (L < nsub) { const int tile = L / nsplit, s = L % nsplit; u.pm = NLAT / BM + tile / nN; u.pn = tile % nN; u.nt = ntk / nsplit; u.k0 = s * (ntk / nsplit) * BK; u.e = -2 - s; return true; }
        return false;
    }
};
struct RowIdent { static constexpr bool IDENT = true;
                  __device__ __forceinline__ unsigned base(const UnitX& u) const { return (unsigned)(u.pm * BM); }
                  __device__ __forceinline__ unsigned row(const UnitX&, int r) const { return (unsigned)r; } };
struct EpiResidX {
    static constexpr bool PERM = false, AFTER_DRAIN = false;
    const float* lat_src; float* lat_dst; const float* gate; float* part; float oscale;
    __device__ __forceinline__ void operator()(const f32x4 (&acc)[2][2][4][2], const UnitX& u, int wr, int wc, int fr, int fq) const {
        const int rowt = u.pm * BM, col0 = u.pn * BM + wc * 32 + 4 * fq;
        if (u.e <= -2) {
            float* pp = part + (size_t)(-2 - u.e) * NCTX * D; const int row0 = rowt - NLAT + wr * 64 + fr;
#pragma unroll
            for (int ai = 0; ai < 2; ++ai)
#pragma unroll
                for (int m = 0; m < 4; ++m) { const size_t off = (size_t)(row0 + ai * HALF + m * 16) * D + col0;
#pragma unroll
                    for (int bj = 0; bj < 2; ++bj)
#pragma unroll
                        for (int n = 0; n < 2; ++n) *(f32x4*)(pp + off + bj * HALF + n * 16) = acc[ai][bj][m][n] * oscale; }
            return; }
        const int c = rowt < SEQ ? 0 : 1; const float* gv = gate + (size_t)c * 6 * D; const int row0 = rowt + wr * 64 + fr;
        f32x4 g[2][2];
#pragma unroll
        for (int bj = 0; bj < 2; ++bj)
#pragma unroll
            for (int n = 0; n < 2; ++n) g[bj][n] = *(const f32x4*)(gv + col0 + bj * HALF + n * 16) * oscale;
#pragma unroll
        for (int ai = 0; ai < 2; ++ai)
#pragma unroll
            for (int m = 0; m < 4; ++m) { const size_t off = (size_t)(row0 + ai * HALF + m * 16) * D + col0;
#pragma unroll
                for (int bj = 0; bj < 2; ++bj)
#pragma unroll
                    for (int n = 0; n < 2; ++n) { const f32x4 s = *(const f32x4*)(lat_src + off + bj * HALF + n * 16); *(f32x4*)(lat_dst + off + bj * HALF + n * 16) = s + g[bj][n] * acc[ai][bj][m][n]; } }
    }
};

struct StaticOrderX {
    int nM, nN, nwg, G, c, ntk;
    __device__ __forceinline__ void init(int M, int N, int K, int G_, int c_) { nM = M / BM; nN = N / BM; nwg = nM * nN; G = G_; c = c_; ntk = K / BK; }
    __device__ __forceinline__ bool next(int i, UnitX& u) const {
        const long L = (long)i * G + c; if (L >= nwg) return false;
        int wgid = (int)L; { const int q = nwg / NXCD, r = nwg % NXCD, xcd = wgid % NXCD, off = wgid / NXCD; wgid = (xcd < r ? xcd * (q + 1) : r * (q + 1) + (xcd - r) * q) + off; }
        const int nig = WGM * nN, gid = wgid / nig, fm = gid * WGM, gsz = (nM - fm) < WGM ? (nM - fm) : WGM;
        u.pm = fm + ((wgid % nig) % gsz); u.pn = (wgid % nig) / gsz; u.e = -1; u.nrows = 0; u.k0 = 0; u.nt = ntk; return true;
    }
};
template <int ACT> struct EpiBf16X {
    static constexpr bool PERM = true, AFTER_DRAIN = false;
    bf16_t* O; int ldc; const float* bias; float oscale;
    __device__ __forceinline__ void operator()(const f32x4 (&acc)[2][2][4][2], const UnitX& u, int wr, int wc, int fr, int fq) const {
        const int row0 = u.pm * BM + wr * 64 + fr, col0 = u.pn * BM + wc * 32 + 8 * fq;
        f32x4 bv[2][2];
#pragma unroll
        for (int bj = 0; bj < 2; ++bj)
#pragma unroll
            for (int n = 0; n < 2; ++n) bv[bj][n] = bias ? *(const f32x4*)(bias + col0 + bj * HALF + 4 * n) : (f32x4){0.f, 0.f, 0.f, 0.f};
#pragma unroll
        for (int ai = 0; ai < 2; ++ai)
#pragma unroll
            for (int m = 0; m < 4; ++m) { bf16_t* rowp = O + (size_t)(row0 + ai * HALF + m * 16) * ldc + col0;
#pragma unroll
                for (int bj = 0; bj < 2; ++bj) { f32x4 v0 = acc[ai][bj][m][0] * oscale + bv[bj][0], v1 = acc[ai][bj][m][1] * oscale + bv[bj][1];
                    if (ACT == 1) { f32x2 a = gelu_pk((f32x2){v0[0], v0[1]}), b = gelu_pk((f32x2){v0[2], v0[3]}), c = gelu_pk((f32x2){v1[0], v1[1]}), d = gelu_pk((f32x2){v1[2], v1[3]});
                        v0 = (f32x4){a.x, a.y, b.x, b.y}; v1 = (f32x4){c.x, c.y, d.x, d.y}; }
                    u32x4 w; w.x = cvt_pk_bf16(v0[0], v0[1]); w.y = cvt_pk_bf16(v0[2], v0[3]); w.z = cvt_pk_bf16(v1[0], v1[1]); w.w = cvt_pk_bf16(v1[2], v1[3]);
                    *(u32x4*)(rowp + bj * HALF) = w; } }
    }
};
}

#ifndef PG8_SP2
#define PG8_SP2 true
#endif
#ifndef PG8_ALIGN
#define PG8_ALIGN true
#endif

#define LAS __attribute__((address_space(3)))
typedef unsigned short bf16_t;
typedef float f32x4 __attribute__((ext_vector_type(4)));
typedef unsigned u32x4 __attribute__((ext_vector_type(4)));
typedef unsigned u32x2 __attribute__((ext_vector_type(2)));

constexpr size_t MiB = 1u << 20;
constexpr size_t WS_CTL = 0, CTL_ZERO_BYTES = 1 * MiB;
constexpr size_t WS_MODS = 1 * MiB;
constexpr size_t WS_RPART = 3 * MiB;
constexpr size_t WS_WR = 4 * MiB;
constexpr size_t WS_RB = 16 * MiB;
constexpr size_t WS_RSTDV = 16 * MiB + 65536;
constexpr size_t WS_GATES = 17 * MiB;
constexpr size_t WS_CX = 22 * MiB;
constexpr size_t WS_WIN = 30 * MiB;
constexpr size_t WS_WOUT = WS_WIN + 96 * MiB;
constexpr size_t WS_WGU = WS_WOUT + 32 * MiB;
constexpr size_t WS_WD = WS_WGU + 144 * MiB;
constexpr size_t WS_H = WS_WD + 72 * MiB;
constexpr size_t WS_P = WS_H + 132 * MiB;
constexpr size_t WS_MIX = WS_P + 396 * MiB;
constexpr size_t WS_UT = WS_MIX + 132 * MiB;
constexpr size_t WS_FILT = WS_UT + 384 * MiB;
constexpr size_t WS_FILTC = WS_FILT + 256 * MiB;
constexpr size_t WS_Z2T = WS_FILTC + 8 * MiB;
constexpr size_t WS_END = WS_Z2T + 128 * MiB;
constexpr size_t WS_WSET2 = WS_END;
constexpr size_t WSET_BYTES = 344 * MiB;
constexpr size_t WS_PART = WS_WSET2 + WSET_BYTES;
constexpr size_t WS_ELIST = WS_PART + 64 * MiB;
constexpr size_t WS_H8E = WS_ELIST + 5 * MiB;
constexpr size_t WS_END2 = WS_H8E + 66 * MiB;
constexpr int CW_BAR = 4096;
constexpr int CW_ECNT = 8192;
constexpr int CW_WQ = 8704;
constexpr int CW_ARR = 8768;
constexpr int TAB_OFF = 131072;

constexpr int LDS_BYTES = 147456;
constexpr int MISC_OFF = 147200;

#define XB_TMO      128
#define XB_XCNT(j)  (256  + 64 * (j))
#define XB_XSUB(j)  (1280 + 64 * (j))
#define XB_XGEN(j)  (2304 + 64 * (j))
#define XB_TOP      3328
#define XB_TOPGEN   3392
#define XCD_BAR_WORDS 3456
#define XB_SPIN_CAP (1u << 21)

__device__ __forceinline__ unsigned xb_ld(unsigned* p)              { return __hip_atomic_load(p, __ATOMIC_RELAXED, __HIP_MEMORY_SCOPE_AGENT); }
__device__ __forceinline__ unsigned xb_add(unsigned* p, unsigned v) { return __hip_atomic_fetch_add(p, v, __ATOMIC_RELAXED, __HIP_MEMORY_SCOPE_AGENT); }
__device__ __forceinline__ unsigned xb_xcc_id() { return (unsigned)__builtin_amdgcn_s_getreg((3 << 11) | 20) & 0xFu; }
#define XB_SPIN(cond, bar) do { unsigned _sp = 0; while (cond) { __builtin_amdgcn_s_sleep(1); \
    if ((++_sp & 255u) == 0u) { if (xb_ld(&(bar)[XB_TMO])) break; if (_sp > XB_SPIN_CAP) { atomicAdd(&(bar)[XB_TMO], 1u); break; } } } } while (0)

struct XcdBarrier { unsigned* bar; unsigned x; volatile LAS unsigned* st; };

__device__ __forceinline__ XcdBarrier xcd_barrier_post(unsigned* bar, volatile LAS unsigned* st) {
    XcdBarrier b; b.bar = bar; b.x = xb_xcc_id(); b.st = st;
    if (threadIdx.x == 0) (void)xb_add(&bar[XB_XCNT(b.x)], 1u);
    return b;
}
__device__ __forceinline__ void xcd_barrier_complete(unsigned* bar, unsigned x, unsigned& nloc, unsigned& nx) {
    const unsigned G = gridDim.x * gridDim.y * gridDim.z;
    unsigned sum, cnt, mine, sp = 0u;
    for (;;) {
        sum = 0u; cnt = 0u; mine = 0u;
#pragma unroll
        for (unsigned j = 0; j < 16; ++j) { const unsigned c = xb_ld(&bar[XB_XCNT(j)]); sum += c; cnt += (c > 0u) ? 1u : 0u; mine = (j == x) ? c : mine; }
        if (sum == G) break;
        __builtin_amdgcn_s_sleep(1);
        if ((++sp & 255u) == 0u) { if (xb_ld(&bar[XB_TMO])) break; if (sp > XB_SPIN_CAP) { atomicAdd(&bar[XB_TMO], 1u); break; } }
    }
    nloc = mine > 0u ? mine : 1u; nx = cnt > 0u ? cnt : 1u;
}
__device__ __forceinline__ void xcd_barrier(const XcdBarrier& b) {
    asm volatile("s_waitcnt vmcnt(0)" ::: "memory");
    __syncthreads();
    if (threadIdx.x == 0) {
        unsigned* bar = b.bar;
        __builtin_amdgcn_s_waitcnt(0);
        unsigned nloc = b.st[0], nx = b.st[1];
        if (nloc == 0u) { xcd_barrier_complete(bar, b.x, nloc, nx); b.st[0] = nloc; b.st[1] = nx; }
        const unsigned old = xb_add(&bar[XB_XSUB(b.x)], 1u);
        const unsigned gen = old / nloc;
        if (old + 1u == (gen + 1u) * nloc) {
            __builtin_amdgcn_fence(__ATOMIC_RELEASE, "agent");
            asm volatile("s_waitcnt vmcnt(0)" ::: "memory");
            const unsigned og = xb_add(&bar[XB_TOP], 1u);
            const unsigned tg = og / nx;
            if (og + 1u == (tg + 1u) * nx) xb_add(&bar[XB_TOPGEN], 1u);
            else XB_SPIN(xb_ld(&bar[XB_TOPGEN]) == tg, bar);
            __builtin_amdgcn_fence(__ATOMIC_ACQUIRE, "agent");
            xb_add(&bar[XB_XGEN(b.x)], 1u);
            asm volatile("s_waitcnt vmcnt(0)" ::: "memory");
        } else {
            XB_SPIN(xb_ld(&bar[XB_XGEN(b.x)]) == gen, bar);
            __builtin_amdgcn_fence(__ATOMIC_ACQUIRE, "agent");
            asm volatile("s_waitcnt vmcnt(0)" ::: "memory");
        }
    }
    __syncthreads();
}

struct Args { const float* in[38]; float* out; unsigned char* ws; int ph_lo, ph_hi; };
enum { I_X = 0, I_C, I_CTX, I_CCTX, I_ADA_A, I_ADA_B, I_ADA_BIAS, I_NORM_MIX, I_NORM_FFN, I_EVEN_WIN, I_QGAIN, I_KGAIN, I_RPB, I_HY_CW, I_HY_CB,
       I_HY_W1, I_HY_B1, I_HY_W2, I_HY_B2, I_HY_W3, I_HY_B3, I_HY_W4, I_HY_FREQ, I_HY_SKIP, I_ODD_WIN, I_ODD_BIN, I_GM_VGAIN, I_GM_WS, I_GM_BS, I_WOUT,
       I_ROUTER, I_MOE_BIAS, I_MOE_WG, I_MOE_WU, I_MOE_WD, I_SH_WG, I_SH_WU, I_SH_WD };

struct Frame { LAS unsigned char* lds; int tid, lane, wave, G, gw, NGW; };

#define LDS_WAIT() asm volatile("s_waitcnt lgkmcnt(0)" ::: "memory")
__device__ __forceinline__ int opaque_zero() { int z; asm volatile("s_mov_b32 %0, 0" : "=s"(z)); return z; }
#define INP(i) (a.in[(i) + Z])
#define WSB(off) (a.ws + ((size_t)(off) + (size_t)Z))
#define AOUT (a.out + (size_t)Z)
#define WSETP(off, l_) ((bf16_t*)(a.ws + (((l_) & 1) ? (WS_WSET2 + ((off) - WS_WIN)) : (off)) + (size_t)Z))
__device__ __forceinline__ unsigned f2bf(float f) { unsigned u = __builtin_bit_cast(unsigned, f); return (u + 0x7fffu + ((u >> 16) & 1u)) >> 16; }
__device__ __forceinline__ unsigned pk2(float lo, float hi) { return f2bf(lo) | (f2bf(hi) << 16); }
__device__ __forceinline__ float sat8(float v) { return __builtin_amdgcn_fmed3f(v, -448.f, 448.f); }
__device__ __forceinline__ unsigned pk4f8(float a0, float a1, float a2, float a3) { a0 = sat8(a0); a1 = sat8(a1); a2 = sat8(a2); a3 = sat8(a3); int w = __builtin_amdgcn_cvt_pk_fp8_f32(a0, a1, 0, false); w = __builtin_amdgcn_cvt_pk_fp8_f32(a2, a3, w, true); return (unsigned)w; }
__device__ __forceinline__ float bflo(unsigned u) { return __builtin_bit_cast(float, u << 16); }
__device__ __forceinline__ float bfhi(unsigned u) { return __builtin_bit_cast(float, u & 0xffff0000u); }
__device__ __forceinline__ float bf2f(bf16_t b) { return __builtin_bit_cast(float, ((unsigned)b) << 16); }
__device__ __forceinline__ float wave_sum(float v) {
#pragma unroll
    for (int o = 1; o < 64; o <<= 1) v += __shfl_xor(v, o);
    return v;
}
__device__ __forceinline__ float wave_max(float v) {
#pragma unroll
    for (int o = 1; o < 64; o <<= 1) v = fmaxf(v, __shfl_xor(v, o));
    return v;
}
__device__ __forceinline__ float* MODSP_(unsigned char* wsz, int l, int c, int i) { return (float*)(wsz + WS_MODS) + ((size_t)(l * 3 + c) * 6 + i) * D; }
#define MODSP(a_, l_, c_, i_) MODSP_(WSB(0), l_, c_, i_)

__device__ __forceinline__ void ph_mods1(const Args& a, const Frame& F) {
    const int Z = opaque_zero();
    LAS float* red = (LAS float*)F.lds;
    const float* c = INP(I_C); const float* cc = INP(I_CCTX); const float* A = INP(I_ADA_A);
    float* rpart = (float*)WSB(WS_RPART);
    for (int it = blockIdx.x; it < 4 * 64; it += F.G) {
        const int l = it >> 6, kc = it & 63, j = F.tid & 255, half = F.tid >> 8, k0 = kc * 64 + half * 32;
        float s0 = 0.f, s1 = 0.f, s2 = 0.f;
        const float* Ap = A + ((size_t)l * D + k0) * RANK + j;
        for (int k = 0; k < 32; ++k) {
            const float w = Ap[(size_t)k * RANK]; const float x0 = c[k0 + k], x1 = c[D + k0 + k], x2 = cc[k0 + k];
            s0 += x0 / (1.f + expf(-x0)) * w; s1 += x1 / (1.f + expf(-x1)) * w; s2 += x2 / (1.f + expf(-x2)) * w;
        }
        if (half == 1) { red[j] = s0; red[256 + j] = s1; red[512 + j] = s2; }
        __syncthreads();
        if (half == 0) { float* o = rpart + (size_t)(l * 64 + kc) * 768; o[j] = s0 + red[j]; o[256 + j] = s1 + red[256 + j]; o[512 + j] = s2 + red[512 + j]; }
        __syncthreads();
    }
}
__device__ __forceinline__ void ph_mods2(const Args& a, const Frame& F) {
    const int Z = opaque_zero();
    LAS float* r = (LAS float*)F.lds;
    const float* rpart = (const float*)WSB(WS_RPART); const float* B = INP(I_ADA_B); const float* bias = INP(I_ADA_BIAS);
    for (int it = blockIdx.x; it < 4 * 48; it += F.G) {
        const int l = it / 48, nc = it % 48;
        for (int idx = F.tid; idx < 768; idx += 512) { float s = 0.f; for (int kc = 0; kc < 64; ++kc) s += rpart[(size_t)(l * 64 + kc) * 768 + idx]; r[idx] = s; }
        __syncthreads();
        const int n = nc * 512 + F.tid; const float* Bp = B + (size_t)l * RANK * 24576 + n;
        float s0 = bias[l * 24576 + n], s1 = s0, s2 = s0;
        for (int j = 0; j < RANK; ++j) { const float w = Bp[(size_t)j * 24576]; s0 += r[j] * w; s1 += r[256 + j] * w; s2 += r[512 + j] * w; }
        float* M = (float*)WSB(WS_MODS);
        M[(size_t)(l * 3 + 0) * 24576 + n] = s0; M[(size_t)(l * 3 + 1) * 24576 + n] = s1; M[(size_t)(l * 3 + 2) * 24576 + n] = s2;
        __syncthreads();
    }
}
__device__ __forceinline__ void ph_rprep(const Args& a, const Frame& F) {
    const int Z = opaque_zero();
    LAS float* tile = (LAS float*)F.lds;
    bf16_t* WRH = (bf16_t*)WSB(WS_WR); bf16_t* WRL = WRH + (size_t)4 * 3 * NE * D; float* RB = (float*)WSB(WS_RB);
    for (int it = blockIdx.x; it < 4 * 64; it += F.G) {
        const int l = it >> 6, kc = it & 63, k0 = kc * 64;
        const float* Wr = INP(I_ROUTER) + ((size_t)l * D + k0) * NE;
        for (int idx = F.tid; idx < 4096; idx += 512) tile[(idx >> 6) * 65 + (idx & 63)] = Wr[idx];
        __syncthreads();
        const float* g = INP(I_NORM_FFN) + (size_t)l * D;
        for (int c = 0; c < 3; ++c) {
            const float* sc = MODSP(a, l, c, 4); const size_t ob = (size_t)(l * 3 + c) * NE * D;
            for (int idx = F.tid; idx < 4096; idx += 512) { const int e = idx >> 6, kk = idx & 63, k = k0 + kk; const float v = tile[kk * 65 + e] * (g[k] * (1.f + sc[k]));
                const unsigned hb = __builtin_bit_cast(unsigned, v) & 0xffff0000u; const float lo = v - __builtin_bit_cast(float, hb);
                WRH[ob + (size_t)e * D + k] = (bf16_t)(hb >> 16); WRL[ob + (size_t)e * D + k] = (bf16_t)f2bf(lo); }
        }
        __syncthreads();
    }
    for (int task = F.gw; task < 4 * 3 * NE; task += F.NGW) {
        const int l = task / 192, c = (task / 64) % 3, e = task & 63;
        const float* sh = MODSP(a, l, c, 3); const float* Wr = INP(I_ROUTER) + (size_t)l * D * NE + e; float s = 0.f;
        for (int k = F.lane; k < D; k += 64) s += sh[k] * Wr[(size_t)k * NE];
        s = wave_sum(s); if (F.lane == 0) RB[task] = s;
    }
}

__device__ __forceinline__ void transpose_item(const float* W, int N, bf16_t* WT, int ldk, int row_off, int row_mul, int koff, LAS float* scr, int item, int lane) {
    const int nblk = N / 32, kb = item / nblk, nb = item % nblk, k0 = 64 * kb, n0 = 32 * nb;
#pragma unroll 8
    for (int i = 0; i < 32; ++i) { const int kk = 2 * i + (lane >> 5); scr[kk * 33 + (lane & 31)] = W[(size_t)(k0 + kk) * N + n0 + (lane & 31)]; }
    LDS_WAIT();
    const int c = lane & 7;
#pragma unroll
    for (int j = 0; j < 4; ++j) { const int n = (lane >> 3) + 8 * j; const LAS float* s = scr + (8 * c) * 33 + n;
        u32x4 o; o.x = pk2(s[0 * 33], s[1 * 33]); o.y = pk2(s[2 * 33], s[3 * 33]); o.z = pk2(s[4 * 33], s[5 * 33]); o.w = pk2(s[6 * 33], s[7 * 33]);
        *(u32x4*)(WT + (size_t)(row_off + (n0 + n) * row_mul) * ldk + koff + k0 + 8 * c) = o; }
    LDS_WAIT();
}
__device__ __forceinline__ void transpose_item_f8(const float* W, int N, unsigned char* WT, int ldk, int row_off, int row_mul, int koff, float scale, LAS float* scr, int item, int lane) {
    const int nblk = N / 32, kb = item / nblk, nb = item % nblk, k0 = 64 * kb, n0 = 32 * nb;
#pragma unroll 8
    for (int i = 0; i < 32; ++i) { const int kk = 2 * i + (lane >> 5); scr[kk * 33 + (lane & 31)] = W[(size_t)(k0 + kk) * N + n0 + (lane & 31)]; }
    LDS_WAIT();
    const int c = lane & 7;
#pragma unroll
    for (int j = 0; j < 4; ++j) { const int n = (lane >> 3) + 8 * j; const LAS float* s = scr + (8 * c) * 33 + n;
        int lo = __builtin_amdgcn_cvt_pk_fp8_f32(s[0 * 33] * scale, s[1 * 33] * scale, 0, false); lo = __builtin_amdgcn_cvt_pk_fp8_f32(s[2 * 33] * scale, s[3 * 33] * scale, lo, true);
        int hi = __builtin_amdgcn_cvt_pk_fp8_f32(s[4 * 33] * scale, s[5 * 33] * scale, 0, false); hi = __builtin_amdgcn_cvt_pk_fp8_f32(s[6 * 33] * scale, s[7 * 33] * scale, hi, true);
        u32x2 o; o.x = (unsigned)lo; o.y = (unsigned)hi;
        *(u32x2*)(WT + (size_t)(row_off + (n0 + n) * row_mul) * ldk + koff + k0 + 8 * c) = o; }
    LDS_WAIT();
}
constexpr float WD_SCALE = 16.f, WGU_SCALE = 64.f;
__device__ __forceinline__ void conv_mat(const Frame& F, const float* W, int K, int N, bf16_t* WT, int ldk, int row_off, int row_mul, int koff, LAS float* scr) {
    const int nitems = (K / 64) * (N / 32);
    for (int it = F.gw; it < nitems; it += F.NGW) transpose_item(W, N, WT, ldk, row_off, row_mul, koff, scr, it, F.lane);
}
constexpr int WQ_CHUNK = 8;
__device__ __forceinline__ int wq_nitems(int lt) { return (((lt & 1) == 0) ? 24576 : 16384) + 8192 + 16384 + 16384 + 2048 + 2048 + 16384 + 2048; }
__device__ __forceinline__ void wq_item(const Args& a, const Frame& F, int lt, int item, LAS float* scr, int Z) {
    const int j = lt >> 1; const int n0 = ((lt & 1) == 0) ? 24576 : 16384;
    bf16_t* WIN = WSETP(WS_WIN, lt); bf16_t* WOUT = WSETP(WS_WOUT, lt); bf16_t* WGU = WSETP(WS_WGU, lt); bf16_t* WD = WSETP(WS_WD, lt);
    int it = item;
    if (it < n0) { if ((lt & 1) == 0) { if ((it % (EVEN_IN / 32)) * 32 < 6144) transpose_item_f8(INP(I_EVEN_WIN) + (size_t)j * D * EVEN_IN, EVEN_IN, (unsigned char*)WIN, D, 0, 1, 0, WGU_SCALE, scr, it, F.lane);
                                        else transpose_item(INP(I_EVEN_WIN) + (size_t)j * D * EVEN_IN, EVEN_IN, WIN, D, 0, 1, 0, scr, it, F.lane); }
                   else transpose_item_f8(INP(I_ODD_WIN) + (size_t)j * D * ODD_IN, ODD_IN, (unsigned char*)WIN, D, 0, 1, 0, WGU_SCALE, scr, it, F.lane); return; }
    it -= n0;
    if (it < 8192) { if (lt & 1) transpose_item_f8(INP(I_WOUT) + (size_t)lt * D * D, D, (unsigned char*)WOUT, D, 0, 1, 0, WGU_SCALE, scr, it, F.lane);
                     else transpose_item(INP(I_WOUT) + (size_t)lt * D * D, D, WOUT, D, 0, 1, 0, scr, it, F.lane); return; }
    it -= 8192;
    if (it < 16384) { const int e = it >> 8, li = it & 255; transpose_item_f8(INP(I_MOE_WG) + ((size_t)lt * NE + e) * D * ED, ED, (unsigned char*)WGU, D, e * 256, 2, 0, WGU_SCALE, scr, li, F.lane); return; }
    it -= 16384;
    if (it < 16384) { const int e = it >> 8, li = it & 255; transpose_item_f8(INP(I_MOE_WU) + ((size_t)lt * NE + e) * D * ED, ED, (unsigned char*)WGU, D, e * 256 + 1, 2, 0, WGU_SCALE, scr, li, F.lane); return; }
    it -= 16384;
    if (it < 2048) { transpose_item_f8(INP(I_SH_WG) + (size_t)lt * D * SHD, SHD, (unsigned char*)WGU, D, NE * 256, 2, 0, WGU_SCALE, scr, it, F.lane); return; }
    it -= 2048;
    if (it < 2048) { transpose_item_f8(INP(I_SH_WU) + (size_t)lt * D * SHD, SHD, (unsigned char*)WGU, D, NE * 256 + 1, 2, 0, WGU_SCALE, scr, it, F.lane); return; }
    it -= 2048;
    if (it < 16384) { const int e = it >> 8, li = it & 255; transpose_item_f8(INP(I_MOE_WD) + ((size_t)lt * NE + e) * ED * D, D, (unsigned char*)WD, DN_K, 0, 1, e * ED, WD_SCALE, scr, li, F.lane); return; }
    it -= 16384;
    transpose_item_f8(INP(I_SH_WD) + (size_t)lt * SHD * D, D, (unsigned char*)WD, DN_K, 0, 1, NE * ED, WD_SCALE, scr, it, F.lane);
}
__device__ __forceinline__ void wq_pull(const Args& a, const Frame& F, int lt, int arr_word) {
    const int Z = opaque_zero();
    unsigned* ctl = (unsigned*)WSB(WS_CTL);
    volatile LAS unsigned* MISC = (volatile LAS unsigned*)(F.lds + MISC_OFF);
    LAS float* scr = (LAS float*)(F.lds + F.wave * 16384);
    const int nchunks = wq_nitems(lt) / WQ_CHUNK;
    __syncthreads();
    if (arr_word >= 0 && F.tid == 0) __hip_atomic_fetch_add(ctl + arr_word, 1u, __ATOMIC_RELAXED, __HIP_MEMORY_SCOPE_AGENT);
    for (;;) {
        if (F.tid == 0) {
            unsigned c = 0xffffffffu;
            const bool go = (arr_word < 0) || (__hip_atomic_load(ctl + arr_word, __ATOMIC_RELAXED, __HIP_MEMORY_SCOPE_AGENT) < (unsigned)F.G);
            if (go) c = __hip_atomic_fetch_add(ctl + CW_WQ + lt, 1u, __ATOMIC_RELAXED, __HIP_MEMORY_SCOPE_AGENT);
            MISC[16] = c;
        }
        __syncthreads();
        const unsigned c = MISC[16];
        __syncthreads();
        if (c >= (unsigned)nchunks) break;
#pragma unroll 1
        for (int q = 0; q < WQ_CHUNK / 8; ++q) wq_item(a, F, lt, (int)c * WQ_CHUNK + F.wave * (WQ_CHUNK / 8) + q, scr, Z);
    }
}

__device__ __forceinline__ void ph_norm(const Args& a, const Frame& F, int l, int which, int gw0, int ngw, bool zero_hall = false) {
    const int Z = opaque_zero();
    bf16_t* HA = (bf16_t*)WSB(WS_P); unsigned char* H8E = (unsigned char*)WSB(WS_H8E);
    const int M = which ? ((l >= 2) ? NLAT : T) : ((l == 3) ? NLAT : T);
    const float* lat_src = (l == 0 && which == 0) ? INP(I_X) : AOUT;
    const float* cx_src = (l == 0 && which == 0) ? INP(I_CTX) : (const float*)WSB(WS_CX);
    const float* g = (which ? INP(I_NORM_FFN) : INP(I_NORM_MIX)) + (size_t)l * D;
    bf16_t* H = (bf16_t*)WSB(WS_H);
    for (int row = gw0; row < M; row += ngw) {
        const float* src = row < NLAT ? lat_src + (size_t)row * D : cx_src + (size_t)(row - NLAT) * D;
        const int c = row < SEQ ? 0 : (row < NLAT ? 1 : 2);
        const float* sh = MODSP(a, l, c, which ? 3 : 0); const float* sc = MODSP(a, l, c, which ? 4 : 1);
        f32x4 v[16]; float ss = 0.f;
#pragma unroll
        for (int j = 0; j < 16; ++j) { v[j] = ((const f32x4*)src)[F.lane + 64 * j]; ss += (v[j].x * v[j].x + v[j].y * v[j].y) + (v[j].z * v[j].z + v[j].w * v[j].w); }
        ss = wave_sum(ss);
        const float rstd = 1.0f / sqrtf(ss * (1.0f / D) + EPS);
        u32x2* o = (u32x2*)(H + (size_t)row * D);
#pragma unroll
        for (int j = 0; j < 16; ++j) { const int idx = F.lane + 64 * j; const f32x4 gg = ((const f32x4*)g)[idx], s1 = ((const f32x4*)sc)[idx], s0 = ((const f32x4*)sh)[idx];
            const f32x4 y = (v[j] * rstd) * gg; const f32x4 hh = y * (1.f + s1) + s0;
            if (which || (l & 1)) { ((unsigned*)((unsigned char*)H + (size_t)row * D))[idx] = pk4f8(hh.x, hh.y, hh.z, hh.w); }
            else { ((unsigned*)(H8E + (size_t)row * D))[idx] = pk4f8(hh.x, hh.y, hh.z, hh.w);
                   u32x2 w; w.x = pk2(hh.x, hh.y); w.y = pk2(hh.z, hh.w); o[idx] = w; } }
        if (zero_hall) { u32x4* hr = (u32x4*)((unsigned char*)HA + (size_t)row * DN_K); const u32x4 z4 = (u32x4){0u, 0u, 0u, 0u};
#pragma unroll
            for (int q = 0; q < 8; ++q) hr[F.lane + 64 * q] = z4; }
    }
}

__device__ __forceinline__ void ph_e1(const Args& a, const Frame& F, int l, bool do_a = true) {
    const int Z = opaque_zero();
    const int j2 = l >> 1;
    bf16_t* P = (bf16_t*)WSB(WS_P);
    const float* qg = INP(I_QGAIN) + j2 * 128; const float* kg = INP(I_KGAIN) + j2 * 128;
    if (do_a) for (int row = F.gw; row < T; row += F.NGW) {
        u32x4* pr = (u32x4*)(P + (size_t)row * EVEN_IN);
#pragma unroll
        for (int j = 0; j < 8; ++j) {
            const int chunk = F.lane + 64 * j; const u32x4 raw = pr[chunk];
            float x[8] = { bflo(raw.x), bfhi(raw.x), bflo(raw.y), bfhi(raw.y), bflo(raw.z), bfhi(raw.z), bflo(raw.w), bfhi(raw.w) };
            float ss = 0.f;
#pragma unroll
            for (int i = 0; i < 8; ++i) ss += x[i] * x[i];
            ss += __shfl_xor(ss, 1); ss += __shfl_xor(ss, 2); ss += __shfl_xor(ss, 4); ss += __shfl_xor(ss, 8);
            const float rstd = 1.0f / sqrtf(ss * (1.0f / 128.f) + EPS);
            const float* gp = (j < 4 ? qg : kg) + (chunk & 15) * 8;
            u32x4 o; o.x = pk2(x[0] * rstd * gp[0], x[1] * rstd * gp[1]); o.y = pk2(x[2] * rstd * gp[2], x[3] * rstd * gp[3]);
            o.z = pk2(x[4] * rstd * gp[4], x[5] * rstd * gp[5]); o.w = pk2(x[6] * rstd * gp[6], x[7] * rstd * gp[7]);
            pr[chunk] = o;
        }
    }
    LAS float* Q = (LAS float*)F.lds;
    const float* cw = INP(I_HY_CW) + (size_t)j2 * 3 * 6144; const float* cb = INP(I_HY_CB) + (size_t)j2 * 6144;
    bf16_t* UT = (bf16_t*)WSB(WS_UT); float* Z2T = (float*)WSB(WS_Z2T); typedef float f32x2e __attribute__((ext_vector_type(2)));
    __syncthreads();
    for (int it = blockIdx.x; it < 2 * 128 * 24; it += F.G) {
        const int b = it / (128 * 24), rem = it % (128 * 24), t0 = (rem / 24) * 64, ch0 = (rem % 24) * 256;
        for (int idx = F.tid; idx < 66 * 32; idx += 512) { const int rr = idx >> 5, ck = idx & 31, t = t0 - 1 + rr; u32x4 raw = (u32x4){0u, 0u, 0u, 0u};
            if (t >= 0 && t < SEQ) raw = *(const u32x4*)(P + (size_t)(b * SEQ + t) * EVEN_IN + 6144 + ch0 + 8 * ck);
            LAS float* d = Q + (ck * 66 + rr) * 9; d[0] = bflo(raw.x); d[1] = bfhi(raw.x); d[2] = bflo(raw.y); d[3] = bfhi(raw.y); d[4] = bflo(raw.z); d[5] = bfhi(raw.z); d[6] = bflo(raw.w); d[7] = bfhi(raw.w); }
        __syncthreads();
        for (int idx = F.tid; idx < 256 * 32; idx += 512) { const int ch = idx >> 5, t = (idx & 31) * 2, chg = ch0 + ch; const float w0 = cw[chg], w1 = cw[6144 + chg], w2 = cw[2 * 6144 + chg], bb = cb[chg];
            const LAS float* q = Q + ((ch >> 3) * 66 + t) * 9 + (ch & 7); const float p0 = q[0], p1 = q[9], p2 = q[18], p3 = q[27];
            const float v0 = bb + p0 * w0 + p1 * w1 + p2 * w2, v1 = bb + p1 * w0 + p2 * w1 + p3 * w2;
            if (chg < 4096) *(unsigned*)(UT + ((size_t)b * 4096 + chg) * SEQ + t0 + t) = pk2(v0, v1);
            else { f32x2e o2; o2.x = v0; o2.y = v1; *(f32x2e*)(Z2T + ((size_t)b * 2048 + (chg - 4096)) * SEQ + t0 + t) = o2; } }
        __syncthreads();
    }
}

__device__ __forceinline__ void ph_hyf(const Args& a, const Frame& F, int l) {
    const int Z = opaque_zero();
    const int j2 = l >> 1;
    const float* w1 = INP(I_HY_W1) + (size_t)j2 * 33 * 64; const float* b1 = INP(I_HY_B1) + j2 * 64;
    const float* w2 = INP(I_HY_W2) + (size_t)j2 * 4096; const float* b2 = INP(I_HY_B2) + j2 * 64;
    const float* w3 = INP(I_HY_W3) + (size_t)j2 * 4096; const float* b3 = INP(I_HY_B3) + j2 * 64;
    const float* w4 = INP(I_HY_W4) + (size_t)j2 * 64 * 8192; const float* fq = INP(I_HY_FREQ) + j2 * 192;
    float* FILT = (float*)WSB(WS_FILT); float* FILTC = (float*)WSB(WS_FILTC);
    LAS float* feats = (LAS float*)F.lds; LAS float* ha = feats + 1056; LAS float* hb = ha + 2048; LAS float* hT = hb + 2048; LAS float* tn = hT + 2048;
    const float dstart = -15.350567286626969f, dstop = -3.0701134573253945f, dstep = (dstop - dstart) / 2047.f;
    __syncthreads();
    for (int it = blockIdx.x; it < 256 + 128; it += F.G) {
        const int L = it < 256 ? SEQ : LC, t0 = (it < 256 ? it : ((it - 256) >> 4)) * 32;
        const int i_lo = it < 256 ? 0 : ((it - 256) & 15), i_hi = it < 256 ? 16 : i_lo + 1;
        const float c2pi = (float)(6.283185307179586 / (double)L), invLm1 = 1.0f / (float)(L - 1);
        for (int idx = F.tid; idx < 1056; idx += 512) { const int p = idx / 33, f = idx % 33; const float pos = (float)(t0 + p); float val;
            if (f == 0) { val = pos * invLm1; tn[p] = val; }
            else { const int bi = (f - 1) & 15; const float band = 1e-4f + (float)bi * ((15.f - 1e-4f) / 15.f); const float ang = (c2pi * pos) * band; val = (f <= 16) ? cosf(ang) : -sinf(ang); }
            feats[idx] = val; }
        __syncthreads();
        const int p = F.tid >> 4, ug = F.tid & 15;
#pragma unroll 1
        for (int q = 0; q < 4; ++q) { const int u = ug * 4 + q; float s = b1[u];
#pragma unroll 3
            for (int f = 0; f < 33; ++f) s += feats[p * 33 + f] * w1[f * 64 + u];
            ha[p * 64 + u] = sinf(fq[u] * s); }
        __syncthreads();
#pragma unroll 1
        for (int q = 0; q < 4; ++q) { const int u = ug * 4 + q; float s = b2[u];
#pragma unroll 4
            for (int m = 0; m < 64; ++m) s += ha[p * 64 + m] * w2[m * 64 + u];
            hb[p * 64 + u] = sinf(fq[64 + u] * s); }
        __syncthreads();
#pragma unroll 1
        for (int q = 0; q < 4; ++q) { const int u = ug * 4 + q; float s = b3[u];
#pragma unroll 4
            for (int m = 0; m < 64; ++m) s += hb[p * 64 + m] * w3[m * 64 + u];
            hT[(u >> 2) * 128 + (p >> 4) * 64 + (u & 3) * 16 + (p & 15)] = sinf(fq[128 + u] * s); }
        __syncthreads();
        {   const int j = F.lane & 15, kq = F.lane >> 4; const int cb_lo = i_lo * 32, cb_hi = i_hi * 32;
            const float rstep = -invLm1;
            float bvn[16];
            { const float* wp = w4 + (size_t)kq * 8192 + (cb_lo + F.wave) * 16 + j;
#pragma unroll
              for (int sk = 0; sk < 16; ++sk) bvn[sk] = wp[(size_t)sk * 4 * 8192]; }
#pragma unroll 1
            for (int cb = cb_lo + F.wave; cb < cb_hi; cb += 8) {
                const int n = cb * 16 + j;
                float bv[16];
#pragma unroll
                for (int sk = 0; sk < 16; ++sk) bv[sk] = bvn[sk];
                if (cb + 8 < cb_hi) { const float* wp = w4 + (size_t)kq * 8192 + (cb + 8) * 16 + j;
#pragma unroll
                    for (int sk = 0; sk < 16; ++sk) bvn[sk] = wp[(size_t)sk * 4 * 8192]; }
                f32x4 acc0 = (f32x4){0.f, 0.f, 0.f, 0.f}, acc1 = (f32x4){0.f, 0.f, 0.f, 0.f};
#pragma unroll
                for (int sk = 0; sk < 16; ++sk) { const float a0 = hT[sk * 128 + F.lane], a1 = hT[sk * 128 + 64 + F.lane];
                    acc0 = __builtin_amdgcn_mfma_f32_16x16x4f32(a0, bv[sk], acc0, 0, 0, 0); acc1 = __builtin_amdgcn_mfma_f32_16x16x4f32(a1, bv[sk], acc1, 0, 0, 0); }
                const int dir = n >> 12, o = (n >> 11) & 1, c = n & 2047; const float delta = fabsf(dstart + (float)c * dstep);
                const float ratio = expf(rstep * delta), e0 = expf(-tn[4 * kq] * delta), e1 = expf(-tn[16 + 4 * kq] * delta);
                float* dst = (L == SEQ) ? FILT + (((size_t)(c * 2 + o) * 2 + dir) * SEQ + t0) : FILTC + (((size_t)(c * 2 + o) * 2 + dir) * LC + t0);
                f32x4 v0, v1; float d0 = e0, d1 = e1;
                v0.x = acc0.x * d0; v1.x = acc1.x * d1; d0 *= ratio; d1 *= ratio; v0.y = acc0.y * d0; v1.y = acc1.y * d1; d0 *= ratio; d1 *= ratio;
                v0.z = acc0.z * d0; v1.z = acc1.z * d1; d0 *= ratio; d1 *= ratio; v0.w = acc0.w * d0; v1.w = acc1.w * d1;
                *(f32x4*)(dst + 4 * kq) = v0; *(f32x4*)(dst + 16 + 4 * kq) = v1;
            }
        }
        __syncthreads();
    }
}

typedef short bf16x8v __attribute__((ext_vector_type(8)));
#define GAS __attribute__((address_space(1)))
typedef const GAS char* gcp_t;
__device__ __forceinline__ float xmax16_32(float v) {
    const unsigned u = __builtin_bit_cast(unsigned, v);
    const auto r = __builtin_amdgcn_permlane32_swap(u, u, false, false);
    unsigned a0 = r[0], a1 = r[1]; asm volatile("" : "+v"(a0), "+v"(a1));
    const float m = fmaxf(__builtin_bit_cast(float, a0), __builtin_bit_cast(float, a1));
    const unsigned um = __builtin_bit_cast(unsigned, m);
    const auto r2 = __builtin_amdgcn_permlane16_swap(um, um, false, false);
    unsigned b0 = r2[0], b1 = r2[1]; asm volatile("" : "+v"(b0), "+v"(b1));
    return fmaxf(__builtin_bit_cast(float, b0), __builtin_bit_cast(float, b1));
}
__device__ __forceinline__ void ph_attn(const Args& a, const Frame& F, int l) {
    const int Z = opaque_zero();
    const int j2 = l >> 1;
    const bf16_t* P = (const bf16_t*)WSB(WS_P); bf16_t* MIX = (bf16_t*)WSB(WS_MIX);
    const int wv = __builtin_amdgcn_readfirstlane(F.wave);
    LAS unsigned char* KT = F.lds;
    LAS unsigned char* VT = F.lds + 32768;
    LAS float* rp = (LAS float*)(F.lds + 65536);
    const unsigned vt_addr = (unsigned)(size_t)VT;
    const int j = F.lane & 15, kq = F.lane >> 4;
    const float qscale = 0.08838834764831845f * 1.4426950408889634f;
    const unsigned koff = (unsigned)((j * EVEN_IN + 8 * kq) * 2);
    unsigned foff[2];
#pragma unroll
    for (int u = 0; u < 2; ++u) foff[u] = (unsigned)((8 * wv + 4 * u + kq) * (EVEN_IN * 2) + ((j ^ ((kq << 2) | ((2 * wv + u) & 3))) * 16));
    const bool fast = (F.G & 15) == 0;
    const int nst = 128 + (l == 0 ? 4 : 0);
    unsigned gs = 0;
#pragma unroll 1
    for (int h = fast ? ((int)blockIdx.x & 15) : 0; h < 16; h += (fast ? 16 : 1)) {
        const float* rpb = INP(I_RPB) + ((size_t)j2 * 16 + h) * 465;
        __syncthreads();
        for (int idx = F.tid; idx < 465; idx += 512) rp[idx] = rpb[idx] * 1.4426950408889634f;
        __syncthreads();
        const int w0 = fast ? ((int)blockIdx.x >> 4) : (int)blockIdx.x, nw = fast ? (F.G >> 4) : F.G;
#pragma unroll 1
        for (int st = w0; st < nst; st += nw) {
            int b, nwin, c0 = 0, ws_ = 0, rs = 0, r = 0, rsA = 0; size_t qrow0;
            if (st < 128) { const int r0 = (st & 63) * 2; b = st >> 6; r = r0 + (wv >> 2); c0 = (wv & 3) * 16; ws_ = min(max(c0 - 8, 0), 32); rs = min(max(r - 4, 0), 120);
                rsA = min(max(r0 - 4, 0), 120); nwin = min(max(r0 - 3, 0), 120) + 8 - rsA; qrow0 = (size_t)b * SEQ + r * 64 + c0; }
            else { const int t2 = st - 128; b = t2 >> 1; qrow0 = (size_t)NLAT + b * LC + ((t2 & 1) * 8 + wv) * 16; nwin = 0; }
            const int nsteps = nwin + 4;
            bf16x8v qf[4];
            { unsigned long long qbi = (unsigned long long)(P + qrow0 * EVEN_IN + h * 128); asm volatile("" : "+s"(qbi)); const gcp_t qb = (gcp_t)qbi;
              unsigned _ko = koff; asm volatile("" : "+v"(_ko));
#pragma unroll
              for (int s = 0; s < 4; ++s) qf[s] = *(const GAS bf16x8v*)(qb + 64 * s + _ko); }
            u32x4 fr[4];
#define ATT_FETCH(s_) do { const int _s = (s_); const size_t _tok0 = (_s < nwin) ? ((size_t)b * SEQ + (rsA + _s) * 64) : ((size_t)NLAT + b * LC + (_s - nwin) * 64); \
            unsigned long long _kbi = (unsigned long long)(P + _tok0 * EVEN_IN + 2048 + h * 128); asm volatile("" : "+s"(_kbi)); const gcp_t _kb = (gcp_t)_kbi; \
            _Pragma("unroll") for (int u = 0; u < 2; ++u) { unsigned _fo = foff[u]; asm volatile("" : "+v"(_fo)); \
                fr[u] = *(const GAS u32x4*)(_kb + _fo); fr[2 + u] = *(const GAS u32x4*)(_kb + 4096 + _fo); } } while (0)
#define ATT_PUT(bf_) do { _Pragma("unroll") for (int u = 0; u < 2; ++u) { \
                *(LAS u32x4*)(KT + (bf_) * 16384 + (2 * wv + u) * 1024 + F.lane * 16) = fr[u]; *(LAS u32x4*)(VT + (bf_) * 16384 + (2 * wv + u) * 1024 + F.lane * 16) = fr[2 + u]; } } while (0)
            ATT_FETCH(0);
            const int cq = c0 + j, cs = min(max(cq - 8, 0), 48);
            int dcv[8]; float madd[8];
#pragma unroll
            for (int e = 0; e < 8; ++e) { const int kcol = ws_ + 8 * kq + e; dcv[e] = min(max(kcol - cq + 15, 0), 30); madd[e] = ((unsigned)(kcol - cs) < 16u) ? 0.f : -1e30f; asm volatile("" : "+v"(madd[e])); }
            unsigned KBw[2], KBc[2], VBw[2], VBc[2];
#pragma unroll
            for (int t = 0; t < 2; ++t) {
                { const unsigned row = (unsigned)(ws_ + 8 * (j >> 2) + (j & 3) + 4 * t), y = (row >> 2) & 3u; KBw[t] = 256u * row + 16u * ((unsigned)kq ^ y) + 64u * (unsigned)(j & 3); }
                { const unsigned row = (unsigned)(8 * (j >> 2) + (j & 3) + 4 * t), y = (row >> 2) & 3u; KBc[t] = 256u * row + 16u * ((unsigned)kq ^ y) + 64u * (unsigned)(j & 3); }
                const unsigned q = (unsigned)j >> 2, p = (unsigned)j & 3u, bq = p >> 1;
                { const unsigned row = (unsigned)(ws_ + 8 * kq + 4 * t) + q, X = (q << 2) | ((row >> 2) & 3u); VBw[t] = 256u * row + 16u * (bq ^ X) + 8u * (p & 1u); }
                { const unsigned row = (unsigned)(8 * kq + 4 * t) + q, X = (q << 2) | ((row >> 2) & 3u); VBc[t] = 256u * row + 16u * (bq ^ X) + 8u * (p & 1u); }
            }
            f32x4 o[8];
#pragma unroll
            for (int d = 0; d < 8; ++d) o[d] = (f32x4){0.f, 0.f, 0.f, 0.f};
            float mrun = -1e30f, lsum = 0.f;
#define ATT_GROUP(KB0_, KB1_, VB0_, VB1_, XO_, WIN, brow_) do { \
            bf16x8v kf[8]; \
            _Pragma("unroll") for (int s = 0; s < 4; ++s) { kf[s] = *(const LAS bf16x8v*)(KT + (((KB0_) ^ (64u * s)) + (XO_))); kf[4 + s] = *(const LAS bf16x8v*)(KT + (((KB1_) ^ (64u * s)) + (XO_))); } \
            float bias[8]; \
            if (WIN) { const LAS float* rrow = rp + (brow_) * 31; \
                _Pragma("unroll") for (int e = 0; e < 8; ++e) bias[e] = rrow[dcv[e]]; } \
            f32x4 s0 = (f32x4){0.f, 0.f, 0.f, 0.f}, s1 = (f32x4){0.f, 0.f, 0.f, 0.f}; \
            _Pragma("unroll") for (int s = 0; s < 4; ++s) { s0 = __builtin_amdgcn_mfma_f32_16x16x32_bf16(kf[s], qf[s], s0, 0, 0, 0); s1 = __builtin_amdgcn_mfma_f32_16x16x32_bf16(kf[4 + s], qf[s], s1, 0, 0, 0); } \
            if (WIN) asm volatile("" : "+v"(bias[0]), "+v"(bias[1]), "+v"(bias[2]), "+v"(bias[3]), "+v"(bias[4]), "+v"(bias[5]), "+v"(bias[6]), "+v"(bias[7]));     \
            else asm volatile("" : "+v"(s0), "+v"(s1)); \
            u32x2 tr[8][2]; unsigned rd[8][2]; \
            _Pragma("unroll") for (int d = 0; d < 8; ++d) { rd[d][0] = vt_addr + ((VB0_) ^ (32u * d)); rd[d][1] = vt_addr + ((VB1_) ^ (32u * d)); } \
            asm volatile("ds_read_b64_tr_b16 %0, %8 offset:%16\n\tds_read_b64_tr_b16 %1, %9 offset:%16\n\tds_read_b64_tr_b16 %2, %10 offset:%16\n\tds_read_b64_tr_b16 %3, %11 offset:%16\n\t" \
                         "ds_read_b64_tr_b16 %4, %12 offset:%16\n\tds_read_b64_tr_b16 %5, %13 offset:%16\n\tds_read_b64_tr_b16 %6, %14 offset:%16\n\tds_read_b64_tr_b16 %7, %15 offset:%16" \
                : "=&v"(tr[0][0]), "=&v"(tr[0][1]), "=&v"(tr[1][0]), "=&v"(tr[1][1]), "=&v"(tr[2][0]), "=&v"(tr[2][1]), "=&v"(tr[3][0]), "=&v"(tr[3][1]) \
                : "v"(rd[0][0]), "v"(rd[0][1]), "v"(rd[1][0]), "v"(rd[1][1]), "v"(rd[2][0]), "v"(rd[2][1]), "v"(rd[3][0]), "v"(rd[3][1]), "i"(XO_)); \
            asm volatile("ds_read_b64_tr_b16 %0, %8 offset:%16\n\tds_read_b64_tr_b16 %1, %9 offset:%16\n\tds_read_b64_tr_b16 %2, %10 offset:%16\n\tds_read_b64_tr_b16 %3, %11 offset:%16\n\t" \
                         "ds_read_b64_tr_b16 %4, %12 offset:%16\n\tds_read_b64_tr_b16 %5, %13 offset:%16\n\tds_read_b64_tr_b16 %6, %14 offset:%16\n\tds_read_b64_tr_b16 %7, %15 offset:%16" \
                : "=&v"(tr[4][0]), "=&v"(tr[4][1]), "=&v"(tr[5][0]), "=&v"(tr[5][1]), "=&v"(tr[6][0]), "=&v"(tr[6][1]), "=&v"(tr[7][0]), "=&v"(tr[7][1]) \
                : "v"(rd[4][0]), "v"(rd[4][1]), "v"(rd[5][0]), "v"(rd[5][1]), "v"(rd[6][0]), "v"(rd[6][1]), "v"(rd[7][0]), "v"(rd[7][1]), "i"(XO_)); \
            float sv[8]; \
            _Pragma("unroll") for (int e = 0; e < 8; ++e) sv[e] = WIN ? fmaf((e >> 2) ? s1[e & 3] : s0[e & 3], qscale, bias[e]) + madd[e] : ((e >> 2) ? s1[e & 3] : s0[e & 3]) * qscale; \
            float gmax = sv[0]; \
            _Pragma("unroll") for (int e = 1; e < 8; ++e) gmax = fmaxf(gmax, sv[e]); \
            gmax = xmax16_32(gmax); \
            const float mnew = fmaxf(mrun, gmax), alpha = __builtin_amdgcn_exp2f(mrun - mnew); \
            if (__builtin_amdgcn_ballot_w64(mnew > mrun) != 0ull) { _Pragma("unroll") for (int d = 0; d < 8; ++d) o[d] = o[d] * alpha; } \
            mrun = mnew; \
            float p[8], psum = 0.f; \
            _Pragma("unroll") for (int e = 0; e < 8; ++e) { p[e] = __builtin_amdgcn_exp2f(sv[e] - mnew); psum += p[e]; } \
            lsum = lsum * alpha + psum; \
            union { bf16x8v v; unsigned u[4]; } pf; \
            pf.u[0] = pk2(p[0], p[1]); pf.u[1] = pk2(p[2], p[3]); pf.u[2] = pk2(p[4], p[5]); pf.u[3] = pk2(p[6], p[7]); \
            asm volatile("s_waitcnt lgkmcnt(0)" : "+v"(tr[0][0]), "+v"(tr[0][1]), "+v"(tr[1][0]), "+v"(tr[1][1]), "+v"(tr[2][0]), "+v"(tr[2][1]), "+v"(tr[3][0]), "+v"(tr[3][1]), \
                                                  "+v"(tr[4][0]), "+v"(tr[4][1]), "+v"(tr[5][0]), "+v"(tr[5][1]), "+v"(tr[6][0]), "+v"(tr[6][1]), "+v"(tr[7][0]), "+v"(tr[7][1]) :: "memory"); \
            _Pragma("unroll") for (int d = 0; d < 8; ++d) { union { bf16x8v v; unsigned u[4]; } vf; vf.u[0] = tr[d][0].x; vf.u[1] = tr[d][0].y; vf.u[2] = tr[d][1].x; vf.u[3] = tr[d][1].y; \
                o[d] = __builtin_amdgcn_mfma_f32_16x16x32_bf16(vf.v, pf.v, o[d], 0, 0, 0); } } while (0)
#pragma unroll 1
            for (int step = 0; step < nsteps; ++step, ++gs) {
                ATT_PUT(gs & 1u);
                __syncthreads();
                if (step + 1 < nsteps) ATT_FETCH(step + 1);
                const unsigned bo = (gs & 1u) * 16384u;
                if (step < nwin) {
                    const int g = rsA + step - rs;
                    if ((unsigned)g < 8u) { const unsigned k0 = KBw[0] + bo, k1 = KBw[1] + bo, v0 = VBw[0] + bo, v1 = VBw[1] + bo; ATT_GROUP(k0, k1, v0, v1, 0, true, rs + g - r + 7); }
                } else {
                    const unsigned k0 = KBc[0] + bo, k1 = KBc[1] + bo, v0 = VBc[0] + bo, v1 = VBc[1] + bo;
                    ATT_GROUP(k0, k1, v0, v1, 0, false, 0);
                    ATT_GROUP(k0, k1, v0, v1, 8192, false, 0);
                }
            }
#undef ATT_FETCH
#undef ATT_PUT
#undef ATT_GROUP
            lsum += __shfl_xor(lsum, 16); lsum += __shfl_xor(lsum, 32);
            const float inv = 1.0f / lsum;
#pragma unroll
            for (int d = 0; d < 8; ++d) { u32x2 w; w.x = pk2(o[d].x * inv, o[d].y * inv); w.y = pk2(o[d].z * inv, o[d].w * inv);
                *(u32x2*)(MIX + (qrow0 + j) * D + h * 128 + 16 * d + 4 * kq) = w; }
        }
    }
    __syncthreads();
}

__device__ __forceinline__ float wave_sum_o(float v) {
    int ln = (int)__builtin_amdgcn_mbcnt_hi(~0u, __builtin_amdgcn_mbcnt_lo(~0u, 0u)); asm volatile("" : "+v"(ln));
#pragma unroll
    for (int o = 1; o < 64; o <<= 1) v += __builtin_bit_cast(float, __builtin_amdgcn_ds_bpermute((ln ^ o) << 2, __builtin_bit_cast(int, v)));
    return v;
}
__device__ __forceinline__ float block_sum(const Frame& F, float v, LAS float* red) {
    v = wave_sum_o(v);
    __syncthreads();
    if (F.lane == 0) red[F.wave] = v;
    __syncthreads();
    float s = 0.f;
#pragma unroll
    for (int w = 0; w < 8; ++w) s += red[w];
    return s;
}
typedef float f32x2 __attribute__((ext_vector_type(2)));
#define FP(idx) ((idx) + ((idx) >> 5))
__device__ constexpr int BR5[32] = {0,16,8,24,4,20,12,28,2,18,10,26,6,22,14,30,1,17,9,25,5,21,13,29,3,19,11,27,7,23,15,31};
__device__ constexpr int BR4[16] = {0,8,4,12,2,10,6,14,1,9,5,13,3,11,7,15};
#define brevn(s, bits) ((bits) == 5 ? BR5[(s)] : BR4[(s)])
__device__ __forceinline__ f32x2 cswap(f32x2 a) { f32x2 r; r.x = a.y; r.y = -a.x; return r; }
__device__ __forceinline__ f32x2 cmul(f32x2 a, f32x2 w) { f32x2 t; t.x = -a.y; t.y = a.x; return a * w.x + t * w.y; }
__device__ __forceinline__ f32x2 cmulc(f32x2 a, f32x2 w) { f32x2 t; t.x = a.y; t.y = -a.x; f32x2 r = a * w.x + t * w.y; r.y = -r.y; return r; }
template <int R> __device__ __forceinline__ void dif(f32x2 (&x)[R]) {
    constexpr float C32[16] = { 1.f, 0.98078528040323043f, 0.92387953251128674f, 0.83146961230254524f, 0.70710678118654752f, 0.55557023301960218f, 0.38268343236508978f, 0.19509032201612825f,
                                0.f, -0.19509032201612825f, -0.38268343236508978f, -0.55557023301960218f, -0.70710678118654752f, -0.83146961230254524f, -0.92387953251128674f, -0.98078528040323043f };
    constexpr float S32[16] = { 0.f, 0.19509032201612825f, 0.38268343236508978f, 0.55557023301960218f, 0.70710678118654752f, 0.83146961230254524f, 0.92387953251128674f, 0.98078528040323043f,
                                1.f, 0.98078528040323043f, 0.92387953251128674f, 0.83146961230254524f, 0.70710678118654752f, 0.55557023301960218f, 0.38268343236508978f, 0.19509032201612825f };
#pragma unroll
    for (int h = R / 2; h >= 1; h >>= 1) {
#pragma unroll
        for (int b = 0; b < R; b += 2 * h) {
#pragma unroll
            for (int k = 0; k < h; ++k) {
                const int i0 = b + k, i1 = b + k + h, ti = k * (16 / h);
                const f32x2 u = x[i0], v = x[i1];
                x[i0] = u + v;
                const f32x2 d = u - v;
                if (ti == 0) x[i1] = d;
                else if (ti == 8) x[i1] = cswap(d);
                else x[i1] = d * C32[ti] + cswap(d) * S32[ti];
            }
        }
    }
}
struct FftCtx { LAS f32x2* X; const LAS f32x2* TW; int tid; };
__device__ __forceinline__ void fft_fwd_A(const FftCtx& f, f32x2 (&x)[32]) {
    dif<32>(x);
    __builtin_amdgcn_sched_barrier(0);
    const int i = f.tid; const f32x2 w = f.TW[i]; f32x2 cw; cw.x = 1.f; cw.y = 0.f;
    __syncthreads();
    LAS f32x2* XA = f.X + (i + (i >> 5));
    XA[0] = x[0];
#pragma unroll
    for (int r = 1; r < 32; ++r) { __builtin_amdgcn_sched_barrier(0); cw = cmul(cw, w); XA[528 * r] = cmul(x[brevn(r, 5)], cw); }
    __syncthreads();
}
__device__ __forceinline__ void fft_fwd_BC(const FftCtx& f, f32x2 (&x)[32]) {
#pragma unroll 1
    for (int u = 0; u < 2; ++u) {
        const int q = f.tid + 512 * u, r = q >> 5, i2 = q & 31;
        f32x2 y[16]; LAS f32x2* XB = f.X + (528 * r + i2);
#pragma unroll
        for (int j2 = 0; j2 < 16; ++j2) y[j2] = XB[33 * j2];
        dif<16>(y);
        __builtin_amdgcn_sched_barrier(0);
        const f32x2 w = f.TW[32 * i2]; f32x2 cw; cw.x = 1.f; cw.y = 0.f;
        XB[0] = y[0];
#pragma unroll
        for (int r2 = 1; r2 < 16; ++r2) { __builtin_amdgcn_sched_barrier(0); cw = cmul(cw, w); XB[33 * r2] = cmul(y[brevn(r2, 4)], cw); }
    }
    __syncthreads();
    { const LAS f32x2* XC = f.X + 33 * f.tid;
#pragma unroll
      for (int m = 0; m < 32; ++m) x[m] = XC[m]; }
    dif<32>(x);
}
__device__ __forceinline__ void fft_inv(const FftCtx& f, f32x2 (&x)[32]) {
    {   f32x2 t[32];
#pragma unroll
        for (int k = 0; k < 32; ++k) { t[k] = x[brevn(k, 5)]; t[k].y = -t[k].y; }
        dif<32>(t);
        LAS f32x2* XC = f.X + 33 * f.tid;
#pragma unroll
        for (int s = 0; s < 32; ++s) { f32x2 v = t[s]; v.y = -v.y; XC[brevn(s, 5)] = v; }
    }
    __syncthreads();
#pragma unroll 1
    for (int u = 0; u < 2; ++u) {
        const int q = f.tid + 512 * u, r = q >> 5, i2 = q & 31;
        f32x2 y[16];
        const f32x2 w = f.TW[32 * i2]; f32x2 cw; cw.x = 1.f; cw.y = 0.f; LAS f32x2* XB = f.X + (528 * r + i2);
        { f32x2 v = XB[0]; v.y = -v.y; y[0] = v; }
#pragma unroll
        for (int r2 = 1; r2 < 16; ++r2) { __builtin_amdgcn_sched_barrier(0); cw = cmul(cw, w); f32x2 v = XB[33 * r2]; v.y = -v.y; y[r2] = cmul(v, cw); }
        dif<16>(y);
#pragma unroll
        for (int s = 0; s < 16; ++s) { f32x2 v = y[s]; v.y = -v.y; XB[33 * brevn(s, 4)] = v; }
    }
    __syncthreads();
    {   const int i = f.tid; const f32x2 w = f.TW[i]; f32x2 cw; cw.x = 1.f; cw.y = 0.f; const LAS f32x2* XA = f.X + (i + (i >> 5));
        { f32x2 v = XA[0]; v.y = -v.y; x[0] = v; }
#pragma unroll
        for (int r = 1; r < 32; ++r) { __builtin_amdgcn_sched_barrier(0); cw = cmul(cw, w); f32x2 v = XA[528 * r]; v.y = -v.y; x[r] = cmul(v, cw); }
        dif<32>(x);
#pragma unroll
        for (int s = 0; s < 32; ++s) x[s].y = -x[s].y;
    }
}
__device__ __forceinline__ void ph_hyc(const Args& a, const Frame& F, int l) {
    const int Z = opaque_zero();
    const int j2 = l >> 1;
    const float* FILT = (const float*)WSB(WS_FILT); const bf16_t* UT = (const bf16_t*)WSB(WS_UT); float* Z2T = (float*)WSB(WS_Z2T);
    const float* skip = INP(I_HY_SKIP) + (size_t)j2 * 2 * 2048;
    FftCtx f; f.X = (LAS f32x2*)F.lds; f.TW = (const LAS f32x2*)(F.lds + 135168); f.tid = F.tid;
    LAS float* red = (LAS float*)(F.lds + 135168 + 8192);
    { LAS f32x2* tw = (LAS f32x2*)(F.lds + 135168);
      for (int m = F.tid; m < 1024; m += 512) { float sn, cs; sincosf(-6.283185307179586f * (float)m * (1.0f / 16384.f), &sn, &cs); f32x2 v; v.x = cs; v.y = sn; tw[m] = v; } }
    __syncthreads();
    const unsigned tu = (unsigned)F.tid, trv = 511u - (unsigned)F.tid;
    for (int c = blockIdx.x; c < 2048; c += F.G) {
        f32x2 nd[16];
        { const float* z0p = Z2T + ((size_t)0 * 2048 + c) * SEQ; const float* z1p = Z2T + ((size_t)1 * 2048 + c) * SEQ;
#pragma unroll
          for (int j = 0; j < 16; ++j) { unsigned long long a0 = (unsigned long long)(z0p + 512 * j), a1 = (unsigned long long)(z1p + 512 * j); asm volatile("" : "+s"(a0), "+s"(a1)); nd[j].x = ((const GAS float*)a0)[tu]; nd[j].y = ((const GAS float*)a1)[tu]; } }
#pragma unroll 1
        for (int o = 0; o < 2; ++o) {
            const float* fwd = FILT + ((size_t)(c * 2 + o) * 2 + 0) * SEQ; const float* bwd = fwd + SEQ;
            f32x2 kx[32]; float ss = 0.f;
#pragma unroll
            for (int j = 0; j < 32; ++j) { float v;
                if (j < 16) v = (fwd + 512 * j)[tu]; else { v = (bwd + (SEQ - 512 * (j - 16) - 511))[trv]; if (j == 16 && F.tid == 0) v = 0.f; }
                kx[j].x = v; kx[j].y = 0.f; ss += v * v; }
            fft_fwd_A(f, kx); fft_fwd_BC(f, kx);
            const float tot = block_sum(F, ss, red);
            const float sc = (1.0f / sqrtf(tot + EPS)) * (1.0f / 16384.f);
            const float skn = skip[o * 2048 + c] * (1.0f / 16384.f);
#pragma unroll
            for (int s = 0; s < 32; ++s) { kx[s] = kx[s] * sc; kx[s].x += skn; }
            f32x2 dx[32];
#pragma unroll
            for (int j = 0; j < 32; ++j) { if (j < 16) dx[j] = nd[j]; else { dx[j].x = 0.f; dx[j].y = 0.f; } }
            fft_fwd_A(f, dx); fft_fwd_BC(f, dx);
#pragma unroll
            for (int s = 0; s < 32; ++s) dx[s] = cmul(dx[s], kx[s]);
            const bf16_t* g0p = UT + ((size_t)0 * 4096 + o * 2048 + c) * SEQ; const bf16_t* g1p = UT + ((size_t)1 * 4096 + o * 2048 + c) * SEQ;
            unsigned short gt0[16], gt1[16];
#pragma unroll
            for (int j = 0; j < 16; ++j) { unsigned long long a0 = (unsigned long long)(g0p + 512 * j), a1 = (unsigned long long)(g1p + 512 * j); asm volatile("" : "+s"(a0), "+s"(a1));
                gt0[j] = ((const GAS bf16_t*)a0)[tu]; gt1[j] = ((const GAS bf16_t*)a1)[tu]; }
            fft_inv(f, dx);
            float* o0p = Z2T + ((size_t)0 * 2048 + c) * SEQ; float* o1p = Z2T + ((size_t)1 * 2048 + c) * SEQ;
#pragma unroll
            for (int j = 0; j < 16; ++j) { const int s = brevn(j, 5);
                nd[j].x = bf2f(gt0[j]) * dx[s].x; nd[j].y = bf2f(gt1[j]) * dx[s].y; }
            if (o == 1) {
#pragma unroll
                for (int j = 0; j < 16; ++j) { unsigned long long b0 = (unsigned long long)(o0p + 512 * j), b1 = (unsigned long long)(o1p + 512 * j); asm volatile("" : "+s"(b0), "+s"(b1));
                    ((GAS float*)b0)[tu] = nd[j].x; ((GAS float*)b1)[tu] = nd[j].y; }
            }
        }
    }
}

__device__ __forceinline__ void ph_hyx(const Args& a, const Frame& F, int l) {
    const int Z = opaque_zero();
    const int j2 = l >> 1;
    const bf16_t* P = (const bf16_t*)WSB(WS_P); bf16_t* MIX = (bf16_t*)WSB(WS_MIX); const float* FILTC = (const float*)WSB(WS_FILTC);
    const float* cw = INP(I_HY_CW) + (size_t)j2 * 3 * 6144; const float* cb = INP(I_HY_CB) + (size_t)j2 * 6144; const float* skip = INP(I_HY_SKIP) + (size_t)j2 * 2 * 2048;
    LAS float* us = (LAS float*)F.lds;
    LAS float* Hh = us + 3 * 2 * 256 * 8;
    LAS float* red = Hh + 2 * 8 * 512;
    const int b = F.tid >> 8, t = F.tid & 255;
    for (int cg = blockIdx.x; cg < 256; cg += F.G) {
        const int c0 = cg * 8;
        __syncthreads();
#pragma unroll 1
        for (int part = 0; part < 3; ++part) { const int ch0 = part * 2048 + c0; float v[8];
#pragma unroll
            for (int k = 0; k < 8; ++k) v[k] = cb[ch0 + k];
#pragma unroll
            for (int i = 0; i < 3; ++i) { const int tt = t + i - 1; if (tt >= 0 && tt < LC) { const u32x4 raw = *(const u32x4*)(P + (size_t)(NLAT + b * LC + tt) * EVEN_IN + 6144 + ch0); const float* w = cw + i * 6144 + ch0;
                v[0] += bflo(raw.x) * w[0]; v[1] += bfhi(raw.x) * w[1]; v[2] += bflo(raw.y) * w[2]; v[3] += bfhi(raw.y) * w[3]; v[4] += bflo(raw.z) * w[4]; v[5] += bfhi(raw.z) * w[5]; v[6] += bflo(raw.w) * w[6]; v[7] += bfhi(raw.w) * w[7]; } }
            LAS f32x4* d = (LAS f32x4*)(us + ((part * 2 + b) * 256 + t) * 8); d[0] = (f32x4){v[0], v[1], v[2], v[3]}; d[1] = (f32x4){v[4], v[5], v[6], v[7]}; }
#pragma unroll 1
        for (int m = 0; m < 8; ++m) { const int idx = F.tid + 512 * m, ok = idx >> 8, d = idx & 255, o = ok >> 3, k = ok & 7;
            const float* fwd = FILTC + ((size_t)((c0 + k) * 2 + o) * 2 + 0) * LC; const float f = fwd[d]; float ss = f * f; Hh[ok * 512 + 256 + d] = f;
            if (d >= 1) { const float g = fwd[LC + d]; Hh[ok * 512 + 256 - d] = g; ss += g * g; } else Hh[ok * 512] = 0.f;
            ss = wave_sum_o(ss); if (F.lane == 0) red[ok * 4 + (F.wave & 3)] = ss; }
        __syncthreads();
#pragma unroll 1
        for (int o = 0; o < 2; ++o) {
            float acc[8];
#pragma unroll
            for (int k = 0; k < 8; ++k) acc[k] = 0.f;
            const LAS float* zb = us + (2 * 2 + b) * 256 * 8; const LAS float* hb = Hh + (o * 8) * 512 + 256 + t;
            for (int sidx = 0; sidx < LC; ++sidx) { const f32x4 z0 = *(const LAS f32x4*)(zb + sidx * 8), z1 = *(const LAS f32x4*)(zb + sidx * 8 + 4);
                acc[0] += hb[0 * 512 - sidx] * z0.x; acc[1] += hb[1 * 512 - sidx] * z0.y; acc[2] += hb[2 * 512 - sidx] * z0.z; acc[3] += hb[3 * 512 - sidx] * z0.w;
                acc[4] += hb[4 * 512 - sidx] * z1.x; acc[5] += hb[5 * 512 - sidx] * z1.y; acc[6] += hb[6 * 512 - sidx] * z1.z; acc[7] += hb[7 * 512 - sidx] * z1.w; }
            float zn[8];
#pragma unroll
            for (int k = 0; k < 8; ++k) { const int ok = o * 8 + k; const float fscale = 1.0f / sqrtf(red[ok * 4] + red[ok * 4 + 1] + red[ok * 4 + 2] + red[ok * 4 + 3] + EPS);
                const float y = acc[k] * fscale + zb[t * 8 + k] * skip[o * 2048 + c0 + k]; zn[k] = us[((o * 2 + b) * 256 + t) * 8 + k] * y; }
            __syncthreads();
            if (o == 0) { LAS f32x4* d = (LAS f32x4*)(us + ((2 * 2 + b) * 256 + t) * 8); d[0] = (f32x4){zn[0], zn[1], zn[2], zn[3]}; d[1] = (f32x4){zn[4], zn[5], zn[6], zn[7]}; __syncthreads(); }
            else { u32x4 w; w.x = pk2(zn[0], zn[1]); w.y = pk2(zn[2], zn[3]); w.z = pk2(zn[4], zn[5]); w.w = pk2(zn[6], zn[7]); *(u32x4*)(MIX + (size_t)(NLAT + b * LC + t) * D + 2048 + c0) = w; }
        }
    }
}
__device__ __forceinline__ void ph_hyt(const Args& a, const Frame& F) {
    const int Z = opaque_zero();
    const float* Z2T = (const float*)WSB(WS_Z2T); bf16_t* MIX = (bf16_t*)WSB(WS_MIX);
    LAS float* tile = (LAS float*)F.lds;
    for (int it = blockIdx.x; it < 2 * 128 * 32; it += F.G) {
        const int b = it >> 12, t0 = ((it >> 5) & 127) * 64, c0 = (it & 31) * 64;
        for (int idx = F.tid; idx < 4096; idx += 512) { const int cc = idx >> 6, tt = idx & 63; tile[cc * 65 + tt] = Z2T[((size_t)b * 2048 + c0 + cc) * SEQ + t0 + tt]; }
        __syncthreads();
        { const int tt = F.tid >> 3, ck = F.tid & 7; const LAS float* sp = tile + (8 * ck) * 65 + tt;
          u32x4 o; o.x = pk2(sp[0], sp[65]); o.y = pk2(sp[2 * 65], sp[3 * 65]); o.z = pk2(sp[4 * 65], sp[5 * 65]); o.w = pk2(sp[6 * 65], sp[7 * 65]);
          *(u32x4*)(MIX + (size_t)(b * SEQ + t0 + tt) * D + 2048 + c0 + 8 * ck) = o; }
        __syncthreads();
    }
}

__device__ __forceinline__ void ph_r1(const Args& a, const Frame& F, int l) {
    const int Z = opaque_zero();
    const int M = (l == 3) ? NLAT : T; const bf16_t* ZB = (const bf16_t*)WSB(WS_P); float* RS = (float*)WSB(WS_RSTDV);
    for (int row = F.gw; row < M; row += F.NGW) {
        const u32x4* vr = (const u32x4*)(ZB + (size_t)row * ODD_IN + 4096); float ss = 0.f;
#pragma unroll
        for (int j = 0; j < 8; ++j) { const u32x4 r = vr[F.lane + 64 * j];
            ss += bflo(r.x) * bflo(r.x) + bfhi(r.x) * bfhi(r.x) + bflo(r.y) * bflo(r.y) + bfhi(r.y) * bfhi(r.y) + bflo(r.z) * bflo(r.z) + bfhi(r.z) * bfhi(r.z) + bflo(r.w) * bflo(r.w) + bfhi(r.w) * bfhi(r.w); }
        ss = wave_sum(ss);
        if (F.lane == 0) RS[row] = 1.0f / sqrtf(ss * (1.0f / 4096.f) + EPS);
    }
}
__device__ __forceinline__ void ph_sg(const Args& a, const Frame& F, int l) {
    const int Z = opaque_zero();
    const int j2 = l >> 1, M = (l == 3) ? NLAT : T;
    const bf16_t* ZB = (const bf16_t*)WSB(WS_P); bf16_t* MIX = (bf16_t*)WSB(WS_MIX); const float* RS = (const float*)WSB(WS_RSTDV);
    const float* vgain = INP(I_GM_VGAIN) + (size_t)j2 * 4096; const float* ws = INP(I_GM_WS) + (size_t)j2 * 32 * 128 * 128; const float* bs = INP(I_GM_BS) + (size_t)j2 * 32 * 128;
    LAS unsigned char* VT = F.lds;
    const int nunits = (M / 128) * 32;
    const int jl = F.lane & 15, kq = F.lane >> 4;
    for (int un = blockIdx.x; un < nunits; un += F.G) {
        const int chunk = un >> 5, g = un & 31;
        __syncthreads();
#pragma unroll
        for (int it = 0; it < 4; ++it) { const int idx = F.tid + 512 * it, q = idx >> 4, c8 = (idx & 15) * 8; const int row = chunk * 128 + q;
            const u32x4 raw = *(const u32x4*)(ZB + (size_t)row * ODD_IN + 4096 + g * 128 + c8); const float rs = RS[row]; const float* gp = vgain + g * 128 + c8;
            const float v[8] = { bflo(raw.x), bfhi(raw.x), bflo(raw.y), bfhi(raw.y), bflo(raw.z), bfhi(raw.z), bflo(raw.w), bfhi(raw.w) };
#pragma unroll
            for (int i = 0; i < 8; ++i) *(LAS unsigned short*)(VT + (c8 + i) * 272 + q * 2) = (unsigned short)f2bf(v[i] * rs * gp[i]); }
        union { bf16x8v v; unsigned u[4]; } wf[4];
        { const float* wp = ws + (size_t)g * 16384 + (size_t)(16 * F.wave + jl) * 128 + 8 * kq;
#pragma unroll
          for (int s4 = 0; s4 < 4; ++s4) { const f32x4 w0 = *(const f32x4*)(wp + 32 * s4), w1 = *(const f32x4*)(wp + 32 * s4 + 4);
              wf[s4].u[0] = pk2(w0.x, w0.y); wf[s4].u[1] = pk2(w0.z, w0.w); wf[s4].u[2] = pk2(w1.x, w1.y); wf[s4].u[3] = pk2(w1.z, w1.w); } }
        __syncthreads();
        const int p = 16 * F.wave + jl, row = chunk * 128 + p; const float bsp = bs[g * 128 + p];
#pragma unroll
        for (int cb = 0; cb < 8; ++cb) {
            f32x4 acc = (f32x4){0.f, 0.f, 0.f, 0.f};
#pragma unroll
            for (int s4 = 0; s4 < 4; ++s4) { const bf16x8v af = *(const LAS bf16x8v*)(VT + (16 * cb + jl) * 272 + (32 * s4 + 8 * kq) * 2);
                acc = __builtin_amdgcn_mfma_f32_16x16x32_bf16(af, wf[s4].v, acc, 0, 0, 0); }
            const int c0 = g * 128 + 16 * cb + 4 * kq;
            const u32x2 ur = *(const u32x2*)(ZB + (size_t)row * ODD_IN + c0);
            *(unsigned*)((unsigned char*)MIX + (size_t)row * D + c0) = pk4f8(bflo(ur.x) * (acc.x + bsp), bfhi(ur.x) * (acc.y + bsp), bflo(ur.y) * (acc.z + bsp), bfhi(ur.y) * (acc.w + bsp));
        }
    }
}

__device__ __forceinline__ void ph_router(const Args& a, const Frame& F, int l) {
    const int Z = opaque_zero();
    const int M = (l >= 2) ? NLAT : T, ntask = M / 16;
    const bf16_t* WRH = (const bf16_t*)WSB(WS_WR); const bf16_t* WRL = WRH + (size_t)4 * 3 * NE * D; const float* RB = (const float*)WSB(WS_RB); float* GATES = (float*)WSB(WS_GATES);
    const float* CX = (const float*)WSB(WS_CX); const float* rbias = INP(I_MOE_BIAS) + l * NE;
    LAS float* S = (LAS float*)(F.lds + F.wave * 8192);
    unsigned* ECNT = (unsigned*)WSB(WS_CTL) + CW_ECNT; int* ELIST = (int*)WSB(WS_ELIST);
    for (int task = F.wave * F.G + (int)blockIdx.x; task < ntask; task += 4 * F.G) {
        const int t0 = task * 16, c = t0 < SEQ ? 0 : (t0 < NLAT ? 1 : 2), j = F.lane & 15, kq = F.lane >> 4, row = t0 + j;
        const float* xr = (row < NLAT ? AOUT + (size_t)row * D : CX + (size_t)(row - NLAT) * D) + 8 * kq;
        const bf16_t* wh = WRH + ((size_t)(l * 3 + c) * NE + j) * D + 8 * kq; const bf16_t* wl = WRL + ((size_t)(l * 3 + c) * NE + j) * D + 8 * kq;
        f32x4 acc[4]; float ss = 0.f;
#pragma unroll
        for (int blk = 0; blk < 4; ++blk) acc[blk] = (f32x4){0.f, 0.f, 0.f, 0.f};
#pragma unroll 2
        for (int k0 = 0; k0 < D; k0 += 32) {
            const f32x4 x0 = *(const f32x4*)(xr + k0), x1 = *(const f32x4*)(xr + k0 + 4);
            ss += (x0.x * x0.x + x0.y * x0.y) + (x0.z * x0.z + x0.w * x0.w) + (x1.x * x1.x + x1.y * x1.y) + (x1.z * x1.z + x1.w * x1.w);
            const float xs[8] = { x0.x, x0.y, x0.z, x0.w, x1.x, x1.y, x1.z, x1.w };
            union { bf16x8v v; unsigned u[4]; } xh, xl;
#pragma unroll
            for (int q = 0; q < 4; ++q) { const unsigned b0 = __builtin_bit_cast(unsigned, xs[2 * q]), b1 = __builtin_bit_cast(unsigned, xs[2 * q + 1]);
                xh.u[q] = (b0 >> 16) | (b1 & 0xffff0000u);
                xl.u[q] = pk2(xs[2 * q] - __builtin_bit_cast(float, b0 & 0xffff0000u), xs[2 * q + 1] - __builtin_bit_cast(float, b1 & 0xffff0000u)); }
#pragma unroll
            for (int blk = 0; blk < 4; ++blk) { const bf16x8v ah = *(const bf16x8v*)(wh + (size_t)blk * 16 * D + k0), al = *(const bf16x8v*)(wl + (size_t)blk * 16 * D + k0);
                acc[blk] = __builtin_amdgcn_mfma_f32_16x16x32_bf16(ah, xh.v, acc[blk], 0, 0, 0);
                acc[blk] = __builtin_amdgcn_mfma_f32_16x16x32_bf16(al, xh.v, acc[blk], 0, 0, 0);
                acc[blk] = __builtin_amdgcn_mfma_f32_16x16x32_bf16(ah, xl.v, acc[blk], 0, 0, 0); }
        }
        ss += __shfl_xor(ss, 16); ss += __shfl_xor(ss, 32);
        const float rstd = 1.0f / sqrtf(ss * (1.0f / D) + EPS);
        LDS_WAIT();
#pragma unroll
        for (int blk = 0; blk < 4; ++blk)
#pragma unroll
            for (int r = 0; r < 4; ++r) { const int e = 16 * blk + 4 * kq + r; const float logit = acc[blk][r] * rstd + RB[(l * 3 + c) * NE + e]; S[j * 65 + e] = 1.0f / (1.0f + expf(-logit)); }
        LDS_WAIT();
        unsigned mlo, mhi; float ssum = 0.f;
        { float sc[16], sb[16];
#pragma unroll
          for (int i = 0; i < 16; ++i) { sc[i] = S[j * 65 + 16 * kq + i]; sb[i] = sc[i] + rbias[16 * kq + i]; }
          unsigned taken = 0u;
#pragma unroll 1
          for (int it = 0; it < 8; ++it) { float best = -1e30f, braw = 0.f; int bi = 0;
#pragma unroll
              for (int i = 0; i < 16; ++i) { const bool ok = !((taken >> i) & 1u) && sb[i] > best; best = ok ? sb[i] : best; bi = ok ? i : bi; braw = ok ? sc[i] : braw; }
              int gi = 16 * kq + bi;
#pragma unroll
              for (int off = 16; off <= 32; off <<= 1) { const float ob = __shfl_xor(best, off), orw = __shfl_xor(braw, off); const int oi = __shfl_xor(gi, off);
                  const bool take = (ob > best) || (ob == best && oi < gi); best = take ? ob : best; gi = take ? oi : gi; braw = take ? orw : braw; }
              if ((gi >> 4) == kq) taken |= 1u << (gi & 15);
              ssum += braw; }
          const unsigned t0m = __shfl(taken, j), t1m = __shfl(taken, j + 16), t2m = __shfl(taken, j + 32), t3m = __shfl(taken, j + 48);
          mlo = t0m | (t1m << 16); mhi = t2m | (t3m << 16); }
        unsigned selbits = 0u;
        for (int tok = 0; tok < 16; ++tok) { const unsigned lo = __shfl(mlo, tok), hi = __shfl(mhi, tok); const float sm = __shfl(ssum, tok);
            const bool sel = F.lane < 32 ? ((lo >> F.lane) & 1u) : ((hi >> (F.lane - 32)) & 1u);
            if (sel) selbits |= 1u << tok;
            GATES[(size_t)(t0 + tok) * NE + F.lane] = sel ? S[tok * 65 + F.lane] / sm * 2.5f : 0.f; }
        const int ne = __popc(selbits);
        if (ne) { int pos = (int)__hip_atomic_fetch_add(ECNT + l * NE + F.lane, (unsigned)ne, __ATOMIC_RELAXED, __HIP_MEMORY_SCOPE_AGENT);
            for (int tok = 0; tok < 16; ++tok) if ((selbits >> tok) & 1u) { ELIST[(size_t)F.lane * T + pos] = t0 + tok; ++pos; } }
    }
}

__device__ __forceinline__ void ph_cxfix(const Args& a, const Frame& F, const float* cx_src_in, int l, int gate_idx, int nsplit) {
    const int Z = opaque_zero();
    const float* cx_src = cx_src_in + Z; float* CX = (float*)WSB(WS_CX); const float* part = (const float*)WSB(WS_PART); const float* gv = MODSP(a, l, 2, gate_idx);
    for (int i = blockIdx.x * 512 + F.tid; i < NCTX * (D / 4); i += F.G * 512) {
        f32x4 s = ((const f32x4*)part)[i];
#pragma unroll
        for (int k = 1; k < 8; ++k) if (k < nsplit) s += ((const f32x4*)(part + (size_t)k * NCTX * D))[i];
        ((f32x4*)CX)[i] = ((const f32x4*)cx_src)[i] + ((const f32x4*)gv)[i & (D / 4 - 1)] * s;
    }
}
template <int l> __device__ __forceinline__ void layer_body(const Args& a, const Frame& F, const XcdBarrier& bar, const int lo, const int hi) {
#define IN(k) (lo <= (k) && (k) < hi)
#if (PROBE_DUP & 256)
#define SEAM(k) do { if (IN(k) && IN((k) + 1)) { xcd_barrier(bar); xcd_barrier(bar); } } while (0)
#else
#define SEAM(k) do { if (IN(k) && IN((k) + 1)) xcd_barrier(bar); } while (0)
#endif
        const int base = 3 + 9 * l; const bool even = (l & 1) == 0; const int M = (l == 3) ? NLAT : T; const int M2 = (l >= 2) ? NLAT : T;
        if (IN(base + 0)) { if (l >= 1 && l <= 2) { ph_cxfix(a, F, (const float*)(a.ws + WS_CX), l - 1, 5, 6); xcd_barrier(bar); }
            wq_pull(a, F, l, -1); ph_norm(a, F, l, 0, F.gw, F.NGW); }
        SEAM(base + 0);
        if (IN(base + 1)) {
            const int Z = opaque_zero(); bf16_t* H = (bf16_t*)WSB(WS_H); bf16_t* WIN = WSETP(WS_WIN, l); bf16_t* P = (bf16_t*)WSB(WS_P);
            if (even) { pg8::RowIdent RM;
                { pg8::Gemm g{(bf16_t*)WSB(WS_H8E), WIN, M, 6144, D / 2}; pg8::StaticOrderX S; S.init(M, 6144, D / 2, F.G, (int)blockIdx.x);
                  pg8::EpiBf16X<0> E{P, EVEN_IN, nullptr, 1.f / WGU_SCALE};
                  pg8::gemm_phase_x<pg8::EpiBf16X<0>, pg8::StaticOrderX, pg8::RowIdent, true>(F.lds, g, S, E, RM); }
                __syncthreads();
                { pg8::Gemm g{H, WIN + (size_t)6144 * D, M, 6144, D}; pg8::StaticOrderX S; S.init(M, 6144, D, F.G, F.G - 1 - (int)blockIdx.x);
                  pg8::EpiBf16X<0> E{P + 6144, EVEN_IN, nullptr, 1.f};
                  pg8::gemm_phase_x<pg8::EpiBf16X<0>, pg8::StaticOrderX, pg8::RowIdent, false>(F.lds, g, S, E, RM); } }
            else { pg8::Gemm g{H, WIN, M, ODD_IN, D / 2}; pg8::StaticOrderX S; S.init(M, ODD_IN, D / 2, F.G, (int)blockIdx.x); pg8::RowIdent RM;
                pg8::EpiBf16X<1> E{P, ODD_IN, INP(I_ODD_BIN) + (size_t)(l >> 1) * ODD_IN, 1.f / WGU_SCALE};
                pg8::gemm_phase_x<pg8::EpiBf16X<1>, pg8::StaticOrderX, pg8::RowIdent, true>(F.lds, g, S, E, RM); }
            if (l < 3) wq_pull(a, F, l + 1, CW_ARR + base + 1);
        }
        SEAM(base + 1);
        if (IN(base + 2)) { if (even) { ph_e1(a, F, l); ph_hyf(a, F, l); } else ph_r1(a, F, l);
#if (PROBE_DUP & 1024)
            __syncthreads(); if (even) { ph_hyf(a, F, l); }
#endif
#if (PROBE_DUP & 2)
            __syncthreads(); if (even) { ph_e1(a, F, l, false); ph_hyf(a, F, l); } else ph_r1(a, F, l);
#endif
        }
        SEAM(base + 2);
        if (IN(base + 3)) { if (even) { ph_attn(a, F, l); __syncthreads(); ph_hyc(a, F, l); __syncthreads(); if (l == 0) ph_hyx(a, F, l); } else ph_sg(a, F, l);
#if (PROBE_DUP & 4)
            __syncthreads(); if (even) { ph_attn(a, F, l); __syncthreads(); ph_hyc(a, F, l); __syncthreads(); ph_hyx(a, F, l); } else ph_sg(a, F, l);
#endif
#if (PROBE_DUP & 16)
            __syncthreads(); if (even) { ph_hyc(a, F, l); }
#endif
#if (PROBE_DUP & 32)
            __syncthreads(); if (even) { ph_attn(a, F, l); }
#endif
#if (PROBE_DUP & 64)
            __syncthreads(); if (!even) { ph_sg(a, F, l); }
#endif
        }
        SEAM(base + 3);
        if (IN(base + 4)) { if (even) ph_hyt(a, F);
#if (PROBE_DUP & 8)
            __syncthreads(); if (even) ph_hyt(a, F);
#endif
        }
        SEAM(base + 4);
        if (IN(base + 5)) {
            const int Z = opaque_zero(); bf16_t* MIX = (bf16_t*)WSB(WS_MIX); bf16_t* WOUT = WSETP(WS_WOUT, l); float* CX = (float*)WSB(WS_CX);
            pg8::RowIdent RM;
            if (even) { pg8::Gemm g{MIX, WOUT, M2, D, D}; pg8::SplitCtxOrder S; S.init(M2, D, D, F.G, (int)blockIdx.x, 8);
                pg8::EpiResidX E{l == 0 ? INP(I_X) : AOUT, AOUT, MODSP(a, l, 0, 2), (float*)WSB(WS_PART), 1.f};
                pg8::gemm_phase_x<pg8::EpiResidX, pg8::SplitCtxOrder, pg8::RowIdent>(F.lds, g, S, E, RM); }
            else { pg8::Gemm g{MIX, WOUT, M2, D, D / 2}; pg8::SplitCtxOrder S; S.init(M2, D, D / 2, F.G, (int)blockIdx.x, 8);
                pg8::EpiResidX E{AOUT, AOUT, MODSP(a, l, 0, 2), (float*)WSB(WS_PART), 1.f / WGU_SCALE};
                pg8::gemm_phase_x<pg8::EpiResidX, pg8::SplitCtxOrder, pg8::RowIdent, true>(F.lds, g, S, E, RM); }
            if (l < 3) wq_pull(a, F, l + 1, CW_ARR + base + 5);
        }
        SEAM(base + 5);
        if (IN(base + 6)) { if (M2 > NLAT) { ph_cxfix(a, F, l == 0 ? a.in[I_CTX] : (const float*)(a.ws + WS_CX), l, 2, 8); xcd_barrier(bar); }
            if (F.wave >= 4) ph_norm(a, F, l, 1, (int)blockIdx.x * 4 + F.wave - 4, F.G * 4, true); else ph_router(a, F, l);
#if (PROBE_DUP & 2048)
            __syncthreads(); if (F.wave >= 4) ph_norm(a, F, l, 1, (int)blockIdx.x * 4 + F.wave - 4, F.G * 4, true);
#endif
            }
        SEAM(base + 6);
        if (IN(base + 7)) {
            const int Z = opaque_zero(); bf16_t* H = (bf16_t*)WSB(WS_H); bf16_t* WGU = WSETP(WS_WGU, l); bf16_t* P = (bf16_t*)WSB(WS_P);
            LAS int* tab = (LAS int*)(F.lds + TAB_OFF); LAS int* cntl = tab + 640;
            const unsigned* ECNT = (const unsigned*)WSB(WS_CTL) + CW_ECNT + l * NE;
            if (F.tid < NE) cntl[F.tid] = (int)__hip_atomic_load(ECNT + F.tid, __ATOMIC_RELAXED, __HIP_MEMORY_SCOPE_AGENT);
            __syncthreads();
            if (F.tid == 0) { int n = 0; for (int e = 0; e < NE; ++e) { const int nt_ = (cntl[e] + 255) >> 8; for (int t = 0; t < nt_; ++t) tab[n++] = e | (t << 8); } cntl[NE] = n; }
            __syncthreads();
            pg8::Gemm g{H, WGU, M2, GU_N, D / 2};
            pg8::MoeOrder S{tab, cntl, cntl[NE], (M2 / 256) * 8, F.G, (int)blockIdx.x, D / 128};
            pg8::RowList RM{(const int*)WSB(WS_ELIST)};
            pg8::EpiSwigluX E{(unsigned char*)P, (const float*)WSB(WS_GATES), (const int*)WSB(WS_ELIST), 1.f / WGU_SCALE};
            pg8::gemm_phase_x<pg8::EpiSwigluX, pg8::MoeOrder, pg8::RowList, true>(F.lds, g, S, E, RM);
#if (PROBE_DUP & 512)
            __syncthreads(); pg8::gemm_phase_x<pg8::EpiSwigluX, pg8::MoeOrder, pg8::RowList, true>(F.lds, g, S, E, RM);
#endif
            if (l < 3) wq_pull(a, F, l + 1, CW_ARR + base + 7);
        }
        SEAM(base + 7);
        if (IN(base + 8)) {
            const int Z = opaque_zero(); bf16_t* P = (bf16_t*)WSB(WS_P); bf16_t* WD = WSETP(WS_WD, l); float* CX = (float*)WSB(WS_CX);
            pg8::Gemm g{P, WD, M2, D, DN_K / 2}; pg8::SplitCtxOrder S; S.init(M2, D, DN_K / 2, F.G, (int)blockIdx.x, 6);
            pg8::EpiResidX E{AOUT, AOUT, MODSP(a, l, 0, 5), (float*)WSB(WS_PART), 1.f / WD_SCALE}; pg8::RowIdent RM;
            pg8::gemm_phase_x<pg8::EpiResidX, pg8::SplitCtxOrder, pg8::RowIdent, true>(F.lds, g, S, E, RM);
            if (l < 3) wq_pull(a, F, l + 1, CW_ARR + base + 8);
        }
        if (l < 3) SEAM(base + 8);
#undef IN
#undef SEAM
}

__global__ void __launch_bounds__(512, 2) fwd_kernel(Args a) {
    extern __shared__ __attribute__((aligned(16))) unsigned char lds_raw[];
    Frame F; F.lds = (LAS unsigned char*)lds_raw; F.tid = threadIdx.x; F.lane = F.tid & 63; F.wave = __builtin_amdgcn_readfirstlane(F.tid >> 6);
    F.G = gridDim.x; F.gw = blockIdx.x * 8 + F.wave; F.NGW = F.G * 8;
    volatile LAS unsigned* MISC = (volatile LAS unsigned*)(F.lds + MISC_OFF);
    if (F.tid < 32) MISC[F.tid] = 0u;
    __syncthreads();
    const int lo = a.ph_lo, hi = a.ph_hi;
    unsigned* barw = (unsigned*)(a.ws) + CW_BAR;
    XcdBarrier bar; bar.bar = barw; bar.x = 0; bar.st = MISC + 8;
    if (hi - lo > 1) bar = xcd_barrier_post(barw, MISC + 8);
#define IN(k) (lo <= (k) && (k) < hi)
#if (PROBE_DUP & 256)
#define SEAM(k) do { if (IN(k) && IN((k) + 1)) { xcd_barrier(bar); xcd_barrier(bar); } } while (0)
#else
#define SEAM(k) do { if (IN(k) && IN((k) + 1)) xcd_barrier(bar); } while (0)
#endif

    if (IN(0)) ph_mods1(a, F);
    SEAM(0);
    if (IN(1)) ph_mods2(a, F);
    SEAM(1);
    if (IN(2)) ph_rprep(a, F);
    SEAM(2);
#if (PROBE_DUP & 4096)
    ph_mods1(a, F); xcd_barrier(bar); ph_mods2(a, F); xcd_barrier(bar); ph_rprep(a, F); xcd_barrier(bar);
#endif
    layer_body<0>(a, F, bar, lo, hi);
    layer_body<1>(a, F, bar, lo, hi);
    layer_body<2>(a, F, bar, lo, hi);
    layer_body<3>(a, F, bar, lo, hi);
#undef IN
#undef SEAM
}
constexpr int N_PHASES = 3 + 9 * 4;

extern "C" void kernel_launch(void* const* d_in, const int* in_sizes, int n_in, void* d_out, int out_size, void* d_ws, size_t ws_size, hipStream_t stream) {
    static int grid = 0;
    if (grid == 0) {
        if (n_in != 38 || out_size != NLAT * D || ws_size < WS_END2) { fprintf(stderr, "kernel_launch: unexpected sizes (n_in %d, out %d, ws %zu < %zu)\n", n_in, out_size, ws_size, (size_t)WS_END2); grid = -1; return; }
        int dev = 0, cus = 0, per_cu = 0;
        if (hipGetDevice(&dev) != hipSuccess || hipDeviceGetAttribute(&cus, hipDeviceAttributeMultiprocessorCount, dev) != hipSuccess) { grid = -1; return; }
        if (hipFuncSetAttribute((const void*)fwd_kernel, hipFuncAttributeMaxDynamicSharedMemorySize, LDS_BYTES) != hipSuccess) { fprintf(stderr, "kernel_launch: hipFuncSetAttribute failed\n"); grid = -1; return; }
        if (hipOccupancyMaxActiveBlocksPerMultiprocessor(&per_cu, (const void*)fwd_kernel, 512, LDS_BYTES) != hipSuccess || per_cu < 1) fprintf(stderr, "kernel_launch: occupancy query reports %d\n", per_cu);
        (void)hipGetLastError();
        grid = cus;
    }
    if (grid < 0) return;
    (void)hipMemsetAsync((char*)d_ws + WS_CTL, 0, CTL_ZERO_BYTES, stream);
    Args a{};
    for (int i = 0; i < 38; ++i) a.in[i] = (const float*)d_in[i];
    a.out = (float*)d_out; a.ws = (unsigned char*)d_ws;
#if MK_PER_PHASE
    for (int k = 0; k < N_PHASES; ++k) { a.ph_lo = k; a.ph_hi = k + 1; hipLaunchKernelGGL(fwd_kernel, dim3(grid), dim3(512), LDS_BYTES, stream, a); }
#else
    a.ph_lo = 0; a.ph_hi = N_PHASES;
    hipLaunchKernelGGL(fwd_kernel, dim3(grid), dim3(512), LDS_BYTES, stream, a);
#endif
}
```

```cpp
#include <hip/hip_runtime.h>
#include <cstdio>
#include <cstdint>

#ifndef MK_PER_PHASE
#define MK_PER_PHASE 0
#endif

#ifndef PROBE_DUP
#define PROBE_DUP 0
#endif

constexpr int D = 4096, SEQ = 8192, NLAT = 16384, LC = 256, NCTX = 512, T = NLAT + NCTX;
constexpr int EVEN_IN = 12288, ODD_IN = 8192, NE = 64, ED = 128, SHD = 1024, RANK = 256;
constexpr int GU_N = (NE * ED + SHD) * 2;
constexpr int DN_K = NE * ED + SHD;
constexpr float EPS = 1e-6f;

namespace pg8 {
#define PG8_LAS __attribute__((address_space(3)))
typedef unsigned short bf16_t;
typedef short bf16x8 __attribute__((ext_vector_type(8)));
typedef float f32x4 __attribute__((ext_vector_type(4)));
typedef unsigned u32x4 __attribute__((ext_vector_type(4)));
constexpr int BM = 256, BK = 64, HALF = 128, HTB = HALF * BK * 2  , STAGE_BYTES = 8 * HTB, NXCD = 8, WGM = 8;

__host__ __device__ __forceinline__ int lds_byte(int r, int c) { const int st = (r >> 4) * 2 + (c >> 5), rr = r & 15, cc = c & 31, ob = rr * 64 + cc * 2; return st * 1024 + (ob ^ (((ob >> 9) & 1) << 5)); }
__host__ __device__ __forceinline__ void stage_rc(int b, int& R, int& C) { const int st = b / 1024, sb = b % 1024, swz = sb ^ (((sb >> 9) & 1) << 5); R = (st >> 1) * 16 + swz / 64; C = (st & 1) * 32 + (swz % 64) / 2; }
__host__ __device__ __forceinline__ int perm32(int rho) { const int n = rho >> 4, i = rho & 15; return 8 * (i >> 2) + 4 * n + (i & 3); }

struct Unit { int pm, pn; };
struct Gemm { const bf16_t* A; const bf16_t* Bt; int M, N, K; };

struct StaticOrder {
    int nM, nN, nwg, G, c;
    __host__ __device__ void init(int M, int N, int G_, int c_) { nM = M / BM; nN = N / BM; nwg = nM * nN; G = G_; c = c_; }
    __host__ __device__ bool next(int i, Unit& u) const {
        const long L = (long)i * G + c; if (L >= nwg) return false;
        int wgid = (int)L; { const int q = nwg / NXCD, r = nwg % NXCD, xcd = wgid % NXCD, off = wgid / NXCD; wgid = (xcd < r ? xcd * (q + 1) : r * (q + 1) + (xcd - r) * q) + off; }
        const int nig = WGM * nN, gid = wgid / nig, fm = gid * WGM, gsz = (nM - fm) < WGM ? (nM - fm) : WGM;
        u.pm = fm + ((wgid % nig) % gsz); u.pn = (wgid % nig) / gsz; return true;
    }
    __device__ __forceinline__ void a_ready(const Unit&) const {}
    __device__ __forceinline__ void done(const Unit&) const {}
};

__device__ __forceinline__ unsigned cvt_pk_bf16(float lo, float hi) { unsigned r; asm volatile("v_cvt_pk_bf16_f32 %0, %1, %2" : "=v"(r) : "v"(lo), "v"(hi)); return r; }
typedef float f32x2 __attribute__((ext_vector_type(2)));
__device__ __forceinline__ f32x2 gelu_pk(f32x2 v) {
    const f32x2 av = __builtin_elementwise_abs(v), d = av * 0.2316418882f + 1.0f;
    f32x2 t; t.x = __builtin_amdgcn_rcpf(d.x); t.y = __builtin_amdgcn_rcpf(d.y);
    f32x2 q = t * 0.5307027145f + (-0.7265760135f); q = q * t + 0.7107068705f; q = q * t + (-0.142248368f); q = q * t + 0.127414796f; q = q * t;
    const f32x2 s = (v * v) * (-0.72134752044f);
    f32x2 e; e.x = __builtin_amdgcn_exp2f(s.x); e.y = __builtin_amdgcn_exp2f(s.y);
    const f32x2 m = v * (q * e), r = v - m;
    f32x2 o; o.x = v.x < 0.f ? m.x : r.x; o.y = v.y < 0.f ? m.y : r.y; return o;
}

template <int ACT  > struct EpiBf16 {
    static constexpr bool PERM = true, AFTER_DRAIN = false; static_assert(ACT == 0 || ACT == 1, "EpiBf16: ACT is 0 (none) or 1 (gelu_pk)");
    bf16_t* O; int ldc; const float* bias; int split_cols; size_t split_stride; float scale0;
    __device__ __forceinline__ void operator()(const f32x4 (&acc)[2][2][4][2], const Unit& u, int wr, int wc, int fr, int fq) const {
        const int row0 = u.pm * BM + wr * 64 + fr; int colt = u.pn * BM; bf16_t* base = O;
        float sc = 1.f; if (split_cols) { const int t = colt / split_cols; base += (size_t)t * split_stride; colt -= t * split_cols; if (t == 0) sc = scale0; }
        const int col0 = colt + wc * 32 + 8 * fq, bcol0 = u.pn * BM + wc * 32 + 8 * fq;
        f32x4 bv[2][2];
#pragma unroll
        for (int bj = 0; bj < 2; ++bj)
#pragma unroll
            for (int n = 0; n < 2; ++n) bv[bj][n] = bias ? *(const f32x4*)(bias + bcol0 + bj * HALF + 4 * n) : (f32x4){0.f, 0.f, 0.f, 0.f};
#pragma unroll
        for (int ai = 0; ai < 2; ++ai)
#pragma unroll
            for (int m = 0; m < 4; ++m) { bf16_t* rowp = base + (size_t)(row0 + ai * HALF + m * 16) * ldc + col0;
#pragma unroll
                for (int bj = 0; bj < 2; ++bj) { f32x4 v0 = acc[ai][bj][m][0] + bv[bj][0], v1 = acc[ai][bj][m][1] + bv[bj][1];
                    if (ACT == 1) { f32x2 a = gelu_pk((f32x2){v0[0], v0[1]}), b = gelu_pk((f32x2){v0[2], v0[3]}), c = gelu_pk((f32x2){v1[0], v1[1]}), d = gelu_pk((f32x2){v1[2], v1[3]});
                        v0 = (f32x4){a.x, a.y, b.x, b.y}; v1 = (f32x4){c.x, c.y, d.x, d.y}; }
                    v0 = v0 * sc; v1 = v1 * sc; u32x4 w; w.x = cvt_pk_bf16(v0[0], v0[1]); w.y = cvt_pk_bf16(v0[2], v0[3]); w.z = cvt_pk_bf16(v1[0], v1[1]); w.w = cvt_pk_bf16(v1[2], v1[3]);
                    *(u32x4*)(rowp + bj * HALF) = w; } }
    }
};

struct EpiResid {
    static constexpr bool PERM = false, AFTER_DRAIN = false;
    const float* lat_src; const float* cx_src; float* lat_dst; float* cx_dst; const float* gate;
    __device__ __forceinline__ void operator()(const f32x4 (&acc)[2][2][4][2], const Unit& u, int wr, int wc, int fr, int fq) const {
        const int rowt = u.pm * BM; int c, rbase; const float* src; float* dst;
        if (rowt < NLAT) { c = rowt < SEQ ? 0 : 1; src = lat_src; dst = lat_dst; rbase = 0; } else { c = 2; src = cx_src; dst = cx_dst; rbase = NLAT; }
        const float* gv = gate + (size_t)c * 6 * D;
        const int row0 = rowt - rbase + wr * 64 + fr, col0 = u.pn * BM + wc * 32 + 4 * fq;
        f32x4 g[2][2];
#pragma unroll
        for (int bj = 0; bj < 2; ++bj)
#pragma unroll
            for (int n = 0; n < 2; ++n) g[bj][n] = *(const f32x4*)(gv + col0 + bj * HALF + n * 16);
#pragma unroll
        for (int ai = 0; ai < 2; ++ai)
#pragma unroll
            for (int m = 0; m < 4; ++m) { const size_t off = (size_t)(row0 + ai * HALF + m * 16) * D + col0;
#pragma unroll
                for (int bj = 0; bj < 2; ++bj)
#pragma unroll
                    for (int n = 0; n < 2; ++n) { const f32x4 s = *(const f32x4*)(src + off + bj * HALF + n * 16); *(f32x4*)(dst + off + bj * HALF + n * 16) = s + g[bj][n] * acc[ai][bj][m][n]; } }
    }
};
struct EpiSwiglu {
    static constexpr bool PERM = true, AFTER_DRAIN = false;
    bf16_t* H; const float* gates;
    __device__ __forceinline__ void operator()(const f32x4 (&acc)[2][2][4][2], const Unit& u, int wr, int wc, int fr, int fq) const {
        const int row0 = u.pm * BM + wr * 64 + fr, hc0 = u.pn * 128 + wc * 16 + 4 * fq;
#pragma unroll
        for (int ai = 0; ai < 2; ++ai)
#pragma unroll
            for (int m = 0; m < 4; ++m) { const int row = row0 + ai * HALF + m * 16; const float gt = (u.pn < NE) ? gates[(size_t)row * NE + u.pn] : 1.f;
#pragma unroll
                for (int bj = 0; bj < 2; ++bj) { const f32x4 v0 = acc[ai][bj][m][0], v1 = acc[ai][bj][m][1];
                    const float h0 = v0[0] / (1.f + __expf(-v0[0])) * v0[1] * gt, h1 = v0[2] / (1.f + __expf(-v0[2])) * v0[3] * gt;
                    const float h2 = v1[0] / (1.f + __expf(-v1[0])) * v1[1] * gt, h3 = v1[2] / (1.f + __expf(-v1[2])) * v1[3] * gt;
                    typedef unsigned u32x2v __attribute__((ext_vector_type(2))); u32x2v w; w.x = cvt_pk_bf16(h0, h1); w.y = cvt_pk_bf16(h2, h3);
                    *(u32x2v*)(H + (size_t)row * DN_K + hc0 + bj * 64) = w; } }
    }
};

template <class Epi, class Sched, bool ALIGN_EPI = false, bool SP2 = false>
__device__ __forceinline__ void gemm_phase(PG8_LAS unsigned char* lds, const Gemm g, const Sched& S, const Epi& E) {
    int tid_o = threadIdx.x; asm volatile("" : "+v"(tid_o));
    const int tid = tid_o, wid = __builtin_amdgcn_readfirstlane(tid >> 6), lane = tid & 63, wr = wid >> 2, wc = wid & 3, fr = lane & 15, fq = lane >> 4;
    const int K = g.K, nt = K / BK;
    unsigned voffA[2], voffB[2];
#pragma unroll
    for (int i = 0; i < 2; ++i) { int R, C; stage_rc(tid * 16 + i * 8192, R, C); const int Rb = Epi::PERM ? ((R & ~31) + perm32(R & 31)) : R;
        voffA[i] = (unsigned)(R * K + C) * 2u; voffB[i] = (unsigned)(Rb * K + C) * 2u; }
    const size_t kstep = (size_t)(BK * 2);
    const size_t hstep = (size_t)HALF * K * 2;
    const size_t tstep = 2 * hstep;
    const unsigned ldsw = (unsigned)wid * 1024u;
    const int aoff = lds_byte(wr * 64 + fr, fq * 8), boff = lds_byte(wc * 32 + fr, fq * 8);
#define PG8_SA(b, h) (((b) * 2 + (h)) * HTB)
#define PG8_SB(b, h) ((4 + (b) * 2 + (h)) * HTB)
#define PG8_STAGE(bufoff, gbase, voff) do { _Pragma("unroll") for (int _i = 0; _i < 2; ++_i) \
        __builtin_amdgcn_global_load_lds((const unsigned*)((const char*)(gbase) + (voff)[_i]), (PG8_LAS unsigned*)(lds + (bufoff) + ldsw + _i * 8192), 16, 0, 0); } while (0)
#define PG8_LDA(dst, b, h) do { _Pragma("unroll") for (int m = 0; m < 4; ++m) _Pragma("unroll") for (int k = 0; k < 2; ++k) dst[m][k] = *(const PG8_LAS bf16x8*)(lds + PG8_SA(b, h) + aoff + m * 2048 + k * 1024); } while (0)
#define PG8_LDB(dst, b, h) do { _Pragma("unroll") for (int n = 0; n < 2; ++n) _Pragma("unroll") for (int k = 0; k < 2; ++k) dst[n][k] = *(const PG8_LAS bf16x8*)(lds + PG8_SB(b, h) + boff + n * 2048 + k * 1024); } while (0)
#define PG8_MMA(ai, bj, At, Bt) do { __builtin_amdgcn_s_setprio(1); _Pragma("unroll") for (int m = 0; m < 4; ++m) _Pragma("unroll") for (int n = 0; n < 2; ++n) _Pragma("unroll") for (int k = 0; k < 2; ++k) \
        acc[ai][bj][m][n] = __builtin_amdgcn_mfma_f32_16x16x32_bf16(Bt[n][k], At[m][k], acc[ai][bj][m][n], 0, 0, 0); __builtin_amdgcn_s_setprio(0); } while (0)
#define PG8_WAIT_V(n) asm volatile("s_waitcnt vmcnt(" #n ")" ::: "memory")
#define PG8_WAIT_L(n) asm volatile("s_waitcnt lgkmcnt(" #n ")" ::: "memory")
#define PG8_BAR __builtin_amdgcn_s_barrier()
#define PG8_SCHED __builtin_amdgcn_sched_barrier(0)
    Unit cur, nxt; int ui = 0;
    if (!S.next(0, cur)) return;
    f32x4 acc[2][2][4][2];
#pragma unroll
    for (int a = 0; a < 2; ++a)
#pragma unroll
        for (int b = 0; b < 2; ++b)
#pragma unroll
            for (int m = 0; m < 4; ++m)
#pragma unroll
                for (int n = 0; n < 2; ++n) acc[a][b][m][n] = (f32x4){0.f, 0.f, 0.f, 0.f};
    bf16x8 At[4][2], B0[2][2], B1[2][2];
    const char* cA = (const char*)g.A + (size_t)cur.pm * tstep; const char* cB = (const char*)g.Bt + (size_t)cur.pn * tstep;
    S.a_ready(cur);
    if constexpr (SP2) {
        PG8_STAGE(PG8_SB(0, 0), cB, voffB); PG8_STAGE(PG8_SB(0, 1), cB + hstep, voffB); PG8_STAGE(PG8_SA(0, 0), cA, voffA); PG8_STAGE(PG8_SA(0, 1), cA + hstep, voffA);
        if (wr == 1) PG8_BAR;
        PG8_WAIT_V(2); PG8_BAR;
        PG8_STAGE(PG8_SB(1, 0), cB + kstep, voffB); PG8_STAGE(PG8_SA(1, 0), cA + kstep, voffA); PG8_STAGE(PG8_SB(1, 1), cB + hstep + kstep, voffB);
        PG8_WAIT_V(6); PG8_BAR;
    } else {
        PG8_STAGE(PG8_SB(0, 0), cB, voffB); PG8_STAGE(PG8_SA(0, 0), cA, voffA); PG8_STAGE(PG8_SB(0, 1), cB + hstep, voffB); PG8_STAGE(PG8_SA(0, 1), cA + hstep, voffA);
        if (wr == 1) PG8_BAR;
        PG8_WAIT_V(4); PG8_BAR;
        PG8_STAGE(PG8_SB(1, 0), cB + kstep, voffB); PG8_STAGE(PG8_SA(1, 0), cA + kstep, voffA); PG8_STAGE(PG8_SB(1, 1), cB + hstep + kstep, voffB);
        PG8_WAIT_V(6); PG8_BAR;
    }
    for (;;) {
        const bool has_next = S.next(ui + 1, nxt);
        const char* nA = has_next ? (const char*)g.A + (size_t)nxt.pm * tstep : cA; const char* nB = has_next ? (const char*)g.Bt + (size_t)nxt.pn * tstep : cB;
        for (int t = 0; t < nt; t += 2) {
            const bool last = (t == nt - 2);
            const char* a1 = cA + (size_t)(t + 1) * kstep;
            const char* a2 = last ? nA : cA + (size_t)(t + 2) * kstep; const char* b2 = last ? nB : cB + (size_t)(t + 2) * kstep;
            const char* a3 = a2 + kstep; const char* b3 = b2 + kstep;
            if (last && has_next) S.a_ready(nxt);
            if constexpr (SP2) {
            PG8_LDB(B0, 0, 0); PG8_LDB(B1, 0, 1); PG8_SCHED; PG8_LDA(At, 0, 0); PG8_STAGE(PG8_SA(1, 1), a1 + hstep, voffA);
            PG8_WAIT_V(8); PG8_WAIT_L(0); PG8_BAR; PG8_MMA(0, 0, At, B0); PG8_MMA(0, 1, At, B1); PG8_BAR; PG8_SCHED;
            PG8_LDA(At, 0, 1); PG8_STAGE(PG8_SB(0, 0), b2, voffB); PG8_STAGE(PG8_SB(0, 1), b2 + hstep, voffB); PG8_STAGE(PG8_SA(0, 0), a2, voffA);
            PG8_WAIT_V(8); PG8_WAIT_L(0); PG8_BAR; PG8_MMA(1, 0, At, B0); PG8_MMA(1, 1, At, B1); PG8_BAR; PG8_SCHED;
            PG8_LDB(B0, 1, 0); PG8_LDB(B1, 1, 1); PG8_SCHED; PG8_LDA(At, 1, 0); PG8_STAGE(PG8_SA(0, 1), a2 + hstep, voffA);
            PG8_WAIT_V(8); PG8_WAIT_L(0); PG8_BAR; PG8_MMA(0, 0, At, B0); PG8_MMA(0, 1, At, B1); PG8_BAR; PG8_SCHED;
            PG8_LDA(At, 1, 1); PG8_STAGE(PG8_SB(1, 0), b3, voffB); PG8_STAGE(PG8_SB(1, 1), b3 + hstep, voffB); PG8_STAGE(PG8_SA(1, 0), a3, voffA);
            PG8_WAIT_V(8); PG8_WAIT_L(0); PG8_BAR; PG8_MMA(1, 0, At, B0); PG8_MMA(1, 1, At, B1); PG8_BAR; PG8_SCHED;
            } else {
            PG8_LDB(B0, 0, 0); PG8_SCHED; PG8_LDA(At, 0, 0); PG8_STAGE(PG8_SA(1, 1), a1 + hstep, voffA);
            PG8_WAIT_L(8); PG8_BAR; PG8_WAIT_L(0); PG8_MMA(0, 0, At, B0); PG8_BAR; PG8_SCHED;
            PG8_LDB(B1, 0, 1); PG8_STAGE(PG8_SB(0, 0), b2, voffB);
            PG8_BAR; PG8_WAIT_L(0); PG8_MMA(0, 1, At, B1); PG8_BAR;
            PG8_LDA(At, 0, 1); PG8_STAGE(PG8_SA(0, 0), a2, voffA);
            PG8_BAR; PG8_WAIT_L(0); PG8_MMA(1, 0, At, B0); PG8_BAR; PG8_SCHED;
            PG8_STAGE(PG8_SB(0, 1), b2 + hstep, voffB);
            PG8_WAIT_V(6); PG8_BAR; PG8_MMA(1, 1, At, B1); PG8_BAR;
            PG8_LDB(B0, 1, 0); PG8_SCHED; PG8_LDA(At, 1, 0); PG8_STAGE(PG8_SA(0, 1), a2 + hstep, voffA);
            PG8_WAIT_L(8); PG8_BAR; PG8_WAIT_L(0); PG8_MMA(0, 0, At, B0); PG8_BAR; PG8_SCHED;
            PG8_LDB(B1, 1, 1); PG8_STAGE(PG8_SB(1, 0), b3, voffB);
            PG8_BAR; PG8_WAIT_L(0); PG8_MMA(0, 1, At, B1); PG8_BAR;
            PG8_LDA(At, 1, 1); PG8_STAGE(PG8_SA(1, 0), a3, voffA);
            PG8_BAR; PG8_WAIT_L(0); PG8_MMA(1, 0, At, B0); PG8_BAR; PG8_SCHED;
            PG8_STAGE(PG8_SB(1, 1), b3 + hstep, voffB);
            PG8_WAIT_V(6); PG8_BAR; PG8_MMA(1, 1, At, B1); PG8_BAR;
            }
        }
        if constexpr (ALIGN_EPI) { if (wr == 0) PG8_BAR; }
        if constexpr (!Epi::AFTER_DRAIN) { E(acc, cur, wr, wc, fr, fq); S.done(cur); }
        if (!has_next) break;
#pragma unroll
        for (int a = 0; a < 2; ++a)
#pragma unroll
            for (int b = 0; b < 2; ++b)
#pragma unroll
                for (int m = 0; m < 4; ++m)
#pragma unroll
                    for (int n = 0; n < 2; ++n) acc[a][b][m][n] = (f32x4){0.f, 0.f, 0.f, 0.f};
        cur = nxt; cA = nA; cB = nB; ++ui;
        if constexpr (ALIGN_EPI) { if (wr == 1) PG8_BAR; }
    }
    PG8_WAIT_V(0);
    if constexpr (!ALIGN_EPI) { if (wr == 0) PG8_BAR; }
    PG8_BAR;
    if constexpr (Epi::AFTER_DRAIN) { E.fused(acc, cur, wr, wc, fr, fq, lds, wid, lane); S.done(cur); }
#undef PG8_SA
#undef PG8_SB
#undef PG8_STAGE
#undef PG8_LDA
#undef PG8_LDB
#undef PG8_MMA
#undef PG8_WAIT_V
#undef PG8_WAIT_L
#undef PG8_BAR
#undef PG8_SCHED
}

struct UnitX { int pm, pn, e, nrows, k0, nt; };
typedef int i32x4 __attribute__((ext_vector_type(4)));
typedef int i32x8 __attribute__((ext_vector_type(8)));
template <class Epi, class Sched, class RowMap, bool F8 = false>
__device__ __forceinline__ void gemm_phase_x(PG8_LAS unsigned char* lds, const Gemm g, const Sched& S, const Epi& E, const RowMap& RM) {
    int tid_o = threadIdx.x; asm volatile("" : "+v"(tid_o));
    const int tid = tid_o, wid = __builtin_amdgcn_readfirstlane(tid >> 6), lane = tid & 63, wr = wid >> 2, wc = wid & 3, fr = lane & 15, fq = lane >> 4;
    const int K = g.K;
    int R_[2], C_[2]; unsigned voffB[2];
#pragma unroll
    for (int i = 0; i < 2; ++i) { stage_rc(tid * 16 + i * 8192, R_[i], C_[i]); const int Rb = Epi::PERM ? ((R_[i] & ~31) + perm32(R_[i] & 31)) : R_[i]; voffB[i] = (unsigned)(Rb * K + C_[i]) * 2u; }
    const size_t kstep = (size_t)(BK * 2);
    const size_t hstep = (size_t)HALF * K * 2;
    const size_t tstep = 2 * hstep;
    const unsigned ldsw = (unsigned)wid * 1024u;
    const int aoff = lds_byte(wr * 64 + fr, fq * 8), boff = lds_byte(wc * 32 + fr, fq * 8);
#define PG8_SA(b, h) (((b) * 2 + (h)) * HTB)
#define PG8_SB(b, h) ((4 + (b) * 2 + (h)) * HTB)
#define PG8_STAGE(bufoff, gbase, voff) do { _Pragma("unroll") for (int _i = 0; _i < 2; ++_i) \
        __builtin_amdgcn_global_load_lds((const unsigned*)((const char*)(gbase) + (voff)[_i]), (PG8_LAS unsigned*)(lds + (bufoff) + ldsw + _i * 8192), 16, 0, 0); } while (0)
#define PG8_LD8(dst, addr) do { const i32x4 _lo = *(const PG8_LAS i32x4*)(addr), _hi = *(const PG8_LAS i32x4*)((addr) + 1024); dst = __builtin_shufflevector(_lo, _hi, 0, 1, 2, 3, 4, 5, 6, 7); } while (0)
#define PG8_LDA(dst, b, h) do { _Pragma("unroll") for (int m = 0; m < 4; ++m) PG8_LD8(dst[m], lds + PG8_SA(b, h) + aoff + m * 2048); } while (0)
#define PG8_LDB(dst, b, h) do { _Pragma("unroll") for (int n = 0; n < 2; ++n) PG8_LD8(dst[n], lds + PG8_SB(b, h) + boff + n * 2048); } while (0)
#define PG8_LOH(v) __builtin_bit_cast(bf16x8, __builtin_shufflevector(v, v, 0, 1, 2, 3))
#define PG8_HIH(v) __builtin_bit_cast(bf16x8, __builtin_shufflevector(v, v, 4, 5, 6, 7))
#define PG8_MMA(ai, bj, At, Bt) do { __builtin_amdgcn_s_setprio(1); _Pragma("unroll") for (int m = 0; m < 4; ++m) _Pragma("unroll") for (int n = 0; n < 2; ++n) { \
        if constexpr (F8) asm volatile("v_mfma_scale_f32_16x16x128_f8f6f4 %0, %1, %2, %0, %3, %3 op_sel_hi:[0,0,0]" : "+v"(acc[ai][bj][m][n]) : "v"(Bt[n]), "v"(At[m]), "v"(sc8)); \
        else { acc[ai][bj][m][n] = __builtin_amdgcn_mfma_f32_16x16x32_bf16(PG8_LOH(Bt[n]), PG8_LOH(At[m]), acc[ai][bj][m][n], 0, 0, 0); \
               acc[ai][bj][m][n] = __builtin_amdgcn_mfma_f32_16x16x32_bf16(PG8_HIH(Bt[n]), PG8_HIH(At[m]), acc[ai][bj][m][n], 0, 0, 0); } } \
        __builtin_amdgcn_s_setprio(0); } while (0)
#define PG8_WAIT_V(n) asm volatile("s_waitcnt vmcnt(" #n ")" ::: "memory")
#define PG8_WAIT_L(n) asm volatile("s_waitcnt lgkmcnt(" #n ")" ::: "memory")
#define PG8_BAR __builtin_amdgcn_s_barrier()
#define PG8_SCHED __builtin_amdgcn_sched_barrier(0)
#define PG8_ROWOFF(dst, u) do { _Pragma("unroll") for (int _h = 0; _h < 2; ++_h) _Pragma("unroll") for (int _i = 0; _i < 2; ++_i) \
        dst[_h][_i] = (RM.row(u, _h * HALF + R_[_i]) * (unsigned)K + (unsigned)C_[_i]) * 2u; } while (0)
#define PG8_ABASE(u) ((const char*)g.A + ((size_t)RM.base(u) * K + (size_t)(u).k0) * 2)
    UnitX cur, nxt; int ui = 0;
    if (!S.next(0, cur)) return;
    f32x4 acc[2][2][4][2];
#pragma unroll
    for (int a = 0; a < 2; ++a)
#pragma unroll
        for (int b = 0; b < 2; ++b)
#pragma unroll
            for (int m = 0; m < 4; ++m)
#pragma unroll
                for (int n = 0; n < 2; ++n) acc[a][b][m][n] = (f32x4){0.f, 0.f, 0.f, 0.f};
    i32x8 At[4], B0[2], B1[2];
    const int sc8 = 0x7f7f7f7f;
    unsigned vc[2][2], vn[2][2];
    PG8_ROWOFF(vc, cur);
    const char* A0 = PG8_ABASE(cur);
    const char* cB = (const char*)g.Bt + (size_t)cur.pn * tstep + (size_t)cur.k0 * 2;
    PG8_STAGE(PG8_SB(0, 0), cB, voffB); PG8_STAGE(PG8_SB(0, 1), cB + hstep, voffB); PG8_STAGE(PG8_SA(0, 0), A0, vc[0]); PG8_STAGE(PG8_SA(0, 1), A0, vc[1]);
    if (wr == 1) PG8_BAR;
    PG8_WAIT_V(2); PG8_BAR;
    PG8_STAGE(PG8_SB(1, 0), cB + kstep, voffB); PG8_STAGE(PG8_SA(1, 0), A0 + kstep, vc[0]); PG8_STAGE(PG8_SB(1, 1), cB + hstep + kstep, voffB);
    PG8_WAIT_V(6); PG8_BAR;
    for (;;) {
        const bool has_next = S.next(ui + 1, nxt);
        if constexpr (!RowMap::IDENT) { if (has_next) { PG8_ROWOFF(vn, nxt); } else {
#pragma unroll
            for (int _h = 0; _h < 2; ++_h)
#pragma unroll
                for (int _i = 0; _i < 2; ++_i) vn[_h][_i] = vc[_h][_i]; } }
        const char* nB = has_next ? (const char*)g.Bt + (size_t)nxt.pn * tstep + (size_t)nxt.k0 * 2 : cB;
        const char* nA = has_next ? PG8_ABASE(nxt) : A0;
        const int nt = cur.nt;
        for (int t = 0; t < nt; t += 2) {
            const bool last = (t == nt - 2);
            const char* a1 = A0 + (size_t)(t + 1) * kstep;
            const char* a2 = last ? nA : A0 + (size_t)(t + 2) * kstep; const char* b2 = last ? nB : cB + (size_t)(t + 2) * kstep;
            const char* a3 = a2 + kstep; const char* b3 = b2 + kstep;
            unsigned v2h0[2], v2h1[2];
#pragma unroll
            for (int _i = 0; _i < 2; ++_i) { if constexpr (RowMap::IDENT) { v2h0[_i] = vc[0][_i]; v2h1[_i] = vc[1][_i]; } else { v2h0[_i] = last ? vn[0][_i] : vc[0][_i]; v2h1[_i] = last ? vn[1][_i] : vc[1][_i]; } }
            PG8_LDB(B0, 0, 0); PG8_LDB(B1, 0, 1); PG8_SCHED; PG8_LDA(At, 0, 0); PG8_STAGE(PG8_SA(1, 1), a1, vc[1]);
            PG8_WAIT_V(8); PG8_WAIT_L(0); PG8_BAR; PG8_MMA(0, 0, At, B0); PG8_MMA(0, 1, At, B1); PG8_BAR; PG8_SCHED;
            PG8_LDA(At, 0, 1); PG8_STAGE(PG8_SB(0, 0), b2, voffB); PG8_STAGE(PG8_SB(0, 1), b2 + hstep, voffB); PG8_STAGE(PG8_SA(0, 0), a2, v2h0);
            PG8_WAIT_V(8); PG8_WAIT_L(0); PG8_BAR; PG8_MMA(1, 0, At, B0); PG8_MMA(1, 1, At, B1); PG8_BAR; PG8_SCHED;
            PG8_LDB(B0, 1, 0); PG8_LDB(B1, 1, 1); PG8_SCHED; PG8_LDA(At, 1, 0); PG8_STAGE(PG8_SA(0, 1), a2, v2h1);
            PG8_WAIT_V(8); PG8_WAIT_L(0); PG8_BAR; PG8_MMA(0, 0, At, B0); PG8_MMA(0, 1, At, B1); PG8_BAR; PG8_SCHED;
            PG8_LDA(At, 1, 1); PG8_STAGE(PG8_SB(1, 0), b3, voffB); PG8_STAGE(PG8_SB(1, 1), b3 + hstep, voffB); PG8_STAGE(PG8_SA(1, 0), a3, v2h0);
            PG8_WAIT_V(8); PG8_WAIT_L(0); PG8_BAR; PG8_MMA(1, 0, At, B0); PG8_MMA(1, 1, At, B1); PG8_BAR; PG8_SCHED;
        }
        if constexpr (F8) asm volatile("s_nop 7\n\ts_nop 7\n\ts_nop 7" ::: "memory");
        if (wr == 0) PG8_BAR;
        E(acc, cur, wr, wc, fr, fq);
        if (!has_next) break;
#pragma unroll
        for (int a = 0; a < 2; ++a)
#pragma unroll
            for (int b = 0; b < 2; ++b)
#pragma unroll
                for (int m = 0; m < 4; ++m)
#pragma unroll
                    for (int n = 0; n < 2; ++n) acc[a][b][m][n] = (f32x4){0.f, 0.f, 0.f, 0.f};
        cur = nxt; cB = nB; A0 = nA; ++ui;
        if constexpr (!RowMap::IDENT) {
#pragma unroll
        for (int _h = 0; _h < 2; ++_h)
#pragma unroll
            for (int _i = 0; _i < 2; ++_i) vc[_h][_i] = vn[_h][_i]; }
        if (wr == 1) PG8_BAR;
    }
    PG8_WAIT_V(0);
    PG8_BAR;
#undef PG8_SA
#undef PG8_SB
#undef PG8_STAGE
#undef PG8_LDA
#undef PG8_LDB
#undef PG8_LD8
#undef PG8_LOH
#undef PG8_HIH
#undef PG8_MMA
#undef PG8_WAIT_V
#undef PG8_WAIT_L
#undef PG8_BAR
#undef PG8_SCHED
#undef PG8_ROWOFF
#undef PG8_ABASE
}

struct MoeOrder {
    const PG8_LAS int* tab; const PG8_LAS int* cnt; int Ur, nSh, G, c, ntk;
    __device__ __forceinline__ bool next(int i, UnitX& u) const {
        int L = i * G + c; u.k0 = 0; u.nt = ntk;
        if (L < Ur) { const int v = tab[L]; u.e = v & 255; u.pm = v >> 8; u.pn = u.e; u.nrows = cnt[u.e]; return true; }
        L -= Ur;
        if (L < nSh) { u.e = -1; u.pm = L >> 3; u.pn = NE + (L & 7); u.nrows = 0; return true; }
        return false;
    }
};
struct RowList {
    const int* list;
    static constexpr bool IDENT = false;
    __device__ __forceinline__ unsigned base(const UnitX&) const { return 0u; }
    __device__ __forceinline__ unsigned row(const UnitX& u, int r) const {
        if (u.e < 0) return (unsigned)(u.pm * BM + r);
        int i = u.pm * BM + r; i = i < u.nrows ? i : u.nrows - 1;
        return (unsigned)list[(size_t)u.e * T + i];
    }
};
struct EpiSwigluX {
    static constexpr bool PERM = true, AFTER_DRAIN = false;
    unsigned char* H; const float* gates; const int* list; float oscale;
    __device__ __forceinline__ void operator()(const f32x4 (&acc)[2][2][4][2], const UnitX& u, int wr, int wc, int fr, int fq) const {
        const int hc0 = u.pn * 128 + wc * 16 + 4 * fq;
#pragma unroll
        for (int ai = 0; ai < 2; ++ai)
#pragma unroll
            for (int m = 0; m < 4; ++m) { const int rloc = u.pm * BM + wr * 64 + fr + ai * HALF + m * 16; int tok = rloc; float gt = 1.f; bool ok = true;
                if (u.e >= 0) { ok = rloc < u.nrows; tok = ok ? list[(size_t)u.e * T + rloc] : 0; gt = ok ? gates[(size_t)tok * NE + u.e] : 0.f; }
                if (ok) {
#pragma unroll
                for (int bj = 0; bj < 2; ++bj) { const f32x4 v0 = acc[ai][bj][m][0] * oscale, v1 = acc[ai][bj][m][1] * oscale;
                    const float h0 = v0[0] / (1.f + __expf(-v0[0])) * v0[1] * gt, h1 = v0[2] / (1.f + __expf(-v0[2])) * v0[3] * gt;
                    const float h2 = v1[0] / (1.f + __expf(-v1[0])) * v1[1] * gt, h3 = v1[2] / (1.f + __expf(-v1[2])) * v1[3] * gt;
                    int w = __builtin_amdgcn_cvt_pk_fp8_f32(__builtin_amdgcn_fmed3f(h0, -448.f, 448.f), __builtin_amdgcn_fmed3f(h1, -448.f, 448.f), 0, false); w = __builtin_amdgcn_cvt_pk_fp8_f32(__builtin_amdgcn_fmed3f(h2, -448.f, 448.f), __builtin_amdgcn_fmed3f(h3, -448.f, 448.f), w, true);
                    *(int*)(H + (size_t)tok * DN_K + hc0 + bj * 64) = w; } } }
    }
};

struct SplitCtxOrder {
    int nN, G, c, ntk, nlat, nsub, nsplit;
    __device__ __forceinline__ void init(int M, int N, int K, int G_, int c_, int nsplit_) { nN = N / BM; G = G_; c = c_; ntk = K / BK; nsplit = nsplit_; nlat = (NLAT / BM) * nN; nsub = (M > NLAT) ? ((M - NLAT) / BM) * nN * nsplit : 0; }
    __device__ __forceinline__ bool next(int i, UnitX& u) const {
        int L = i * G + c; u.e = -1; u.nrows = 0;
        if (L < nlat) { int wgid = L; { const int q = nlat / NXCD, xcd = wgid % NXCD, off = wgid / NXCD; wgid = xcd * q + off; }
            const int nig = WGM * nN, gid = wgid / nig, fm = gid * WGM; u.pm = fm + ((wgid % nig) % WGM); u.pn = (wgid % nig) / WGM; u.k0 = 0; u.nt = ntk; return true; }
        L -= nlat;
        if (L < nsub) { const int tile = L / nsplit, s = L % nsplit; u.pm = NLAT / BM + tile / nN; u.pn = tile % nN; u.nt = ntk / nsplit; u.k0 = s * (ntk / nsplit) * BK; u.e = -2 - s; return true; }
        return false;
    }
};
struct RowIdent { static constexpr bool IDENT = true;
                  __device__ __forceinline__ unsigned base(const UnitX& u) const { return (unsigned)(u.pm * BM); }
                  __device__ __forceinline__ unsigned row(const UnitX&, int r) const { return (unsigned)r; } };
struct EpiResidX {
    static constexpr bool PERM = false, AFTER_DRAIN = false;
    const float* lat_src; float* lat_dst; const float* gate; float* part; float oscale;
    __device__ __forceinline__ void operator()(const f32x4 (&acc)[2][2][4][2], const UnitX& u, int wr, int wc, int fr, int fq) const {
        const int rowt = u.pm * BM, col0 = u.pn * BM + wc * 32 + 4 * fq;
        if (u.e <= -2) {
            float* pp = part + (size_t)(-2 - u.e) * NCTX * D; const int row0 = rowt - NLAT + wr * 64 + fr;
#pragma unroll
            for (int ai = 0; ai < 2; ++ai)
#pragma unroll
                for (int m = 0; m < 4; ++m) { const size_t off = (size_t)(row0 + ai * HALF + m * 16) * D + col0;
#pragma unroll
                    for (int bj = 0; bj < 2; ++bj)
#pragma unroll
                        for (int n = 0; n < 2; ++n) *(f32x4*)(pp + off + bj * HALF + n * 16) = acc[ai][bj][m][n] * oscale; }
            return; }
        const int c = rowt < SEQ ? 0 : 1; const float* gv = gate + (size_t)c * 6 * D; const int row0 = rowt + wr * 64 + fr;
        f32x4 g[2][2];
#pragma unroll
        for (int bj = 0; bj < 2; ++bj)
#pragma unroll
            for (int n = 0; n < 2; ++n) g[bj][n] = *(const f32x4*)(gv + col0 + bj * HALF + n * 16) * oscale;
#pragma unroll
        for (int ai = 0; ai < 2; ++ai)
#pragma unroll
            for (int m = 0; m < 4; ++m) { const size_t off = (size_t)(row0 + ai * HALF + m * 16) * D + col0;
#pragma unroll
                for (int bj = 0; bj < 2; ++bj)
#pragma unroll
                    for (int n = 0; n < 2; ++n) { const f32x4 s = *(const f32x4*)(lat_src + off + bj * HALF + n * 16); *(f32x4*)(lat_dst + off + bj * HALF + n * 16) = s + g[bj][n] * acc[ai][bj][m][n]; } }
    }
};

struct StaticOrderX {
    int nM, nN, nwg, G, c, ntk;
    __device__ __forceinline__ void init(int M, int N, int K, int G_, int c_) { nM = M / BM; nN = N / BM; nwg = nM * nN; G = G_; c = c_; ntk = K / BK; }
    __device__ __forceinline__ bool next(int i, UnitX& u) const {
        const long L = (long)i * G + c; if (L >= nwg) return false;
        int wgid = (int)L; { const int q = nwg / NXCD, r = nwg % NXCD, xcd = wgid % NXCD, off = wgid / NXCD; wgid = (xcd < r ? xcd * (q + 1) : r * (q + 1) + (xcd - r) * q) + off; }
        const int nig = WGM * nN, gid = wgid / nig, fm = gid * WGM, gsz = (nM - fm) < WGM ? (nM - fm) : WGM;
        u.pm = fm + ((wgid % nig) % gsz); u.pn = (wgid % nig) / gsz; u.e = -1; u.nrows = 0; u.k0 = 0; u.nt = ntk; return true;
    }
};
template <int ACT> struct EpiBf16X {
    static constexpr bool PERM = true, AFTER_DRAIN = false;
    bf16_t* O; int ldc; const float* bias; float oscale;
    __device__ __forceinline__ void operator()(const f32x4 (&acc)[2][2][4][2], const UnitX& u, int wr, int wc, int fr, int fq) const {
        const int row0 = u.pm * BM + wr * 64 + fr, col0 = u.pn * BM + wc * 32 + 8 * fq;
        f32x4 bv[2][2];
#pragma unroll
        for (int bj = 0; bj < 2; ++bj)
#pragma unroll
            for (int n = 0; n < 2; ++n) bv[bj][n] = bias ? *(const f32x4*)(bias + col0 + bj * HALF + 4 * n) : (f32x4){0.f, 0.f, 0.f, 0.f};
#pragma unroll
        for (int ai = 0; ai < 2; ++ai)
#pragma unroll
            for (int m = 0; m < 4; ++m) { bf16_t* rowp = O + (size_t)(row0 + ai * HALF + m * 16) * ldc + col0;
#pragma unroll
                for (int bj = 0; bj < 2; ++bj) { f32x4 v0 = acc[ai][bj][m][0] * oscale + bv[bj][0], v1 = acc[ai][bj][m][1] * oscale + bv[bj][1];
                    if (ACT == 1) { f32x2 a = gelu_pk((f32x2){v0[0], v0[1]}), b = gelu_pk((f32x2){v0[2], v0[3]}), c = gelu_pk((f32x2){v1[0], v1[1]}), d = gelu_pk((f32x2){v1[2], v1[3]});
                        v0 = (f32x4){a.x, a.y, b.x, b.y}; v1 = (f32x4){c.x, c.y, d.x, d.y}; }
                    u32x4 w; w.x = cvt_pk_bf16(v0[0], v0[1]); w.y = cvt_pk_bf16(v0[2], v0[3]); w.z = cvt_pk_bf16(v1[0], v1[1]); w.w = cvt_pk_bf16(v1[2], v1[3]);
                    *(u32x4*)(rowp + bj * HALF) = w; } }
    }
};
}

#ifndef PG8_SP2
#define PG8_SP2 true
#endif
#ifndef PG8_ALIGN
#define PG8_ALIGN true
#endif

#define LAS __attribute__((address_space(3)))
typedef unsigned short bf16_t;
typedef float f32x4 __attribute__((ext_vector_type(4)));
typedef unsigned u32x4 __attribute__((ext_vector_type(4)));
typedef unsigned u32x2 __attribute__((ext_vector_type(2)));

constexpr size_t MiB = 1u << 20;
constexpr size_t WS_CTL = 0, CTL_ZERO_BYTES = 1 * MiB;
constexpr size_t WS_MODS = 1 * MiB;
constexpr size_t WS_RPART = 3 * MiB;
constexpr size_t WS_WR = 4 * MiB;
constexpr size_t WS_RB = 16 * MiB;
constexpr size_t WS_RSTDV = 16 * MiB + 65536;
constexpr size_t WS_GATES = 17 * MiB;
constexpr size_t WS_CX = 22 * MiB;
constexpr size_t WS_WIN = 30 * MiB;
constexpr size_t WS_WOUT = WS_WIN + 96 * MiB;
constexpr size_t WS_WGU = WS_WOUT + 32 * MiB;
constexpr size_t WS_WD = WS_WGU + 144 * MiB;
constexpr size_t WS_H = WS_WD + 72 * MiB;
constexpr size_t WS_P = WS_H + 132 * MiB;
constexpr size_t WS_MIX = WS_P + 396 * MiB;
constexpr size_t WS_UT = WS_MIX + 132 * MiB;
constexpr size_t WS_FILT = WS_UT + 384 * MiB;
constexpr size_t WS_FILTC = WS_FILT + 256 * MiB;
constexpr size_t WS_Z2T = WS_FILTC + 8 * MiB;
constexpr size_t WS_END = WS_Z2T + 128 * MiB;
constexpr size_t WS_WSET2 = WS_END;
constexpr size_t WSET_BYTES = 344 * MiB;
constexpr size_t WS_PART = WS_WSET2 + WSET_BYTES;
constexpr size_t WS_ELIST = WS_PART + 64 * MiB;
constexpr size_t WS_H8E = WS_ELIST + 5 * MiB;
constexpr size_t WS_END2 = WS_H8E + 66 * MiB;
constexpr int CW_BAR = 4096;
constexpr int CW_ECNT = 8192;
constexpr int CW_WQ = 8704;
constexpr int CW_ARR = 8768;
constexpr int TAB_OFF = 131072;

constexpr int LDS_BYTES = 147456;
constexpr int MISC_OFF = 147200;

#define XB_TMO      128
#define XB_XCNT(j)  (256  + 64 * (j))
#define XB_XSUB(j)  (1280 + 64 * (j))
#define XB_XGEN(j)  (2304 + 64 * (j))
#define XB_TOP      3328
#define XB_TOPGEN   3392
#define XCD_BAR_WORDS 3456
#define XB_SPIN_CAP (1u << 21)

__device__ __forceinline__ unsigned xb_ld(unsigned* p)              { return __hip_atomic_load(p, __ATOMIC_RELAXED, __HIP_MEMORY_SCOPE_AGENT); }
__device__ __forceinline__ unsigned xb_add(unsigned* p, unsigned v) { return __hip_atomic_fetch_add(p, v, __ATOMIC_RELAXED, __HIP_MEMORY_SCOPE_AGENT); }
__device__ __forceinline__ unsigned xb_xcc_id() { return (unsigned)__builtin_amdgcn_s_getreg((3 << 11) | 20) & 0xFu; }
#define XB_SPIN(cond, bar) do { unsigned _sp = 0; while (cond) { __builtin_amdgcn_s_sleep(1); \
    if ((++_sp & 255u) == 0u) { if (xb_ld(&(bar)[XB_TMO])) break; if (_sp > XB_SPIN_CAP) { atomicAdd(&(bar)[XB_TMO], 1u); break; } } } } while (0)

struct XcdBarrier { unsigned* bar; unsigned x; volatile LAS unsigned* st; };

__device__ __forceinline__ XcdBarrier xcd_barrier_post(unsigned* bar, volatile LAS unsigned* st) {
    XcdBarrier b; b.bar = bar; b.x = xb_xcc_id(); b.st = st;
    if (threadIdx.x == 0) (void)xb_add(&bar[XB_XCNT(b.x)], 1u);
    return b;
}
__device__ __forceinline__ void xcd_barrier_complete(unsigned* bar, unsigned x, unsigned& nloc, unsigned& nx) {
    const unsigned G = gridDim.x * gridDim.y * gridDim.z;
    unsigned sum, cnt, mine, sp = 0u;
    for (;;) {
        sum = 0u; cnt = 0u; mine = 0u;
#pragma unroll
        for (unsigned j = 0; j < 16; ++j) { const unsigned c = xb_ld(&bar[XB_XCNT(j)]); sum += c; cnt += (c > 0u) ? 1u : 0u; mine = (j == x) ? c : mine; }
        if (sum == G) break;
        __builtin_amdgcn_s_sleep(1);
        if ((++sp & 255u) == 0u) { if (xb_ld(&bar[XB_TMO])) break; if (sp > XB_SPIN_CAP) { atomicAdd(&bar[XB_TMO], 1u); break; } }
    }
    nloc = mine > 0u ? mine : 1u; nx = cnt > 0u ? cnt : 1u;
}
__device__ __forceinline__ void xcd_barrier(const XcdBarrier& b) {
    asm volatile("s_waitcnt vmcnt(0)" ::: "memory");
    __syncthreads();
    if (threadIdx.x == 0) {
        unsigned* bar = b.bar;
        __builtin_amdgcn_s_waitcnt(0);
        unsigned nloc = b.st[0], nx = b.st[1];
        if (nloc == 0u) { xcd_barrier_complete(bar, b.x, nloc, nx); b.st[0] = nloc; b.st[1] = nx; }
        const unsigned old = xb_add(&bar[XB_XSUB(b.x)], 1u);
        const unsigned gen = old / nloc;
        if (old + 1u == (gen + 1u) * nloc) {
            __builtin_amdgcn_fence(__ATOMIC_RELEASE, "agent");
            asm volatile("s_waitcnt vmcnt(0)" ::: "memory");
            const unsigned og = xb_add(&bar[XB_TOP], 1u);
            const unsigned tg = og / nx;
            if (og + 1u == (tg + 1u) * nx) xb_add(&bar[XB_TOPGEN], 1u);
            else XB_SPIN(xb_ld(&bar[XB_TOPGEN]) == tg, bar);
            __builtin_amdgcn_fence(__ATOMIC_ACQUIRE, "agent");
            xb_add(&bar[XB_XGEN(b.x)], 1u);
            asm volatile("s_waitcnt vmcnt(0)" ::: "memory");
        } else {
            XB_SPIN(xb_ld(&bar[XB_XGEN(b.x)]) == gen, bar);
            __builtin_amdgcn_fence(__ATOMIC_ACQUIRE, "agent");
            asm volatile("s_waitcnt vmcnt(0)" ::: "memory");
        }
    }
    __syncthreads();
}

struct Args { const float* in[38]; float* out; unsigned char* ws; int ph_lo, ph_hi; };
enum { I_X = 0, I_C, I_CTX, I_CCTX, I_ADA_A, I_ADA_B, I_ADA_BIAS, I_NORM_MIX, I_NORM_FFN, I_EVEN_WIN, I_QGAIN, I_KGAIN, I_RPB, I_HY_CW, I_HY_CB,
       I_HY_W1, I_HY_B1, I_HY_W2, I_HY_B2, I_HY_W3, I_HY_B3, I_HY_W4, I_HY_FREQ, I_HY_SKIP, I_ODD_WIN, I_ODD_BIN, I_GM_VGAIN, I_GM_WS, I_GM_BS, I_WOUT,
       I_ROUTER, I_MOE_BIAS, I_MOE_WG, I_MOE_WU, I_MOE_WD, I_SH_WG, I_SH_WU, I_SH_WD };

struct Frame { LAS unsigned char* lds; int tid, lane, wave, G, gw, NGW; };

#define LDS_WAIT() asm volatile("s_waitcnt lgkmcnt(0)" ::: "memory")
__device__ __forceinline__ int opaque_zero() { int z; asm volatile("s_mov_b32 %0, 0" : "=s"(z)); return z; }
#define INP(i) (a.in[(i) + Z])
#define WSB(off) (a.ws + ((size_t)(off) + (size_t)Z))
#define AOUT (a.out + (size_t)Z)
#define WSETP(off, l_) ((bf16_t*)(a.ws + (((l_) & 1) ? (WS_WSET2 + ((off) - WS_WIN)) : (off)) + (size_t)Z))
__device__ __forceinline__ unsigned f2bf(float f) { unsigned u = __builtin_bit_cast(unsigned, f); return (u + 0x7fffu + ((u >> 16) & 1u)) >> 16; }
typedef __bf16 bf16x2_t __attribute__((ext_vector_type(2)));
__device__ __forceinline__ unsigned pk2(float lo, float hi) { bf16x2_t v; v.x = (__bf16)lo; v.y = (__bf16)hi; return __builtin_bit_cast(unsigned, v); }
__device__ __forceinline__ float sat8(float v) { return __builtin_amdgcn_fmed3f(v, -448.f, 448.f); }
__device__ __forceinline__ unsigned pk4f8(float a0, float a1, float a2, float a3) { a0 = sat8(a0); a1 = sat8(a1); a2 = sat8(a2); a3 = sat8(a3); int w = __builtin_amdgcn_cvt_pk_fp8_f32(a0, a1, 0, false); w = __builtin_amdgcn_cvt_pk_fp8_f32(a2, a3, w, true); return (unsigned)w; }
__device__ __forceinline__ float bflo(unsigned u) { return __builtin_bit_cast(float, u << 16); }
__device__ __forceinline__ float bfhi(unsigned u) { return __builtin_bit_cast(float, u & 0xffff0000u); }
__device__ __forceinline__ float bf2f(bf16_t b) { return __builtin_bit_cast(float, ((unsigned)b) << 16); }
__device__ __forceinline__ float wave_sum(float v) {
#pragma unroll
    for (int o = 1; o < 64; o <<= 1) v += __shfl_xor(v, o);
    return v;
}
__device__ __forceinline__ float wave_max(float v) {
#pragma unroll
    for (int o = 1; o < 64; o <<= 1) v = fmaxf(v, __shfl_xor(v, o));
    return v;
}
__device__ __forceinline__ float* MODSP_(unsigned char* wsz, int l, int c, int i) { return (float*)(wsz + WS_MODS) + ((size_t)(l * 3 + c) * 6 + i) * D; }
#define MODSP(a_, l_, c_, i_) MODSP_(WSB(0), l_, c_, i_)

__device__ __forceinline__ void ph_mods1(const Args& a, const Frame& F) {
    const int Z = opaque_zero();
    LAS float* red = (LAS float*)F.lds;
    const float* c = INP(I_C); const float* cc = INP(I_CCTX); const float* A = INP(I_ADA_A);
    float* rpart = (float*)WSB(WS_RPART);
    for (int it = blockIdx.x; it < 4 * 64; it += F.G) {
        const int l = it >> 6, kc = it & 63, j = F.tid & 255, half = F.tid >> 8, k0 = kc * 64 + half * 32;
        float s0 = 0.f, s1 = 0.f, s2 = 0.f;
        const float* Ap = A + ((size_t)l * D + k0) * RANK + j;
        for (int k = 0; k < 32; ++k) {
            const float w = Ap[(size_t)k * RANK]; const float x0 = c[k0 + k], x1 = c[D + k0 + k], x2 = cc[k0 + k];
            s0 += x0 / (1.f + expf(-x0)) * w; s1 += x1 / (1.f + expf(-x1)) * w; s2 += x2 / (1.f + expf(-x2)) * w;
        }
        if (half == 1) { red[j] = s0; red[256 + j] = s1; red[512 + j] = s2; }
        __syncthreads();
        if (half == 0) { float* o = rpart + (size_t)(l * 64 + kc) * 768; o[j] = s0 + red[j]; o[256 + j] = s1 + red[256 + j]; o[512 + j] = s2 + red[512 + j]; }
        __syncthreads();
    }
}
__device__ __forceinline__ void ph_mods2(const Args& a, const Frame& F) {
    const int Z = opaque_zero();
    LAS float* r = (LAS float*)F.lds;
    const float* rpart = (const float*)WSB(WS_RPART); const float* B = INP(I_ADA_B); const float* bias = INP(I_ADA_BIAS);
    for (int it = blockIdx.x; it < 4 * 48; it += F.G) {
        const int l = it / 48, nc = it % 48;
        for (int idx = F.tid; idx < 768; idx += 512) { float s = 0.f; for (int kc = 0; kc < 64; ++kc) s += rpart[(size_t)(l * 64 + kc) * 768 + idx]; r[idx] = s; }
        __syncthreads();
        const int n = nc * 512 + F.tid; const float* Bp = B + (size_t)l * RANK * 24576 + n;
        float s0 = bias[l * 24576 + n], s1 = s0, s2 = s0;
        for (int j = 0; j < RANK; ++j) { const float w = Bp[(size_t)j * 24576]; s0 += r[j] * w; s1 += r[256 + j] * w; s2 += r[512 + j] * w; }
        float* M = (float*)WSB(WS_MODS);
        M[(size_t)(l * 3 + 0) * 24576 + n] = s0; M[(size_t)(l * 3 + 1) * 24576 + n] = s1; M[(size_t)(l * 3 + 2) * 24576 + n] = s2;
        __syncthreads();
    }
}
__device__ __forceinline__ void ph_rprep(const Args& a, const Frame& F) {
    const int Z = opaque_zero();
    LAS float* tile = (LAS float*)F.lds;
    bf16_t* WRH = (bf16_t*)WSB(WS_WR); bf16_t* WRL = WRH + (size_t)4 * 3 * NE * D; float* RB = (float*)WSB(WS_RB);
    for (int it = blockIdx.x; it < 4 * 64; it += F.G) {
        const int l = it >> 6, kc = it & 63, k0 = kc * 64;
        const float* Wr = INP(I_ROUTER) + ((size_t)l * D + k0) * NE;
        for (int idx = F.tid; idx < 4096; idx += 512) tile[(idx >> 6) * 65 + (idx & 63)] = Wr[idx];
        __syncthreads();
        const float* g = INP(I_NORM_FFN) + (size_t)l * D;
        for (int c = 0; c < 3; ++c) {
            const float* sc = MODSP(a, l, c, 4); const size_t ob = (size_t)(l * 3 + c) * NE * D;
            for (int idx = F.tid; idx < 4096; idx += 512) { const int e = idx >> 6, kk = idx & 63, k = k0 + kk; const float v = tile[kk * 65 + e] * (g[k] * (1.f + sc[k]));
                const unsigned hb = __builtin_bit_cast(unsigned, v) & 0xffff0000u; const float lo = v - __builtin_bit_cast(float, hb);
                WRH[ob + (size_t)e * D + k] = (bf16_t)(hb >> 16); WRL[ob + (size_t)e * D + k] = (bf16_t)f2bf(lo); }
        }
        __syncthreads();
    }
    for (int task = F.gw; task < 4 * 3 * NE; task += F.NGW) {
        const int l = task / 192, c = (task / 64) % 3, e = task & 63;
        const float* sh = MODSP(a, l, c, 3); const float* Wr = INP(I_ROUTER) + (size_t)l * D * NE + e; float s = 0.f;
        for (int k = F.lane; k < D; k += 64) s += sh[k] * Wr[(size_t)k * NE];
        s = wave_sum(s); if (F.lane == 0) RB[task] = s;
    }
}

__device__ __forceinline__ void transpose_item(const float* W, int N, bf16_t* WT, int ldk, int row_off, int row_mul, int koff, LAS float* scr, int item, int lane) {
    const int nblk = N / 32, kb = item / nblk, nb = item % nblk, k0 = 64 * kb, n0 = 32 * nb;
#pragma unroll 8
    for (int i = 0; i < 32; ++i) { const int kk = 2 * i + (lane >> 5); scr[kk * 33 + (lane & 31)] = W[(size_t)(k0 + kk) * N + n0 + (lane & 31)]; }
    LDS_WAIT();
    const int c = lane & 7;
#pragma unroll
    for (int j = 0; j < 4; ++j) { const int n = (lane >> 3) + 8 * j; const LAS float* s = scr + (8 * c) * 33 + n;
        u32x4 o; o.x = pk2(s[0 * 33], s[1 * 33]); o.y = pk2(s[2 * 33], s[3 * 33]); o.z = pk2(s[4 * 33], s[5 * 33]); o.w = pk2(s[6 * 33], s[7 * 33]);
        *(u32x4*)(WT + (size_t)(row_off + (n0 + n) * row_mul) * ldk + koff + k0 + 8 * c) = o; }
    LDS_WAIT();
}
__device__ __forceinline__ void transpose_item_f8(const float* W, int N, unsigned char* WT, int ldk, int row_off, int row_mul, int koff, float scale, LAS float* scr, int item, int lane) {
    const int nblk = N / 32, kb = item / nblk, nb = item % nblk, k0 = 64 * kb, n0 = 32 * nb;
#pragma unroll 8
    for (int i = 0; i < 32; ++i) { const int kk = 2 * i + (lane >> 5); scr[kk * 33 + (lane & 31)] = W[(size_t)(k0 + kk) * N + n0 + (lane & 31)]; }
    LDS_WAIT();
    const int c = lane & 7;
#pragma unroll
    for (int j = 0; j < 4; ++j) { const int n = (lane >> 3) + 8 * j; const LAS float* s = scr + (8 * c) * 33 + n;
        int lo = __builtin_amdgcn_cvt_pk_fp8_f32(s[0 * 33] * scale, s[1 * 33] * scale, 0, false); lo = __builtin_amdgcn_cvt_pk_fp8_f32(s[2 * 33] * scale, s[3 * 33] * scale, lo, true);
        int hi = __builtin_amdgcn_cvt_pk_fp8_f32(s[4 * 33] * scale, s[5 * 33] * scale, 0, false); hi = __builtin_amdgcn_cvt_pk_fp8_f32(s[6 * 33] * scale, s[7 * 33] * scale, hi, true);
        u32x2 o; o.x = (unsigned)lo; o.y = (unsigned)hi;
        *(u32x2*)(WT + (size_t)(row_off + (n0 + n) * row_mul) * ldk + koff + k0 + 8 * c) = o; }
    LDS_WAIT();
}
constexpr float WD_SCALE = 16.f, WGU_SCALE = 64.f;
__device__ __forceinline__ void conv_mat(const Frame& F, const float* W, int K, int N, bf16_t* WT, int ldk, int row_off, int row_mul, int koff, LAS float* scr) {
    const int nitems = (K / 64) * (N / 32);
    for (int it = F.gw; it < nitems; it += F.NGW) transpose_item(W, N, WT, ldk, row_off, row_mul, koff, scr, it, F.lane);
}
constexpr int WQ_CHUNK = 8;
__device__ __forceinline__ int wq_nitems(int lt) { return (((lt & 1) == 0) ? 24576 : 16384) + 8192 + 16384 + 16384 + 2048 + 2048 + 16384 + 2048; }
__device__ __forceinline__ void wq_item(const Args& a, const Frame& F, int lt, int item, LAS float* scr, int Z) {
    const int j = lt >> 1; const int n0 = ((lt & 1) == 0) ? 24576 : 16384;
    bf16_t* WIN = WSETP(WS_WIN, lt); bf16_t* WOUT = WSETP(WS_WOUT, lt); bf16_t* WGU = WSETP(WS_WGU, lt); bf16_t* WD = WSETP(WS_WD, lt);
    int it = item;
    if (it < n0) { if ((lt & 1) == 0) { if ((it % (EVEN_IN / 32)) * 32 < 6144) transpose_item_f8(INP(I_EVEN_WIN) + (size_t)j * D * EVEN_IN, EVEN_IN, (unsigned char*)WIN, D, 0, 1, 0, WGU_SCALE, scr, it, F.lane);
                                        else transpose_item(INP(I_EVEN_WIN) + (size_t)j * D * EVEN_IN, EVEN_IN, WIN, D, 0, 1, 0, scr, it, F.lane); }
                   else transpose_item_f8(INP(I_ODD_WIN) + (size_t)j * D * ODD_IN, ODD_IN, (unsigned char*)WIN, D, 0, 1, 0, WGU_SCALE, scr, it, F.lane); return; }
    it -= n0;
    if (it < 8192) { if (lt & 1) transpose_item_f8(INP(I_WOUT) + (size_t)lt * D * D, D, (unsigned char*)WOUT, D, 0, 1, 0, WGU_SCALE, scr, it, F.lane);
                     else transpose_item(INP(I_WOUT) + (size_t)lt * D * D, D, WOUT, D, 0, 1, 0, scr, it, F.lane); return; }
    it -= 8192;
    if (it < 16384) { const int e = it >> 8, li = it & 255; transpose_item_f8(INP(I_MOE_WG) + ((size_t)lt * NE + e) * D * ED, ED, (unsigned char*)WGU, D, e * 256, 2, 0, WGU_SCALE, scr, li, F.lane); return; }
    it -= 16384;
    if (it < 16384) { const int e = it >> 8, li = it & 255; transpose_item_f8(INP(I_MOE_WU) + ((size_t)lt * NE + e) * D * ED, ED, (unsigned char*)WGU, D, e * 256 + 1, 2, 0, WGU_SCALE, scr, li, F.lane); return; }
    it -= 16384;
    if (it < 2048) { transpose_item_f8(INP(I_SH_WG) + (size_t)lt * D * SHD, SHD, (unsigned char*)WGU, D, NE * 256, 2, 0, WGU_SCALE, scr, it, F.lane); return; }
    it -= 2048;
    if (it < 2048) { transpose_item_f8(INP(I_SH_WU) + (size_t)lt * D * SHD, SHD, (unsigned char*)WGU, D, NE * 256 + 1, 2, 0, WGU_SCALE, scr, it, F.lane); return; }
    it -= 2048;
    if (it < 16384) { const int e = it >> 8, li = it & 255; transpose_item_f8(INP(I_MOE_WD) + ((size_t)lt * NE + e) * ED * D, D, (unsigned char*)WD, DN_K, 0, 1, e * ED, WD_SCALE, scr, li, F.lane); return; }
    it -= 16384;
    transpose_item_f8(INP(I_SH_WD) + (size_t)lt * SHD * D, D, (unsigned char*)WD, DN_K, 0, 1, NE * ED, WD_SCALE, scr, it, F.lane);
}
__device__ __forceinline__ void wq_pull(const Args& a, const Frame& F, int lt, int arr_word) {
    const int Z = opaque_zero();
    unsigned* ctl = (unsigned*)WSB(WS_CTL);
    volatile LAS unsigned* MISC = (volatile LAS unsigned*)(F.lds + MISC_OFF);
    LAS float* scr = (LAS float*)(F.lds + F.wave * 16384);
    const int nchunks = wq_nitems(lt) / WQ_CHUNK;
    __syncthreads();
    if (arr_word >= 0 && F.tid == 0) __hip_atomic_fetch_add(ctl + arr_word, 1u, __ATOMIC_RELAXED, __HIP_MEMORY_SCOPE_AGENT);
    for (;;) {
        if (F.tid == 0) {
            unsigned c = 0xffffffffu;
            const bool go = (arr_word < 0) || (__hip_atomic_load(ctl + arr_word, __ATOMIC_RELAXED, __HIP_MEMORY_SCOPE_AGENT) < (unsigned)F.G);
            if (go) c = __hip_atomic_fetch_add(ctl + CW_WQ + lt, 1u, __ATOMIC_RELAXED, __HIP_MEMORY_SCOPE_AGENT);
            MISC[16] = c;
        }
        __syncthreads();
        const unsigned c = MISC[16];
        __syncthreads();
        if (c >= (unsigned)nchunks) break;
#pragma unroll 1
        for (int q = 0; q < WQ_CHUNK / 8; ++q) wq_item(a, F, lt, (int)c * WQ_CHUNK + F.wave * (WQ_CHUNK / 8) + q, scr, Z);
    }
}

__device__ __forceinline__ void ph_norm(const Args& a, const Frame& F, int l, int which, int gw0, int ngw, bool zero_hall = false) {
    const int Z = opaque_zero();
    bf16_t* HA = (bf16_t*)WSB(WS_P); unsigned char* H8E = (unsigned char*)WSB(WS_H8E);
    const int M = which ? ((l >= 2) ? NLAT : T) : ((l == 3) ? NLAT : T);
    const float* lat_src = (l == 0 && which == 0) ? INP(I_X) : AOUT;
    const float* cx_src = (l == 0 && which == 0) ? INP(I_CTX) : (const float*)WSB(WS_CX);
    const float* g = (which ? INP(I_NORM_FFN) : INP(I_NORM_MIX)) + (size_t)l * D;
    bf16_t* H = (bf16_t*)WSB(WS_H);
    for (int row = gw0; row < M; row += ngw) {
        const float* src = row < NLAT ? lat_src + (size_t)row * D : cx_src + (size_t)(row - NLAT) * D;
        const int c = row < SEQ ? 0 : (row < NLAT ? 1 : 2);
        const float* sh = MODSP(a, l, c, which ? 3 : 0); const float* sc = MODSP(a, l, c, which ? 4 : 1);
        f32x4 v[16]; float ss = 0.f;
#pragma unroll
        for (int j = 0; j < 16; ++j) { v[j] = ((const f32x4*)src)[F.lane + 64 * j]; ss += (v[j].x * v[j].x + v[j].y * v[j].y) + (v[j].z * v[j].z + v[j].w * v[j].w); }
        ss = wave_sum(ss);
        const float rstd = 1.0f / sqrtf(ss * (1.0f / D) + EPS);
        u32x2* o = (u32x2*)(H + (size_t)row * D);
#pragma unroll
        for (int j = 0; j < 16; ++j) { const int idx = F.lane + 64 * j; const f32x4 gg = ((const f32x4*)g)[idx], s1 = ((const f32x4*)sc)[idx], s0 = ((const f32x4*)sh)[idx];
            const f32x4 y = (v[j] * rstd) * gg; const f32x4 hh = y * (1.f + s1) + s0;
            if (which || (l & 1)) { ((unsigned*)((unsigned char*)H + (size_t)row * D))[idx] = pk4f8(hh.x, hh.y, hh.z, hh.w); }
            else { ((unsigned*)(H8E + (size_t)row * D))[idx] = pk4f8(hh.x, hh.y, hh.z, hh.w);
                   u32x2 w; w.x = pk2(hh.x, hh.y); w.y = pk2(hh.z, hh.w); o[idx] = w; } }
        if (zero_hall) { u32x4* hr = (u32x4*)((unsigned char*)HA + (size_t)row * DN_K); const u32x4 z4 = (u32x4){0u, 0u, 0u, 0u};
#pragma unroll
            for (int q = 0; q < 8; ++q) hr[F.lane + 64 * q] = z4; }
    }
}

__device__ __forceinline__ void ph_e1(const Args& a, const Frame& F, int l, bool do_a = true) {
    const int Z = opaque_zero();
    const int j2 = l >> 1;
    bf16_t* P = (bf16_t*)WSB(WS_P);
    const float* qg = INP(I_QGAIN) + j2 * 128; const float* kg = INP(I_KGAIN) + j2 * 128;
    if (do_a) for (int row = F.gw; row < T; row += F.NGW) {
        u32x4* pr = (u32x4*)(P + (size_t)row * EVEN_IN);
#pragma unroll
        for (int j = 0; j < 8; ++j) {
            const int chunk = F.lane + 64 * j; const u32x4 raw = pr[chunk];
            float x[8] = { bflo(raw.x), bfhi(raw.x), bflo(raw.y), bfhi(raw.y), bflo(raw.z), bfhi(raw.z), bflo(raw.w), bfhi(raw.w) };
            float ss = 0.f;
#pragma unroll
            for (int i = 0; i < 8; ++i) ss += x[i] * x[i];
            ss += __shfl_xor(ss, 1); ss += __shfl_xor(ss, 2); ss += __shfl_xor(ss, 4); ss += __shfl_xor(ss, 8);
            const float rstd = 1.0f / sqrtf(ss * (1.0f / 128.f) + EPS);
            const float* gp = (j < 4 ? qg : kg) + (chunk & 15) * 8;
            u32x4 o; o.x = pk2(x[0] * rstd * gp[0], x[1] * rstd * gp[1]); o.y = pk2(x[2] * rstd * gp[2], x[3] * rstd * gp[3]);
            o.z = pk2(x[4] * rstd * gp[4], x[5] * rstd * gp[5]); o.w = pk2(x[6] * rstd * gp[6], x[7] * rstd * gp[7]);
            pr[chunk] = o;
        }
    }
    LAS float* Q = (LAS float*)F.lds;
    const float* cw = INP(I_HY_CW) + (size_t)j2 * 3 * 6144; const float* cb = INP(I_HY_CB) + (size_t)j2 * 6144;
    bf16_t* UT = (bf16_t*)WSB(WS_UT); float* Z2T = (float*)WSB(WS_Z2T); typedef float f32x2e __attribute__((ext_vector_type(2)));
    __syncthreads();
    for (int it = blockIdx.x; it < 2 * 128 * 24; it += F.G) {
        const int b = it / (128 * 24), rem = it % (128 * 24), t0 = (rem / 24) * 64, ch0 = (rem % 24) * 256;
        for (int idx = F.tid; idx < 66 * 32; idx += 512) { const int rr = idx >> 5, ck = idx & 31, t = t0 - 1 + rr; u32x4 raw = (u32x4){0u, 0u, 0u, 0u};
            if (t >= 0 && t < SEQ) raw = *(const u32x4*)(P + (size_t)(b * SEQ + t) * EVEN_IN + 6144 + ch0 + 8 * ck);
            LAS float* d = Q + (ck * 66 + rr) * 9; d[0] = bflo(raw.x); d[1] = bfhi(raw.x); d[2] = bflo(raw.y); d[3] = bfhi(raw.y); d[4] = bflo(raw.z); d[5] = bfhi(raw.z); d[6] = bflo(raw.w); d[7] = bfhi(raw.w); }
        __syncthreads();
        for (int idx = F.tid; idx < 256 * 32; idx += 512) { const int ch = idx >> 5, t = (idx & 31) * 2, chg = ch0 + ch; const float w0 = cw[chg], w1 = cw[6144 + chg], w2 = cw[2 * 6144 + chg], bb = cb[chg];
            const LAS float* q = Q + ((ch >> 3) * 66 + t) * 9 + (ch & 7); const float p0 = q[0], p1 = q[9], p2 = q[18], p3 = q[27];
            const float v0 = bb + p0 * w0 + p1 * w1 + p2 * w2, v1 = bb + p1 * w0 + p2 * w1 + p3 * w2;
            if (chg < 4096) *(unsigned*)(UT + ((size_t)b * 4096 + chg) * SEQ + t0 + t) = pk2(v0, v1);
            else { f32x2e o2; o2.x = v0; o2.y = v1; *(f32x2e*)(Z2T + ((size_t)b * 2048 + (chg - 4096)) * SEQ + t0 + t) = o2; } }
        __syncthreads();
    }
}

__device__ __forceinline__ void ph_hyf(const Args& a, const Frame& F, int l) {
    const int Z = opaque_zero();
    const int j2 = l >> 1;
    const float* w1 = INP(I_HY_W1) + (size_t)j2 * 33 * 64; const float* b1 = INP(I_HY_B1) + j2 * 64;
    const float* w2 = INP(I_HY_W2) + (size_t)j2 * 4096; const float* b2 = INP(I_HY_B2) + j2 * 64;
    const float* w3 = INP(I_HY_W3) + (size_t)j2 * 4096; const float* b3 = INP(I_HY_B3) + j2 * 64;
    const float* w4 = INP(I_HY_W4) + (size_t)j2 * 64 * 8192; const float* fq = INP(I_HY_FREQ) + j2 * 192;
    float* FILT = (float*)WSB(WS_FILT); float* FILTC = (float*)WSB(WS_FILTC);
    LAS float* feats = (LAS float*)F.lds; LAS float* ha = feats + 1056; LAS float* hb = ha + 2048; LAS float* hT = hb + 2048; LAS float* tn = hT + 2048;
    const float dstart = -15.350567286626969f, dstop = -3.0701134573253945f, dstep = (dstop - dstart) / 2047.f;
    __syncthreads();
    for (int it = blockIdx.x; it < 256 + 128; it += F.G) {
        const int L = it < 256 ? SEQ : LC, t0 = (it < 256 ? it : ((it - 256) >> 4)) * 32;
        const int i_lo = it < 256 ? 0 : ((it - 256) & 15), i_hi = it < 256 ? 16 : i_lo + 1;
        const float c2pi = (float)(6.283185307179586 / (double)L), invLm1 = 1.0f / (float)(L - 1);
        for (int idx = F.tid; idx < 1056; idx += 512) { const int p = idx / 33, f = idx % 33; const float pos = (float)(t0 + p); float val;
            if (f == 0) { val = pos * invLm1; tn[p] = val; }
            else { const int bi = (f - 1) & 15; const float band = 1e-4f + (float)bi * ((15.f - 1e-4f) / 15.f); const float ang = (c2pi * pos) * band; val = (f <= 16) ? cosf(ang) : -sinf(ang); }
            feats[idx] = val; }
        __syncthreads();
        const int p = F.tid >> 4, ug = F.tid & 15;
#pragma unroll 1
        for (int q = 0; q < 4; ++q) { const int u = ug * 4 + q; float s = b1[u];
#pragma unroll 3
            for (int f = 0; f < 33; ++f) s += feats[p * 33 + f] * w1[f * 64 + u];
            ha[p * 64 + u] = sinf(fq[u] * s); }
        __syncthreads();
#pragma unroll 1
        for (int q = 0; q < 4; ++q) { const int u = ug * 4 + q; float s = b2[u];
#pragma unroll 4
            for (int m = 0; m < 64; ++m) s += ha[p * 64 + m] * w2[m * 64 + u];
            hb[p * 64 + u] = sinf(fq[64 + u] * s); }
        __syncthreads();
#pragma unroll 1
        for (int q = 0; q < 4; ++q) { const int u = ug * 4 + q; float s = b3[u];
#pragma unroll 4
            for (int m = 0; m < 64; ++m) s += hb[p * 64 + m] * w3[m * 64 + u];
            hT[(u >> 2) * 128 + (p >> 4) * 64 + (u & 3) * 16 + (p & 15)] = sinf(fq[128 + u] * s); }
        __syncthreads();
        {   const int j = F.lane & 15, kq = F.lane >> 4; const int cb_lo = i_lo * 32, cb_hi = i_hi * 32;
            const float rstep = -invLm1;
            float bvn[16];
            { const float* wp = w4 + (size_t)kq * 8192 + (cb_lo + F.wave) * 16 + j;
#pragma unroll
              for (int sk = 0; sk < 16; ++sk) bvn[sk] = wp[(size_t)sk * 4 * 8192]; }
#pragma unroll 1
            for (int cb = cb_lo + F.wave; cb < cb_hi; cb += 8) {
                const int n = cb * 16 + j;
                float bv[16];
#pragma unroll
                for (int sk = 0; sk < 16; ++sk) bv[sk] = bvn[sk];
                if (cb + 8 < cb_hi) { const float* wp = w4 + (size_t)kq * 8192 + (cb + 8) * 16 + j;
#pragma unroll
                    for (int sk = 0; sk < 16; ++sk) bvn[sk] = wp[(size_t)sk * 4 * 8192]; }
                f32x4 acc0 = (f32x4){0.f, 0.f, 0.f, 0.f}, acc1 = (f32x4){0.f, 0.f, 0.f, 0.f};
#pragma unroll
                for (int sk = 0; sk < 16; ++sk) { const float a0 = hT[sk * 128 + F.lane], a1 = hT[sk * 128 + 64 + F.lane];
                    acc0 = __builtin_amdgcn_mfma_f32_16x16x4f32(a0, bv[sk], acc0, 0, 0, 0); acc1 = __builtin_amdgcn_mfma_f32_16x16x4f32(a1, bv[sk], acc1, 0, 0, 0); }
                const int dir = n >> 12, o = (n >> 11) & 1, c = n & 2047; const float delta = fabsf(dstart + (float)c * dstep);
                const float ratio = expf(rstep * delta), e0 = expf(-tn[4 * kq] * delta), e1 = expf(-tn[16 + 4 * kq] * delta);
                float* dst = (L == SEQ) ? FILT + (((size_t)(c * 2 + o) * 2 + dir) * SEQ + t0) : FILTC + (((size_t)(c * 2 + o) * 2 + dir) * LC + t0);
                f32x4 v0, v1; float d0 = e0, d1 = e1;
                v0.x = acc0.x * d0; v1.x = acc1.x * d1; d0 *= ratio; d1 *= ratio; v0.y = acc0.y * d0; v1.y = acc1.y * d1; d0 *= ratio; d1 *= ratio;
                v0.z = acc0.z * d0; v1.z = acc1.z * d1; d0 *= ratio; d1 *= ratio; v0.w = acc0.w * d0; v1.w = acc1.w * d1;
                *(f32x4*)(dst + 4 * kq) = v0; *(f32x4*)(dst + 16 + 4 * kq) = v1;
            }
        }
        __syncthreads();
    }
}

typedef short bf16x8v __attribute__((ext_vector_type(8)));
#define GAS __attribute__((address_space(1)))
typedef const GAS char* gcp_t;
__device__ __forceinline__ float xmax16_32(float v) {
    const unsigned u = __builtin_bit_cast(unsigned, v);
    const auto r = __builtin_amdgcn_permlane32_swap(u, u, false, false);
    unsigned a0 = r[0], a1 = r[1]; asm volatile("" : "+v"(a0), "+v"(a1));
    const float m = fmaxf(__builtin_bit_cast(float, a0), __builtin_bit_cast(float, a1));
    const unsigned um = __builtin_bit_cast(unsigned, m);
    const auto r2 = __builtin_amdgcn_permlane16_swap(um, um, false, false);
    unsigned b0 = r2[0], b1 = r2[1]; asm volatile("" : "+v"(b0), "+v"(b1));
    return fmaxf(__builtin_bit_cast(float, b0), __builtin_bit_cast(float, b1));
}
__device__ __forceinline__ void ph_attn(const Args& a, const Frame& F, int l) {
    const int Z = opaque_zero();
    const int j2 = l >> 1;
    const bf16_t* P = (const bf16_t*)WSB(WS_P); bf16_t* MIX = (bf16_t*)WSB(WS_MIX);
    const int wv = __builtin_amdgcn_readfirstlane(F.wave);
    LAS unsigned char* KT = F.lds;
    LAS unsigned char* VT = F.lds + 32768;
    LAS float* rp = (LAS float*)(F.lds + 65536);
    const unsigned vt_addr = (unsigned)(size_t)VT;
    const int j = F.lane & 15, kq = F.lane >> 4;
    const float qscale = 0.08838834764831845f * 1.4426950408889634f;
    const unsigned koff = (unsigned)((j * EVEN_IN + 8 * kq) * 2);
    unsigned foff[2];
#pragma unroll
    for (int u = 0; u < 2; ++u) foff[u] = (unsigned)((8 * wv + 4 * u + kq) * (EVEN_IN * 2) + ((j ^ ((kq << 2) | ((2 * wv + u) & 3))) * 16));
    const bool fast = (F.G & 15) == 0;
    const int nst = 128 + (l == 0 ? 4 : 0);
    unsigned gs = 0;
#pragma unroll 1
    for (int h = fast ? ((int)blockIdx.x & 15) : 0; h < 16; h += (fast ? 16 : 1)) {
        const float* rpb = INP(I_RPB) + ((size_t)j2 * 16 + h) * 465;
        __syncthreads();
        for (int idx = F.tid; idx < 465; idx += 512) rp[idx] = rpb[idx] * 1.4426950408889634f;
        __syncthreads();
        const int w0 = fast ? ((int)blockIdx.x >> 4) : (int)blockIdx.x, nw = fast ? (F.G >> 4) : F.G;
#pragma unroll 1
        for (int st = w0; st < nst; st += nw) {
            int b, nwin, c0 = 0, ws_ = 0, rs = 0, r = 0, rsA = 0; size_t qrow0;
            if (st < 128) { const int r0 = (st & 63) * 2; b = st >> 6; r = r0 + (wv >> 2); c0 = (wv & 3) * 16; ws_ = min(max(c0 - 8, 0), 32); rs = min(max(r - 4, 0), 120);
                rsA = min(max(r0 - 4, 0), 120); nwin = min(max(r0 - 3, 0), 120) + 8 - rsA; qrow0 = (size_t)b * SEQ + r * 64 + c0; }
            else { const int t2 = st - 128; b = t2 >> 1; qrow0 = (size_t)NLAT + b * LC + ((t2 & 1) * 8 + wv) * 16; nwin = 0; }
            const int nsteps = nwin + 4;
            bf16x8v qf[4];
            { unsigned long long qbi = (unsigned long long)(P + qrow0 * EVEN_IN + h * 128); asm volatile("" : "+s"(qbi)); const gcp_t qb = (gcp_t)qbi;
              unsigned _ko = koff; asm volatile("" : "+v"(_ko));
#pragma unroll
              for (int s = 0; s < 4; ++s) qf[s] = *(const GAS bf16x8v*)(qb + 64 * s + _ko); }
            u32x4 fr[4];
#define ATT_FETCH(s_) do { const int _s = (s_); const size_t _tok0 = (_s < nwin) ? ((size_t)b * SEQ + (rsA + _s) * 64) : ((size_t)NLAT + b * LC + (_s - nwin) * 64); \
            unsigned long long _kbi = (unsigned long long)(P + _tok0 * EVEN_IN + 2048 + h * 128); asm volatile("" : "+s"(_kbi)); const gcp_t _kb = (gcp_t)_kbi; \
            _Pragma("unroll") for (int u = 0; u < 2; ++u) { unsigned _fo = foff[u]; asm volatile("" : "+v"(_fo)); \
                fr[u] = *(const GAS u32x4*)(_kb + _fo); fr[2 + u] = *(const GAS u32x4*)(_kb + 4096 + _fo); } } while (0)
#define ATT_PUT(bf_) do { _Pragma("unroll") for (int u = 0; u < 2; ++u) { \
                *(LAS u32x4*)(KT + (bf_) * 16384 + (2 * wv + u) * 1024 + F.lane * 16) = fr[u]; *(LAS u32x4*)(VT + (bf_) * 16384 + (2 * wv + u) * 1024 + F.lane * 16) = fr[2 + u]; } } while (0)
            ATT_FETCH(0);
            const int cq = c0 + j, cs = min(max(cq - 8, 0), 48);
            int dcv[8]; float madd[8];
#pragma unroll
            for (int e = 0; e < 8; ++e) { const int kcol = ws_ + 8 * kq + e; dcv[e] = min(max(kcol - cq + 15, 0), 30); madd[e] = ((unsigned)(kcol - cs) < 16u) ? 0.f : -1e30f; asm volatile("" : "+v"(madd[e])); }
            unsigned KBw[2], KBc[2], VBw[2], VBc[2];
#pragma unroll
            for (int t = 0; t < 2; ++t) {
                { const unsigned row = (unsigned)(ws_ + 8 * (j >> 2) + (j & 3) + 4 * t), y = (row >> 2) & 3u; KBw[t] = 256u * row + 16u * ((unsigned)kq ^ y) + 64u * (unsigned)(j & 3); }
                { const unsigned row = (unsigned)(8 * (j >> 2) + (j & 3) + 4 * t), y = (row >> 2) & 3u; KBc[t] = 256u * row + 16u * ((unsigned)kq ^ y) + 64u * (unsigned)(j & 3); }
                const unsigned q = (unsigned)j >> 2, p = (unsigned)j & 3u, bq = p >> 1;
                { const unsigned row = (unsigned)(ws_ + 8 * kq + 4 * t) + q, X = (q << 2) | ((row >> 2) & 3u); VBw[t] = 256u * row + 16u * (bq ^ X) + 8u * (p & 1u); }
                { const unsigned row = (unsigned)(8 * kq + 4 * t) + q, X = (q << 2) | ((row >> 2) & 3u); VBc[t] = 256u * row + 16u * (bq ^ X) + 8u * (p & 1u); }
            }
            f32x4 o[8];
#pragma unroll
            for (int d = 0; d < 8; ++d) o[d] = (f32x4){0.f, 0.f, 0.f, 0.f};
            float mrun = -1e30f, lsum = 0.f;
#define ATT_GROUP(KB0_, KB1_, VB0_, VB1_, XO_, WIN, brow_) do { \
            bf16x8v kf[8]; \
            _Pragma("unroll") for (int s = 0; s < 4; ++s) { kf[s] = *(const LAS bf16x8v*)(KT + (((KB0_) ^ (64u * s)) + (XO_))); kf[4 + s] = *(const LAS bf16x8v*)(KT + (((KB1_) ^ (64u * s)) + (XO_))); } \
            float bias[8]; \
            if (WIN) { const LAS float* rrow = rp + (brow_) * 31; \
                _Pragma("unroll") for (int e = 0; e < 8; ++e) bias[e] = rrow[dcv[e]]; } \
            f32x4 s0 = (f32x4){0.f, 0.f, 0.f, 0.f}, s1 = (f32x4){0.f, 0.f, 0.f, 0.f}; \
            _Pragma("unroll") for (int s = 0; s < 4; ++s) { s0 = __builtin_amdgcn_mfma_f32_16x16x32_bf16(kf[s], qf[s], s0, 0, 0, 0); s1 = __builtin_amdgcn_mfma_f32_16x16x32_bf16(kf[4 + s], qf[s], s1, 0, 0, 0); } \
            if (WIN) asm volatile("" : "+v"(bias[0]), "+v"(bias[1]), "+v"(bias[2]), "+v"(bias[3]), "+v"(bias[4]), "+v"(bias[5]), "+v"(bias[6]), "+v"(bias[7]));     \
            else asm volatile("" : "+v"(s0), "+v"(s1)); \
            u32x2 tr[8][2]; unsigned rd[8][2]; \
            _Pragma("unroll") for (int d = 0; d < 8; ++d) { rd[d][0] = vt_addr + ((VB0_) ^ (32u * d)); rd[d][1] = vt_addr + ((VB1_) ^ (32u * d)); } \
            asm volatile("ds_read_b64_tr_b16 %0, %8 offset:%16\n\tds_read_b64_tr_b16 %1, %9 offset:%16\n\tds_read_b64_tr_b16 %2, %10 offset:%16\n\tds_read_b64_tr_b16 %3, %11 offset:%16\n\t" \
                         "ds_read_b64_tr_b16 %4, %12 offset:%16\n\tds_read_b64_tr_b16 %5, %13 offset:%16\n\tds_read_b64_tr_b16 %6, %14 offset:%16\n\tds_read_b64_tr_b16 %7, %15 offset:%16" \
                : "=&v"(tr[0][0]), "=&v"(tr[0][1]), "=&v"(tr[1][0]), "=&v"(tr[1][1]), "=&v"(tr[2][0]), "=&v"(tr[2][1]), "=&v"(tr[3][0]), "=&v"(tr[3][1]) \
                : "v"(rd[0][0]), "v"(rd[0][1]), "v"(rd[1][0]), "v"(rd[1][1]), "v"(rd[2][0]), "v"(rd[2][1]), "v"(rd[3][0]), "v"(rd[3][1]), "i"(XO_)); \
            asm volatile("ds_read_b64_tr_b16 %0, %8 offset:%16\n\tds_read_b64_tr_b16 %1, %9 offset:%16\n\tds_read_b64_tr_b16 %2, %10 offset:%16\n\tds_read_b64_tr_b16 %3, %11 offset:%16\n\t" \
                         "ds_read_b64_tr_b16 %4, %12 offset:%16\n\tds_read_b64_tr_b16 %5, %13 offset:%16\n\tds_read_b64_tr_b16 %6, %14 offset:%16\n\tds_read_b64_tr_b16 %7, %15 offset:%16" \
                : "=&v"(tr[4][0]), "=&v"(tr[4][1]), "=&v"(tr[5][0]), "=&v"(tr[5][1]), "=&v"(tr[6][0]), "=&v"(tr[6][1]), "=&v"(tr[7][0]), "=&v"(tr[7][1]) \
                : "v"(rd[4][0]), "v"(rd[4][1]), "v"(rd[5][0]), "v"(rd[5][1]), "v"(rd[6][0]), "v"(rd[6][1]), "v"(rd[7][0]), "v"(rd[7][1]), "i"(XO_)); \
            float sv[8]; \
            _Pragma("unroll") for (int e = 0; e < 8; ++e) sv[e] = WIN ? fmaf((e >> 2) ? s1[e & 3] : s0[e & 3], qscale, bias[e]) + madd[e] : ((e >> 2) ? s1[e & 3] : s0[e & 3]) * qscale; \
            float gmax = sv[0]; \
            _Pragma("unroll") for (int e = 1; e < 8; ++e) gmax = fmaxf(gmax, sv[e]); \
            gmax = xmax16_32(gmax); \
            const float mnew = fmaxf(mrun, gmax), alpha = __builtin_amdgcn_exp2f(mrun - mnew); \
            if (__builtin_amdgcn_ballot_w64(mnew > mrun) != 0ull) { _Pragma("unroll") for (int d = 0; d < 8; ++d) o[d] = o[d] * alpha; } \
            mrun = mnew; \
            float p[8], psum = 0.f; \
            _Pragma("unroll") for (int e = 0; e < 8; ++e) { p[e] = __builtin_amdgcn_exp2f(sv[e] - mnew); psum += p[e]; } \
            lsum = lsum * alpha + psum; \
            union { bf16x8v v; unsigned u[4]; } pf; \
            pf.u[0] = pk2(p[0], p[1]); pf.u[1] = pk2(p[2], p[3]); pf.u[2] = pk2(p[4], p[5]); pf.u[3] = pk2(p[6], p[7]); \
            asm volatile("s_waitcnt lgkmcnt(0)" : "+v"(tr[0][0]), "+v"(tr[0][1]), "+v"(tr[1][0]), "+v"(tr[1][1]), "+v"(tr[2][0]), "+v"(tr[2][1]), "+v"(tr[3][0]), "+v"(tr[3][1]), \
                                                  "+v"(tr[4][0]), "+v"(tr[4][1]), "+v"(tr[5][0]), "+v"(tr[5][1]), "+v"(tr[6][0]), "+v"(tr[6][1]), "+v"(tr[7][0]), "+v"(tr[7][1]) :: "memory"); \
            _Pragma("unroll") for (int d = 0; d < 8; ++d) { union { bf16x8v v; unsigned u[4]; } vf; vf.u[0] = tr[d][0].x; vf.u[1] = tr[d][0].y; vf.u[2] = tr[d][1].x; vf.u[3] = tr[d][1].y; \
                o[d] = __builtin_amdgcn_mfma_f32_16x16x32_bf16(vf.v, pf.v, o[d], 0, 0, 0); } } while (0)
#pragma unroll 1
            for (int step = 0; step < nsteps; ++step, ++gs) {
                ATT_PUT(gs & 1u);
                __syncthreads();
                if (step + 1 < nsteps) ATT_FETCH(step + 1);
                const unsigned bo = (gs & 1u) * 16384u;
                if (step < nwin) {
                    const int g = rsA + step - rs;
                    if ((unsigned)g < 8u) { const unsigned k0 = KBw[0] + bo, k1 = KBw[1] + bo, v0 = VBw[0] + bo, v1 = VBw[1] + bo; ATT_GROUP(k0, k1, v0, v1, 0, true, rs + g - r + 7); }
                } else {
                    const unsigned k0 = KBc[0] + bo, k1 = KBc[1] + bo, v0 = VBc[0] + bo, v1 = VBc[1] + bo;
                    ATT_GROUP(k0, k1, v0, v1, 0, false, 0);
                    ATT_GROUP(k0, k1, v0, v1, 8192, false, 0);
                }
            }
#undef ATT_FETCH
#undef ATT_PUT
#undef ATT_GROUP
            lsum += __shfl_xor(lsum, 16); lsum += __shfl_xor(lsum, 32);
            const float inv = 1.0f / lsum;
#pragma unroll
            for (int d = 0; d < 8; ++d) { u32x2 w; w.x = pk2(o[d].x * inv, o[d].y * inv); w.y = pk2(o[d].z * inv, o[d].w * inv);
                *(u32x2*)(MIX + (qrow0 + j) * D + h * 128 + 16 * d + 4 * kq) = w; }
        }
    }
    __syncthreads();
}

__device__ __forceinline__ float wave_sum_o(float v) {
    int ln = (int)__builtin_amdgcn_mbcnt_hi(~0u, __builtin_amdgcn_mbcnt_lo(~0u, 0u)); asm volatile("" : "+v"(ln));
#pragma unroll
    for (int o = 1; o < 64; o <<= 1) v += __builtin_bit_cast(float, __builtin_amdgcn_ds_bpermute((ln ^ o) << 2, __builtin_bit_cast(int, v)));
    return v;
}
__device__ __forceinline__ float block_sum(const Frame& F, float v, LAS float* red) {
    v = wave_sum_o(v);
    __syncthreads();
    if (F.lane == 0) red[F.wave] = v;
    __syncthreads();
    float s = 0.f;
#pragma unroll
    for (int w = 0; w < 8; ++w) s += red[w];
    return s;
}
typedef float f32x2 __attribute__((ext_vector_type(2)));
#define FP(idx) ((idx) + ((idx) >> 5))
__device__ constexpr int BR5[32] = {0,16,8,24,4,20,12,28,2,18,10,26,6,22,14,30,1,17,9,25,5,21,13,29,3,19,11,27,7,23,15,31};
__device__ constexpr int BR4[16] = {0,8,4,12,2,10,6,14,1,9,5,13,3,11,7,15};
#define brevn(s, bits) ((bits) == 5 ? BR5[(s)] : BR4[(s)])
__device__ __forceinline__ f32x2 cswap(f32x2 a) { f32x2 r; r.x = a.y; r.y = -a.x; return r; }
__device__ __forceinline__ f32x2 cmul(f32x2 a, f32x2 w) { f32x2 t; t.x = -a.y; t.y = a.x; return a * w.x + t * w.y; }
__device__ __forceinline__ f32x2 cmulc(f32x2 a, f32x2 w) { f32x2 t; t.x = a.y; t.y = -a.x; f32x2 r = a * w.x + t * w.y; r.y = -r.y; return r; }
template <int R> __device__ __forceinline__ void dif(f32x2 (&x)[R]) {
    constexpr float C32[16] = { 1.f, 0.98078528040323043f, 0.92387953251128674f, 0.83146961230254524f, 0.70710678118654752f, 0.55557023301960218f, 0.38268343236508978f, 0.19509032201612825f,
                                0.f, -0.19509032201612825f, -0.38268343236508978f, -0.55557023301960218f, -0.70710678118654752f, -0.83146961230254524f, -0.92387953251128674f, -0.98078528040323043f };
    constexpr float S32[16] = { 0.f, 0.19509032201612825f, 0.38268343236508978f, 0.55557023301960218f, 0.70710678118654752f, 0.83146961230254524f, 0.92387953251128674f, 0.98078528040323043f,
                                1.f, 0.98078528040323043f, 0.92387953251128674f, 0.83146961230254524f, 0.70710678118654752f, 0.55557023301960218f, 0.38268343236508978f, 0.19509032201612825f };
#pragma unroll
    for (int h = R / 2; h >= 1; h >>= 1) {
#pragma unroll
        for (int b = 0; b < R; b += 2 * h) {
#pragma unroll
            for (int k = 0; k < h; ++k) {
                const int i0 = b + k, i1 = b + k + h, ti = k * (16 / h);
                const f32x2 u = x[i0], v = x[i1];
                x[i0] = u + v;
                const f32x2 d = u - v;
                if (ti == 0) x[i1] = d;
                else if (ti == 8) x[i1] = cswap(d);
                else x[i1] = d * C32[ti] + cswap(d) * S32[ti];
            }
        }
    }
}
struct FftCtx { LAS f32x2* X; const LAS f32x2* TW; int tid; };
__device__ __forceinline__ void fft_fwd_A(const FftCtx& f, f32x2 (&x)[32]) {
    dif<32>(x);
    __builtin_amdgcn_sched_barrier(0);
    const int i = f.tid; const f32x2 w = f.TW[i]; f32x2 cw; cw.x = 1.f; cw.y = 0.f;
    __syncthreads();
    LAS f32x2* XA = f.X + (i + (i >> 5));
    XA[0] = x[0];
#pragma unroll
    for (int r = 1; r < 32; ++r) { __builtin_amdgcn_sched_barrier(0); cw = cmul(cw, w); XA[528 * r] = cmul(x[brevn(r, 5)], cw); }
    __syncthreads();
}
__device__ __forceinline__ void fft_fwd_BC(const FftCtx& f, f32x2 (&x)[32]) {
#pragma unroll 1
    for (int u = 0; u < 2; ++u) {
        const int q = f.tid + 512 * u, r = q >> 5, i2 = q & 31;
        f32x2 y[16]; LAS f32x2* XB = f.X + (528 * r + i2);
#pragma unroll
        for (int j2 = 0; j2 < 16; ++j2) y[j2] = XB[33 * j2];
        dif<16>(y);
        __builtin_amdgcn_sched_barrier(0);
        const f32x2 w = f.TW[32 * i2]; f32x2 cw; cw.x = 1.f; cw.y = 0.f;
        XB[0] = y[0];
#pragma unroll
        for (int r2 = 1; r2 < 16; ++r2) { __builtin_amdgcn_sched_barrier(0); cw = cmul(cw, w); XB[33 * r2] = cmul(y[brevn(r2, 4)], cw); }
    }
    __syncthreads();
    { const LAS f32x2* XC = f.X + 33 * f.tid;
#pragma unroll
      for (int m = 0; m < 32; ++m) x[m] = XC[m]; }
    dif<32>(x);
}
__device__ __forceinline__ void fft_inv(const FftCtx& f, f32x2 (&x)[32]) {
    {   f32x2 t[32];
#pragma unroll
        for (int k = 0; k < 32; ++k) { t[k] = x[brevn(k, 5)]; t[k].y = -t[k].y; }
        dif<32>(t);
        LAS f32x2* XC = f.X + 33 * f.tid;
#pragma unroll
        for (int s = 0; s < 32; ++s) { f32x2 v = t[s]; v.y = -v.y; XC[brevn(s, 5)] = v; }
    }
    __syncthreads();
#pragma unroll 1
    for (int u = 0; u < 2; ++u) {
        const int q = f.tid + 512 * u, r = q >> 5, i2 = q & 31;
        f32x2 y[16];
        const f32x2 w = f.TW[32 * i2]; f32x2 cw; cw.x = 1.f; cw.y = 0.f; LAS f32x2* XB = f.X + (528 * r + i2);
        { f32x2 v = XB[0]; v.y = -v.y; y[0] = v; }
#pragma unroll
        for (int r2 = 1; r2 < 16; ++r2) { __builtin_amdgcn_sched_barrier(0); cw = cmul(cw, w); f32x2 v = XB[33 * r2]; v.y = -v.y; y[r2] = cmul(v, cw); }
        dif<16>(y);
#pragma unroll
        for (int s = 0; s < 16; ++s) { f32x2 v = y[s]; v.y = -v.y; XB[33 * brevn(s, 4)] = v; }
    }
    __syncthreads();
    {   const int i = f.tid; const f32x2 w = f.TW[i]; f32x2 cw; cw.x = 1.f; cw.y = 0.f; const LAS f32x2* XA = f.X + (i + (i >> 5));
        { f32x2 v = XA[0]; v.y = -v.y; x[0] = v; }
#pragma unroll
        for (int r = 1; r < 32; ++r) { __builtin_amdgcn_sched_barrier(0); cw = cmul(cw, w); f32x2 v = XA[528 * r]; v.y = -v.y; x[r] = cmul(v, cw); }
        dif<32>(x);
#pragma unroll
        for (int s = 0; s < 32; ++s) x[s].y = -x[s].y;
    }
}
__device__ __forceinline__ void ph_hyc(const Args& a, const Frame& F, int l) {
    const int Z = opaque_zero();
    const int j2 = l >> 1;
    const float* FILT = (const float*)WSB(WS_FILT); const bf16_t* UT = (const bf16_t*)WSB(WS_UT); float* Z2T = (float*)WSB(WS_Z2T);
    const float* skip = INP(I_HY_SKIP) + (size_t)j2 * 2 * 2048;
    FftCtx f; f.X = (LAS f32x2*)F.lds; f.TW = (const LAS f32x2*)(F.lds + 135168); f.tid = F.tid;
    LAS float* red = (LAS float*)(F.lds + 135168 + 8192);
    { LAS f32x2* tw = (LAS f32x2*)(F.lds + 135168);
      for (int m = F.tid; m < 1024; m += 512) { float sn, cs; sincosf(-6.283185307179586f * (float)m * (1.0f / 16384.f), &sn, &cs); f32x2 v; v.x = cs; v.y = sn; tw[m] = v; } }
    __syncthreads();
    const unsigned tu = (unsigned)F.tid, trv = 511u - (unsigned)F.tid;
    for (int c = blockIdx.x; c < 2048; c += F.G) {
        f32x2 nd[16];
        { const float* z0p = Z2T + ((size_t)0 * 2048 + c) * SEQ; const float* z1p = Z2T + ((size_t)1 * 2048 + c) * SEQ;
#pragma unroll
          for (int j = 0; j < 16; ++j) { unsigned long long a0 = (unsigned long long)(z0p + 512 * j), a1 = (unsigned long long)(z1p + 512 * j); asm volatile("" : "+s"(a0), "+s"(a1)); nd[j].x = ((const GAS float*)a0)[tu]; nd[j].y = ((const GAS float*)a1)[tu]; } }
#pragma unroll 1
        for (int o = 0; o < 2; ++o) {
            const float* fwd = FILT + ((size_t)(c * 2 + o) * 2 + 0) * SEQ; const float* bwd = fwd + SEQ;
            f32x2 kx[32]; float ss = 0.f;
#pragma unroll
            for (int j = 0; j < 32; ++j) { float v;
                if (j < 16) v = (fwd + 512 * j)[tu]; else { v = (bwd + (SEQ - 512 * (j - 16) - 511))[trv]; if (j == 16 && F.tid == 0) v = 0.f; }
                kx[j].x = v; kx[j].y = 0.f; ss += v * v; }
            fft_fwd_A(f, kx); fft_fwd_BC(f, kx);
            const float tot = block_sum(F, ss, red);
            const float sc = (1.0f / sqrtf(tot + EPS)) * (1.0f / 16384.f);
            const float skn = skip[o * 2048 + c] * (1.0f / 16384.f);
#pragma unroll
            for (int s = 0; s < 32; ++s) { kx[s] = kx[s] * sc; kx[s].x += skn; }
            f32x2 dx[32];
#pragma unroll
            for (int j = 0; j < 32; ++j) { if (j < 16) dx[j] = nd[j]; else { dx[j].x = 0.f; dx[j].y = 0.f; } }
            fft_fwd_A(f, dx); fft_fwd_BC(f, dx);
#pragma unroll
            for (int s = 0; s < 32; ++s) dx[s] = cmul(dx[s], kx[s]);
            const bf16_t* g0p = UT + ((size_t)0 * 4096 + o * 2048 + c) * SEQ; const bf16_t* g1p = UT + ((size_t)1 * 4096 + o * 2048 + c) * SEQ;
            unsigned short gt0[16], gt1[16];
#pragma unroll
            for (int j = 0; j < 16; ++j) { unsigned long long a0 = (unsigned long long)(g0p + 512 * j), a1 = (unsigned long long)(g1p + 512 * j); asm volatile("" : "+s"(a0), "+s"(a1));
                gt0[j] = ((const GAS bf16_t*)a0)[tu]; gt1[j] = ((const GAS bf16_t*)a1)[tu]; }
            fft_inv(f, dx);
            float* o0p = Z2T + ((size_t)0 * 2048 + c) * SEQ; float* o1p = Z2T + ((size_t)1 * 2048 + c) * SEQ;
#pragma unroll
            for (int j = 0; j < 16; ++j) { const int s = brevn(j, 5);
                nd[j].x = bf2f(gt0[j]) * dx[s].x; nd[j].y = bf2f(gt1[j]) * dx[s].y; }
            if (o == 1) {
#pragma unroll
                for (int j = 0; j < 16; ++j) { unsigned long long b0 = (unsigned long long)(o0p + 512 * j), b1 = (unsigned long long)(o1p + 512 * j); asm volatile("" : "+s"(b0), "+s"(b1));
                    ((GAS float*)b0)[tu] = nd[j].x; ((GAS float*)b1)[tu] = nd[j].y; }
            }
        }
    }
}

__device__ __forceinline__ void ph_hyx(const Args& a, const Frame& F, int l) {
    const int Z = opaque_zero();
    const int j2 = l >> 1;
    const bf16_t* P = (const bf16_t*)WSB(WS_P); bf16_t* MIX = (bf16_t*)WSB(WS_MIX); const float* FILTC = (const float*)WSB(WS_FILTC);
    const float* cw = INP(I_HY_CW) + (size_t)j2 * 3 * 6144; const float* cb = INP(I_HY_CB) + (size_t)j2 * 6144; const float* skip = INP(I_HY_SKIP) + (size_t)j2 * 2 * 2048;
    LAS float* us = (LAS float*)F.lds;
    LAS float* Hh = us + 3 * 2 * 256 * 8;
    LAS float* red = Hh + 2 * 8 * 512;
    const int b = F.tid >> 8, t = F.tid & 255;
    for (int cg = blockIdx.x; cg < 256; cg += F.G) {
        const int c0 = cg * 8;
        __syncthreads();
#pragma unroll 1
        for (int part = 0; part < 3; ++part) { const int ch0 = part * 2048 + c0; float v[8];
#pragma unroll
            for (int k = 0; k < 8; ++k) v[k] = cb[ch0 + k];
#pragma unroll
            for (int i = 0; i < 3; ++i) { const int tt = t + i - 1; if (tt >= 0 && tt < LC) { const u32x4 raw = *(const u32x4*)(P + (size_t)(NLAT + b * LC + tt) * EVEN_IN + 6144 + ch0); const float* w = cw + i * 6144 + ch0;
                v[0] += bflo(raw.x) * w[0]; v[1] += bfhi(raw.x) * w[1]; v[2] += bflo(raw.y) * w[2]; v[3] += bfhi(raw.y) * w[3]; v[4] += bflo(raw.z) * w[4]; v[5] += bfhi(raw.z) * w[5]; v[6] += bflo(raw.w) * w[6]; v[7] += bfhi(raw.w) * w[7]; } }
            LAS f32x4* d = (LAS f32x4*)(us + ((part * 2 + b) * 256 + t) * 8); d[0] = (f32x4){v[0], v[1], v[2], v[3]}; d[1] = (f32x4){v[4], v[5], v[6], v[7]}; }
#pragma unroll 1
        for (int m = 0; m < 8; ++m) { const int idx = F.tid + 512 * m, ok = idx >> 8, d = idx & 255, o = ok >> 3, k = ok & 7;
            const float* fwd = FILTC + ((size_t)((c0 + k) * 2 + o) * 2 + 0) * LC; const float f = fwd[d]; float ss = f * f; Hh[ok * 512 + 256 + d] = f;
            if (d >= 1) { const float g = fwd[LC + d]; Hh[ok * 512 + 256 - d] = g; ss += g * g; } else Hh[ok * 512] = 0.f;
            ss = wave_sum_o(ss); if (F.lane == 0) red[ok * 4 + (F.wave & 3)] = ss; }
        __syncthreads();
#pragma unroll 1
        for (int o = 0; o < 2; ++o) {
            float acc[8];
#pragma unroll
            for (int k = 0; k < 8; ++k) acc[k] = 0.f;
            const LAS float* zb = us + (2 * 2 + b) * 256 * 8; const LAS float* hb = Hh + (o * 8) * 512 + 256 + t;
            for (int sidx = 0; sidx < LC; ++sidx) { const f32x4 z0 = *(const LAS f32x4*)(zb + sidx * 8), z1 = *(const LAS f32x4*)(zb + sidx * 8 + 4);
                acc[0] += hb[0 * 512 - sidx] * z0.x; acc[1] += hb[1 * 512 - sidx] * z0.y; acc[2] += hb[2 * 512 - sidx] * z0.z; acc[3] += hb[3 * 512 - sidx] * z0.w;
                acc[4] += hb[4 * 512 - sidx] * z1.x; acc[5] += hb[5 * 512 - sidx] * z1.y; acc[6] += hb[6 * 512 - sidx] * z1.z; acc[7] += hb[7 * 512 - sidx] * z1.w; }
            float zn[8];
#pragma unroll
            for (int k = 0; k < 8; ++k) { const int ok = o * 8 + k; const float fscale = 1.0f / sqrtf(red[ok * 4] + red[ok * 4 + 1] + red[ok * 4 + 2] + red[ok * 4 + 3] + EPS);
                const float y = acc[k] * fscale + zb[t * 8 + k] * skip[o * 2048 + c0 + k]; zn[k] = us[((o * 2 + b) * 256 + t) * 8 + k] * y; }
            __syncthreads();
            if (o == 0) { LAS f32x4* d = (LAS f32x4*)(us + ((2 * 2 + b) * 256 + t) * 8); d[0] = (f32x4){zn[0], zn[1], zn[2], zn[3]}; d[1] = (f32x4){zn[4], zn[5], zn[6], zn[7]}; __syncthreads(); }
            else { u32x4 w; w.x = pk2(zn[0], zn[1]); w.y = pk2(zn[2], zn[3]); w.z = pk2(zn[4], zn[5]); w.w = pk2(zn[6], zn[7]); *(u32x4*)(MIX + (size_t)(NLAT + b * LC + t) * D + 2048 + c0) = w; }
        }
    }
}
__device__ __forceinline__ void ph_hyt(const Args& a, const Frame& F) {
    const int Z = opaque_zero();
    const float* Z2T = (const float*)WSB(WS_Z2T); bf16_t* MIX = (bf16_t*)WSB(WS_MIX);
    LAS float* tile = (LAS float*)F.lds;
    for (int it = blockIdx.x; it < 2 * 128 * 32; it += F.G) {
        const int b = it >> 12, t0 = ((it >> 5) & 127) * 64, c0 = (it & 31) * 64;
        for (int idx = F.tid; idx < 4096; idx += 512) { const int cc = idx >> 6, tt = idx & 63; tile[cc * 65 + tt] = Z2T[((size_t)b * 2048 + c0 + cc) * SEQ + t0 + tt]; }
        __syncthreads();
        { const int tt = F.tid >> 3, ck = F.tid & 7; const LAS float* sp = tile + (8 * ck) * 65 + tt;
          u32x4 o; o.x = pk2(sp[0], sp[65]); o.y = pk2(sp[2 * 65], sp[3 * 65]); o.z = pk2(sp[4 * 65], sp[5 * 65]); o.w = pk2(sp[6 * 65], sp[7 * 65]);
          *(u32x4*)(MIX + (size_t)(b * SEQ + t0 + tt) * D + 2048 + c0 + 8 * ck) = o; }
        __syncthreads();
    }
}

__device__ __forceinline__ void ph_r1(const Args& a, const Frame& F, int l) {
    const int Z = opaque_zero();
    const int M = (l == 3) ? NLAT : T; const bf16_t* ZB = (const bf16_t*)WSB(WS_P); float* RS = (float*)WSB(WS_RSTDV);
    for (int row = F.gw; row < M; row += F.NGW) {
        const u32x4* vr = (const u32x4*)(ZB + (size_t)row * ODD_IN + 4096); float ss = 0.f;
#pragma unroll
        for (int j = 0; j < 8; ++j) { const u32x4 r = vr[F.lane + 64 * j];
            ss += bflo(r.x) * bflo(r.x) + bfhi(r.x) * bfhi(r.x) + bflo(r.y) * bflo(r.y) + bfhi(r.y) * bfhi(r.y) + bflo(r.z) * bflo(r.z) + bfhi(r.z) * bfhi(r.z) + bflo(r.w) * bflo(r.w) + bfhi(r.w) * bfhi(r.w); }
        ss = wave_sum(ss);
        if (F.lane == 0) RS[row] = 1.0f / sqrtf(ss * (1.0f / 4096.f) + EPS);
    }
}
__device__ __forceinline__ void ph_sg(const Args& a, const Frame& F, int l) {
    const int Z = opaque_zero();
    const int j2 = l >> 1, M = (l == 3) ? NLAT : T;
    const bf16_t* ZB = (const bf16_t*)WSB(WS_P); bf16_t* MIX = (bf16_t*)WSB(WS_MIX); const float* RS = (const float*)WSB(WS_RSTDV);
    const float* vgain = INP(I_GM_VGAIN) + (size_t)j2 * 4096; const float* ws = INP(I_GM_WS) + (size_t)j2 * 32 * 128 * 128; const float* bs = INP(I_GM_BS) + (size_t)j2 * 32 * 128;
    LAS unsigned char* VT = F.lds;
    const int nunits = (M / 128) * 32;
    const int jl = F.lane & 15, kq = F.lane >> 4;
    for (int un = blockIdx.x; un < nunits; un += F.G) {
        const int chunk = un >> 5, g = un & 31;
        __syncthreads();
#pragma unroll
        for (int it = 0; it < 4; ++it) { const int idx = F.tid + 512 * it, q = idx >> 4, c8 = (idx & 15) * 8; const int row = chunk * 128 + q;
            const u32x4 raw = *(const u32x4*)(ZB + (size_t)row * ODD_IN + 4096 + g * 128 + c8); const float rs = RS[row]; const float* gp = vgain + g * 128 + c8;
            const float v[8] = { bflo(raw.x), bfhi(raw.x), bflo(raw.y), bfhi(raw.y), bflo(raw.z), bfhi(raw.z), bflo(raw.w), bfhi(raw.w) };
#pragma unroll
            for (int i = 0; i < 8; ++i) *(LAS unsigned short*)(VT + (c8 + i) * 272 + q * 2) = (unsigned short)f2bf(v[i] * rs * gp[i]); }
        union { bf16x8v v; unsigned u[4]; } wf[4];
        { const float* wp = ws + (size_t)g * 16384 + (size_t)(16 * F.wave + jl) * 128 + 8 * kq;
#pragma unroll
          for (int s4 = 0; s4 < 4; ++s4) { const f32x4 w0 = *(const f32x4*)(wp + 32 * s4), w1 = *(const f32x4*)(wp + 32 * s4 + 4);
              wf[s4].u[0] = pk2(w0.x, w0.y); wf[s4].u[1] = pk2(w0.z, w0.w); wf[s4].u[2] = pk2(w1.x, w1.y); wf[s4].u[3] = pk2(w1.z, w1.w); } }
        __syncthreads();
        const int p = 16 * F.wave + jl, row = chunk * 128 + p; const float bsp = bs[g * 128 + p];
#pragma unroll
        for (int cb = 0; cb < 8; ++cb) {
            f32x4 acc = (f32x4){0.f, 0.f, 0.f, 0.f};
#pragma unroll
            for (int s4 = 0; s4 < 4; ++s4) { const bf16x8v af = *(const LAS bf16x8v*)(VT + (16 * cb + jl) * 272 + (32 * s4 + 8 * kq) * 2);
                acc = __builtin_amdgcn_mfma_f32_16x16x32_bf16(af, wf[s4].v, acc, 0, 0, 0); }
            const int c0 = g * 128 + 16 * cb + 4 * kq;
            const u32x2 ur = *(const u32x2*)(ZB + (size_t)row * ODD_IN + c0);
            *(unsigned*)((unsigned char*)MIX + (size_t)row * D + c0) = pk4f8(bflo(ur.x) * (acc.x + bsp), bfhi(ur.x) * (acc.y + bsp), bflo(ur.y) * (acc.z + bsp), bfhi(ur.y) * (acc.w + bsp));
        }
    }
}

__device__ __forceinline__ void ph_router(const Args& a, const Frame& F, int l) {
    const int Z = opaque_zero();
    const int M = (l >= 2) ? NLAT : T, ntask = M / 16;
    const bf16_t* WRH = (const bf16_t*)WSB(WS_WR); const bf16_t* WRL = WRH + (size_t)4 * 3 * NE * D; const float* RB = (const float*)WSB(WS_RB); float* GATES = (float*)WSB(WS_GATES);
    const float* CX = (const float*)WSB(WS_CX); const float* rbias = INP(I_MOE_BIAS) + l * NE;
    LAS float* S = (LAS float*)(F.lds + F.wave * 8192);
    unsigned* ECNT = (unsigned*)WSB(WS_CTL) + CW_ECNT; int* ELIST = (int*)WSB(WS_ELIST);
    for (int task = F.wave * F.G + (int)blockIdx.x; task < ntask; task += 4 * F.G) {
        const int t0 = task * 16, c = t0 < SEQ ? 0 : (t0 < NLAT ? 1 : 2), j = F.lane & 15, kq = F.lane >> 4, row = t0 + j;
        const float* xr = (row < NLAT ? AOUT + (size_t)row * D : CX + (size_t)(row - NLAT) * D) + 8 * kq;
        const bf16_t* wh = WRH + ((size_t)(l * 3 + c) * NE + j) * D + 8 * kq; const bf16_t* wl = WRL + ((size_t)(l * 3 + c) * NE + j) * D + 8 * kq;
        f32x4 acc[4]; float ss = 0.f;
#pragma unroll
        for (int blk = 0; blk < 4; ++blk) acc[blk] = (f32x4){0.f, 0.f, 0.f, 0.f};
#pragma unroll 2
        for (int k0 = 0; k0 < D; k0 += 32) {
            const f32x4 x0 = *(const f32x4*)(xr + k0), x1 = *(const f32x4*)(xr + k0 + 4);
            ss += (x0.x * x0.x + x0.y * x0.y) + (x0.z * x0.z + x0.w * x0.w) + (x1.x * x1.x + x1.y * x1.y) + (x1.z * x1.z + x1.w * x1.w);
            const float xs[8] = { x0.x, x0.y, x0.z, x0.w, x1.x, x1.y, x1.z, x1.w };
            union { bf16x8v v; unsigned u[4]; } xh, xl;
#pragma unroll
            for (int q = 0; q < 4; ++q) { const unsigned b0 = __builtin_bit_cast(unsigned, xs[2 * q]), b1 = __builtin_bit_cast(unsigned, xs[2 * q + 1]);
                xh.u[q] = (b0 >> 16) | (b1 & 0xffff0000u);
                xl.u[q] = pk2(xs[2 * q] - __builtin_bit_cast(float, b0 & 0xffff0000u), xs[2 * q + 1] - __builtin_bit_cast(float, b1 & 0xffff0000u)); }
#pragma unroll
            for (int blk = 0; blk < 4; ++blk) { const bf16x8v ah = *(const bf16x8v*)(wh + (size_t)blk * 16 * D + k0), al = *(const bf16x8v*)(wl + (size_t)blk * 16 * D + k0);
                acc[blk] = __builtin_amdgcn_mfma_f32_16x16x32_bf16(ah, xh.v, acc[blk], 0, 0, 0);
                acc[blk] = __builtin_amdgcn_mfma_f32_16x16x32_bf16(al, xh.v, acc[blk], 0, 0, 0);
                acc[blk] = __builtin_amdgcn_mfma_f32_16x16x32_bf16(ah, xl.v, acc[blk], 0, 0, 0); }
        }
        ss += __shfl_xor(ss, 16); ss += __shfl_xor(ss, 32);
        const float rstd = 1.0f / sqrtf(ss * (1.0f / D) + EPS);
        LDS_WAIT();
#pragma unroll
        for (int blk = 0; blk < 4; ++blk)
#pragma unroll
            for (int r = 0; r < 4; ++r) { const int e = 16 * blk + 4 * kq + r; const float logit = acc[blk][r] * rstd + RB[(l * 3 + c) * NE + e]; S[j * 65 + e] = 1.0f / (1.0f + expf(-logit)); }
        LDS_WAIT();
        unsigned mlo, mhi; float ssum = 0.f;
        { float sc[16], sb[16];
#pragma unroll
          for (int i = 0; i < 16; ++i) { sc[i] = S[j * 65 + 16 * kq + i]; sb[i] = sc[i] + rbias[16 * kq + i]; }
          unsigned taken = 0u;
#pragma unroll 1
          for (int it = 0; it < 8; ++it) { float best = -1e30f, braw = 0.f; int bi = 0;
#pragma unroll
              for (int i = 0; i < 16; ++i) { const bool ok = !((taken >> i) & 1u) && sb[i] > best; best = ok ? sb[i] : best; bi = ok ? i : bi; braw = ok ? sc[i] : braw; }
              int gi = 16 * kq + bi;
#pragma unroll
              for (int off = 16; off <= 32; off <<= 1) { const float ob = __shfl_xor(best, off), orw = __shfl_xor(braw, off); const int oi = __shfl_xor(gi, off);
                  const bool take = (ob > best) || (ob == best && oi < gi); best = take ? ob : best; gi = take ? oi : gi; braw = take ? orw : braw; }
              if ((gi >> 4) == kq) taken |= 1u << (gi & 15);
              ssum += braw; }
          const unsigned t0m = __shfl(taken, j), t1m = __shfl(taken, j + 16), t2m = __shfl(taken, j + 32), t3m = __shfl(taken, j + 48);
          mlo = t0m | (t1m << 16); mhi = t2m | (t3m << 16); }
        unsigned selbits = 0u;
        for (int tok = 0; tok < 16; ++tok) { const unsigned lo = __shfl(mlo, tok), hi = __shfl(mhi, tok); const float sm = __shfl(ssum, tok);
            const bool sel = F.lane < 32 ? ((lo >> F.lane) & 1u) : ((hi >> (F.lane - 32)) & 1u);
            if (sel) selbits |= 1u << tok;
            GATES[(size_t)(t0 + tok) * NE + F.lane] = sel ? S[tok * 65 + F.lane] / sm * 2.5f : 0.f; }
        const int ne = __popc(selbits);
        if (ne) { int pos = (int)__hip_atomic_fetch_add(ECNT + l * NE + F.lane, (unsigned)ne, __ATOMIC_RELAXED, __HIP_MEMORY_SCOPE_AGENT);
            for (int tok = 0; tok < 16; ++tok) if ((selbits >> tok) & 1u) { ELIST[(size_t)F.lane * T + pos] = t0 + tok; ++pos; } }
    }
}

__device__ __forceinline__ void ph_cxfix(const Args& a, const Frame& F, const float* cx_src_in, int l, int gate_idx, int nsplit) {
    const int Z = opaque_zero();
    const float* cx_src = cx_src_in + Z; float* CX = (float*)WSB(WS_CX); const float* part = (const float*)WSB(WS_PART); const float* gv = MODSP(a, l, 2, gate_idx);
    for (int i = blockIdx.x * 512 + F.tid; i < NCTX * (D / 4); i += F.G * 512) {
        f32x4 s = ((const f32x4*)part)[i];
#pragma unroll
        for (int k = 1; k < 8; ++k) if (k < nsplit) s += ((const f32x4*)(part + (size_t)k * NCTX * D))[i];
        ((f32x4*)CX)[i] = ((const f32x4*)cx_src)[i] + ((const f32x4*)gv)[i & (D / 4 - 1)] * s;
    }
}
template <int l> __device__ __forceinline__ void layer_body(const Args& a, const Frame& F, const XcdBarrier& bar, const int lo, const int hi) {
#define IN(k) (lo <= (k) && (k) < hi)
#if (PROBE_DUP & 256)
#define SEAM(k) do { if (IN(k) && IN((k) + 1)) { xcd_barrier(bar); xcd_barrier(bar); } } while (0)
#else
#define SEAM(k) do { if (IN(k) && IN((k) + 1)) xcd_barrier(bar); } while (0)
#endif
        const int base = 3 + 9 * l; const bool even = (l & 1) == 0; const int M = (l == 3) ? NLAT : T; const int M2 = (l >= 2) ? NLAT : T;
        if (IN(base + 0)) { if (l >= 1 && l <= 2) { ph_cxfix(a, F, (const float*)(a.ws + WS_CX), l - 1, 5, 6); xcd_barrier(bar); }
            wq_pull(a, F, l, -1); ph_norm(a, F, l, 0, F.gw, F.NGW); }
        SEAM(base + 0);
        if (IN(base + 1)) {
            const int Z = opaque_zero(); bf16_t* H = (bf16_t*)WSB(WS_H); bf16_t* WIN = WSETP(WS_WIN, l); bf16_t* P = (bf16_t*)WSB(WS_P);
            if (even) { pg8::RowIdent RM;
                { pg8::Gemm g{(bf16_t*)WSB(WS_H8E), WIN, M, 6144, D / 2}; pg8::StaticOrderX S; S.init(M, 6144, D / 2, F.G, (int)blockIdx.x);
                  pg8::EpiBf16X<0> E{P, EVEN_IN, nullptr, 1.f / WGU_SCALE};
                  pg8::gemm_phase_x<pg8::EpiBf16X<0>, pg8::StaticOrderX, pg8::RowIdent, true>(F.lds, g, S, E, RM); }
                __syncthreads();
                { pg8::Gemm g{H, WIN + (size_t)6144 * D, M, 6144, D}; pg8::StaticOrderX S; S.init(M, 6144, D, F.G, F.G - 1 - (int)blockIdx.x);
                  pg8::EpiBf16X<0> E{P + 6144, EVEN_IN, nullptr, 1.f};
                  pg8::gemm_phase_x<pg8::EpiBf16X<0>, pg8::StaticOrderX, pg8::RowIdent, false>(F.lds, g, S, E, RM); } }
            else { pg8::Gemm g{H, WIN, M, ODD_IN, D / 2}; pg8::StaticOrderX S; S.init(M, ODD_IN, D / 2, F.G, (int)blockIdx.x); pg8::RowIdent RM;
                pg8::EpiBf16X<1> E{P, ODD_IN, INP(I_ODD_BIN) + (size_t)(l >> 1) * ODD_IN, 1.f / WGU_SCALE};
                pg8::gemm_phase_x<pg8::EpiBf16X<1>, pg8::StaticOrderX, pg8::RowIdent, true>(F.lds, g, S, E, RM); }
            if (l < 3) wq_pull(a, F, l + 1, CW_ARR + base + 1);
        }
        SEAM(base + 1);
        if (IN(base + 2)) { if (even) { ph_e1(a, F, l); ph_hyf(a, F, l); } else ph_r1(a, F, l);
#if (PROBE_DUP & 1024)
            __syncthreads(); if (even) { ph_hyf(a, F, l); }
#endif
#if (PROBE_DUP & 2)
            __syncthreads(); if (even) { ph_e1(a, F, l, false); ph_hyf(a, F, l); } else ph_r1(a, F, l);
#endif
        }
        SEAM(base + 2);
        if (IN(base + 3)) { if (even) { ph_attn(a, F, l); __syncthreads(); ph_hyc(a, F, l); __syncthreads(); if (l == 0) ph_hyx(a, F, l); } else ph_sg(a, F, l);
#if (PROBE_DUP & 4)
            __syncthreads(); if (even) { ph_attn(a, F, l); __syncthreads(); ph_hyc(a, F, l); __syncthreads(); ph_hyx(a, F, l); } else ph_sg(a, F, l);
#endif
#if (PROBE_DUP & 16)
            __syncthreads(); if (even) { ph_hyc(a, F, l); }
#endif
#if (PROBE_DUP & 32)
            __syncthreads(); if (even) { ph_attn(a, F, l); }
#endif
#if (PROBE_DUP & 64)
            __syncthreads(); if (!even) { ph_sg(a, F, l); }
#endif
        }
        SEAM(base + 3);
        if (IN(base + 4)) { if (even) ph_hyt(a, F);
#if (PROBE_DUP & 8)
            __syncthreads(); if (even) ph_hyt(a, F);
#endif
        }
        SEAM(base + 4);
        if (IN(base + 5)) {
            const int Z = opaque_zero(); bf16_t* MIX = (bf16_t*)WSB(WS_MIX); bf16_t* WOUT = WSETP(WS_WOUT, l); float* CX = (float*)WSB(WS_CX);
            pg8::RowIdent RM;
            if (even) { pg8::Gemm g{MIX, WOUT, M2, D, D}; pg8::SplitCtxOrder S; S.init(M2, D, D, F.G, (int)blockIdx.x, 8);
                pg8::EpiResidX E{l == 0 ? INP(I_X) : AOUT, AOUT, MODSP(a, l, 0, 2), (float*)WSB(WS_PART), 1.f};
                pg8::gemm_phase_x<pg8::EpiResidX, pg8::SplitCtxOrder, pg8::RowIdent>(F.lds, g, S, E, RM); }
            else { pg8::Gemm g{MIX, WOUT, M2, D, D / 2}; pg8::SplitCtxOrder S; S.init(M2, D, D / 2, F.G, (int)blockIdx.x, 8);
                pg8::EpiResidX E{AOUT, AOUT, MODSP(a, l, 0, 2), (float*)WSB(WS_PART), 1.f / WGU_SCALE};
                pg8::gemm_phase_x<pg8::EpiResidX, pg8::SplitCtxOrder, pg8::RowIdent, true>(F.lds, g, S, E, RM); }
            if (l < 3) wq_pull(a, F, l + 1, CW_ARR + base + 5);
        }
        SEAM(base + 5);
        if (IN(base + 6)) { if (M2 > NLAT) { ph_cxfix(a, F, l == 0 ? a.in[I_CTX] : (const float*)(a.ws + WS_CX), l, 2, 8); xcd_barrier(bar); }
            if (F.wave >= 4) ph_norm(a, F, l, 1, (int)blockIdx.x * 4 + F.wave - 4, F.G * 4, true); else ph_router(a, F, l);
#if (PROBE_DUP & 2048)
            __syncthreads(); if (F.wave >= 4) ph_norm(a, F, l, 1, (int)blockIdx.x * 4 + F.wave - 4, F.G * 4, true);
#endif
            }
        SEAM(base + 6);
        if (IN(base + 7)) {
            const int Z = opaque_zero(); bf16_t* H = (bf16_t*)WSB(WS_H); bf16_t* WGU = WSETP(WS_WGU, l); bf16_t* P = (bf16_t*)WSB(WS_P);
            LAS int* tab = (LAS int*)(F.lds + TAB_OFF); LAS int* cntl = tab + 640;
            const unsigned* ECNT = (const unsigned*)WSB(WS_CTL) + CW_ECNT + l * NE;
            if (F.tid < NE) cntl[F.tid] = (int)__hip_atomic_load(ECNT + F.tid, __ATOMIC_RELAXED, __HIP_MEMORY_SCOPE_AGENT);
            __syncthreads();
            if (F.tid == 0) { int n = 0; for (int e = 0; e < NE; ++e) { const int nt_ = (cntl[e] + 255) >> 8; for (int t = 0; t < nt_; ++t) tab[n++] = e | (t << 8); } cntl[NE] = n; }
            __syncthreads();
            pg8::Gemm g{H, WGU, M2, GU_N, D / 2};
            pg8::MoeOrder S{tab, cntl, cntl[NE], (M2 / 256) * 8, F.G, (int)blockIdx.x, D / 128};
            pg8::RowList RM{(const int*)WSB(WS_ELIST)};
            pg8::EpiSwigluX E{(unsigned char*)P, (const float*)WSB(WS_GATES), (const int*)WSB(WS_ELIST), 1.f / WGU_SCALE};
            pg8::gemm_phase_x<pg8::EpiSwigluX, pg8::MoeOrder, pg8::RowList, true>(F.lds, g, S, E, RM);
#if (PROBE_DUP & 512)
            __syncthreads(); pg8::gemm_phase_x<pg8::EpiSwigluX, pg8::MoeOrder, pg8::RowList, true>(F.lds, g, S, E, RM);
#endif
            if (l < 3) wq_pull(a, F, l + 1, CW_ARR + base + 7);
        }
        SEAM(base + 7);
        if (IN(base + 8)) {
            const int Z = opaque_zero(); bf16_t* P = (bf16_t*)WSB(WS_P); bf16_t* WD = WSETP(WS_WD, l); float* CX = (float*)WSB(WS_CX);
            pg8::Gemm g{P, WD, M2, D, DN_K / 2}; pg8::SplitCtxOrder S; S.init(M2, D, DN_K / 2, F.G, (int)blockIdx.x, 6);
            pg8::EpiResidX E{AOUT, AOUT, MODSP(a, l, 0, 5), (float*)WSB(WS_PART), 1.f / WD_SCALE}; pg8::RowIdent RM;
            pg8::gemm_phase_x<pg8::EpiResidX, pg8::SplitCtxOrder, pg8::RowIdent, true>(F.lds, g, S, E, RM);
            if (l < 3) wq_pull(a, F, l + 1, CW_ARR + base + 8);
        }
        if (l < 3) SEAM(base + 8);
#undef IN
#undef SEAM
}

__global__ void __launch_bounds__(512, 2) fwd_kernel(Args a) {
    extern __shared__ __attribute__((aligned(16))) unsigned char lds_raw[];
    Frame F; F.lds = (LAS unsigned char*)lds_raw; F.tid = threadIdx.x; F.lane = F.tid & 63; F.wave = __builtin_amdgcn_readfirstlane(F.tid >> 6);
    F.G = gridDim.x; F.gw = blockIdx.x * 8 + F.wave; F.NGW = F.G * 8;
    volatile LAS unsigned* MISC = (volatile LAS unsigned*)(F.lds + MISC_OFF);
    if (F.tid < 32) MISC[F.tid] = 0u;
    __syncthreads();
    const int lo = a.ph_lo, hi = a.ph_hi;
    unsigned* barw = (unsigned*)(a.ws) + CW_BAR;
    XcdBarrier bar; bar.bar = barw; bar.x = 0; bar.st = MISC + 8;
    if (hi - lo > 1) bar = xcd_barrier_post(barw, MISC + 8);
#define IN(k) (lo <= (k) && (k) < hi)
#if (PROBE_DUP & 256)
#define SEAM(k) do { if (IN(k) && IN((k) + 1)) { xcd_barrier(bar); xcd_barrier(bar); } } while (0)
#else
#define SEAM(k) do { if (IN(k) && IN((k) + 1)) xcd_barrier(bar); } while (0)
#endif

    if (IN(0)) ph_mods1(a, F);
    SEAM(0);
    if (IN(1)) ph_mods2(a, F);
    SEAM(1);
    if (IN(2)) ph_rprep(a, F);
    SEAM(2);
#if (PROBE_DUP & 4096)
    ph_mods1(a, F); xcd_barrier(bar); ph_mods2(a, F); xcd_barrier(bar); ph_rprep(a, F); xcd_barrier(bar);
#endif
    layer_body<0>(a, F, bar, lo, hi);
    layer_body<1>(a, F, bar, lo, hi);
    layer_body<2>(a, F, bar, lo, hi);
    layer_body<3>(a, F, bar, lo, hi);
#undef IN
#undef SEAM
}
constexpr int N_PHASES = 3 + 9 * 4;

extern "C" void kernel_launch(void* const* d_in, const int* in_sizes, int n_in, void* d_out, int out_size, void* d_ws, size_t ws_size, hipStream_t stream) {
    static int grid = 0;
    if (grid == 0) {
        if (n_in != 38 || out_size != NLAT * D || ws_size < WS_END2) { fprintf(stderr, "kernel_launch: unexpected sizes (n_in %d, out %d, ws %zu < %zu)\n", n_in, out_size, ws_size, (size_t)WS_END2); grid = -1; return; }
        int dev = 0, cus = 0, per_cu = 0;
        if (hipGetDevice(&dev) != hipSuccess || hipDeviceGetAttribute(&cus, hipDeviceAttributeMultiprocessorCount, dev) != hipSuccess) { grid = -1; return; }
        if (hipFuncSetAttribute((const void*)fwd_kernel, hipFuncAttributeMaxDynamicSharedMemorySize, LDS_BYTES) != hipSuccess) { fprintf(stderr, "kernel_launch: hipFuncSetAttribute failed\n"); grid = -1; return; }
        if (hipOccupancyMaxActiveBlocksPerMultiprocessor(&per_cu, (const void*)fwd_kernel, 512, LDS_BYTES) != hipSuccess || per_cu < 1) fprintf(stderr, "kernel_launch: occupancy query reports %d\n", per_cu);
        (void)hipGetLastError();
        grid = cus;
    }
    if (grid < 0) return;
    (void)hipMemsetAsync((char*)d_ws + WS_CTL, 0, CTL_ZERO_BYTES, stream);
    Args a{};
    for (int i = 0; i < 38; ++i) a.in[i] = (const float*)d_in[i];
    a.out = (float*)d_out; a.ws = (unsigned char*)d_ws;
#if MK_PER_PHASE
    for (int k = 0; k < N_PHASES; ++k) { a.ph_lo = k; a.ph_hi = k + 1; hipLaunchKernelGGL(fwd_kernel, dim3(grid), dim3(512), LDS_BYTES, stream, a); }
#else
    a.ph_lo = 0; a.ph_hi = N_PHASES;
    hipLaunchKernelGGL(fwd_kernel, dim3(grid), dim3(512), LDS_BYTES, stream, a);
#endif
}
```

```cpp
#include <hip/hip_runtime.h>
#include <cstdio>
#include <cstdint>

#ifndef MK_PER_PHASE
#define MK_PER_PHASE 0
#endif

#ifndef PROBE_DUP
#define PROBE_DUP 0
#endif

constexpr int D = 4096, SEQ = 8192, NLAT = 16384, LC = 256, NCTX = 512, T = NLAT + NCTX;
constexpr int EVEN_IN = 12288, ODD_IN = 8192, NE = 64, ED = 128, SHD = 1024, RANK = 256;
constexpr int GU_N = (NE * ED + SHD) * 2;
constexpr int DN_K = NE * ED + SHD;
constexpr float EPS = 1e-6f;

namespace pg8 {
#define PG8_LAS __attribute__((address_space(3)))
typedef unsigned short bf16_t;
typedef short bf16x8 __attribute__((ext_vector_type(8)));
typedef float f32x4 __attribute__((ext_vector_type(4)));
typedef unsigned u32x4 __attribute__((ext_vector_type(4)));
constexpr int BM = 256, BK = 64, HALF = 128, HTB = HALF * BK * 2  , STAGE_BYTES = 8 * HTB, NXCD = 8, WGM = 8;

__host__ __device__ __forceinline__ int lds_byte(int r, int c) { const int st = (r >> 4) * 2 + (c >> 5), rr = r & 15, cc = c & 31, ob = rr * 64 + cc * 2; return st * 1024 + (ob ^ (((ob >> 9) & 1) << 5)); }
__host__ __device__ __forceinline__ void stage_rc(int b, int& R, int& C) { const int st = b / 1024, sb = b % 1024, swz = sb ^ (((sb >> 9) & 1) << 5); R = (st >> 1) * 16 + swz / 64; C = (st & 1) * 32 + (swz % 64) / 2; }
__host__ __device__ __forceinline__ int perm32(int rho) { const int n = rho >> 4, i = rho & 15; return 8 * (i >> 2) + 4 * n + (i & 3); }

struct Unit { int pm, pn; };
struct Gemm { const bf16_t* A; const bf16_t* Bt; int M, N, K; };

struct StaticOrder {
    int nM, nN, nwg, G, c;
    __host__ __device__ void init(int M, int N, int G_, int c_) { nM = M / BM; nN = N / BM; nwg = nM * nN; G = G_; c = c_; }
    __host__ __device__ bool next(int i, Unit& u) const {
        const long L = (long)i * G + c; if (L >= nwg) return false;
        int wgid = (int)L; { const int q = nwg / NXCD, r = nwg % NXCD, xcd = wgid % NXCD, off = wgid / NXCD; wgid = (xcd < r ? xcd * (q + 1) : r * (q + 1) + (xcd - r) * q) + off; }
        const int nig = WGM * nN, gid = wgid / nig, fm = gid * WGM, gsz = (nM - fm) < WGM ? (nM - fm) : WGM;
        u.pm = fm + ((wgid % nig) % gsz); u.pn = (wgid % nig) / gsz; return true;
    }
    __device__ __forceinline__ void a_ready(const Unit&) const {}
    __device__ __forceinline__ void done(const Unit&) const {}
};

__device__ __forceinline__ unsigned cvt_pk_bf16(float lo, float hi) { unsigned r; asm volatile("v_cvt_pk_bf16_f32 %0, %1, %2" : "=v"(r) : "v"(lo), "v"(hi)); return r; }
typedef float f32x2 __attribute__((ext_vector_type(2)));
__device__ __forceinline__ f32x2 gelu_pk(f32x2 v) {
    const f32x2 av = __builtin_elementwise_abs(v), d = av * 0.2316418882f + 1.0f;
    f32x2 t; t.x = __builtin_amdgcn_rcpf(d.x); t.y = __builtin_amdgcn_rcpf(d.y);
    f32x2 q = t * 0.5307027145f + (-0.7265760135f); q = q * t + 0.7107068705f; q = q * t + (-0.142248368f); q = q * t + 0.127414796f; q = q * t;
    const f32x2 s = (v * v) * (-0.72134752044f);
    f32x2 e; e.x = __builtin_amdgcn_exp2f(s.x); e.y = __builtin_amdgcn_exp2f(s.y);
    const f32x2 m = v * (q * e), r = v - m;
    f32x2 o; o.x = v.x < 0.f ? m.x : r.x; o.y = v.y < 0.f ? m.y : r.y; return o;
}

template <int ACT  > struct EpiBf16 {
    static constexpr bool PERM = true, AFTER_DRAIN = false; static_assert(ACT == 0 || ACT == 1, "EpiBf16: ACT is 0 (none) or 1 (gelu_pk)");
    bf16_t* O; int ldc; const float* bias; int split_cols; size_t split_stride; float scale0;
    __device__ __forceinline__ void operator()(const f32x4 (&acc)[2][2][4][2], const Unit& u, int wr, int wc, int fr, int fq) const {
        const int row0 = u.pm * BM + wr * 64 + fr; int colt = u.pn * BM; bf16_t* base = O;
        float sc = 1.f; if (split_cols) { const int t = colt / split_cols; base += (size_t)t * split_stride; colt -= t * split_cols; if (t == 0) sc = scale0; }
        const int col0 = colt + wc * 32 + 8 * fq, bcol0 = u.pn * BM + wc * 32 + 8 * fq;
        f32x4 bv[2][2];
#pragma unroll
        for (int bj = 0; bj < 2; ++bj)
#pragma unroll
            for (int n = 0; n < 2; ++n) bv[bj][n] = bias ? *(const f32x4*)(bias + bcol0 + bj * HALF + 4 * n) : (f32x4){0.f, 0.f, 0.f, 0.f};
#pragma unroll
        for (int ai = 0; ai < 2; ++ai)
#pragma unroll
            for (int m = 0; m < 4; ++m) { bf16_t* rowp = base + (size_t)(row0 + ai * HALF + m * 16) * ldc + col0;
#pragma unroll
                for (int bj = 0; bj < 2; ++bj) { f32x4 v0 = acc[ai][bj][m][0] + bv[bj][0], v1 = acc[ai][bj][m][1] + bv[bj][1];
                    if (ACT == 1) { f32x2 a = gelu_pk((f32x2){v0[0], v0[1]}), b = gelu_pk((f32x2){v0[2], v0[3]}), c = gelu_pk((f32x2){v1[0], v1[1]}), d = gelu_pk((f32x2){v1[2], v1[3]});
                        v0 = (f32x4){a.x, a.y, b.x, b.y}; v1 = (f32x4){c.x, c.y, d.x, d.y}; }
                    v0 = v0 * sc; v1 = v1 * sc; u32x4 w; w.x = cvt_pk_bf16(v0[0], v0[1]); w.y = cvt_pk_bf16(v0[2], v0[3]); w.z = cvt_pk_bf16(v1[0], v1[1]); w.w = cvt_pk_bf16(v1[2], v1[3]);
                    *(u32x4*)(rowp + bj * HALF) = w; } }
    }
};

struct EpiResid {
    static constexpr bool PERM = false, AFTER_DRAIN = false;
    const float* lat_src; const float* cx_src; float* lat_dst; float* cx_dst; const float* gate;
    __device__ __forceinline__ void operator()(const f32x4 (&acc)[2][2][4][2], const Unit& u, int wr, int wc, int fr, int fq) const {
        const int rowt = u.pm * BM; int c, rbase; const float* src; float* dst;
        if (rowt < NLAT) { c = rowt < SEQ ? 0 : 1; src = lat_src; dst = lat_dst; rbase = 0; } else { c = 2; src = cx_src; dst = cx_dst; rbase = NLAT; }
        const float* gv = gate + (size_t)c * 6 * D;
        const int row0 = rowt - rbase + wr * 64 + fr, col0 = u.pn * BM + wc * 32 + 4 * fq;
        f32x4 g[2][2];
#pragma unroll
        for (int bj = 0; bj < 2; ++bj)
#pragma unroll
            for (int n = 0; n < 2; ++n) g[bj][n] = *(const f32x4*)(gv + col0 + bj * HALF + n * 16);
#pragma unroll
        for (int ai = 0; ai < 2; ++ai)
#pragma unroll
            for (int m = 0; m < 4; ++m) { const size_t off = (size_t)(row0 + ai * HALF + m * 16) * D + col0;
#pragma unroll
                for (int bj = 0; bj < 2; ++bj)
#pragma unroll
                    for (int n = 0; n < 2; ++n) { const f32x4 s = *(const f32x4*)(src + off + bj * HALF + n * 16); *(f32x4*)(dst + off + bj * HALF + n * 16) = s + g[bj][n] * acc[ai][bj][m][n]; } }
    }
};
struct EpiSwiglu {
    static constexpr bool PERM = true, AFTER_DRAIN = false;
    bf16_t* H; const float* gates;
    __device__ __forceinline__ void operator()(const f32x4 (&acc)[2][2][4][2], const Unit& u, int wr, int wc, int fr, int fq) const {
        const int row0 = u.pm * BM + wr * 64 + fr, hc0 = u.pn * 128 + wc * 16 + 4 * fq;
#pragma unroll
        for (int ai = 0; ai < 2; ++ai)
#pragma unroll
            for (int m = 0; m < 4; ++m) { const int row = row0 + ai * HALF + m * 16; const float gt = (u.pn < NE) ? gates[(size_t)row * NE + u.pn] : 1.f;
#pragma unroll
                for (int bj = 0; bj < 2; ++bj) { const f32x4 v0 = acc[ai][bj][m][0], v1 = acc[ai][bj][m][1];
                    const float h0 = v0[0] / (1.f + __expf(-v0[0])) * v0[1] * gt, h1 = v0[2] / (1.f + __expf(-v0[2])) * v0[3] * gt;
                    const float h2 = v1[0] / (1.f + __expf(-v1[0])) * v1[1] * gt, h3 = v1[2] / (1.f + __expf(-v1[2])) * v1[3] * gt;
                    typedef unsigned u32x2v __attribute__((ext_vector_type(2))); u32x2v w; w.x = cvt_pk_bf16(h0, h1); w.y = cvt_pk_bf16(h2, h3);
                    *(u32x2v*)(H + (size_t)row * DN_K + hc0 + bj * 64) = w; } }
    }
};

template <class Epi, class Sched, bool ALIGN_EPI = false, bool SP2 = false>
__device__ __forceinline__ void gemm_phase(PG8_LAS unsigned char* lds, const Gemm g, const Sched& S, const Epi& E) {
    int tid_o = threadIdx.x; asm volatile("" : "+v"(tid_o));
    const int tid = tid_o, wid = __builtin_amdgcn_readfirstlane(tid >> 6), lane = tid & 63, wr = wid >> 2, wc = wid & 3, fr = lane & 15, fq = lane >> 4;
    const int K = g.K, nt = K / BK;
    unsigned voffA[2], voffB[2];
#pragma unroll
    for (int i = 0; i < 2; ++i) { int R, C; stage_rc(tid * 16 + i * 8192, R, C); const int Rb = Epi::PERM ? ((R & ~31) + perm32(R & 31)) : R;
        voffA[i] = (unsigned)(R * K + C) * 2u; voffB[i] = (unsigned)(Rb * K + C) * 2u; }
    const size_t kstep = (size_t)(BK * 2);
    const size_t hstep = (size_t)HALF * K * 2;
    const size_t tstep = 2 * hstep;
    const unsigned ldsw = (unsigned)wid * 1024u;
    const int aoff = lds_byte(wr * 64 + fr, fq * 8), boff = lds_byte(wc * 32 + fr, fq * 8);
#define PG8_SA(b, h) (((b) * 2 + (h)) * HTB)
#define PG8_SB(b, h) ((4 + (b) * 2 + (h)) * HTB)
#define PG8_STAGE(bufoff, gbase, voff) do { _Pragma("unroll") for (int _i = 0; _i < 2; ++_i) \
        __builtin_amdgcn_global_load_lds((const unsigned*)((const char*)(gbase) + (voff)[_i]), (PG8_LAS unsigned*)(lds + (bufoff) + ldsw + _i * 8192), 16, 0, 0); } while (0)
#define PG8_LDA(dst, b, h) do { _Pragma("unroll") for (int m = 0; m < 4; ++m) _Pragma("unroll") for (int k = 0; k < 2; ++k) dst[m][k] = *(const PG8_LAS bf16x8*)(lds + PG8_SA(b, h) + aoff + m * 2048 + k * 1024); } while (0)
#define PG8_LDB(dst, b, h) do { _Pragma("unroll") for (int n = 0; n < 2; ++n) _Pragma("unroll") for (int k = 0; k < 2; ++k) dst[n][k] = *(const PG8_LAS bf16x8*)(lds + PG8_SB(b, h) + boff + n * 2048 + k * 1024); } while (0)
#define PG8_MMA(ai, bj, At, Bt) do { __builtin_amdgcn_s_setprio(1); _Pragma("unroll") for (int m = 0; m < 4; ++m) _Pragma("unroll") for (int n = 0; n < 2; ++n) _Pragma("unroll") for (int k = 0; k < 2; ++k) \
        acc[ai][bj][m][n] = __builtin_amdgcn_mfma_f32_16x16x32_bf16(Bt[n][k], At[m][k], acc[ai][bj][m][n], 0, 0, 0); __builtin_amdgcn_s_setprio(0); } while (0)
#define PG8_WAIT_V(n) asm volatile("s_waitcnt vmcnt(" #n ")" ::: "memory")
#define PG8_WAIT_L(n) asm volatile("s_waitcnt lgkmcnt(" #n ")" ::: "memory")
#define PG8_BAR __builtin_amdgcn_s_barrier()
#define PG8_SCHED __builtin_amdgcn_sched_barrier(0)
    Unit cur, nxt; int ui = 0;
    if (!S.next(0, cur)) return;
    f32x4 acc[2][2][4][2];
#pragma unroll
    for (int a = 0; a < 2; ++a)
#pragma unroll
        for (int b = 0; b < 2; ++b)
#pragma unroll
            for (int m = 0; m < 4; ++m)
#pragma unroll
                for (int n = 0; n < 2; ++n) acc[a][b][m][n] = (f32x4){0.f, 0.f, 0.f, 0.f};
    bf16x8 At[4][2], B0[2][2], B1[2][2];
    const char* cA = (const char*)g.A + (size_t)cur.pm * tstep; const char* cB = (const char*)g.Bt + (size_t)cur.pn * tstep;
    S.a_ready(cur);
    if constexpr (SP2) {
        PG8_STAGE(PG8_SB(0, 0), cB, voffB); PG8_STAGE(PG8_SB(0, 1), cB + hstep, voffB); PG8_STAGE(PG8_SA(0, 0), cA, voffA); PG8_STAGE(PG8_SA(0, 1), cA + hstep, voffA);
        if (wr == 1) PG8_BAR;
        PG8_WAIT_V(2); PG8_BAR;
        PG8_STAGE(PG8_SB(1, 0), cB + kstep, voffB); PG8_STAGE(PG8_SA(1, 0), cA + kstep, voffA); PG8_STAGE(PG8_SB(1, 1), cB + hstep + kstep, voffB);
        PG8_WAIT_V(6); PG8_BAR;
    } else {
        PG8_STAGE(PG8_SB(0, 0), cB, voffB); PG8_STAGE(PG8_SA(0, 0), cA, voffA); PG8_STAGE(PG8_SB(0, 1), cB + hstep, voffB); PG8_STAGE(PG8_SA(0, 1), cA + hstep, voffA);
        if (wr == 1) PG8_BAR;
        PG8_WAIT_V(4); PG8_BAR;
        PG8_STAGE(PG8_SB(1, 0), cB + kstep, voffB); PG8_STAGE(PG8_SA(1, 0), cA + kstep, voffA); PG8_STAGE(PG8_SB(1, 1), cB + hstep + kstep, voffB);
        PG8_WAIT_V(6); PG8_BAR;
    }
    for (;;) {
        const bool has_next = S.next(ui + 1, nxt);
        const char* nA = has_next ? (const char*)g.A + (size_t)nxt.pm * tstep : cA; const char* nB = has_next ? (const char*)g.Bt + (size_t)nxt.pn * tstep : cB;
        for (int t = 0; t < nt; t += 2) {
            const bool last = (t == nt - 2);
            const char* a1 = cA + (size_t)(t + 1) * kstep;
            const char* a2 = last ? nA : cA + (size_t)(t + 2) * kstep; const char* b2 = last ? nB : cB + (size_t)(t + 2) * kstep;
            const char* a3 = a2 + kstep; const char* b3 = b2 + kstep;
            if (last && has_next) S.a_ready(nxt);
            if constexpr (SP2) {
            PG8_LDB(B0, 0, 0); PG8_LDB(B1, 0, 1); PG8_SCHED; PG8_LDA(At, 0, 0); PG8_STAGE(PG8_SA(1, 1), a1 + hstep, voffA);
            PG8_WAIT_V(8); PG8_WAIT_L(0); PG8_BAR; PG8_MMA(0, 0, At, B0); PG8_MMA(0, 1, At, B1); PG8_BAR; PG8_SCHED;
            PG8_LDA(At, 0, 1); PG8_STAGE(PG8_SB(0, 0), b2, voffB); PG8_STAGE(PG8_SB(0, 1), b2 + hstep, voffB); PG8_STAGE(PG8_SA(0, 0), a2, voffA);
            PG8_WAIT_V(8); PG8_WAIT_L(0); PG8_BAR; PG8_MMA(1, 0, At, B0); PG8_MMA(1, 1, At, B1); PG8_BAR; PG8_SCHED;
            PG8_LDB(B0, 1, 0); PG8_LDB(B1, 1, 1); PG8_SCHED; PG8_LDA(At, 1, 0); PG8_STAGE(PG8_SA(0, 1), a2 + hstep, voffA);
            PG8_WAIT_V(8); PG8_WAIT_L(0); PG8_BAR; PG8_MMA(0, 0, At, B0); PG8_MMA(0, 1, At, B1); PG8_BAR; PG8_SCHED;
            PG8_LDA(At, 1, 1); PG8_STAGE(PG8_SB(1, 0), b3, voffB); PG8_STAGE(PG8_SB(1, 1), b3 + hstep, voffB); PG8_STAGE(PG8_SA(1, 0), a3, voffA);
            PG8_WAIT_V(8); PG8_WAIT_L(0); PG8_BAR; PG8_MMA(1, 0, At, B0); PG8_MMA(1, 1, At, B1); PG8_BAR; PG8_SCHED;
            } else {
            PG8_LDB(B0, 0, 0); PG8_SCHED; PG8_LDA(At, 0, 0); PG8_STAGE(PG8_SA(1, 1), a1 + hstep, voffA);
            PG8_WAIT_L(8); PG8_BAR; PG8_WAIT_L(0); PG8_MMA(0, 0, At, B0); PG8_BAR; PG8_SCHED;
            PG8_LDB(B1, 0, 1); PG8_STAGE(PG8_SB(0, 0), b2, voffB);
            PG8_BAR; PG8_WAIT_L(0); PG8_MMA(0, 1, At, B1); PG8_BAR;
            PG8_LDA(At, 0, 1); PG8_STAGE(PG8_SA(0, 0), a2, voffA);
            PG8_BAR; PG8_WAIT_L(0); PG8_MMA(1, 0, At, B0); PG8_BAR; PG8_SCHED;
            PG8_STAGE(PG8_SB(0, 1), b2 + hstep, voffB);
            PG8_WAIT_V(6); PG8_BAR; PG8_MMA(1, 1, At, B1); PG8_BAR;
            PG8_LDB(B0, 1, 0); PG8_SCHED; PG8_LDA(At, 1, 0); PG8_STAGE(PG8_SA(0, 1), a2 + hstep, voffA);
            PG8_WAIT_L(8); PG8_BAR; PG8_WAIT_L(0); PG8_MMA(0, 0, At, B0); PG8_BAR; PG8_SCHED;
            PG8_LDB(B1, 1, 1); PG8_STAGE(PG8_SB(1, 0), b3, voffB);
            PG8_BAR; PG8_WAIT_L(0); PG8_MMA(0, 1, At, B1); PG8_BAR;
            PG8_LDA(At, 1, 1); PG8_STAGE(PG8_SA(1, 0), a3, voffA);
            PG8_BAR; PG8_WAIT_L(0); PG8_MMA(1, 0, At, B0); PG8_BAR; PG8_SCHED;
            PG8_STAGE(PG8_SB(1, 1), b3 + hstep, voffB);
            PG8_WAIT_V(6); PG8_BAR; PG8_MMA(1, 1, At, B1); PG8_BAR;
            }
        }
        if constexpr (ALIGN_EPI) { if (wr == 0) PG8_BAR; }
        if constexpr (!Epi::AFTER_DRAIN) { E(acc, cur, wr, wc, fr, fq); S.done(cur); }
        if (!has_next) break;
#pragma unroll
        for (int a = 0; a < 2; ++a)
#pragma unroll
            for (int b = 0; b < 2; ++b)
#pragma unroll
                for (int m = 0; m < 4; ++m)
#pragma unroll
                    for (int n = 0; n < 2; ++n) acc[a][b][m][n] = (f32x4){0.f, 0.f, 0.f, 0.f};
        cur = nxt; cA = nA; cB = nB; ++ui;
        if constexpr (ALIGN_EPI) { if (wr == 1) PG8_BAR; }
    }
    PG8_WAIT_V(0);
    if constexpr (!ALIGN_EPI) { if (wr == 0) PG8_BAR; }
    PG8_BAR;
    if constexpr (Epi::AFTER_DRAIN) { E.fused(acc, cur, wr, wc, fr, fq, lds, wid, lane); S.done(cur); }
#undef PG8_SA
#undef PG8_SB
#undef PG8_STAGE
#undef PG8_LDA
#undef PG8_LDB
#undef PG8_MMA
#undef PG8_WAIT_V
#undef PG8_WAIT_L
#undef PG8_BAR
#undef PG8_SCHED
}

struct UnitX { int pm, pn, e, nrows, k0, nt; };
typedef int i32x4 __attribute__((ext_vector_type(4)));
typedef int i32x8 __attribute__((ext_vector_type(8)));
template <class Epi, class Sched, class RowMap, bool F8 = false>
__device__ __forceinline__ void gemm_phase_x(PG8_LAS unsigned char* lds, const Gemm g, const Sched& S, const Epi& E, const RowMap& RM) {
    int tid_o = threadIdx.x; asm volatile("" : "+v"(tid_o));
    const int tid = tid_o, wid = __builtin_amdgcn_readfirstlane(tid >> 6), lane = tid & 63, wr = wid >> 2, wc = wid & 3, fr = lane & 15, fq = lane >> 4;
    const int K = g.K;
    int R_[2], C_[2]; unsigned voffB[2];
#pragma unroll
    for (int i = 0; i < 2; ++i) { stage_rc(tid * 16 + i * 8192, R_[i], C_[i]); const int Rb = Epi::PERM ? ((R_[i] & ~31) + perm32(R_[i] & 31)) : R_[i]; voffB[i] = (unsigned)(Rb * K + C_[i]) * 2u; }
    const size_t kstep = (size_t)(BK * 2);
    const size_t hstep = (size_t)HALF * K * 2;
    const size_t tstep = 2 * hstep;
    const unsigned ldsw = (unsigned)wid * 1024u;
    const int aoff = lds_byte(wr * 64 + fr, fq * 8), boff = lds_byte(wc * 32 + fr, fq * 8);
#define PG8_SA(b, h) (((b) * 2 + (h)) * HTB)
#define PG8_SB(b, h) ((4 + (b) * 2 + (h)) * HTB)
#define PG8_STAGE(bufoff, gbase, voff) do { _Pragma("unroll") for (int _i = 0; _i < 2; ++_i) \
        __builtin_amdgcn_global_load_lds((const unsigned*)((const char*)(gbase) + (voff)[_i]), (PG8_LAS unsigned*)(lds + (bufoff) + ldsw + _i * 8192), 16, 0, 0); } while (0)
#define PG8_LD8(dst, addr) do { const i32x4 _lo = *(const PG8_LAS i32x4*)(addr), _hi = *(const PG8_LAS i32x4*)((addr) + 1024); dst = __builtin_shufflevector(_lo, _hi, 0, 1, 2, 3, 4, 5, 6, 7); } while (0)
#define PG8_LDA(dst, b, h) do { _Pragma("unroll") for (int m = 0; m < 4; ++m) PG8_LD8(dst[m], lds + PG8_SA(b, h) + aoff + m * 2048); } while (0)
#define PG8_LDB(dst, b, h) do { _Pragma("unroll") for (int n = 0; n < 2; ++n) PG8_LD8(dst[n], lds + PG8_SB(b, h) + boff + n * 2048); } while (0)
#define PG8_LOH(v) __builtin_bit_cast(bf16x8, __builtin_shufflevector(v, v, 0, 1, 2, 3))
#define PG8_HIH(v) __builtin_bit_cast(bf16x8, __builtin_shufflevector(v, v, 4, 5, 6, 7))
#define PG8_MMA(ai, bj, At, Bt) do { __builtin_amdgcn_s_setprio(1); _Pragma("unroll") for (int m = 0; m < 4; ++m) _Pragma("unroll") for (int n = 0; n < 2; ++n) { \
        if constexpr (F8) asm volatile("v_mfma_scale_f32_16x16x128_f8f6f4 %0, %1, %2, %0, %3, %3 op_sel_hi:[0,0,0]" : "+v"(acc[ai][bj][m][n]) : "v"(Bt[n]), "v"(At[m]), "v"(sc8)); \
        else { acc[ai][bj][m][n] = __builtin_amdgcn_mfma_f32_16x16x32_bf16(PG8_LOH(Bt[n]), PG8_LOH(At[m]), acc[ai][bj][m][n], 0, 0, 0); \
               acc[ai][bj][m][n] = __builtin_amdgcn_mfma_f32_16x16x32_bf16(PG8_HIH(Bt[n]), PG8_HIH(At[m]), acc[ai][bj][m][n], 0, 0, 0); } } \
        __builtin_amdgcn_s_setprio(0); } while (0)
#define PG8_WAIT_V(n) asm volatile("s_waitcnt vmcnt(" #n ")" ::: "memory")
#define PG8_WAIT_L(n) asm volatile("s_waitcnt lgkmcnt(" #n ")" ::: "memory")
#define PG8_BAR __builtin_amdgcn_s_barrier()
#define PG8_SCHED __builtin_amdgcn_sched_barrier(0)
#define PG8_ROWOFF(dst, u) do { _Pragma("unroll") for (int _h = 0; _h < 2; ++_h) _Pragma("unroll") for (int _i = 0; _i < 2; ++_i) \
        dst[_h][_i] = (RM.row(u, _h * HALF + R_[_i]) * (unsigned)K + (unsigned)C_[_i]) * 2u; } while (0)
#define PG8_ABASE(u) ((const char*)g.A + ((size_t)RM.base(u) * K + (size_t)(u).k0) * 2)
    UnitX cur, nxt; int ui = 0;
    if (!S.next(0, cur)) return;
    f32x4 acc[2][2][4][2];
#pragma unroll
    for (int a = 0; a < 2; ++a)
#pragma unroll
        for (int b = 0; b < 2; ++b)
#pragma unroll
            for (int m = 0; m < 4; ++m)
#pragma unroll
                for (int n = 0; n < 2; ++n) acc[a][b][m][n] = (f32x4){0.f, 0.f, 0.f, 0.f};
    i32x8 At[4], B0[2], B1[2];
    const int sc8 = 0x7f7f7f7f;
    unsigned vc[2][2], vn[2][2];
    PG8_ROWOFF(vc, cur);
    const char* A0 = PG8_ABASE(cur);
    const char* cB = (const char*)g.Bt + (size_t)cur.pn * tstep + (size_t)cur.k0 * 2;
    PG8_STAGE(PG8_SB(0, 0), cB, voffB); PG8_STAGE(PG8_SB(0, 1), cB + hstep, voffB); PG8_STAGE(PG8_SA(0, 0), A0, vc[0]); PG8_STAGE(PG8_SA(0, 1), A0, vc[1]);
    if (wr == 1) PG8_BAR;
    PG8_WAIT_V(2); PG8_BAR;
    PG8_STAGE(PG8_SB(1, 0), cB + kstep, voffB); PG8_STAGE(PG8_SA(1, 0), A0 + kstep, vc[0]); PG8_STAGE(PG8_SB(1, 1), cB + hstep + kstep, voffB);
    PG8_WAIT_V(6); PG8_BAR;
    for (;;) {
        const bool has_next = S.next(ui + 1, nxt);
        if constexpr (!RowMap::IDENT) { if (has_next) { PG8_ROWOFF(vn, nxt); } else {
#pragma unroll
            for (int _h = 0; _h < 2; ++_h)
#pragma unroll
                for (int _i = 0; _i < 2; ++_i) vn[_h][_i] = vc[_h][_i]; } }
        const char* nB = has_next ? (const char*)g.Bt + (size_t)nxt.pn * tstep + (size_t)nxt.k0 * 2 : cB;
        const char* nA = has_next ? PG8_ABASE(nxt) : A0;
        const int nt = cur.nt;
        for (int t = 0; t < nt; t += 2) {
            const bool last = (t == nt - 2);
            const char* a1 = A0 + (size_t)(t + 1) * kstep;
            const char* a2 = last ? nA : A0 + (size_t)(t + 2) * kstep; const char* b2 = last ? nB : cB + (size_t)(t + 2) * kstep;
            const char* a3 = a2 + kstep; const char* b3 = b2 + kstep;
            unsigned v2h0[2], v2h1[2];
#pragma unroll
            for (int _i = 0; _i < 2; ++_i) { if constexpr (RowMap::IDENT) { v2h0[_i] = vc[0][_i]; v2h1[_i] = vc[1][_i]; } else { v2h0[_i] = last ? vn[0][_i] : vc[0][_i]; v2h1[_i] = last ? vn[1][_i] : vc[1][_i]; } }
            PG8_LDB(B0, 0, 0); PG8_LDB(B1, 0, 1); PG8_SCHED; PG8_LDA(At, 0, 0); PG8_STAGE(PG8_SA(1, 1), a1, vc[1]);
            PG8_WAIT_V(8); PG8_WAIT_L(0); PG8_BAR; PG8_MMA(0, 0, At, B0); PG8_MMA(0, 1, At, B1); PG8_BAR; PG8_SCHED;
            PG8_LDA(At, 0, 1); PG8_STAGE(PG8_SB(0, 0), b2, voffB); PG8_STAGE(PG8_SB(0, 1), b2 + hstep, voffB); PG8_STAGE(PG8_SA(0, 0), a2, v2h0);
            PG8_WAIT_V(8); PG8_WAIT_L(0); PG8_BAR; PG8_MMA(1, 0, At, B0); PG8_MMA(1, 1, At, B1); PG8_BAR; PG8_SCHED;
            PG8_LDB(B0, 1, 0); PG8_LDB(B1, 1, 1); PG8_SCHED; PG8_LDA(At, 1, 0); PG8_STAGE(PG8_SA(0, 1), a2, v2h1);
            PG8_WAIT_V(8); PG8_WAIT_L(0); PG8_BAR; PG8_MMA(0, 0, At, B0); PG8_MMA(0, 1, At, B1); PG8_BAR; PG8_SCHED;
            PG8_LDA(At, 1, 1); PG8_STAGE(PG8_SB(1, 0), b3, voffB); PG8_STAGE(PG8_SB(1, 1), b3 + hstep, voffB); PG8_STAGE(PG8_SA(1, 0), a3, v2h0);
            PG8_WAIT_V(8); PG8_WAIT_L(0); PG8_BAR; PG8_MMA(1, 0, At, B0); PG8_MMA(1, 1, At, B1); PG8_BAR; PG8_SCHED;
        }
        if constexpr (F8) asm volatile("s_nop 7\n\ts_nop 7\n\ts_nop 7" ::: "memory");
        if (wr == 0) PG8_BAR;
        E(acc, cur, wr, wc, fr, fq);
        if (!has_next) break;
#pragma unroll
        for (int a = 0; a < 2; ++a)
#pragma unroll
            for (int b = 0; b < 2; ++b)
#pragma unroll
                for (int m = 0; m < 4; ++m)
#pragma unroll
                    for (int n = 0; n < 2; ++n) acc[a][b][m][n] = (f32x4){0.f, 0.f, 0.f, 0.f};
        cur = nxt; cB = nB; A0 = nA; ++ui;
        if constexpr (!RowMap::IDENT) {
#pragma unroll
        for (int _h = 0; _h < 2; ++_h)
#pragma unroll
            for (int _i = 0; _i < 2; ++_i) vc[_h][_i] = vn[_h][_i]; }
        if (wr == 1) PG8_BAR;
    }
    PG8_WAIT_V(0);
    PG8_BAR;
#undef PG8_SA
#undef PG8_SB
#undef PG8_STAGE
#undef PG8_LDA
#undef PG8_LDB
#undef PG8_LD8
#undef PG8_LOH
#undef PG8_HIH
#undef PG8_MMA
#undef PG8_WAIT_V
#undef PG8_WAIT_L
#undef PG8_BAR
#undef PG8_SCHED
#undef PG8_ROWOFF
#undef PG8_ABASE
}

struct MoeOrder {
    const PG8_LAS int* tab; const PG8_LAS int* cnt; int Ur, nSh, G, c, ntk;
    __device__ __forceinline__ bool next(int i, UnitX& u) const {
        int L = i * G + c; u.k0 = 0; u.nt = ntk;
        if (L < Ur) { const int v = tab[L]; u.e = v & 255; u.pm = v >> 8; u.pn = u.e; u.nrows = cnt[u.e]; return true; }
        L -= Ur;
        if (L < nSh) { u.e = -1; u.pm = L >> 3; u.pn = NE + (L & 7); u.nrows = 0; return true; }
        return false;
    }
};
struct RowList {
    const int* list;
    static constexpr bool IDENT = false;
    __device__ __forceinline__ unsigned base(const UnitX&) const { return 0u; }
    __device__ __forceinline__ unsigned row(const UnitX& u, int r) const {
        if (u.e < 0) return (unsigned)(u.pm * BM + r);
        int i = u.pm * BM + r; i = i < u.nrows ? i : u.nrows - 1;
        return (unsigned)list[(size_t)u.e * T + i];
    }
};
struct EpiSwigluX {
    static constexpr bool PERM = true, AFTER_DRAIN = false;
    unsigned char* H; const float* gates; const int* list; float oscale;
    __device__ __forceinline__ void operator()(const f32x4 (&acc)[2][2][4][2], const UnitX& u, int wr, int wc, int fr, int fq) const {
        const int hc0 = u.pn * 128 + wc * 16 + 4 * fq;
#pragma unroll
        for (int ai = 0; ai < 2; ++ai)
#pragma unroll
            for (int m = 0; m < 4; ++m) { const int rloc = u.pm * BM + wr * 64 + fr + ai * HALF + m * 16; int tok = rloc; float gt = 1.f; bool ok = true;
                if (u.e >= 0) { ok = rloc < u.nrows; tok = ok ? list[(size_t)u.e * T + rloc] : 0; gt = ok ? gates[(size_t)tok * NE + u.e] : 0.f; }
                if (ok) {
#pragma unroll
                for (int bj = 0; bj < 2; ++bj) { const f32x4 v0 = acc[ai][bj][m][0] * oscale, v1 = acc[ai][bj][m][1] * oscale;
                    const float h0 = v0[0] / (1.f + __expf(-v0[0])) * v0[1] * gt, h1 = v0[2] / (1.f + __expf(-v0[2])) * v0[3] * gt;
                    const float h2 = v1[0] / (1.f + __expf(-v1[0])) * v1[1] * gt, h3 = v1[2] / (1.f + __expf(-v1[2])) * v1[3] * gt;
                    int w = __builtin_amdgcn_cvt_pk_fp8_f32(__builtin_amdgcn_fmed3f(h0, -448.f, 448.f), __builtin_amdgcn_fmed3f(h1, -448.f, 448.f), 0, false); w = __builtin_amdgcn_cvt_pk_fp8_f32(__builtin_amdgcn_fmed3f(h2, -448.f, 448.f), __builtin_amdgcn_fmed3f(h3, -448.f, 448.f), w, true);
                    *(int*)(H + (size_t)tok * DN_K + hc0 + bj * 64) = w; } } }
    }
};

struct SplitCtxOrder {
    int nN, G, c, ntk, nlat, nsub, nsplit;
    __device__ __forceinline__ void init(int M, int N, int K, int G_, int c_, int nsplit_) { nN = N / BM; G = G_; c = c_; ntk = K / BK; nsplit = nsplit_; nlat = (NLAT / BM) * nN; nsub = (M > NLAT) ? ((M - NLAT) / BM) * nN * nsplit : 0; }
    __device__ __forceinline__ bool next(int i, UnitX& u) const {
        int L = i * G + c; u.e = -1; u.nrows = 0;
        if (L < nlat) { int wgid = L; { const int q = nlat / NXCD, xcd = wgid % NXCD, off = wgid / NXCD; wgid = xcd * q + off; }
            const int nig = WGM * nN, gid = wgid / nig, fm = gid * WGM; u.pm = fm + ((wgid % nig) % WGM); u.pn = (wgid % nig) / WGM; u.k0 = 0; u.nt = ntk; return true; }
        L -= nlat;
        if (L < nsub) { const int tile = L / nsplit, s = L % nsplit; u.pm = NLAT / BM + tile / nN; u.pn = tile % nN; u.nt = ntk / nsplit; u.k0 = s * (ntk / nsplit) * BK; u.e = -2 - s; return true; }
        return false;
    }
};
struct RowIdent { static constexpr bool IDENT = true;
                  __device__ __forceinline__ unsigned base(const UnitX& u) const { return (unsigned)(u.pm * BM); }
                  __device__ __forceinline__ unsigned row(const UnitX&, int r) const { return (unsigned)r; } };
struct EpiResidX {
    static constexpr bool PERM = false, AFTER_DRAIN = false;
    const float* lat_src; float* lat_dst; const float* gate; float* part; float oscale;
    __device__ __forceinline__ void operator()(const f32x4 (&acc)[2][2][4][2], const UnitX& u, int wr, int wc, int fr, int fq) const {
        const int rowt = u.pm * BM, col0 = u.pn * BM + wc * 32 + 4 * fq;
        if (u.e <= -2) {
            float* pp = part + (size_t)(-2 - u.e) * NCTX * D; const int row0 = rowt - NLAT + wr * 64 + fr;
#pragma unroll
            for (int ai = 0; ai < 2; ++ai)
#pragma unroll
                for (int m = 0; m < 4; ++m) { const size_t off = (size_t)(row0 + ai * HALF + m * 16) * D + col0;
#pragma unroll
                    for (int bj = 0; bj < 2; ++bj)
#pragma unroll
                        for (int n = 0; n < 2; ++n) *(f32x4*)(pp + off + bj * HALF + n * 16) = acc[ai][bj][m][n] * oscale; }
            return; }
        const int c = rowt < SEQ ? 0 : 1; const float* gv = gate + (size_t)c * 6 * D; const int row0 = rowt + wr * 64 + fr;
        f32x4 g[2][2];
#pragma unroll
        for (int bj = 0; bj < 2; ++bj)
#pragma unroll
            for (int n = 0; n < 2; ++n) g[bj][n] = *(const f32x4*)(gv + col0 + bj * HALF + n * 16) * oscale;
#pragma unroll
        for (int ai = 0; ai < 2; ++ai)
#pragma unroll
            for (int m = 0; m < 4; ++m) { const size_t off = (size_t)(row0 + ai * HALF + m * 16) * D + col0;
#pragma unroll
                for (int bj = 0; bj < 2; ++bj)
#pragma unroll
                    for (int n = 0; n < 2; ++n) { const f32x4 s = *(const f32x4*)(lat_src + off + bj * HALF + n * 16); *(f32x4*)(lat_dst + off + bj * HALF + n * 16) = s + g[bj][n] * acc[ai][bj][m][n]; } }
    }
};

struct StaticOrderX {
    int nM, nN, nwg, G, c, ntk;
    __device__ __forceinline__ void init(int M, int N, int K, int G_, int c_) { nM = M / BM; nN = N / BM; nwg = nM * nN; G = G_; c = c_; ntk = K / BK; }
    __device__ __forceinline__ bool next(int i, UnitX& u) const {
        const long L = (long)i * G + c; if (L >= nwg) return false;
        int wgid = (int)L; { const int q = nwg / NXCD, r = nwg % NXCD, xcd = wgid % NXCD, off = wgid / NXCD; wgid = (xcd < r ? xcd * (q + 1) : r * (q + 1) + (xcd - r) * q) + off; }
        const int nig = WGM * nN, gid = wgid / nig, fm = gid * WGM, gsz = (nM - fm) < WGM ? (nM - fm) : WGM;
        u.pm = fm + ((wgid % nig) % gsz); u.pn = (wgid % nig) / gsz; u.e = -1; u.nrows = 0; u.k0 = 0; u.nt = ntk; return true;
    }
};
template <int ACT> struct EpiBf16X {
    static constexpr bool PERM = true, AFTER_DRAIN = false;
    bf16_t* O; int ldc; const float* bias; float oscale;
    __device__ __forceinline__ void operator()(const f32x4 (&acc)[2][2][4][2], const UnitX& u, int wr, int wc, int fr, int fq) const {
        const int row0 = u.pm * BM + wr * 64 + fr, col0 = u.pn * BM + wc * 32 + 8 * fq;
        f32x4 bv[2][2];
#pragma unroll
        for (int bj = 0; bj < 2; ++bj)
#pragma unroll
            for (int n = 0; n < 2; ++n) bv[bj][n] = bias ? *(const f32x4*)(bias + col0 + bj * HALF + 4 * n) : (f32x4){0.f, 0.f, 0.f, 0.f};
#pragma unroll
        for (int ai = 0; ai < 2; ++ai)
#pragma unroll
            for (int m = 0; m < 4; ++m) { bf16_t* rowp = O + (size_t)(row0 + ai * HALF + m * 16) * ldc + col0;
#pragma unroll
                for (int bj = 0; bj < 2; ++bj) { f32x4 v0 = acc[ai][bj][m][0] * oscale + bv[bj][0], v1 = acc[ai][bj][m][1] * oscale + bv[bj][1];
                    if (ACT == 1) { f32x2 a = gelu_pk((f32x2){v0[0], v0[1]}), b = gelu_pk((f32x2){v0[2], v0[3]}), c = gelu_pk((f32x2){v1[0], v1[1]}), d = gelu_pk((f32x2){v1[2], v1[3]});
                        v0 = (f32x4){a.x, a.y, b.x, b.y}; v1 = (f32x4){c.x, c.y, d.x, d.y}; }
                    u32x4 w; w.x = cvt_pk_bf16(v0[0], v0[1]); w.y = cvt_pk_bf16(v0[2], v0[3]); w.z = cvt_pk_bf16(v1[0], v1[1]); w.w = cvt_pk_bf16(v1[2], v1[3]);
                    *(u32x4*)(rowp + bj * HALF) = w; } }
    }
};
}

#ifndef PG8_SP2
#define PG8_SP2 true
#endif
#ifndef PG8_ALIGN
#define PG8_ALIGN true
#endif

#define LAS __attribute__((address_space(3)))
typedef unsigned short bf16_t;
typedef float f32x4 __attribute__((ext_vector_type(4)));
typedef unsigned u32x4 __attribute__((ext_vector_type(4)));
typedef unsigned u32x2 __attribute__((ext_vector_type(2)));

constexpr size_t MiB = 1u << 20;
constexpr size_t WS_CTL = 0, CTL_ZERO_BYTES = 1 * MiB;
constexpr size_t WS_MODS = 1 * MiB;
constexpr size_t WS_RPART = 3 * MiB;
constexpr size_t WS_WR = 4 * MiB;
constexpr size_t WS_RB = 16 * MiB;
constexpr size_t WS_RSTDV = 16 * MiB + 65536;
constexpr size_t WS_GATES = 17 * MiB;
constexpr size_t WS_CX = 22 * MiB;
constexpr size_t WS_WIN = 30 * MiB;
constexpr size_t WS_WOUT = WS_WIN + 96 * MiB;
constexpr size_t WS_WGU = WS_WOUT + 32 * MiB;
constexpr size_t WS_WD = WS_WGU + 144 * MiB;
constexpr size_t WS_H = WS_WD + 72 * MiB;
constexpr size_t WS_P = WS_H + 132 * MiB;
constexpr size_t WS_MIX = WS_P + 396 * MiB;
constexpr size_t WS_UT = WS_MIX + 132 * MiB;
constexpr size_t WS_FILT = WS_UT + 384 * MiB;
constexpr size_t WS_FILTC = WS_FILT + 256 * MiB;
constexpr size_t WS_Z2T = WS_FILTC + 8 * MiB;
constexpr size_t WS_END = WS_Z2T + 128 * MiB;
constexpr size_t WS_WSET2 = WS_END;
constexpr size_t WSET_BYTES = 344 * MiB;
constexpr size_t WS_PART = WS_WSET2 + WSET_BYTES;
constexpr size_t WS_ELIST = WS_PART + 64 * MiB;
constexpr size_t WS_H8E = WS_ELIST + 5 * MiB;
constexpr size_t WS_END2 = WS_H8E + 66 * MiB;
constexpr int CW_BAR = 4096;
constexpr int CW_ECNT = 8192;
constexpr int CW_WQ = 8704;
constexpr int CW_ARR = 8768;
constexpr int TAB_OFF = 131072;

constexpr int LDS_BYTES = 147456;
constexpr int MISC_OFF = 147200;

#define XB_TMO      128
#define XB_XCNT(j)  (256  + 64 * (j))
#define XB_XSUB(j)  (1280 + 64 * (j))
#define XB_XGEN(j)  (2304 + 64 * (j))
#define XB_TOP      3328
#define XB_TOPGEN   3392
#define XCD_BAR_WORDS 3456
#define XB_SPIN_CAP (1u << 21)

__device__ __forceinline__ unsigned xb_ld(unsigned* p)              { return __hip_atomic_load(p, __ATOMIC_RELAXED, __HIP_MEMORY_SCOPE_AGENT); }
__device__ __forceinline__ unsigned xb_add(unsigned* p, unsigned v) { return __hip_atomic_fetch_add(p, v, __ATOMIC_RELAXED, __HIP_MEMORY_SCOPE_AGENT); }
__device__ __forceinline__ unsigned xb_xcc_id() { return (unsigned)__builtin_amdgcn_s_getreg((3 << 11) | 20) & 0xFu; }
#define XB_SPIN(cond, bar) do { unsigned _sp = 0; while (cond) { __builtin_amdgcn_s_sleep(1); \
    if ((++_sp & 255u) == 0u) { if (xb_ld(&(bar)[XB_TMO])) break; if (_sp > XB_SPIN_CAP) { atomicAdd(&(bar)[XB_TMO], 1u); break; } } } } while (0)

struct XcdBarrier { unsigned* bar; unsigned x; volatile LAS unsigned* st; };

__device__ __forceinline__ XcdBarrier xcd_barrier_post(unsigned* bar, volatile LAS unsigned* st) {
    XcdBarrier b; b.bar = bar; b.x = xb_xcc_id(); b.st = st;
    if (threadIdx.x == 0) (void)xb_add(&bar[XB_XCNT(b.x)], 1u);
    return b;
}
__device__ __forceinline__ void xcd_barrier_complete(unsigned* bar, unsigned x, unsigned& nloc, unsigned& nx) {
    const unsigned G = gridDim.x * gridDim.y * gridDim.z;
    unsigned sum, cnt, mine, sp = 0u;
    for (;;) {
        sum = 0u; cnt = 0u; mine = 0u;
#pragma unroll
        for (unsigned j = 0; j < 16; ++j) { const unsigned c = xb_ld(&bar[XB_XCNT(j)]); sum += c; cnt += (c > 0u) ? 1u : 0u; mine = (j == x) ? c : mine; }
        if (sum == G) break;
        __builtin_amdgcn_s_sleep(1);
        if ((++sp & 255u) == 0u) { if (xb_ld(&bar[XB_TMO])) break; if (sp > XB_SPIN_CAP) { atomicAdd(&bar[XB_TMO], 1u); break; } }
    }
    nloc = mine > 0u ? mine : 1u; nx = cnt > 0u ? cnt : 1u;
}
__device__ __forceinline__ void xcd_barrier(const XcdBarrier& b) {
    asm volatile("s_waitcnt vmcnt(0)" ::: "memory");
    __syncthreads();
    if (threadIdx.x == 0) {
        unsigned* bar = b.bar;
        __builtin_amdgcn_s_waitcnt(0);
        unsigned nloc = b.st[0], nx = b.st[1];
        if (nloc == 0u) { xcd_barrier_complete(bar, b.x, nloc, nx); b.st[0] = nloc; b.st[1] = nx; }
        const unsigned old = xb_add(&bar[XB_XSUB(b.x)], 1u);
        const unsigned gen = old / nloc;
        if (old + 1u == (gen + 1u) * nloc) {
            __builtin_amdgcn_fence(__ATOMIC_RELEASE, "agent");
            asm volatile("s_waitcnt vmcnt(0)" ::: "memory");
            const unsigned og = xb_add(&bar[XB_TOP], 1u);
            const unsigned tg = og / nx;
            if (og + 1u == (tg + 1u) * nx) xb_add(&bar[XB_TOPGEN], 1u);
            else XB_SPIN(xb_ld(&bar[XB_TOPGEN]) == tg, bar);
            __builtin_amdgcn_fence(__ATOMIC_ACQUIRE, "agent");
            xb_add(&bar[XB_XGEN(b.x)], 1u);
            asm volatile("s_waitcnt vmcnt(0)" ::: "memory");
        } else {
            XB_SPIN(xb_ld(&bar[XB_XGEN(b.x)]) == gen, bar);
            __builtin_amdgcn_fence(__ATOMIC_ACQUIRE, "agent");
            asm volatile("s_waitcnt vmcnt(0)" ::: "memory");
        }
    }
    __syncthreads();
}

struct Args { const float* in[38]; float* out; unsigned char* ws; int ph_lo, ph_hi; };
enum { I_X = 0, I_C, I_CTX, I_CCTX, I_ADA_A, I_ADA_B, I_ADA_BIAS, I_NORM_MIX, I_NORM_FFN, I_EVEN_WIN, I_QGAIN, I_KGAIN, I_RPB, I_HY_CW, I_HY_CB,
       I_HY_W1, I_HY_B1, I_HY_W2, I_HY_B2, I_HY_W3, I_HY_B3, I_HY_W4, I_HY_FREQ, I_HY_SKIP, I_ODD_WIN, I_ODD_BIN, I_GM_VGAIN, I_GM_WS, I_GM_BS, I_WOUT,
       I_ROUTER, I_MOE_BIAS, I_MOE_WG, I_MOE_WU, I_MOE_WD, I_SH_WG, I_SH_WU, I_SH_WD };

struct Frame { LAS unsigned char* lds; int tid, lane, wave, G, gw, NGW; };

#define LDS_WAIT() asm volatile("s_waitcnt lgkmcnt(0)" ::: "memory")
__device__ __forceinline__ int opaque_zero() { int z; asm volatile("s_mov_b32 %0, 0" : "=s"(z)); return z; }
#define INP(i) (a.in[(i) + Z])
#define WSB(off) (a.ws + ((size_t)(off) + (size_t)Z))
#define AOUT (a.out + (size_t)Z)
#define WSETP(off, l_) ((bf16_t*)(a.ws + (((l_) & 1) ? (WS_WSET2 + ((off) - WS_WIN)) : (off)) + (size_t)Z))
__device__ __forceinline__ unsigned f2bf(float f) { unsigned u = __builtin_bit_cast(unsigned, f); return (u + 0x7fffu + ((u >> 16) & 1u)) >> 16; }
typedef __bf16 bf16x2_t __attribute__((ext_vector_type(2)));
__device__ __forceinline__ unsigned pk2(float lo, float hi) { bf16x2_t v; v.x = (__bf16)lo; v.y = (__bf16)hi; return __builtin_bit_cast(unsigned, v); }
__device__ __forceinline__ float sat8(float v) { return __builtin_amdgcn_fmed3f(v, -448.f, 448.f); }
__device__ __forceinline__ unsigned pk4f8(float a0, float a1, float a2, float a3) { a0 = sat8(a0); a1 = sat8(a1); a2 = sat8(a2); a3 = sat8(a3); int w = __builtin_amdgcn_cvt_pk_fp8_f32(a0, a1, 0, false); w = __builtin_amdgcn_cvt_pk_fp8_f32(a2, a3, w, true); return (unsigned)w; }
__device__ __forceinline__ float bflo(unsigned u) { return __builtin_bit_cast(float, u << 16); }
__device__ __forceinline__ float bfhi(unsigned u) { return __builtin_bit_cast(float, u & 0xffff0000u); }
__device__ __forceinline__ float bf2f(bf16_t b) { return __builtin_bit_cast(float, ((unsigned)b) << 16); }
__device__ __forceinline__ float wave_sum(float v) {
#pragma unroll
    for (int o = 1; o < 64; o <<= 1) v += __shfl_xor(v, o);
    return v;
}
__device__ __forceinline__ float wave_max(float v) {
#pragma unroll
    for (int o = 1; o < 64; o <<= 1) v = fmaxf(v, __shfl_xor(v, o));
    return v;
}
__device__ __forceinline__ float* MODSP_(unsigned char* wsz, int l, int c, int i) { return (float*)(wsz + WS_MODS) + ((size_t)(l * 3 + c) * 6 + i) * D; }
#define MODSP(a_, l_, c_, i_) MODSP_(WSB(0), l_, c_, i_)

__device__ __forceinline__ void ph_mods1(const Args& a, const Frame& F) {
    const int Z = opaque_zero();
    LAS float* red = (LAS float*)F.lds;
    const float* c = INP(I_C); const float* cc = INP(I_CCTX); const float* A = INP(I_ADA_A);
    float* rpart = (float*)WSB(WS_RPART);
    for (int it = blockIdx.x; it < 4 * 64; it += F.G) {
        const int l = it >> 6, kc = it & 63, j = F.tid & 255, half = F.tid >> 8, k0 = kc * 64 + half * 32;
        float s0 = 0.f, s1 = 0.f, s2 = 0.f;
        const float* Ap = A + ((size_t)l * D + k0) * RANK + j;
        for (int k = 0; k < 32; ++k) {
            const float w = Ap[(size_t)k * RANK]; const float x0 = c[k0 + k], x1 = c[D + k0 + k], x2 = cc[k0 + k];
            s0 += x0 / (1.f + expf(-x0)) * w; s1 += x1 / (1.f + expf(-x1)) * w; s2 += x2 / (1.f + expf(-x2)) * w;
        }
        if (half == 1) { red[j] = s0; red[256 + j] = s1; red[512 + j] = s2; }
        __syncthreads();
        if (half == 0) { float* o = rpart + (size_t)(l * 64 + kc) * 768; o[j] = s0 + red[j]; o[256 + j] = s1 + red[256 + j]; o[512 + j] = s2 + red[512 + j]; }
        __syncthreads();
    }
}
__device__ __forceinline__ void ph_mods2(const Args& a, const Frame& F) {
    const int Z = opaque_zero();
    LAS float* r = (LAS float*)F.lds;
    const float* rpart = (const float*)WSB(WS_RPART); const float* B = INP(I_ADA_B); const float* bias = INP(I_ADA_BIAS);
    for (int it = blockIdx.x; it < 4 * 48; it += F.G) {
        const int l = it / 48, nc = it % 48;
        for (int idx = F.tid; idx < 768; idx += 512) { float s = 0.f; for (int kc = 0; kc < 64; ++kc) s += rpart[(size_t)(l * 64 + kc) * 768 + idx]; r[idx] = s; }
        __syncthreads();
        const int n = nc * 512 + F.tid; const float* Bp = B + (size_t)l * RANK * 24576 + n;
        float s0 = bias[l * 24576 + n], s1 = s0, s2 = s0;
        for (int j = 0; j < RANK; ++j) { const float w = Bp[(size_t)j * 24576]; s0 += r[j] * w; s1 += r[256 + j] * w; s2 += r[512 + j] * w; }
        float* M = (float*)WSB(WS_MODS);
        M[(size_t)(l * 3 + 0) * 24576 + n] = s0; M[(size_t)(l * 3 + 1) * 24576 + n] = s1; M[(size_t)(l * 3 + 2) * 24576 + n] = s2;
        __syncthreads();
    }
}
__device__ __forceinline__ void ph_rprep(const Args& a, const Frame& F) {
    const int Z = opaque_zero();
    LAS float* tile = (LAS float*)F.lds;
    bf16_t* WRH = (bf16_t*)WSB(WS_WR); bf16_t* WRL = WRH + (size_t)4 * 3 * NE * D; float* RB = (float*)WSB(WS_RB);
    for (int it = blockIdx.x; it < 4 * 64; it += F.G) {
        const int l = it >> 6, kc = it & 63, k0 = kc * 64;
        const float* Wr = INP(I_ROUTER) + ((size_t)l * D + k0) * NE;
        for (int idx = F.tid; idx < 4096; idx += 512) tile[(idx >> 6) * 65 + (idx & 63)] = Wr[idx];
        __syncthreads();
        const float* g = INP(I_NORM_FFN) + (size_t)l * D;
        for (int c = 0; c < 3; ++c) {
            const float* sc = MODSP(a, l, c, 4); const size_t ob = (size_t)(l * 3 + c) * NE * D;
            for (int idx = F.tid; idx < 4096; idx += 512) { const int e = idx >> 6, kk = idx & 63, k = k0 + kk; const float v = tile[kk * 65 + e] * (g[k] * (1.f + sc[k]));
                const unsigned hb = __builtin_bit_cast(unsigned, v) & 0xffff0000u; const float lo = v - __builtin_bit_cast(float, hb);
                const size_t fo = ob + ((size_t)(((k >> 5) * 4 + (e >> 4)) * 64 + ((k & 31) >> 3) * 16 + (e & 15))) * 8 + (k & 7);
                WRH[fo] = (bf16_t)(hb >> 16); WRL[fo] = (bf16_t)f2bf(lo); }
        }
        __syncthreads();
    }
    for (int task = F.gw; task < 4 * 3 * NE; task += F.NGW) {
        const int l = task / 192, c = (task / 64) % 3, e = task & 63;
        const float* sh = MODSP(a, l, c, 3); const float* Wr = INP(I_ROUTER) + (size_t)l * D * NE + e; float s = 0.f;
        for (int k = F.lane; k < D; k += 64) s += sh[k] * Wr[(size_t)k * NE];
        s = wave_sum(s); if (F.lane == 0) RB[task] = s;
    }
}

__device__ __forceinline__ void transpose_item(const float* W, int N, bf16_t* WT, int ldk, int row_off, int row_mul, int koff, LAS float* scr, int item, int lane) {
    const int nblk = N / 32, kb = item / nblk, nb = item % nblk, k0 = 64 * kb, n0 = 32 * nb;
#pragma unroll 8
    for (int i = 0; i < 32; ++i) { const int kk = 2 * i + (lane >> 5); scr[kk * 33 + (lane & 31)] = W[(size_t)(k0 + kk) * N + n0 + (lane & 31)]; }
    LDS_WAIT();
    const int c = lane & 7;
#pragma unroll
    for (int j = 0; j < 4; ++j) { const int n = (lane >> 3) + 8 * j; const LAS float* s = scr + (8 * c) * 33 + n;
        u32x4 o; o.x = pk2(s[0 * 33], s[1 * 33]); o.y = pk2(s[2 * 33], s[3 * 33]); o.z = pk2(s[4 * 33], s[5 * 33]); o.w = pk2(s[6 * 33], s[7 * 33]);
        *(u32x4*)(WT + (size_t)(row_off + (n0 + n) * row_mul) * ldk + koff + k0 + 8 * c) = o; }
    LDS_WAIT();
}
__device__ __forceinline__ void transpose_item_f8(const float* W, int N, unsigned char* WT, int ldk, int row_off, int row_mul, int koff, float scale, LAS float* scr, int item, int lane) {
    const int nblk = N / 32, kb = item / nblk, nb = item % nblk, k0 = 64 * kb, n0 = 32 * nb;
#pragma unroll 8
    for (int i = 0; i < 32; ++i) { const int kk = 2 * i + (lane >> 5); scr[kk * 33 + (lane & 31)] = W[(size_t)(k0 + kk) * N + n0 + (lane & 31)]; }
    LDS_WAIT();
    const int c = lane & 7;
#pragma unroll
    for (int j = 0; j < 4; ++j) { const int n = (lane >> 3) + 8 * j; const LAS float* s = scr + (8 * c) * 33 + n;
        int lo = __builtin_amdgcn_cvt_pk_fp8_f32(s[0 * 33] * scale, s[1 * 33] * scale, 0, false); lo = __builtin_amdgcn_cvt_pk_fp8_f32(s[2 * 33] * scale, s[3 * 33] * scale, lo, true);
        int hi = __builtin_amdgcn_cvt_pk_fp8_f32(s[4 * 33] * scale, s[5 * 33] * scale, 0, false); hi = __builtin_amdgcn_cvt_pk_fp8_f32(s[6 * 33] * scale, s[7 * 33] * scale, hi, true);
        u32x2 o; o.x = (unsigned)lo; o.y = (unsigned)hi;
        *(u32x2*)(WT + (size_t)(row_off + (n0 + n) * row_mul) * ldk + koff + k0 + 8 * c) = o; }
    LDS_WAIT();
}
constexpr float WD_SCALE = 16.f, WGU_SCALE = 64.f;
__device__ __forceinline__ void conv_mat(const Frame& F, const float* W, int K, int N, bf16_t* WT, int ldk, int row_off, int row_mul, int koff, LAS float* scr) {
    const int nitems = (K / 64) * (N / 32);
    for (int it = F.gw; it < nitems; it += F.NGW) transpose_item(W, N, WT, ldk, row_off, row_mul, koff, scr, it, F.lane);
}
constexpr int WQ_CHUNK = 8;
__device__ __forceinline__ int wq_nitems(int lt) { return (((lt & 1) == 0) ? 24576 : 16384) + 8192 + 16384 + 16384 + 2048 + 2048 + 16384 + 2048; }
__device__ __forceinline__ void wq_item(const Args& a, const Frame& F, int lt, int item, LAS float* scr, int Z) {
    const int j = lt >> 1; const int n0 = ((lt & 1) == 0) ? 24576 : 16384;
    bf16_t* WIN = WSETP(WS_WIN, lt); bf16_t* WOUT = WSETP(WS_WOUT, lt); bf16_t* WGU = WSETP(WS_WGU, lt); bf16_t* WD = WSETP(WS_WD, lt);
    int it = item;
    if (it < n0) { if ((lt & 1) == 0) { if ((it % (EVEN_IN / 32)) * 32 < 6144) transpose_item_f8(INP(I_EVEN_WIN) + (size_t)j * D * EVEN_IN, EVEN_IN, (unsigned char*)WIN, D, 0, 1, 0, WGU_SCALE, scr, it, F.lane);
                                        else transpose_item(INP(I_EVEN_WIN) + (size_t)j * D * EVEN_IN, EVEN_IN, WIN, D, 0, 1, 0, scr, it, F.lane); }
                   else transpose_item_f8(INP(I_ODD_WIN) + (size_t)j * D * ODD_IN, ODD_IN, (unsigned char*)WIN, D, 0, 1, 0, WGU_SCALE, scr, it, F.lane); return; }
    it -= n0;
    if (it < 8192) { if (lt & 1) transpose_item_f8(INP(I_WOUT) + (size_t)lt * D * D, D, (unsigned char*)WOUT, D, 0, 1, 0, WGU_SCALE, scr, it, F.lane);
                     else transpose_item(INP(I_WOUT) + (size_t)lt * D * D, D, WOUT, D, 0, 1, 0, scr, it, F.lane); return; }
    it -= 8192;
    if (it < 16384) { const int e = it >> 8, li = it & 255; transpose_item_f8(INP(I_MOE_WG) + ((size_t)lt * NE + e) * D * ED, ED, (unsigned char*)WGU, D, e * 256, 2, 0, WGU_SCALE, scr, li, F.lane); return; }
    it -= 16384;
    if (it < 16384) { const int e = it >> 8, li = it & 255; transpose_item_f8(INP(I_MOE_WU) + ((size_t)lt * NE + e) * D * ED, ED, (unsigned char*)WGU, D, e * 256 + 1, 2, 0, WGU_SCALE, scr, li, F.lane); return; }
    it -= 16384;
    if (it < 2048) { transpose_item_f8(INP(I_SH_WG) + (size_t)lt * D * SHD, SHD, (unsigned char*)WGU, D, NE * 256, 2, 0, WGU_SCALE, scr, it, F.lane); return; }
    it -= 2048;
    if (it < 2048) { transpose_item_f8(INP(I_SH_WU) + (size_t)lt * D * SHD, SHD, (unsigned char*)WGU, D, NE * 256 + 1, 2, 0, WGU_SCALE, scr, it, F.lane); return; }
    it -= 2048;
    if (it < 16384) { const int e = it >> 8, li = it & 255; transpose_item_f8(INP(I_MOE_WD) + ((size_t)lt * NE + e) * ED * D, D, (unsigned char*)WD, DN_K, 0, 1, e * ED, WD_SCALE, scr, li, F.lane); return; }
    it -= 16384;
    transpose_item_f8(INP(I_SH_WD) + (size_t)lt * SHD * D, D, (unsigned char*)WD, DN_K, 0, 1, NE * ED, WD_SCALE, scr, it, F.lane);
}
__device__ __forceinline__ void wq_pull(const Args& a, const Frame& F, int lt, int arr_word) {
    const int Z = opaque_zero();
    unsigned* ctl = (unsigned*)WSB(WS_CTL);
    volatile LAS unsigned* MISC = (volatile LAS unsigned*)(F.lds + MISC_OFF);
    LAS float* scr = (LAS float*)(F.lds + F.wave * 16384);
    const int nchunks = wq_nitems(lt) / WQ_CHUNK;
    __syncthreads();
    if (arr_word >= 0 && F.tid == 0) __hip_atomic_fetch_add(ctl + arr_word, 1u, __ATOMIC_RELAXED, __HIP_MEMORY_SCOPE_AGENT);
    for (;;) {
        if (F.tid == 0) {
            unsigned c = 0xffffffffu;
            const bool go = (arr_word < 0) || (__hip_atomic_load(ctl + arr_word, __ATOMIC_RELAXED, __HIP_MEMORY_SCOPE_AGENT) < (unsigned)F.G);
            if (go) c = __hip_atomic_fetch_add(ctl + CW_WQ + lt, 1u, __ATOMIC_RELAXED, __HIP_MEMORY_SCOPE_AGENT);
            MISC[16] = c;
        }
        __syncthreads();
        const unsigned c = MISC[16];
        __syncthreads();
        if (c >= (unsigned)nchunks) break;
#pragma unroll 1
        for (int q = 0; q < WQ_CHUNK / 8; ++q) wq_item(a, F, lt, (int)c * WQ_CHUNK + F.wave * (WQ_CHUNK / 8) + q, scr, Z);
    }
}

__device__ __forceinline__ void ph_norm(const Args& a, const Frame& F, int l, int which, int gw0, int ngw, bool zero_hall = false) {
    const int Z = opaque_zero();
    bf16_t* HA = (bf16_t*)WSB(WS_P); unsigned char* H8E = (unsigned char*)WSB(WS_H8E);
    const int M = which ? ((l >= 2) ? NLAT : T) : ((l == 3) ? NLAT : T);
    const float* lat_src = (l == 0 && which == 0) ? INP(I_X) : AOUT;
    const float* cx_src = (l == 0 && which == 0) ? INP(I_CTX) : (const float*)WSB(WS_CX);
    const float* g = (which ? INP(I_NORM_FFN) : INP(I_NORM_MIX)) + (size_t)l * D;
    bf16_t* H = (bf16_t*)WSB(WS_H);
    for (int row = gw0; row < M; row += ngw) {
        const float* src = row < NLAT ? lat_src + (size_t)row * D : cx_src + (size_t)(row - NLAT) * D;
        const int c = row < SEQ ? 0 : (row < NLAT ? 1 : 2);
        const float* sh = MODSP(a, l, c, which ? 3 : 0); const float* sc = MODSP(a, l, c, which ? 4 : 1);
        f32x4 v[16]; float ss = 0.f;
#pragma unroll
        for (int j = 0; j < 16; ++j) { v[j] = ((const f32x4*)src)[F.lane + 64 * j]; ss += (v[j].x * v[j].x + v[j].y * v[j].y) + (v[j].z * v[j].z + v[j].w * v[j].w); }
        ss = wave_sum(ss);
        const float rstd = 1.0f / sqrtf(ss * (1.0f / D) + EPS);
        u32x2* o = (u32x2*)(H + (size_t)row * D);
#pragma unroll
        for (int j = 0; j < 16; ++j) { const int idx = F.lane + 64 * j; const f32x4 gg = ((const f32x4*)g)[idx], s1 = ((const f32x4*)sc)[idx], s0 = ((const f32x4*)sh)[idx];
            const f32x4 y = (v[j] * rstd) * gg; const f32x4 hh = y * (1.f + s1) + s0;
            if (which || (l & 1)) { ((unsigned*)((unsigned char*)H + (size_t)row * D))[idx] = pk4f8(hh.x, hh.y, hh.z, hh.w); }
            else { ((unsigned*)(H8E + (size_t)row * D))[idx] = pk4f8(hh.x, hh.y, hh.z, hh.w);
                   u32x2 w; w.x = pk2(hh.x, hh.y); w.y = pk2(hh.z, hh.w); o[idx] = w; } }
        if (zero_hall) { u32x4* hr = (u32x4*)((unsigned char*)HA + (size_t)row * DN_K); const u32x4 z4 = (u32x4){0u, 0u, 0u, 0u};
#pragma unroll
            for (int q = 0; q < 8; ++q) hr[F.lane + 64 * q] = z4; }
    }
}

__device__ __forceinline__ void ph_e1(const Args& a, const Frame& F, int l, bool do_a = true) {
    const int Z = opaque_zero();
    const int j2 = l >> 1;
    bf16_t* P = (bf16_t*)WSB(WS_P);
    const float* qg = INP(I_QGAIN) + j2 * 128; const float* kg = INP(I_KGAIN) + j2 * 128;
    if (do_a) for (int row = F.gw; row < T; row += F.NGW) {
        u32x4* pr = (u32x4*)(P + (size_t)row * EVEN_IN);
#pragma unroll
        for (int j = 0; j < 8; ++j) {
            const int chunk = F.lane + 64 * j; const u32x4 raw = pr[chunk];
            float x[8] = { bflo(raw.x), bfhi(raw.x), bflo(raw.y), bfhi(raw.y), bflo(raw.z), bfhi(raw.z), bflo(raw.w), bfhi(raw.w) };
            float ss = 0.f;
#pragma unroll
            for (int i = 0; i < 8; ++i) ss += x[i] * x[i];
            ss += __shfl_xor(ss, 1); ss += __shfl_xor(ss, 2); ss += __shfl_xor(ss, 4); ss += __shfl_xor(ss, 8);
            const float rstd = 1.0f / sqrtf(ss * (1.0f / 128.f) + EPS);
            const float* gp = (j < 4 ? qg : kg) + (chunk & 15) * 8;
            u32x4 o; o.x = pk2(x[0] * rstd * gp[0], x[1] * rstd * gp[1]); o.y = pk2(x[2] * rstd * gp[2], x[3] * rstd * gp[3]);
            o.z = pk2(x[4] * rstd * gp[4], x[5] * rstd * gp[5]); o.w = pk2(x[6] * rstd * gp[6], x[7] * rstd * gp[7]);
            pr[chunk] = o;
        }
    }
    LAS float* Q = (LAS float*)F.lds;
    const float* cw = INP(I_HY_CW) + (size_t)j2 * 3 * 6144; const float* cb = INP(I_HY_CB) + (size_t)j2 * 6144;
    bf16_t* UT = (bf16_t*)WSB(WS_UT); float* Z2T = (float*)WSB(WS_Z2T); typedef float f32x2e __attribute__((ext_vector_type(2)));
    __syncthreads();
    for (int it = blockIdx.x; it < 2 * 128 * 24; it += F.G) {
        const int b = it / (128 * 24), rem = it % (128 * 24), t0 = (rem / 24) * 64, ch0 = (rem % 24) * 256;
        for (int idx = F.tid; idx < 66 * 32; idx += 512) { const int rr = idx >> 5, ck = idx & 31, t = t0 - 1 + rr; u32x4 raw = (u32x4){0u, 0u, 0u, 0u};
            if (t >= 0 && t < SEQ) raw = *(const u32x4*)(P + (size_t)(b * SEQ + t) * EVEN_IN + 6144 + ch0 + 8 * ck);
            LAS float* d = Q + (ck * 66 + rr) * 9; d[0] = bflo(raw.x); d[1] = bfhi(raw.x); d[2] = bflo(raw.y); d[3] = bfhi(raw.y); d[4] = bflo(raw.z); d[5] = bfhi(raw.z); d[6] = bflo(raw.w); d[7] = bfhi(raw.w); }
        __syncthreads();
        for (int idx = F.tid; idx < 256 * 32; idx += 512) { const int ch = idx >> 5, t = (idx & 31) * 2, chg = ch0 + ch; const float w0 = cw[chg], w1 = cw[6144 + chg], w2 = cw[2 * 6144 + chg], bb = cb[chg];
            const LAS float* q = Q + ((ch >> 3) * 66 + t) * 9 + (ch & 7); const float p0 = q[0], p1 = q[9], p2 = q[18], p3 = q[27];
            const float v0 = bb + p0 * w0 + p1 * w1 + p2 * w2, v1 = bb + p1 * w0 + p2 * w1 + p3 * w2;
            if (chg < 4096) *(unsigned*)(UT + ((size_t)b * 4096 + chg) * SEQ + t0 + t) = pk2(v0, v1);
            else { f32x2e o2; o2.x = v0; o2.y = v1; *(f32x2e*)(Z2T + ((size_t)b * 2048 + (chg - 4096)) * SEQ + t0 + t) = o2; } }
        __syncthreads();
    }
}

__device__ __forceinline__ void ph_hyf(const Args& a, const Frame& F, int l) {
    const int Z = opaque_zero();
    const int j2 = l >> 1;
    const float* w1 = INP(I_HY_W1) + (size_t)j2 * 33 * 64; const float* b1 = INP(I_HY_B1) + j2 * 64;
    const float* w2 = INP(I_HY_W2) + (size_t)j2 * 4096; const float* b2 = INP(I_HY_B2) + j2 * 64;
    const float* w3 = INP(I_HY_W3) + (size_t)j2 * 4096; const float* b3 = INP(I_HY_B3) + j2 * 64;
    const float* w4 = INP(I_HY_W4) + (size_t)j2 * 64 * 8192; const float* fq = INP(I_HY_FREQ) + j2 * 192;
    float* FILT = (float*)WSB(WS_FILT); float* FILTC = (float*)WSB(WS_FILTC);
    LAS float* feats = (LAS float*)F.lds; LAS float* ha = feats + 1056; LAS float* hb = ha + 2048; LAS float* hT = hb + 2048; LAS float* tn = hT + 2048;
    const float dstart = -15.350567286626969f, dstop = -3.0701134573253945f, dstep = (dstop - dstart) / 2047.f;
    __syncthreads();
    for (int it = blockIdx.x; it < 256 + 128; it += F.G) {
        const int L = it < 256 ? SEQ : LC, t0 = (it < 256 ? it : ((it - 256) >> 4)) * 32;
        const int i_lo = it < 256 ? 0 : ((it - 256) & 15), i_hi = it < 256 ? 16 : i_lo + 1;
        const float c2pi = (float)(6.283185307179586 / (double)L), invLm1 = 1.0f / (float)(L - 1);
        for (int idx = F.tid; idx < 1056; idx += 512) { const int p = idx / 33, f = idx % 33; const float pos = (float)(t0 + p); float val;
            if (f == 0) { val = pos * invLm1; tn[p] = val; }
            else { const int bi = (f - 1) & 15; const float band = 1e-4f + (float)bi * ((15.f - 1e-4f) / 15.f); const float ang = (c2pi * pos) * band; val = (f <= 16) ? cosf(ang) : -sinf(ang); }
            feats[idx] = val; }
        __syncthreads();
        const int p = F.tid >> 4, ug = F.tid & 15;
#pragma unroll 1
        for (int q = 0; q < 4; ++q) { const int u = ug * 4 + q; float s = b1[u];
#pragma unroll 3
            for (int f = 0; f < 33; ++f) s += feats[p * 33 + f] * w1[f * 64 + u];
            ha[p * 64 + u] = sinf(fq[u] * s); }
        __syncthreads();
#pragma unroll 1
        for (int q = 0; q < 4; ++q) { const int u = ug * 4 + q; float s = b2[u];
#pragma unroll 4
            for (int m = 0; m < 64; ++m) s += ha[p * 64 + m] * w2[m * 64 + u];
            hb[p * 64 + u] = sinf(fq[64 + u] * s); }
        __syncthreads();
#pragma unroll 1
        for (int q = 0; q < 4; ++q) { const int u = ug * 4 + q; float s = b3[u];
#pragma unroll 4
            for (int m = 0; m < 64; ++m) s += hb[p * 64 + m] * w3[m * 64 + u];
            hT[(u >> 2) * 128 + (p >> 4) * 64 + (u & 3) * 16 + (p & 15)] = sinf(fq[128 + u] * s); }
        __syncthreads();
        {   const int j = F.lane & 15, kq = F.lane >> 4; const int cb_lo = i_lo * 32, cb_hi = i_hi * 32;
            const float rstep = -invLm1;
            float bvn[16];
            { const float* wp = w4 + (size_t)kq * 8192 + (cb_lo + F.wave) * 16 + j;
#pragma unroll
              for (int sk = 0; sk < 16; ++sk) bvn[sk] = wp[(size_t)sk * 4 * 8192]; }
#pragma unroll 1
            for (int cb = cb_lo + F.wave; cb < cb_hi; cb += 8) {
                const int n = cb * 16 + j;
                float bv[16];
#pragma unroll
                for (int sk = 0; sk < 16; ++sk) bv[sk] = bvn[sk];
                if (cb + 8 < cb_hi) { const float* wp = w4 + (size_t)kq * 8192 + (cb + 8) * 16 + j;
#pragma unroll
                    for (int sk = 0; sk < 16; ++sk) bvn[sk] = wp[(size_t)sk * 4 * 8192]; }
                f32x4 acc0 = (f32x4){0.f, 0.f, 0.f, 0.f}, acc1 = (f32x4){0.f, 0.f, 0.f, 0.f};
#pragma unroll
                for (int sk = 0; sk < 16; ++sk) { const float a0 = hT[sk * 128 + F.lane], a1 = hT[sk * 128 + 64 + F.lane];
                    acc0 = __builtin_amdgcn_mfma_f32_16x16x4f32(a0, bv[sk], acc0, 0, 0, 0); acc1 = __builtin_amdgcn_mfma_f32_16x16x4f32(a1, bv[sk], acc1, 0, 0, 0); }
                const int dir = n >> 12, o = (n >> 11) & 1, c = n & 2047; const float delta = fabsf(dstart + (float)c * dstep);
                const float ratio = expf(rstep * delta), e0 = expf(-tn[4 * kq] * delta), e1 = expf(-tn[16 + 4 * kq] * delta);
                float* dst = (L == SEQ) ? FILT + (((size_t)(c * 2 + o) * 2 + dir) * SEQ + t0) : FILTC + (((size_t)(c * 2 + o) * 2 + dir) * LC + t0);
                f32x4 v0, v1; float d0 = e0, d1 = e1;
                v0.x = acc0.x * d0; v1.x = acc1.x * d1; d0 *= ratio; d1 *= ratio; v0.y = acc0.y * d0; v1.y = acc1.y * d1; d0 *= ratio; d1 *= ratio;
                v0.z = acc0.z * d0; v1.z = acc1.z * d1; d0 *= ratio; d1 *= ratio; v0.w = acc0.w * d0; v1.w = acc1.w * d1;
                *(f32x4*)(dst + 4 * kq) = v0; *(f32x4*)(dst + 16 + 4 * kq) = v1;
            }
        }
        __syncthreads();
    }
}

typedef short bf16x8v __attribute__((ext_vector_type(8)));
#define GAS __attribute__((address_space(1)))
typedef const GAS char* gcp_t;
__device__ __forceinline__ float xmax16_32(float v) {
    const unsigned u = __builtin_bit_cast(unsigned, v);
    const auto r = __builtin_amdgcn_permlane32_swap(u, u, false, false);
    unsigned a0 = r[0], a1 = r[1]; asm volatile("" : "+v"(a0), "+v"(a1));
    const float m = fmaxf(__builtin_bit_cast(float, a0), __builtin_bit_cast(float, a1));
    const unsigned um = __builtin_bit_cast(unsigned, m);
    const auto r2 = __builtin_amdgcn_permlane16_swap(um, um, false, false);
    unsigned b0 = r2[0], b1 = r2[1]; asm volatile("" : "+v"(b0), "+v"(b1));
    return fmaxf(__builtin_bit_cast(float, b0), __builtin_bit_cast(float, b1));
}
__device__ __forceinline__ void ph_attn(const Args& a, const Frame& F, int l) {
    const int Z = opaque_zero();
    const int j2 = l >> 1;
    const bf16_t* P = (const bf16_t*)WSB(WS_P); bf16_t* MIX = (bf16_t*)WSB(WS_MIX);
    const int wv = __builtin_amdgcn_readfirstlane(F.wave);
    LAS unsigned char* KT = F.lds;
    LAS unsigned char* VT = F.lds + 32768;
    LAS float* rp = (LAS float*)(F.lds + 65536);
    const unsigned vt_addr = (unsigned)(size_t)VT;
    const int j = F.lane & 15, kq = F.lane >> 4;
    const float qscale = 0.08838834764831845f * 1.4426950408889634f;
    const unsigned koff = (unsigned)((j * EVEN_IN + 8 * kq) * 2);
    unsigned foff[2];
#pragma unroll
    for (int u = 0; u < 2; ++u) foff[u] = (unsigned)((8 * wv + 4 * u + kq) * (EVEN_IN * 2) + ((j ^ ((kq << 2) | ((2 * wv + u) & 3))) * 16));
    const bool fast = (F.G & 15) == 0;
    const int nst = 128 + (l == 0 ? 4 : 0);
    unsigned gs = 0;
#pragma unroll 1
    for (int h = fast ? ((int)blockIdx.x & 15) : 0; h < 16; h += (fast ? 16 : 1)) {
        const float* rpb = INP(I_RPB) + ((size_t)j2 * 16 + h) * 465;
        __syncthreads();
        for (int idx = F.tid; idx < 465; idx += 512) rp[idx] = rpb[idx] * 1.4426950408889634f;
        __syncthreads();
        const int w0 = fast ? ((int)blockIdx.x >> 4) : (int)blockIdx.x, nw = fast ? (F.G >> 4) : F.G;
#pragma unroll 1
        for (int st = w0; st < nst; st += nw) {
            int b, nwin, c0 = 0, ws_ = 0, rs = 0, r = 0, rsA = 0; size_t qrow0;
            if (st < 128) { const int r0 = (st & 63) * 2; b = st >> 6; r = r0 + (wv >> 2); c0 = (wv & 3) * 16; ws_ = min(max(c0 - 8, 0), 32); rs = min(max(r - 4, 0), 120);
                rsA = min(max(r0 - 4, 0), 120); nwin = min(max(r0 - 3, 0), 120) + 8 - rsA; qrow0 = (size_t)b * SEQ + r * 64 + c0; }
            else { const int t2 = st - 128; b = t2 >> 1; qrow0 = (size_t)NLAT + b * LC + ((t2 & 1) * 8 + wv) * 16; nwin = 0; }
            const int nsteps = nwin + 4;
            bf16x8v qf[4];
            { unsigned long long qbi = (unsigned long long)(P + qrow0 * EVEN_IN + h * 128); asm volatile("" : "+s"(qbi)); const gcp_t qb = (gcp_t)qbi;
              unsigned _ko = koff; asm volatile("" : "+v"(_ko));
#pragma unroll
              for (int s = 0; s < 4; ++s) qf[s] = *(const GAS bf16x8v*)(qb + 64 * s + _ko); }
            u32x4 fr[4];
#define ATT_FETCH(s_) do { const int _s = (s_); const size_t _tok0 = (_s < nwin) ? ((size_t)b * SEQ + (rsA + _s) * 64) : ((size_t)NLAT + b * LC + (_s - nwin) * 64); \
            unsigned long long _kbi = (unsigned long long)(P + _tok0 * EVEN_IN + 2048 + h * 128); asm volatile("" : "+s"(_kbi)); const gcp_t _kb = (gcp_t)_kbi; \
            _Pragma("unroll") for (int u = 0; u < 2; ++u) { unsigned _fo = foff[u]; asm volatile("" : "+v"(_fo)); \
                fr[u] = *(const GAS u32x4*)(_kb + _fo); fr[2 + u] = *(const GAS u32x4*)(_kb + 4096 + _fo); } } while (0)
#define ATT_PUT(bf_) do { _Pragma("unroll") for (int u = 0; u < 2; ++u) { \
                *(LAS u32x4*)(KT + (bf_) * 16384 + (2 * wv + u) * 1024 + F.lane * 16) = fr[u]; *(LAS u32x4*)(VT + (bf_) * 16384 + (2 * wv + u) * 1024 + F.lane * 16) = fr[2 + u]; } } while (0)
            ATT_FETCH(0);
            const int cq = c0 + j, cs = min(max(cq - 8, 0), 48);
            int dcv[8]; float madd[8];
#pragma unroll
            for (int e = 0; e < 8; ++e) { const int kcol = ws_ + 8 * kq + e; dcv[e] = min(max(kcol - cq + 15, 0), 30); madd[e] = ((unsigned)(kcol - cs) < 16u) ? 0.f : -1e30f; asm volatile("" : "+v"(madd[e])); }
            unsigned KBw[2], KBc[2], VBw[2], VBc[2];
#pragma unroll
            for (int t = 0; t < 2; ++t) {
                { const unsigned row = (unsigned)(ws_ + 8 * (j >> 2) + (j & 3) + 4 * t), y = (row >> 2) & 3u; KBw[t] = 256u * row + 16u * ((unsigned)kq ^ y) + 64u * (unsigned)(j & 3); }
                { const unsigned row = (unsigned)(8 * (j >> 2) + (j & 3) + 4 * t), y = (row >> 2) & 3u; KBc[t] = 256u * row + 16u * ((unsigned)kq ^ y) + 64u * (unsigned)(j & 3); }
                const unsigned q = (unsigned)j >> 2, p = (unsigned)j & 3u, bq = p >> 1;
                { const unsigned row = (unsigned)(ws_ + 8 * kq + 4 * t) + q, X = (q << 2) | ((row >> 2) & 3u); VBw[t] = 256u * row + 16u * (bq ^ X) + 8u * (p & 1u); }
                { const unsigned row = (unsigned)(8 * kq + 4 * t) + q, X = (q << 2) | ((row >> 2) & 3u); VBc[t] = 256u * row + 16u * (bq ^ X) + 8u * (p & 1u); }
            }
            f32x4 o[8];
#pragma unroll
            for (int d = 0; d < 8; ++d) o[d] = (f32x4){0.f, 0.f, 0.f, 0.f};
            float mrun = -1e30f, lsum = 0.f;
#define ATT_GROUP(KB0_, KB1_, VB0_, VB1_, XO_, WIN, brow_) do { \
            bf16x8v kf[8]; \
            _Pragma("unroll") for (int s = 0; s < 4; ++s) { kf[s] = *(const LAS bf16x8v*)(KT + (((KB0_) ^ (64u * s)) + (XO_))); kf[4 + s] = *(const LAS bf16x8v*)(KT + (((KB1_) ^ (64u * s)) + (XO_))); } \
            float bias[8]; \
            if (WIN) { const LAS float* rrow = rp + (brow_) * 31; \
                _Pragma("unroll") for (int e = 0; e < 8; ++e) bias[e] = rrow[dcv[e]]; } \
            f32x4 s0 = (f32x4){0.f, 0.f, 0.f, 0.f}, s1 = (f32x4){0.f, 0.f, 0.f, 0.f}; \
            _Pragma("unroll") for (int s = 0; s < 4; ++s) { s0 = __builtin_amdgcn_mfma_f32_16x16x32_bf16(kf[s], qf[s], s0, 0, 0, 0); s1 = __builtin_amdgcn_mfma_f32_16x16x32_bf16(kf[4 + s], qf[s], s1, 0, 0, 0); } \
            if (WIN) asm volatile("" : "+v"(bias[0]), "+v"(bias[1]), "+v"(bias[2]), "+v"(bias[3]), "+v"(bias[4]), "+v"(bias[5]), "+v"(bias[6]), "+v"(bias[7]));     \
            else asm volatile("" : "+v"(s0), "+v"(s1)); \
            u32x2 tr[8][2]; unsigned rd[8][2]; \
            _Pragma("unroll") for (int d = 0; d < 8; ++d) { rd[d][0] = vt_addr + ((VB0_) ^ (32u * d)); rd[d][1] = vt_addr + ((VB1_) ^ (32u * d)); } \
            asm volatile("ds_read_b64_tr_b16 %0, %8 offset:%16\n\tds_read_b64_tr_b16 %1, %9 offset:%16\n\tds_read_b64_tr_b16 %2, %10 offset:%16\n\tds_read_b64_tr_b16 %3, %11 offset:%16\n\t" \
                         "ds_read_b64_tr_b16 %4, %12 offset:%16\n\tds_read_b64_tr_b16 %5, %13 offset:%16\n\tds_read_b64_tr_b16 %6, %14 offset:%16\n\tds_read_b64_tr_b16 %7, %15 offset:%16" \
                : "=&v"(tr[0][0]), "=&v"(tr[0][1]), "=&v"(tr[1][0]), "=&v"(tr[1][1]), "=&v"(tr[2][0]), "=&v"(tr[2][1]), "=&v"(tr[3][0]), "=&v"(tr[3][1]) \
                : "v"(rd[0][0]), "v"(rd[0][1]), "v"(rd[1][0]), "v"(rd[1][1]), "v"(rd[2][0]), "v"(rd[2][1]), "v"(rd[3][0]), "v"(rd[3][1]), "i"(XO_)); \
            asm volatile("ds_read_b64_tr_b16 %0, %8 offset:%16\n\tds_read_b64_tr_b16 %1, %9 offset:%16\n\tds_read_b64_tr_b16 %2, %10 offset:%16\n\tds_read_b64_tr_b16 %3, %11 offset:%16\n\t" \
                         "ds_read_b64_tr_b16 %4, %12 offset:%16\n\tds_read_b64_tr_b16 %5, %13 offset:%16\n\tds_read_b64_tr_b16 %6, %14 offset:%16\n\tds_read_b64_tr_b16 %7, %15 offset:%16" \
                : "=&v"(tr[4][0]), "=&v"(tr[4][1]), "=&v"(tr[5][0]), "=&v"(tr[5][1]), "=&v"(tr[6][0]), "=&v"(tr[6][1]), "=&v"(tr[7][0]), "=&v"(tr[7][1]) \
                : "v"(rd[4][0]), "v"(rd[4][1]), "v"(rd[5][0]), "v"(rd[5][1]), "v"(rd[6][0]), "v"(rd[6][1]), "v"(rd[7][0]), "v"(rd[7][1]), "i"(XO_)); \
            float sv[8]; \
            _Pragma("unroll") for (int e = 0; e < 8; ++e) sv[e] = WIN ? fmaf((e >> 2) ? s1[e & 3] : s0[e & 3], qscale, bias[e]) + madd[e] : ((e >> 2) ? s1[e & 3] : s0[e & 3]) * qscale; \
            float gmax = sv[0]; \
            _Pragma("unroll") for (int e = 1; e < 8; ++e) gmax = fmaxf(gmax, sv[e]); \
            gmax = xmax16_32(gmax); \
            const float mnew = fmaxf(mrun, gmax), alpha = __builtin_amdgcn_exp2f(mrun - mnew); \
            if (__builtin_amdgcn_ballot_w64(mnew > mrun) != 0ull) { _Pragma("unroll") for (int d = 0; d < 8; ++d) o[d] = o[d] * alpha; } \
            mrun = mnew; \
            float p[8], psum = 0.f; \
            _Pragma("unroll") for (int e = 0; e < 8; ++e) { p[e] = __builtin_amdgcn_exp2f(sv[e] - mnew); psum += p[e]; } \
            lsum = lsum * alpha + psum; \
            union { bf16x8v v; unsigned u[4]; } pf; \
            pf.u[0] = pk2(p[0], p[1]); pf.u[1] = pk2(p[2], p[3]); pf.u[2] = pk2(p[4], p[5]); pf.u[3] = pk2(p[6], p[7]); \
            asm volatile("s_waitcnt lgkmcnt(0)" : "+v"(tr[0][0]), "+v"(tr[0][1]), "+v"(tr[1][0]), "+v"(tr[1][1]), "+v"(tr[2][0]), "+v"(tr[2][1]), "+v"(tr[3][0]), "+v"(tr[3][1]), \
                                                  "+v"(tr[4][0]), "+v"(tr[4][1]), "+v"(tr[5][0]), "+v"(tr[5][1]), "+v"(tr[6][0]), "+v"(tr[6][1]), "+v"(tr[7][0]), "+v"(tr[7][1]) :: "memory"); \
            _Pragma("unroll") for (int d = 0; d < 8; ++d) { union { bf16x8v v; unsigned u[4]; } vf; vf.u[0] = tr[d][0].x; vf.u[1] = tr[d][0].y; vf.u[2] = tr[d][1].x; vf.u[3] = tr[d][1].y; \
                o[d] = __builtin_amdgcn_mfma_f32_16x16x32_bf16(vf.v, pf.v, o[d], 0, 0, 0); } } while (0)
#pragma unroll 1
            for (int step = 0; step < nsteps; ++step, ++gs) {
                ATT_PUT(gs & 1u);
                __syncthreads();
                if (step + 1 < nsteps) ATT_FETCH(step + 1);
                const unsigned bo = (gs & 1u) * 16384u;
                if (step < nwin) {
                    const int g = rsA + step - rs;
                    if ((unsigned)g < 8u) { const unsigned k0 = KBw[0] + bo, k1 = KBw[1] + bo, v0 = VBw[0] + bo, v1 = VBw[1] + bo; ATT_GROUP(k0, k1, v0, v1, 0, true, rs + g - r + 7); }
                } else {
                    const unsigned k0 = KBc[0] + bo, k1 = KBc[1] + bo, v0 = VBc[0] + bo, v1 = VBc[1] + bo;
                    ATT_GROUP(k0, k1, v0, v1, 0, false, 0);
                    ATT_GROUP(k0, k1, v0, v1, 8192, false, 0);
                }
            }
#undef ATT_FETCH
#undef ATT_PUT
#undef ATT_GROUP
            lsum += __shfl_xor(lsum, 16); lsum += __shfl_xor(lsum, 32);
            const float inv = 1.0f / lsum;
#pragma unroll
            for (int d = 0; d < 8; ++d) { u32x2 w; w.x = pk2(o[d].x * inv, o[d].y * inv); w.y = pk2(o[d].z * inv, o[d].w * inv);
                *(u32x2*)(MIX + (qrow0 + j) * D + h * 128 + 16 * d + 4 * kq) = w; }
        }
    }
    __syncthreads();
}

__device__ __forceinline__ float wave_sum_o(float v) {
    int ln = (int)__builtin_amdgcn_mbcnt_hi(~0u, __builtin_amdgcn_mbcnt_lo(~0u, 0u)); asm volatile("" : "+v"(ln));
#pragma unroll
    for (int o = 1; o < 64; o <<= 1) v += __builtin_bit_cast(float, __builtin_amdgcn_ds_bpermute((ln ^ o) << 2, __builtin_bit_cast(int, v)));
    return v;
}
__device__ __forceinline__ float block_sum(const Frame& F, float v, LAS float* red) {
    v = wave_sum_o(v);
    __syncthreads();
    if (F.lane == 0) red[F.wave] = v;
    __syncthreads();
    float s = 0.f;
#pragma unroll
    for (int w = 0; w < 8; ++w) s += red[w];
    return s;
}
typedef float f32x2 __attribute__((ext_vector_type(2)));
#define FP(idx) ((idx) + ((idx) >> 5))
__device__ constexpr int BR5[32] = {0,16,8,24,4,20,12,28,2,18,10,26,6,22,14,30,1,17,9,25,5,21,13,29,3,19,11,27,7,23,15,31};
__device__ constexpr int BR4[16] = {0,8,4,12,2,10,6,14,1,9,5,13,3,11,7,15};
#define brevn(s, bits) ((bits) == 5 ? BR5[(s)] : BR4[(s)])
__device__ __forceinline__ f32x2 cswap(f32x2 a) { f32x2 r; r.x = a.y; r.y = -a.x; return r; }
__device__ __forceinline__ f32x2 cmul(f32x2 a, f32x2 w) { f32x2 t; t.x = -a.y; t.y = a.x; return a * w.x + t * w.y; }
__device__ __forceinline__ f32x2 cmulc(f32x2 a, f32x2 w) { f32x2 t; t.x = a.y; t.y = -a.x; f32x2 r = a * w.x + t * w.y; r.y = -r.y; return r; }
template <int R> __device__ __forceinline__ void dif(f32x2 (&x)[R]) {
    constexpr float C32[16] = { 1.f, 0.98078528040323043f, 0.92387953251128674f, 0.83146961230254524f, 0.70710678118654752f, 0.55557023301960218f, 0.38268343236508978f, 0.19509032201612825f,
                                0.f, -0.19509032201612825f, -0.38268343236508978f, -0.55557023301960218f, -0.70710678118654752f, -0.83146961230254524f, -0.92387953251128674f, -0.98078528040323043f };
    constexpr float S32[16] = { 0.f, 0.19509032201612825f, 0.38268343236508978f, 0.55557023301960218f, 0.70710678118654752f, 0.83146961230254524f, 0.92387953251128674f, 0.98078528040323043f,
                                1.f, 0.98078528040323043f, 0.92387953251128674f, 0.83146961230254524f, 0.70710678118654752f, 0.55557023301960218f, 0.38268343236508978f, 0.19509032201612825f };
#pragma unroll
    for (int h = R / 2; h >= 1; h >>= 1) {
#pragma unroll
        for (int b = 0; b < R; b += 2 * h) {
#pragma unroll
            for (int k = 0; k < h; ++k) {
                const int i0 = b + k, i1 = b + k + h, ti = k * (16 / h);
                const f32x2 u = x[i0], v = x[i1];
                x[i0] = u + v;
                const f32x2 d = u - v;
                if (ti == 0) x[i1] = d;
                else if (ti == 8) x[i1] = cswap(d);
                else x[i1] = d * C32[ti] + cswap(d) * S32[ti];
            }
        }
    }
}
struct FftCtx { LAS f32x2* X; const LAS f32x2* TW; int tid; };
__device__ __forceinline__ void fft_fwd_A(const FftCtx& f, f32x2 (&x)[32]) {
    dif<32>(x);
    __builtin_amdgcn_sched_barrier(0);
    const int i = f.tid; const f32x2 w = f.TW[i]; f32x2 cw; cw.x = 1.f; cw.y = 0.f;
    __syncthreads();
    LAS f32x2* XA = f.X + (i + (i >> 5));
    XA[0] = x[0];
#pragma unroll
    for (int r = 1; r < 32; ++r) { __builtin_amdgcn_sched_barrier(0); cw = cmul(cw, w); XA[528 * r] = cmul(x[brevn(r, 5)], cw); }
    __syncthreads();
}
__device__ __forceinline__ void fft_fwd_BC(const FftCtx& f, f32x2 (&x)[32]) {
#pragma unroll 1
    for (int u = 0; u < 2; ++u) {
        const int q = f.tid + 512 * u, r = q >> 5, i2 = q & 31;
        f32x2 y[16]; LAS f32x2* XB = f.X + (528 * r + i2);
#pragma unroll
        for (int j2 = 0; j2 < 16; ++j2) y[j2] = XB[33 * j2];
        dif<16>(y);
        __builtin_amdgcn_sched_barrier(0);
        const f32x2 w = f.TW[32 * i2]; f32x2 cw; cw.x = 1.f; cw.y = 0.f;
        XB[0] = y[0];
#pragma unroll
        for (int r2 = 1; r2 < 16; ++r2) { __builtin_amdgcn_sched_barrier(0); cw = cmul(cw, w); XB[33 * r2] = cmul(y[brevn(r2, 4)], cw); }
    }
    __syncthreads();
    { const LAS f32x2* XC = f.X + 33 * f.tid;
#pragma unroll
      for (int m = 0; m < 32; ++m) x[m] = XC[m]; }
    dif<32>(x);
}
__device__ __forceinline__ void fft_inv(const FftCtx& f, f32x2 (&x)[32]) {
    {   f32x2 t[32];
#pragma unroll
        for (int k = 0; k < 32; ++k) { t[k] = x[brevn(k, 5)]; t[k].y = -t[k].y; }
        dif<32>(t);
        LAS f32x2* XC = f.X + 33 * f.tid;
#pragma unroll
        for (int s = 0; s < 32; ++s) { f32x2 v = t[s]; v.y = -v.y; XC[brevn(s, 5)] = v; }
    }
    __syncthreads();
#pragma unroll 1
    for (int u = 0; u < 2; ++u) {
        const int q = f.tid + 512 * u, r = q >> 5, i2 = q & 31;
        f32x2 y[16];
        const f32x2 w = f.TW[32 * i2]; f32x2 cw; cw.x = 1.f; cw.y = 0.f; LAS f32x2* XB = f.X + (528 * r + i2);
        { f32x2 v = XB[0]; v.y = -v.y; y[0] = v; }
#pragma unroll
        for (int r2 = 1; r2 < 16; ++r2) { __builtin_amdgcn_sched_barrier(0); cw = cmul(cw, w); f32x2 v = XB[33 * r2]; v.y = -v.y; y[r2] = cmul(v, cw); }
        dif<16>(y);
#pragma unroll
        for (int s = 0; s < 16; ++s) { f32x2 v = y[s]; v.y = -v.y; XB[33 * brevn(s, 4)] = v; }
    }
    __syncthreads();
    {   const int i = f.tid; const f32x2 w = f.TW[i]; f32x2 cw; cw.x = 1.f; cw.y = 0.f; const LAS f32x2* XA = f.X + (i + (i >> 5));
        { f32x2 v = XA[0]; v.y = -v.y; x[0] = v; }
#pragma unroll
        for (int r = 1; r < 32; ++r) { __builtin_amdgcn_sched_barrier(0); cw = cmul(cw, w); f32x2 v = XA[528 * r]; v.y = -v.y; x[r] = cmul(v, cw); }
        dif<32>(x);
#pragma unroll
        for (int s = 0; s < 32; ++s) x[s].y = -x[s].y;
    }
}
__device__ __forceinline__ void ph_hyc(const Args& a, const Frame& F, int l) {
    const int Z = opaque_zero();
    const int j2 = l >> 1;
    const float* FILT = (const float*)WSB(WS_FILT); const bf16_t* UT = (const bf16_t*)WSB(WS_UT); float* Z2T = (float*)WSB(WS_Z2T);
    const float* skip = INP(I_HY_SKIP) + (size_t)j2 * 2 * 2048;
    FftCtx f; f.X = (LAS f32x2*)F.lds; f.TW = (const LAS f32x2*)(F.lds + 135168); f.tid = F.tid;
    LAS float* red = (LAS float*)(F.lds + 135168 + 8192);
    { LAS f32x2* tw = (LAS f32x2*)(F.lds + 135168);
      for (int m = F.tid; m < 1024; m += 512) { float sn, cs; sincosf(-6.283185307179586f * (float)m * (1.0f / 16384.f), &sn, &cs); f32x2 v; v.x = cs; v.y = sn; tw[m] = v; } }
    __syncthreads();
    const unsigned tu = (unsigned)F.tid, trv = 511u - (unsigned)F.tid;
    for (int c = blockIdx.x; c < 2048; c += F.G) {
        f32x2 nd[16];
        { const float* z0p = Z2T + ((size_t)0 * 2048 + c) * SEQ; const float* z1p = Z2T + ((size_t)1 * 2048 + c) * SEQ;
#pragma unroll
          for (int j = 0; j < 16; ++j) { unsigned long long a0 = (unsigned long long)(z0p + 512 * j), a1 = (unsigned long long)(z1p + 512 * j); asm volatile("" : "+s"(a0), "+s"(a1)); nd[j].x = ((const GAS float*)a0)[tu]; nd[j].y = ((const GAS float*)a1)[tu]; } }
#pragma unroll 1
        for (int o = 0; o < 2; ++o) {
            const float* fwd = FILT + ((size_t)(c * 2 + o) * 2 + 0) * SEQ; const float* bwd = fwd + SEQ;
            f32x2 kx[32]; float ss = 0.f;
#pragma unroll
            for (int j = 0; j < 32; ++j) { float v;
                if (j < 16) v = (fwd + 512 * j)[tu]; else { v = (bwd + (SEQ - 512 * (j - 16) - 511))[trv]; if (j == 16 && F.tid == 0) v = 0.f; }
                kx[j].x = v; kx[j].y = 0.f; ss += v * v; }
            fft_fwd_A(f, kx); fft_fwd_BC(f, kx);
            const float tot = block_sum(F, ss, red);
            const float sc = (1.0f / sqrtf(tot + EPS)) * (1.0f / 16384.f);
            const float skn = skip[o * 2048 + c] * (1.0f / 16384.f);
#pragma unroll
            for (int s = 0; s < 32; ++s) { kx[s] = kx[s] * sc; kx[s].x += skn; }
            f32x2 dx[32];
#pragma unroll
            for (int j = 0; j < 32; ++j) { if (j < 16) dx[j] = nd[j]; else { dx[j].x = 0.f; dx[j].y = 0.f; } }
            fft_fwd_A(f, dx); fft_fwd_BC(f, dx);
#pragma unroll
            for (int s = 0; s < 32; ++s) dx[s] = cmul(dx[s], kx[s]);
            const bf16_t* g0p = UT + ((size_t)0 * 4096 + o * 2048 + c) * SEQ; const bf16_t* g1p = UT + ((size_t)1 * 4096 + o * 2048 + c) * SEQ;
            unsigned short gt0[16], gt1[16];
#pragma unroll
            for (int j = 0; j < 16; ++j) { unsigned long long a0 = (unsigned long long)(g0p + 512 * j), a1 = (unsigned long long)(g1p + 512 * j); asm volatile("" : "+s"(a0), "+s"(a1));
                gt0[j] = ((const GAS bf16_t*)a0)[tu]; gt1[j] = ((const GAS bf16_t*)a1)[tu]; }
            fft_inv(f, dx);
            float* o0p = Z2T + ((size_t)0 * 2048 + c) * SEQ; float* o1p = Z2T + ((size_t)1 * 2048 + c) * SEQ;
#pragma unroll
            for (int j = 0; j < 16; ++j) { const int s = brevn(j, 5);
                nd[j].x = bf2f(gt0[j]) * dx[s].x; nd[j].y = bf2f(gt1[j]) * dx[s].y; }
            if (o == 1) {
#pragma unroll
                for (int j = 0; j < 16; ++j) { unsigned long long b0 = (unsigned long long)(o0p + 512 * j), b1 = (unsigned long long)(o1p + 512 * j); asm volatile("" : "+s"(b0), "+s"(b1));
                    ((GAS float*)b0)[tu] = nd[j].x; ((GAS float*)b1)[tu] = nd[j].y; }
            }
        }
    }
}

__device__ __forceinline__ void ph_hyx(const Args& a, const Frame& F, int l) {
    const int Z = opaque_zero();
    const int j2 = l >> 1;
    const bf16_t* P = (const bf16_t*)WSB(WS_P); bf16_t* MIX = (bf16_t*)WSB(WS_MIX); const float* FILTC = (const float*)WSB(WS_FILTC);
    const float* cw = INP(I_HY_CW) + (size_t)j2 * 3 * 6144; const float* cb = INP(I_HY_CB) + (size_t)j2 * 6144; const float* skip = INP(I_HY_SKIP) + (size_t)j2 * 2 * 2048;
    LAS float* us = (LAS float*)F.lds;
    LAS float* Hh = us + 3 * 2 * 256 * 8;
    LAS float* red = Hh + 2 * 8 * 512;
    const int b = F.tid >> 8, t = F.tid & 255;
    for (int cg = blockIdx.x; cg < 256; cg += F.G) {
        const int c0 = cg * 8;
        __syncthreads();
#pragma unroll 1
        for (int part = 0; part < 3; ++part) { const int ch0 = part * 2048 + c0; float v[8];
#pragma unroll
            for (int k = 0; k < 8; ++k) v[k] = cb[ch0 + k];
#pragma unroll
            for (int i = 0; i < 3; ++i) { const int tt = t + i - 1; if (tt >= 0 && tt < LC) { const u32x4 raw = *(const u32x4*)(P + (size_t)(NLAT + b * LC + tt) * EVEN_IN + 6144 + ch0); const float* w = cw + i * 6144 + ch0;
                v[0] += bflo(raw.x) * w[0]; v[1] += bfhi(raw.x) * w[1]; v[2] += bflo(raw.y) * w[2]; v[3] += bfhi(raw.y) * w[3]; v[4] += bflo(raw.z) * w[4]; v[5] += bfhi(raw.z) * w[5]; v[6] += bflo(raw.w) * w[6]; v[7] += bfhi(raw.w) * w[7]; } }
            LAS f32x4* d = (LAS f32x4*)(us + ((part * 2 + b) * 256 + t) * 8); d[0] = (f32x4){v[0], v[1], v[2], v[3]}; d[1] = (f32x4){v[4], v[5], v[6], v[7]}; }
#pragma unroll 1
        for (int m = 0; m < 8; ++m) { const int idx = F.tid + 512 * m, ok = idx >> 8, d = idx & 255, o = ok >> 3, k = ok & 7;
            const float* fwd = FILTC + ((size_t)((c0 + k) * 2 + o) * 2 + 0) * LC; const float f = fwd[d]; float ss = f * f; Hh[ok * 512 + 256 + d] = f;
            if (d >= 1) { const float g = fwd[LC + d]; Hh[ok * 512 + 256 - d] = g; ss += g * g; } else Hh[ok * 512] = 0.f;
            ss = wave_sum_o(ss); if (F.lane == 0) red[ok * 4 + (F.wave & 3)] = ss; }
        __syncthreads();
#pragma unroll 1
        for (int o = 0; o < 2; ++o) {
            float acc[8];
#pragma unroll
            for (int k = 0; k < 8; ++k) acc[k] = 0.f;
            const LAS float* zb = us + (2 * 2 + b) * 256 * 8; const LAS float* hb = Hh + (o * 8) * 512 + 256 + t;
            for (int sidx = 0; sidx < LC; ++sidx) { const f32x4 z0 = *(const LAS f32x4*)(zb + sidx * 8), z1 = *(const LAS f32x4*)(zb + sidx * 8 + 4);
                acc[0] += hb[0 * 512 - sidx] * z0.x; acc[1] += hb[1 * 512 - sidx] * z0.y; acc[2] += hb[2 * 512 - sidx] * z0.z; acc[3] += hb[3 * 512 - sidx] * z0.w;
                acc[4] += hb[4 * 512 - sidx] * z1.x; acc[5] += hb[5 * 512 - sidx] * z1.y; acc[6] += hb[6 * 512 - sidx] * z1.z; acc[7] += hb[7 * 512 - sidx] * z1.w; }
            float zn[8];
#pragma unroll
            for (int k = 0; k < 8; ++k) { const int ok = o * 8 + k; const float fscale = 1.0f / sqrtf(red[ok * 4] + red[ok * 4 + 1] + red[ok * 4 + 2] + red[ok * 4 + 3] + EPS);
                const float y = acc[k] * fscale + zb[t * 8 + k] * skip[o * 2048 + c0 + k]; zn[k] = us[((o * 2 + b) * 256 + t) * 8 + k] * y; }
            __syncthreads();
            if (o == 0) { LAS f32x4* d = (LAS f32x4*)(us + ((2 * 2 + b) * 256 + t) * 8); d[0] = (f32x4){zn[0], zn[1], zn[2], zn[3]}; d[1] = (f32x4){zn[4], zn[5], zn[6], zn[7]}; __syncthreads(); }
            else { u32x4 w; w.x = pk2(zn[0], zn[1]); w.y = pk2(zn[2], zn[3]); w.z = pk2(zn[4], zn[5]); w.w = pk2(zn[6], zn[7]); *(u32x4*)(MIX + (size_t)(NLAT + b * LC + t) * D + 2048 + c0) = w; }
        }
    }
}
__device__ __forceinline__ void ph_hyt(const Args& a, const Frame& F) {
    const int Z = opaque_zero();
    const float* Z2T = (const float*)WSB(WS_Z2T); bf16_t* MIX = (bf16_t*)WSB(WS_MIX);
    LAS float* tile = (LAS float*)F.lds;
    for (int it = blockIdx.x; it < 2 * 128 * 32; it += F.G) {
        const int b = it >> 12, t0 = ((it >> 5) & 127) * 64, c0 = (it & 31) * 64;
        for (int idx = F.tid; idx < 4096; idx += 512) { const int cc = idx >> 6, tt = idx & 63; tile[cc * 65 + tt] = Z2T[((size_t)b * 2048 + c0 + cc) * SEQ + t0 + tt]; }
        __syncthreads();
        { const int tt = F.tid >> 3, ck = F.tid & 7; const LAS float* sp = tile + (8 * ck) * 65 + tt;
          u32x4 o; o.x = pk2(sp[0], sp[65]); o.y = pk2(sp[2 * 65], sp[3 * 65]); o.z = pk2(sp[4 * 65], sp[5 * 65]); o.w = pk2(sp[6 * 65], sp[7 * 65]);
          *(u32x4*)(MIX + (size_t)(b * SEQ + t0 + tt) * D + 2048 + c0 + 8 * ck) = o; }
        __syncthreads();
    }
}

__device__ __forceinline__ void ph_r1(const Args& a, const Frame& F, int l) {
    const int Z = opaque_zero();
    const int M = (l == 3) ? NLAT : T; const bf16_t* ZB = (const bf16_t*)WSB(WS_P); float* RS = (float*)WSB(WS_RSTDV);
    for (int row = F.gw; row < M; row += F.NGW) {
        const u32x4* vr = (const u32x4*)(ZB + (size_t)row * ODD_IN + 4096); float ss = 0.f;
#pragma unroll
        for (int j = 0; j < 8; ++j) { const u32x4 r = vr[F.lane + 64 * j];
            ss += bflo(r.x) * bflo(r.x) + bfhi(r.x) * bfhi(r.x) + bflo(r.y) * bflo(r.y) + bfhi(r.y) * bfhi(r.y) + bflo(r.z) * bflo(r.z) + bfhi(r.z) * bfhi(r.z) + bflo(r.w) * bflo(r.w) + bfhi(r.w) * bfhi(r.w); }
        ss = wave_sum(ss);
        if (F.lane == 0) RS[row] = 1.0f / sqrtf(ss * (1.0f / 4096.f) + EPS);
    }
}
__device__ __forceinline__ void ph_sg(const Args& a, const Frame& F, int l) {
    const int Z = opaque_zero();
    const int j2 = l >> 1, M = (l == 3) ? NLAT : T;
    const bf16_t* ZB = (const bf16_t*)WSB(WS_P); bf16_t* MIX = (bf16_t*)WSB(WS_MIX); const float* RS = (const float*)WSB(WS_RSTDV);
    const float* vgain = INP(I_GM_VGAIN) + (size_t)j2 * 4096; const float* ws = INP(I_GM_WS) + (size_t)j2 * 32 * 128 * 128; const float* bs = INP(I_GM_BS) + (size_t)j2 * 32 * 128;
    LAS unsigned char* VT = F.lds;
    const int nunits = (M / 128) * 32;
    const int jl = F.lane & 15, kq = F.lane >> 4;
    for (int un = blockIdx.x; un < nunits; un += F.G) {
        const int chunk = un >> 5, g = un & 31;
        __syncthreads();
#pragma unroll
        for (int it = 0; it < 4; ++it) { const int idx = F.tid + 512 * it, q = idx >> 4, c8 = (idx & 15) * 8; const int row = chunk * 128 + q;
            const u32x4 raw = *(const u32x4*)(ZB + (size_t)row * ODD_IN + 4096 + g * 128 + c8); const float rs = RS[row]; const float* gp = vgain + g * 128 + c8;
            const float v[8] = { bflo(raw.x), bfhi(raw.x), bflo(raw.y), bfhi(raw.y), bflo(raw.z), bfhi(raw.z), bflo(raw.w), bfhi(raw.w) };
#pragma unroll
            for (int i = 0; i < 8; ++i) *(LAS unsigned short*)(VT + (c8 + i) * 272 + q * 2) = (unsigned short)f2bf(v[i] * rs * gp[i]); }
        union { bf16x8v v; unsigned u[4]; } wf[4];
        { const float* wp = ws + (size_t)g * 16384 + (size_t)(16 * F.wave + jl) * 128 + 8 * kq;
#pragma unroll
          for (int s4 = 0; s4 < 4; ++s4) { const f32x4 w0 = *(const f32x4*)(wp + 32 * s4), w1 = *(const f32x4*)(wp + 32 * s4 + 4);
              wf[s4].u[0] = pk2(w0.x, w0.y); wf[s4].u[1] = pk2(w0.z, w0.w); wf[s4].u[2] = pk2(w1.x, w1.y); wf[s4].u[3] = pk2(w1.z, w1.w); } }
        __syncthreads();
        const int p = 16 * F.wave + jl, row = chunk * 128 + p; const float bsp = bs[g * 128 + p];
#pragma unroll
        for (int cb = 0; cb < 8; ++cb) {
            f32x4 acc = (f32x4){0.f, 0.f, 0.f, 0.f};
#pragma unroll
            for (int s4 = 0; s4 < 4; ++s4) { const bf16x8v af = *(const LAS bf16x8v*)(VT + (16 * cb + jl) * 272 + (32 * s4 + 8 * kq) * 2);
                acc = __builtin_amdgcn_mfma_f32_16x16x32_bf16(af, wf[s4].v, acc, 0, 0, 0); }
            const int c0 = g * 128 + 16 * cb + 4 * kq;
            const u32x2 ur = *(const u32x2*)(ZB + (size_t)row * ODD_IN + c0);
            *(unsigned*)((unsigned char*)MIX + (size_t)row * D + c0) = pk4f8(bflo(ur.x) * (acc.x + bsp), bfhi(ur.x) * (acc.y + bsp), bflo(ur.y) * (acc.z + bsp), bfhi(ur.y) * (acc.w + bsp));
        }
    }
}

__device__ __forceinline__ void ph_router(const Args& a, const Frame& F, int l) {
    const int Z = opaque_zero();
    const int M = (l >= 2) ? NLAT : T, ntask = M / 16;
    const bf16_t* WRH = (const bf16_t*)WSB(WS_WR); const bf16_t* WRL = WRH + (size_t)4 * 3 * NE * D; const float* RB = (const float*)WSB(WS_RB); float* GATES = (float*)WSB(WS_GATES);
    const float* CX = (const float*)WSB(WS_CX); const float* rbias = INP(I_MOE_BIAS) + l * NE;
    LAS float* S = (LAS float*)(F.lds + F.wave * 8192);
    unsigned* ECNT = (unsigned*)WSB(WS_CTL) + CW_ECNT; int* ELIST = (int*)WSB(WS_ELIST);
    for (int task = F.wave * F.G + (int)blockIdx.x; task < ntask; task += 4 * F.G) {
        const int t0 = task * 16, c = t0 < SEQ ? 0 : (t0 < NLAT ? 1 : 2), j = F.lane & 15, kq = F.lane >> 4, row = t0 + j;
        const float* xr = (row < NLAT ? AOUT + (size_t)row * D : CX + (size_t)(row - NLAT) * D) + 8 * kq;
        const bf16_t* wh = WRH + (size_t)(l * 3 + c) * NE * D + F.lane * 8; const bf16_t* wl = WRL + (size_t)(l * 3 + c) * NE * D + F.lane * 8;
        f32x4 acc[4]; float ss = 0.f;
#pragma unroll
        for (int blk = 0; blk < 4; ++blk) acc[blk] = (f32x4){0.f, 0.f, 0.f, 0.f};
#pragma unroll 2
        for (int k0 = 0; k0 < D; k0 += 32) {
            const f32x4 x0 = *(const f32x4*)(xr + k0), x1 = *(const f32x4*)(xr + k0 + 4);
            ss += (x0.x * x0.x + x0.y * x0.y) + (x0.z * x0.z + x0.w * x0.w) + (x1.x * x1.x + x1.y * x1.y) + (x1.z * x1.z + x1.w * x1.w);
            const float xs[8] = { x0.x, x0.y, x0.z, x0.w, x1.x, x1.y, x1.z, x1.w };
            union { bf16x8v v; unsigned u[4]; } xh, xl;
#pragma unroll
            for (int q = 0; q < 4; ++q) { const unsigned b0 = __builtin_bit_cast(unsigned, xs[2 * q]), b1 = __builtin_bit_cast(unsigned, xs[2 * q + 1]);
                xh.u[q] = (b0 >> 16) | (b1 & 0xffff0000u);
                xl.u[q] = pk2(xs[2 * q] - __builtin_bit_cast(float, b0 & 0xffff0000u), xs[2 * q + 1] - __builtin_bit_cast(float, b1 & 0xffff0000u)); }
#pragma unroll
            for (int blk = 0; blk < 4; ++blk) { const bf16x8v ah = *(const bf16x8v*)(wh + (size_t)k0 * 64 + blk * 512), al = *(const bf16x8v*)(wl + (size_t)k0 * 64 + blk * 512);
                acc[blk] = __builtin_amdgcn_mfma_f32_16x16x32_bf16(ah, xh.v, acc[blk], 0, 0, 0);
                acc[blk] = __builtin_amdgcn_mfma_f32_16x16x32_bf16(al, xh.v, acc[blk], 0, 0, 0);
                acc[blk] = __builtin_amdgcn_mfma_f32_16x16x32_bf16(ah, xl.v, acc[blk], 0, 0, 0); }
        }
        ss += __shfl_xor(ss, 16); ss += __shfl_xor(ss, 32);
        const float rstd = 1.0f / sqrtf(ss * (1.0f / D) + EPS);
        LDS_WAIT();
#pragma unroll
        for (int blk = 0; blk < 4; ++blk)
#pragma unroll
            for (int r = 0; r < 4; ++r) { const int e = 16 * blk + 4 * kq + r; const float logit = acc[blk][r] * rstd + RB[(l * 3 + c) * NE + e]; S[j * 65 + e] = 1.0f / (1.0f + expf(-logit)); }
        LDS_WAIT();
        unsigned mlo, mhi; float ssum = 0.f;
        { float sc[16], sb[16];
#pragma unroll
          for (int i = 0; i < 16; ++i) { sc[i] = S[j * 65 + 16 * kq + i]; sb[i] = sc[i] + rbias[16 * kq + i]; }
          unsigned taken = 0u;
#pragma unroll 1
          for (int it = 0; it < 8; ++it) { float best = -1e30f, braw = 0.f; int bi = 0;
#pragma unroll
              for (int i = 0; i < 16; ++i) { const bool ok = !((taken >> i) & 1u) && sb[i] > best; best = ok ? sb[i] : best; bi = ok ? i : bi; braw = ok ? sc[i] : braw; }
              int gi = 16 * kq + bi;
#pragma unroll
              for (int off = 16; off <= 32; off <<= 1) { const float ob = __shfl_xor(best, off), orw = __shfl_xor(braw, off); const int oi = __shfl_xor(gi, off);
                  const bool take = (ob > best) || (ob == best && oi < gi); best = take ? ob : best; gi = take ? oi : gi; braw = take ? orw : braw; }
              if ((gi >> 4) == kq) taken |= 1u << (gi & 15);
              ssum += braw; }
          const unsigned t0m = __shfl(taken, j), t1m = __shfl(taken, j + 16), t2m = __shfl(taken, j + 32), t3m = __shfl(taken, j + 48);
          mlo = t0m | (t1m << 16); mhi = t2m | (t3m << 16); }
        unsigned selbits = 0u;
        for (int tok = 0; tok < 16; ++tok) { const unsigned lo = __shfl(mlo, tok), hi = __shfl(mhi, tok); const float sm = __shfl(ssum, tok);
            const bool sel = F.lane < 32 ? ((lo >> F.lane) & 1u) : ((hi >> (F.lane - 32)) & 1u);
            if (sel) selbits |= 1u << tok;
            GATES[(size_t)(t0 + tok) * NE + F.lane] = sel ? S[tok * 65 + F.lane] / sm * 2.5f : 0.f; }
        const int ne = __popc(selbits);
        if (ne) { int pos = (int)__hip_atomic_fetch_add(ECNT + l * NE + F.lane, (unsigned)ne, __ATOMIC_RELAXED, __HIP_MEMORY_SCOPE_AGENT);
            for (int tok = 0; tok < 16; ++tok) if ((selbits >> tok) & 1u) { ELIST[(size_t)F.lane * T + pos] = t0 + tok; ++pos; } }
    }
}

__device__ __forceinline__ void ph_cxfix(const Args& a, const Frame& F, const float* cx_src_in, int l, int gate_idx, int nsplit) {
    const int Z = opaque_zero();
    const float* cx_src = cx_src_in + Z; float* CX = (float*)WSB(WS_CX); const float* part = (const float*)WSB(WS_PART); const float* gv = MODSP(a, l, 2, gate_idx);
    for (int i = blockIdx.x * 512 + F.tid; i < NCTX * (D / 4); i += F.G * 512) {
        f32x4 s = ((const f32x4*)part)[i];
#pragma unroll
        for (int k = 1; k < 8; ++k) if (k < nsplit) s += ((const f32x4*)(part + (size_t)k * NCTX * D))[i];
        ((f32x4*)CX)[i] = ((const f32x4*)cx_src)[i] + ((const f32x4*)gv)[i & (D / 4 - 1)] * s;
    }
}
template <int l> __device__ __forceinline__ void layer_body(const Args& a, const Frame& F, const XcdBarrier& bar, const int lo, const int hi) {
#define IN(k) (lo <= (k) && (k) < hi)
#if (PROBE_DUP & 256)
#define SEAM(k) do { if (IN(k) && IN((k) + 1)) { xcd_barrier(bar); xcd_barrier(bar); } } while (0)
#else
#define SEAM(k) do { if (IN(k) && IN((k) + 1)) xcd_barrier(bar); } while (0)
#endif
        const int base = 3 + 9 * l; const bool even = (l & 1) == 0; const int M = (l == 3) ? NLAT : T; const int M2 = (l >= 2) ? NLAT : T;
        if (IN(base + 0)) { if (l >= 1 && l <= 2) { ph_cxfix(a, F, (const float*)(a.ws + WS_CX), l - 1, 5, 6); xcd_barrier(bar); }
            wq_pull(a, F, l, -1); ph_norm(a, F, l, 0, F.gw, F.NGW); }
        SEAM(base + 0);
        if (IN(base + 1)) {
            const int Z = opaque_zero(); bf16_t* H = (bf16_t*)WSB(WS_H); bf16_t* WIN = WSETP(WS_WIN, l); bf16_t* P = (bf16_t*)WSB(WS_P);
            if (even) { pg8::RowIdent RM;
                { pg8::Gemm g{(bf16_t*)WSB(WS_H8E), WIN, M, 6144, D / 2}; pg8::StaticOrderX S; S.init(M, 6144, D / 2, F.G, (int)blockIdx.x);
                  pg8::EpiBf16X<0> E{P, EVEN_IN, nullptr, 1.f / WGU_SCALE};
                  pg8::gemm_phase_x<pg8::EpiBf16X<0>, pg8::StaticOrderX, pg8::RowIdent, true>(F.lds, g, S, E, RM); }
                __syncthreads();
                { pg8::Gemm g{H, WIN + (size_t)6144 * D, M, 6144, D}; pg8::StaticOrderX S; S.init(M, 6144, D, F.G, F.G - 1 - (int)blockIdx.x);
                  pg8::EpiBf16X<0> E{P + 6144, EVEN_IN, nullptr, 1.f};
                  pg8::gemm_phase_x<pg8::EpiBf16X<0>, pg8::StaticOrderX, pg8::RowIdent, false>(F.lds, g, S, E, RM); } }
            else { pg8::Gemm g{H, WIN, M, ODD_IN, D / 2}; pg8::StaticOrderX S; S.init(M, ODD_IN, D / 2, F.G, (int)blockIdx.x); pg8::RowIdent RM;
                pg8::EpiBf16X<1> E{P, ODD_IN, INP(I_ODD_BIN) + (size_t)(l >> 1) * ODD_IN, 1.f / WGU_SCALE};
                pg8::gemm_phase_x<pg8::EpiBf16X<1>, pg8::StaticOrderX, pg8::RowIdent, true>(F.lds, g, S, E, RM); }
            if (l < 3) wq_pull(a, F, l + 1, CW_ARR + base + 1);
        }
        SEAM(base + 1);
        if (IN(base + 2)) { if (even) { ph_e1(a, F, l); ph_hyf(a, F, l); } else ph_r1(a, F, l);
#if (PROBE_DUP & 1024)
            __syncthreads(); if (even) { ph_hyf(a, F, l); }
#endif
#if (PROBE_DUP & 2)
            __syncthreads(); if (even) { ph_e1(a, F, l, false); ph_hyf(a, F, l); } else ph_r1(a, F, l);
#endif
        }
        SEAM(base + 2);
        if (IN(base + 3)) { if (even) { ph_attn(a, F, l); __syncthreads(); ph_hyc(a, F, l); __syncthreads(); if (l == 0) ph_hyx(a, F, l); } else ph_sg(a, F, l);
#if (PROBE_DUP & 4)
            __syncthreads(); if (even) { ph_attn(a, F, l); __syncthreads(); ph_hyc(a, F, l); __syncthreads(); ph_hyx(a, F, l); } else ph_sg(a, F, l);
#endif
#if (PROBE_DUP & 16)
            __syncthreads(); if (even) { ph_hyc(a, F, l); }
#endif
#if (PROBE_DUP & 32)
            __syncthreads(); if (even) { ph_attn(a, F, l); }
#endif
#if (PROBE_DUP & 64)
            __syncthreads(); if (!even) { ph_sg(a, F, l); }
#endif
        }
        SEAM(base + 3);
        if (IN(base + 4)) { if (even) ph_hyt(a, F);
#if (PROBE_DUP & 8)
            __syncthreads(); if (even) ph_hyt(a, F);
#endif
        }
        SEAM(base + 4);
        if (IN(base + 5)) {
            const int Z = opaque_zero(); bf16_t* MIX = (bf16_t*)WSB(WS_MIX); bf16_t* WOUT = WSETP(WS_WOUT, l); float* CX = (float*)WSB(WS_CX);
            pg8::RowIdent RM;
            if (even) { pg8::Gemm g{MIX, WOUT, M2, D, D}; pg8::SplitCtxOrder S; S.init(M2, D, D, F.G, (int)blockIdx.x, 8);
                pg8::EpiResidX E{l == 0 ? INP(I_X) : AOUT, AOUT, MODSP(a, l, 0, 2), (float*)WSB(WS_PART), 1.f};
                pg8::gemm_phase_x<pg8::EpiResidX, pg8::SplitCtxOrder, pg8::RowIdent>(F.lds, g, S, E, RM); }
            else { pg8::Gemm g{MIX, WOUT, M2, D, D / 2}; pg8::SplitCtxOrder S; S.init(M2, D, D / 2, F.G, (int)blockIdx.x, 8);
                pg8::EpiResidX E{AOUT, AOUT, MODSP(a, l, 0, 2), (float*)WSB(WS_PART), 1.f / WGU_SCALE};
                pg8::gemm_phase_x<pg8::EpiResidX, pg8::SplitCtxOrder, pg8::RowIdent, true>(F.lds, g, S, E, RM); }
            if (l < 3) wq_pull(a, F, l + 1, CW_ARR + base + 5);
        }
        SEAM(base + 5);
        if (IN(base + 6)) { if (M2 > NLAT) { ph_cxfix(a, F, l == 0 ? a.in[I_CTX] : (const float*)(a.ws + WS_CX), l, 2, 8); xcd_barrier(bar); }
            if (F.wave >= 4) ph_norm(a, F, l, 1, (int)blockIdx.x * 4 + F.wave - 4, F.G * 4, true); else ph_router(a, F, l);
#if (PROBE_DUP & 2048)
            __syncthreads(); if (F.wave >= 4) ph_norm(a, F, l, 1, (int)blockIdx.x * 4 + F.wave - 4, F.G * 4, true);
#endif
            }
        SEAM(base + 6);
        if (IN(base + 7)) {
            const int Z = opaque_zero(); bf16_t* H = (bf16_t*)WSB(WS_H); bf16_t* WGU = WSETP(WS_WGU, l); bf16_t* P = (bf16_t*)WSB(WS_P);
            LAS int* tab = (LAS int*)(F.lds + TAB_OFF); LAS int* cntl = tab + 640;
            const unsigned* ECNT = (const unsigned*)WSB(WS_CTL) + CW_ECNT + l * NE;
            if (F.tid < NE) cntl[F.tid] = (int)__hip_atomic_load(ECNT + F.tid, __ATOMIC_RELAXED, __HIP_MEMORY_SCOPE_AGENT);
            __syncthreads();
            if (F.tid == 0) { int n = 0; for (int e = 0; e < NE; ++e) { const int nt_ = (cntl[e] + 255) >> 8; for (int t = 0; t < nt_; ++t) tab[n++] = e | (t << 8); } cntl[NE] = n; }
            __syncthreads();
            pg8::Gemm g{H, WGU, M2, GU_N, D / 2};
            pg8::MoeOrder S{tab, cntl, cntl[NE], (M2 / 256) * 8, F.G, (int)blockIdx.x, D / 128};
            pg8::RowList RM{(const int*)WSB(WS_ELIST)};
            pg8::EpiSwigluX E{(unsigned char*)P, (const float*)WSB(WS_GATES), (const int*)WSB(WS_ELIST), 1.f / WGU_SCALE};
            pg8::gemm_phase_x<pg8::EpiSwigluX, pg8::MoeOrder, pg8::RowList, true>(F.lds, g, S, E, RM);
#if (PROBE_DUP & 512)
            __syncthreads(); pg8::gemm_phase_x<pg8::EpiSwigluX, pg8::MoeOrder, pg8::RowList, true>(F.lds, g, S, E, RM);
#endif
            if (l < 3) wq_pull(a, F, l + 1, CW_ARR + base + 7);
        }
        SEAM(base + 7);
        if (IN(base + 8)) {
            const int Z = opaque_zero(); bf16_t* P = (bf16_t*)WSB(WS_P); bf16_t* WD = WSETP(WS_WD, l); float* CX = (float*)WSB(WS_CX);
            pg8::Gemm g{P, WD, M2, D, DN_K / 2}; pg8::SplitCtxOrder S; S.init(M2, D, DN_K / 2, F.G, (int)blockIdx.x, 6);
            pg8::EpiResidX E{AOUT, AOUT, MODSP(a, l, 0, 5), (float*)WSB(WS_PART), 1.f / WD_SCALE}; pg8::RowIdent RM;
            pg8::gemm_phase_x<pg8::EpiResidX, pg8::SplitCtxOrder, pg8::RowIdent, true>(F.lds, g, S, E, RM);
            if (l < 3) wq_pull(a, F, l + 1, CW_ARR + base + 8);
        }
        if (l < 3) SEAM(base + 8);
#undef IN
#undef SEAM
}

__global__ void __launch_bounds__(512, 2) fwd_kernel(Args a) {
    extern __shared__ __attribute__((aligned(16))) unsigned char lds_raw[];
    Frame F; F.lds = (LAS unsigned char*)lds_raw; F.tid = threadIdx.x; F.lane = F.tid & 63; F.wave = __builtin_amdgcn_readfirstlane(F.tid >> 6);
    F.G = gridDim.x; F.gw = blockIdx.x * 8 + F.wave; F.NGW = F.G * 8;
    volatile LAS unsigned* MISC = (volatile LAS unsigned*)(F.lds + MISC_OFF);
    if (F.tid < 32) MISC[F.tid] = 0u;
    __syncthreads();
    const int lo = a.ph_lo, hi = a.ph_hi;
    unsigned* barw = (unsigned*)(a.ws) + CW_BAR;
    XcdBarrier bar; bar.bar = barw; bar.x = 0; bar.st = MISC + 8;
    if (hi - lo > 1) bar = xcd_barrier_post(barw, MISC + 8);
#define IN(k) (lo <= (k) && (k) < hi)
#if (PROBE_DUP & 256)
#define SEAM(k) do { if (IN(k) && IN((k) + 1)) { xcd_barrier(bar); xcd_barrier(bar); } } while (0)
#else
#define SEAM(k) do { if (IN(k) && IN((k) + 1)) xcd_barrier(bar); } while (0)
#endif

    if (IN(0)) ph_mods1(a, F);
    SEAM(0);
    if (IN(1)) ph_mods2(a, F);
    SEAM(1);
    if (IN(2)) ph_rprep(a, F);
    SEAM(2);
#if (PROBE_DUP & 4096)
    ph_mods1(a, F); xcd_barrier(bar); ph_mods2(a, F); xcd_barrier(bar); ph_rprep(a, F); xcd_barrier(bar);
#endif
    layer_body<0>(a, F, bar, lo, hi);
    layer_body<1>(a, F, bar, lo, hi);
    layer_body<2>(a, F, bar, lo, hi);
    layer_body<3>(a, F, bar, lo, hi);
#undef IN
#undef SEAM
}
constexpr int N_PHASES = 3 + 9 * 4;

extern "C" void kernel_launch(void* const* d_in, const int* in_sizes, int n_in, void* d_out, int out_size, void* d_ws, size_t ws_size, hipStream_t stream) {
    static int grid = 0;
    if (grid == 0) {
        if (n_in != 38 || out_size != NLAT * D || ws_size < WS_END2) { fprintf(stderr, "kernel_launch: unexpected sizes (n_in %d, out %d, ws %zu < %zu)\n", n_in, out_size, ws_size, (size_t)WS_END2); grid = -1; return; }
        int dev = 0, cus = 0, per_cu = 0;
        if (hipGetDevice(&dev) != hipSuccess || hipDeviceGetAttribute(&cus, hipDeviceAttributeMultiprocessorCount, dev) != hipSuccess) { grid = -1; return; }
        if (hipFuncSetAttribute((const void*)fwd_kernel, hipFuncAttributeMaxDynamicSharedMemorySize, LDS_BYTES) != hipSuccess) { fprintf(stderr, "kernel_launch: hipFuncSetAttribute failed\n"); grid = -1; return; }
        if (hipOccupancyMaxActiveBlocksPerMultiprocessor(&per_cu, (const void*)fwd_kernel, 512, LDS_BYTES) != hipSuccess || per_cu < 1) fprintf(stderr, "kernel_launch: occupancy query reports %d\n", per_cu);
        (void)hipGetLastError();
        grid = cus;
    }
    if (grid < 0) return;
    (void)hipMemsetAsync((char*)d_ws + WS_CTL, 0, CTL_ZERO_BYTES, stream);
    Args a{};
    for (int i = 0; i < 38; ++i) a.in[i] = (const float*)d_in[i];
    a.out = (float*)d_out; a.ws = (unsigned char*)d_ws;
#if MK_PER_PHASE
    for (int k = 0; k < N_PHASES; ++k) { a.ph_lo = k; a.ph_hi = k + 1; hipLaunchKernelGGL(fwd_kernel, dim3(grid), dim3(512), LDS_BYTES, stream, a); }
#else
    a.ph_lo = 0; a.ph_hi = N_PHASES;
    hipLaunchKernelGGL(fwd_kernel, dim3(grid), dim3(512), LDS_BYTES, stream, a);
#endif
}
```

```cpp
#include <hip/hip_runtime.h>
#include <cstdio>
#include <cstdint>

#ifndef MK_PER_PHASE
#define MK_PER_PHASE 0
#endif

#ifndef PROBE_DUP
#define PROBE_DUP 0
#endif

constexpr int D = 4096, SEQ = 8192, NLAT = 16384, LC = 256, NCTX = 512, T = NLAT + NCTX;
constexpr int EVEN_IN = 12288, ODD_IN = 8192, NE = 64, ED = 128, SHD = 1024, RANK = 256;
constexpr int GU_N = (NE * ED + SHD) * 2;
constexpr int DN_K = NE * ED + SHD;
constexpr float EPS = 1e-6f;

namespace pg8 {
#define PG8_LAS __attribute__((address_space(3)))
typedef unsigned short bf16_t;
typedef short bf16x8 __attribute__((ext_vector_type(8)));
typedef float f32x4 __attribute__((ext_vector_type(4)));
typedef unsigned u32x4 __attribute__((ext_vector_type(4)));
constexpr int BM = 256, BK = 64, HALF = 128, HTB = HALF * BK * 2  , STAGE_BYTES = 8 * HTB, NXCD = 8, WGM = 8;

__host__ __device__ __forceinline__ int lds_byte(int r, int c) { const int st = (r >> 4) * 2 + (c >> 5), rr = r & 15, cc = c & 31, ob = rr * 64 + cc * 2; return st * 1024 + (ob ^ (((ob >> 9) & 1) << 5)); }
__host__ __device__ __forceinline__ void stage_rc(int b, int& R, int& C) { const int st = b / 1024, sb = b % 1024, swz = sb ^ (((sb >> 9) & 1) << 5); R = (st >> 1) * 16 + swz / 64; C = (st & 1) * 32 + (swz % 64) / 2; }
__host__ __device__ __forceinline__ int perm32(int rho) { const int n = rho >> 4, i = rho & 15; return 8 * (i >> 2) + 4 * n + (i & 3); }

struct Unit { int pm, pn; };
struct Gemm { const bf16_t* A; const bf16_t* Bt; int M, N, K; };

struct StaticOrder {
    int nM, nN, nwg, G, c;
    __host__ __device__ void init(int M, int N, int G_, int c_) { nM = M / BM; nN = N / BM; nwg = nM * nN; G = G_; c = c_; }
    __host__ __device__ bool next(int i, Unit& u) const {
        const long L = (long)i * G + c; if (L >= nwg) return false;
        int wgid = (int)L; { const int q = nwg / NXCD, r = nwg % NXCD, xcd = wgid % NXCD, off = wgid / NXCD; wgid = (xcd < r ? xcd * (q + 1) : r * (q + 1) + (xcd - r) * q) + off; }
        const int nig = WGM * nN, gid = wgid / nig, fm = gid * WGM, gsz = (nM - fm) < WGM ? (nM - fm) : WGM;
        u.pm = fm + ((wgid % nig) % gsz); u.pn = (wgid % nig) / gsz; return true;
    }
    __device__ __forceinline__ void a_ready(const Unit&) const {}
    __device__ __forceinline__ void done(const Unit&) const {}
};

__device__ __forceinline__ unsigned cvt_pk_bf16(float lo, float hi) { unsigned r; asm volatile("v_cvt_pk_bf16_f32 %0, %1, %2" : "=v"(r) : "v"(lo), "v"(hi)); return r; }
typedef float f32x2 __attribute__((ext_vector_type(2)));
__device__ __forceinline__ f32x2 gelu_pk(f32x2 v) {
    const f32x2 av = __builtin_elementwise_abs(v), d = av * 0.2316418882f + 1.0f;
    f32x2 t; t.x = __builtin_amdgcn_rcpf(d.x); t.y = __builtin_amdgcn_rcpf(d.y);
    f32x2 q = t * 0.5307027145f + (-0.7265760135f); q = q * t + 0.7107068705f; q = q * t + (-0.142248368f); q = q * t + 0.127414796f; q = q * t;
    const f32x2 s = (v * v) * (-0.72134752044f);
    f32x2 e; e.x = __builtin_amdgcn_exp2f(s.x); e.y = __builtin_amdgcn_exp2f(s.y);
    const f32x2 m = v * (q * e), r = v - m;
    f32x2 o; o.x = v.x < 0.f ? m.x : r.x; o.y = v.y < 0.f ? m.y : r.y; return o;
}

template <int ACT  > struct EpiBf16 {
    static constexpr bool PERM = true, AFTER_DRAIN = false; static_assert(ACT == 0 || ACT == 1, "EpiBf16: ACT is 0 (none) or 1 (gelu_pk)");
    bf16_t* O; int ldc; const float* bias; int split_cols; size_t split_stride; float scale0;
    __device__ __forceinline__ void operator()(const f32x4 (&acc)[2][2][4][2], const Unit& u, int wr, int wc, int fr, int fq) const {
        const int row0 = u.pm * BM + wr * 64 + fr; int colt = u.pn * BM; bf16_t* base = O;
        float sc = 1.f; if (split_cols) { const int t = colt / split_cols; base += (size_t)t * split_stride; colt -= t * split_cols; if (t == 0) sc = scale0; }
        const int col0 = colt + wc * 32 + 8 * fq, bcol0 = u.pn * BM + wc * 32 + 8 * fq;
        f32x4 bv[2][2];
#pragma unroll
        for (int bj = 0; bj < 2; ++bj)
#pragma unroll
            for (int n = 0; n < 2; ++n) bv[bj][n] = bias ? *(const f32x4*)(bias + bcol0 + bj * HALF + 4 * n) : (f32x4){0.f, 0.f, 0.f, 0.f};
#pragma unroll
        for (int ai = 0; ai < 2; ++ai)
#pragma unroll
            for (int m = 0; m < 4; ++m) { bf16_t* rowp = base + (size_t)(row0 + ai * HALF + m * 16) * ldc + col0;
#pragma unroll
                for (int bj = 0; bj < 2; ++bj) { f32x4 v0 = acc[ai][bj][m][0] + bv[bj][0], v1 = acc[ai][bj][m][1] + bv[bj][1];
                    if (ACT == 1) { f32x2 a = gelu_pk((f32x2){v0[0], v0[1]}), b = gelu_pk((f32x2){v0[2], v0[3]}), c = gelu_pk((f32x2){v1[0], v1[1]}), d = gelu_pk((f32x2){v1[2], v1[3]});
                        v0 = (f32x4){a.x, a.y, b.x, b.y}; v1 = (f32x4){c.x, c.y, d.x, d.y}; }
                    v0 = v0 * sc; v1 = v1 * sc; u32x4 w; w.x = cvt_pk_bf16(v0[0], v0[1]); w.y = cvt_pk_bf16(v0[2], v0[3]); w.z = cvt_pk_bf16(v1[0], v1[1]); w.w = cvt_pk_bf16(v1[2], v1[3]);
                    *(u32x4*)(rowp + bj * HALF) = w; } }
    }
};

struct EpiResid {
    static constexpr bool PERM = false, AFTER_DRAIN = false;
    const float* lat_src; const float* cx_src; float* lat_dst; float* cx_dst; const float* gate;
    __device__ __forceinline__ void operator()(const f32x4 (&acc)[2][2][4][2], const Unit& u, int wr, int wc, int fr, int fq) const {
        const int rowt = u.pm * BM; int c, rbase; const float* src; float* dst;
        if (rowt < NLAT) { c = rowt < SEQ ? 0 : 1; src = lat_src; dst = lat_dst; rbase = 0; } else { c = 2; src = cx_src; dst = cx_dst; rbase = NLAT; }
        const float* gv = gate + (size_t)c * 6 * D;
        const int row0 = rowt - rbase + wr * 64 + fr, col0 = u.pn * BM + wc * 32 + 4 * fq;
        f32x4 g[2][2];
#pragma unroll
        for (int bj = 0; bj < 2; ++bj)
#pragma unroll
            for (int n = 0; n < 2; ++n) g[bj][n] = *(const f32x4*)(gv + col0 + bj * HALF + n * 16);
#pragma unroll
        for (int ai = 0; ai < 2; ++ai)
#pragma unroll
            for (int m = 0; m < 4; ++m) { const size_t off = (size_t)(row0 + ai * HALF + m * 16) * D + col0;
#pragma unroll
                for (int bj = 0; bj < 2; ++bj)
#pragma unroll
                    for (int n = 0; n < 2; ++n) { const f32x4 s = *(const f32x4*)(src + off + bj * HALF + n * 16); *(f32x4*)(dst + off + bj * HALF + n * 16) = s + g[bj][n] * acc[ai][bj][m][n]; } }
    }
};
struct EpiSwiglu {
    static constexpr bool PERM = true, AFTER_DRAIN = false;
    bf16_t* H; const float* gates;
    __device__ __forceinline__ void operator()(const f32x4 (&acc)[2][2][4][2], const Unit& u, int wr, int wc, int fr, int fq) const {
        const int row0 = u.pm * BM + wr * 64 + fr, hc0 = u.pn * 128 + wc * 16 + 4 * fq;
#pragma unroll
        for (int ai = 0; ai < 2; ++ai)
#pragma unroll
            for (int m = 0; m < 4; ++m) { const int row = row0 + ai * HALF + m * 16; const float gt = (u.pn < NE) ? gates[(size_t)row * NE + u.pn] : 1.f;
#pragma unroll
                for (int bj = 0; bj < 2; ++bj) { const f32x4 v0 = acc[ai][bj][m][0], v1 = acc[ai][bj][m][1];
                    const float h0 = v0[0] / (1.f + __expf(-v0[0])) * v0[1] * gt, h1 = v0[2] / (1.f + __expf(-v0[2])) * v0[3] * gt;
                    const float h2 = v1[0] / (1.f + __expf(-v1[0])) * v1[1] * gt, h3 = v1[2] / (1.f + __expf(-v1[2])) * v1[3] * gt;
                    typedef unsigned u32x2v __attribute__((ext_vector_type(2))); u32x2v w; w.x = cvt_pk_bf16(h0, h1); w.y = cvt_pk_bf16(h2, h3);
                    *(u32x2v*)(H + (size_t)row * DN_K + hc0 + bj * 64) = w; } }
    }
};

template <class Epi, class Sched, bool ALIGN_EPI = false, bool SP2 = false>
__device__ __forceinline__ void gemm_phase(PG8_LAS unsigned char* lds, const Gemm g, const Sched& S, const Epi& E) {
    int tid_o = threadIdx.x; asm volatile("" : "+v"(tid_o));
    const int tid = tid_o, wid = __builtin_amdgcn_readfirstlane(tid >> 6), lane = tid & 63, wr = wid >> 2, wc = wid & 3, fr = lane & 15, fq = lane >> 4;
    const int K = g.K, nt = K / BK;
    unsigned voffA[2], voffB[2];
#pragma unroll
    for (int i = 0; i < 2; ++i) { int R, C; stage_rc(tid * 16 + i * 8192, R, C); const int Rb = Epi::PERM ? ((R & ~31) + perm32(R & 31)) : R;
        voffA[i] = (unsigned)(R * K + C) * 2u; voffB[i] = (unsigned)(Rb * K + C) * 2u; }
    const size_t kstep = (size_t)(BK * 2);
    const size_t hstep = (size_t)HALF * K * 2;
    const size_t tstep = 2 * hstep;
    const unsigned ldsw = (unsigned)wid * 1024u;
    const int aoff = lds_byte(wr * 64 + fr, fq * 8), boff = lds_byte(wc * 32 + fr, fq * 8);
#define PG8_SA(b, h) (((b) * 2 + (h)) * HTB)
#define PG8_SB(b, h) ((4 + (b) * 2 + (h)) * HTB)
#define PG8_STAGE(bufoff, gbase, voff) do { _Pragma("unroll") for (int _i = 0; _i < 2; ++_i) \
        __builtin_amdgcn_global_load_lds((const unsigned*)((const char*)(gbase) + (voff)[_i]), (PG8_LAS unsigned*)(lds + (bufoff) + ldsw + _i * 8192), 16, 0, 0); } while (0)
#define PG8_LDA(dst, b, h) do { _Pragma("unroll") for (int m = 0; m < 4; ++m) _Pragma("unroll") for (int k = 0; k < 2; ++k) dst[m][k] = *(const PG8_LAS bf16x8*)(lds + PG8_SA(b, h) + aoff + m * 2048 + k * 1024); } while (0)
#define PG8_LDB(dst, b, h) do { _Pragma("unroll") for (int n = 0; n < 2; ++n) _Pragma("unroll") for (int k = 0; k < 2; ++k) dst[n][k] = *(const PG8_LAS bf16x8*)(lds + PG8_SB(b, h) + boff + n * 2048 + k * 1024); } while (0)
#define PG8_MMA(ai, bj, At, Bt) do { __builtin_amdgcn_s_setprio(1); _Pragma("unroll") for (int m = 0; m < 4; ++m) _Pragma("unroll") for (int n = 0; n < 2; ++n) _Pragma("unroll") for (int k = 0; k < 2; ++k) \
        acc[ai][bj][m][n] = __builtin_amdgcn_mfma_f32_16x16x32_bf16(Bt[n][k], At[m][k], acc[ai][bj][m][n], 0, 0, 0); __builtin_amdgcn_s_setprio(0); } while (0)
#define PG8_WAIT_V(n) asm volatile("s_waitcnt vmcnt(" #n ")" ::: "memory")
#define PG8_WAIT_L(n) asm volatile("s_waitcnt lgkmcnt(" #n ")" ::: "memory")
#define PG8_BAR __builtin_amdgcn_s_barrier()
#define PG8_SCHED __builtin_amdgcn_sched_barrier(0)
    Unit cur, nxt; int ui = 0;
    if (!S.next(0, cur)) return;
    f32x4 acc[2][2][4][2];
#pragma unroll
    for (int a = 0; a < 2; ++a)
#pragma unroll
        for (int b = 0; b < 2; ++b)
#pragma unroll
            for (int m = 0; m < 4; ++m)
#pragma unroll
                for (int n = 0; n < 2; ++n) acc[a][b][m][n] = (f32x4){0.f, 0.f, 0.f, 0.f};
    bf16x8 At[4][2], B0[2][2], B1[2][2];
    const char* cA = (const char*)g.A + (size_t)cur.pm * tstep; const char* cB = (const char*)g.Bt + (size_t)cur.pn * tstep;
    S.a_ready(cur);
    if constexpr (SP2) {
        PG8_STAGE(PG8_SB(0, 0), cB, voffB); PG8_STAGE(PG8_SB(0, 1), cB + hstep, voffB); PG8_STAGE(PG8_SA(0, 0), cA, voffA); PG8_STAGE(PG8_SA(0, 1), cA + hstep, voffA);
        if (wr == 1) PG8_BAR;
        PG8_WAIT_V(2); PG8_BAR;
        PG8_STAGE(PG8_SB(1, 0), cB + kstep, voffB); PG8_STAGE(PG8_SA(1, 0), cA + kstep, voffA); PG8_STAGE(PG8_SB(1, 1), cB + hstep + kstep, voffB);
        PG8_WAIT_V(6); PG8_BAR;
    } else {
        PG8_STAGE(PG8_SB(0, 0), cB, voffB); PG8_STAGE(PG8_SA(0, 0), cA, voffA); PG8_STAGE(PG8_SB(0, 1), cB + hstep, voffB); PG8_STAGE(PG8_SA(0, 1), cA + hstep, voffA);
        if (wr == 1) PG8_BAR;
        PG8_WAIT_V(4); PG8_BAR;
        PG8_STAGE(PG8_SB(1, 0), cB + kstep, voffB); PG8_STAGE(PG8_SA(1, 0), cA + kstep, voffA); PG8_STAGE(PG8_SB(1, 1), cB + hstep + kstep, voffB);
        PG8_WAIT_V(6); PG8_BAR;
    }
    for (;;) {
        const bool has_next = S.next(ui + 1, nxt);
        const char* nA = has_next ? (const char*)g.A + (size_t)nxt.pm * tstep : cA; const char* nB = has_next ? (const char*)g.Bt + (size_t)nxt.pn * tstep : cB;
        for (int t = 0; t < nt; t += 2) {
            const bool last = (t == nt - 2);
            const char* a1 = cA + (size_t)(t + 1) * kstep;
            const char* a2 = last ? nA : cA + (size_t)(t + 2) * kstep; const char* b2 = last ? nB : cB + (size_t)(t + 2) * kstep;
            const char* a3 = a2 + kstep; const char* b3 = b2 + kstep;
            if (last && has_next) S.a_ready(nxt);
            if constexpr (SP2) {
            PG8_LDB(B0, 0, 0); PG8_LDB(B1, 0, 1); PG8_SCHED; PG8_LDA(At, 0, 0); PG8_STAGE(PG8_SA(1, 1), a1 + hstep, voffA);
            PG8_WAIT_V(8); PG8_WAIT_L(0); PG8_BAR; PG8_MMA(0, 0, At, B0); PG8_MMA(0, 1, At, B1); PG8_BAR; PG8_SCHED;
            PG8_LDA(At, 0, 1); PG8_STAGE(PG8_SB(0, 0), b2, voffB); PG8_STAGE(PG8_SB(0, 1), b2 + hstep, voffB); PG8_STAGE(PG8_SA(0, 0), a2, voffA);
            PG8_WAIT_V(8); PG8_WAIT_L(0); PG8_BAR; PG8_MMA(1, 0, At, B0); PG8_MMA(1, 1, At, B1); PG8_BAR; PG8_SCHED;
            PG8_LDB(B0, 1, 0); PG8_LDB(B1, 1, 1); PG8_SCHED; PG8_LDA(At, 1, 0); PG8_STAGE(PG8_SA(0, 1), a2 + hstep, voffA);
            PG8_WAIT_V(8); PG8_WAIT_L(0); PG8_BAR; PG8_MMA(0, 0, At, B0); PG8_MMA(0, 1, At, B1); PG8_BAR; PG8_SCHED;
            PG8_LDA(At, 1, 1); PG8_STAGE(PG8_SB(1, 0), b3, voffB); PG8_STAGE(PG8_SB(1, 1), b3 + hstep, voffB); PG8_STAGE(PG8_SA(1, 0), a3, voffA);
            PG8_WAIT_V(8); PG8_WAIT_L(0); PG8_BAR; PG8_MMA(1, 0, At, B0); PG8_MMA(1, 1, At, B1); PG8_BAR; PG8_SCHED;
            } else {
            PG8_LDB(B0, 0, 0); PG8_SCHED; PG8_LDA(At, 0, 0); PG8_STAGE(PG8_SA(1, 1), a1 + hstep, voffA);
            PG8_WAIT_L(8); PG8_BAR; PG8_WAIT_L(0); PG8_MMA(0, 0, At, B0); PG8_BAR; PG8_SCHED;
            PG8_LDB(B1, 0, 1); PG8_STAGE(PG8_SB(0, 0), b2, voffB);
            PG8_BAR; PG8_WAIT_L(0); PG8_MMA(0, 1, At, B1); PG8_BAR;
            PG8_LDA(At, 0, 1); PG8_STAGE(PG8_SA(0, 0), a2, voffA);
            PG8_BAR; PG8_WAIT_L(0); PG8_MMA(1, 0, At, B0); PG8_BAR; PG8_SCHED;
            PG8_STAGE(PG8_SB(0, 1), b2 + hstep, voffB);
            PG8_WAIT_V(6); PG8_BAR; PG8_MMA(1, 1, At, B1); PG8_BAR;
            PG8_LDB(B0, 1, 0); PG8_SCHED; PG8_LDA(At, 1, 0); PG8_STAGE(PG8_SA(0, 1), a2 + hstep, voffA);
            PG8_WAIT_L(8); PG8_BAR; PG8_WAIT_L(0); PG8_MMA(0, 0, At, B0); PG8_BAR; PG8_SCHED;
            PG8_LDB(B1, 1, 1); PG8_STAGE(PG8_SB(1, 0), b3, voffB);
            PG8_BAR; PG8_WAIT_L(0); PG8_MMA(0, 1, At, B1); PG8_BAR;
            PG8_LDA(At, 1, 1); PG8_STAGE(PG8_SA(1, 0), a3, voffA);
            PG8_BAR; PG8_WAIT_L(0); PG8_MMA(1, 0, At, B0); PG8_BAR; PG8_SCHED;
            PG8_STAGE(PG8_SB(1, 1), b3 + hstep, voffB);
            PG8_WAIT_V(6); PG8_BAR; PG8_MMA(1, 1, At, B1); PG8_BAR;
            }
        }
        if constexpr (ALIGN_EPI) { if (wr == 0) PG8_BAR; }
        if constexpr (!Epi::AFTER_DRAIN) { E(acc, cur, wr, wc, fr, fq); S.done(cur); }
        if (!has_next) break;
#pragma unroll
        for (int a = 0; a < 2; ++a)
#pragma unroll
            for (int b = 0; b < 2; ++b)
#pragma unroll
                for (int m = 0; m < 4; ++m)
#pragma unroll
                    for (int n = 0; n < 2; ++n) acc[a][b][m][n] = (f32x4){0.f, 0.f, 0.f, 0.f};
        cur = nxt; cA = nA; cB = nB; ++ui;
        if constexpr (ALIGN_EPI) { if (wr == 1) PG8_BAR; }
    }
    PG8_WAIT_V(0);
    if constexpr (!ALIGN_EPI) { if (wr == 0) PG8_BAR; }
    PG8_BAR;
    if constexpr (Epi::AFTER_DRAIN) { E.fused(acc, cur, wr, wc, fr, fq, lds, wid, lane); S.done(cur); }
#undef PG8_SA
#undef PG8_SB
#undef PG8_STAGE
#undef PG8_LDA
#undef PG8_LDB
#undef PG8_MMA
#undef PG8_WAIT_V
#undef PG8_WAIT_L
#undef PG8_BAR
#undef PG8_SCHED
}

struct UnitX { int pm, pn, e, nrows, k0, nt; };
typedef int i32x4 __attribute__((ext_vector_type(4)));
typedef int i32x8 __attribute__((ext_vector_type(8)));
template <class Epi, class Sched, class RowMap, bool F8 = false>
__device__ __forceinline__ void gemm_phase_x(PG8_LAS unsigned char* lds, const Gemm g, const Sched& S, const Epi& E, const RowMap& RM) {
    int tid_o = threadIdx.x; asm volatile("" : "+v"(tid_o));
    const int tid = tid_o, wid = __builtin_amdgcn_readfirstlane(tid >> 6), lane = tid & 63, wr = wid >> 2, wc = wid & 3, fr = lane & 15, fq = lane >> 4;
    const int K = g.K;
    int R_[2], C_[2]; unsigned voffB[2];
#pragma unroll
    for (int i = 0; i < 2; ++i) { stage_rc(tid * 16 + i * 8192, R_[i], C_[i]); const int Rb = Epi::PERM ? ((R_[i] & ~31) + perm32(R_[i] & 31)) : R_[i]; voffB[i] = (unsigned)(Rb * K + C_[i]) * 2u; }
    const size_t kstep = (size_t)(BK * 2);
    const size_t hstep = (size_t)HALF * K * 2;
    const size_t tstep = 2 * hstep;
    const unsigned ldsw = (unsigned)wid * 1024u;
    const int aoff = lds_byte(wr * 64 + fr, fq * 8), boff = lds_byte(wc * 32 + fr, fq * 8);
#define PG8_SA(b, h) (((b) * 2 + (h)) * HTB)
#define PG8_SB(b, h) ((4 + (b) * 2 + (h)) * HTB)
#define PG8_STAGE(bufoff, gbase, voff) do { _Pragma("unroll") for (int _i = 0; _i < 2; ++_i) \
        __builtin_amdgcn_global_load_lds((const unsigned*)((const char*)(gbase) + (voff)[_i]), (PG8_LAS unsigned*)(lds + (bufoff) + ldsw + _i * 8192), 16, 0, 0); } while (0)
#define PG8_LD8(dst, addr) do { const i32x4 _lo = *(const PG8_LAS i32x4*)(addr), _hi = *(const PG8_LAS i32x4*)((addr) + 1024); dst = __builtin_shufflevector(_lo, _hi, 0, 1, 2, 3, 4, 5, 6, 7); } while (0)
#define PG8_LDA(dst, b, h) do { _Pragma("unroll") for (int m = 0; m < 4; ++m) PG8_LD8(dst[m], lds + PG8_SA(b, h) + aoff + m * 2048); } while (0)
#define PG8_LDB(dst, b, h) do { _Pragma("unroll") for (int n = 0; n < 2; ++n) PG8_LD8(dst[n], lds + PG8_SB(b, h) + boff + n * 2048); } while (0)
#define PG8_LOH(v) __builtin_bit_cast(bf16x8, __builtin_shufflevector(v, v, 0, 1, 2, 3))
#define PG8_HIH(v) __builtin_bit_cast(bf16x8, __builtin_shufflevector(v, v, 4, 5, 6, 7))
#define PG8_MMA(ai, bj, At, Bt) do { __builtin_amdgcn_s_setprio(1); _Pragma("unroll") for (int m = 0; m < 4; ++m) _Pragma("unroll") for (int n = 0; n < 2; ++n) { \
        if constexpr (F8) asm volatile("v_mfma_scale_f32_16x16x128_f8f6f4 %0, %1, %2, %0, %3, %3 op_sel_hi:[0,0,0]" : "+v"(acc[ai][bj][m][n]) : "v"(Bt[n]), "v"(At[m]), "v"(sc8)); \
        else { acc[ai][bj][m][n] = __builtin_amdgcn_mfma_f32_16x16x32_bf16(PG8_LOH(Bt[n]), PG8_LOH(At[m]), acc[ai][bj][m][n], 0, 0, 0); \
               acc[ai][bj][m][n] = __builtin_amdgcn_mfma_f32_16x16x32_bf16(PG8_HIH(Bt[n]), PG8_HIH(At[m]), acc[ai][bj][m][n], 0, 0, 0); } } \
        __builtin_amdgcn_s_setprio(0); } while (0)
#define PG8_WAIT_V(n) asm volatile("s_waitcnt vmcnt(" #n ")" ::: "memory")
#define PG8_WAIT_L(n) asm volatile("s_waitcnt lgkmcnt(" #n ")" ::: "memory")
#define PG8_BAR __builtin_amdgcn_s_barrier()
#define PG8_SCHED __builtin_amdgcn_sched_barrier(0)
#define PG8_ROWOFF(dst, u) do { _Pragma("unroll") for (int _h = 0; _h < 2; ++_h) _Pragma("unroll") for (int _i = 0; _i < 2; ++_i) \
        dst[_h][_i] = (RM.row(u, _h * HALF + R_[_i]) * (unsigned)K + (unsigned)C_[_i]) * 2u; } while (0)
#define PG8_ABASE(u) ((const char*)g.A + ((size_t)RM.base(u) * K + (size_t)(u).k0) * 2)
    UnitX cur, nxt; int ui = 0;
    if (!S.next(0, cur)) return;
    f32x4 acc[2][2][4][2];
#pragma unroll
    for (int a = 0; a < 2; ++a)
#pragma unroll
        for (int b = 0; b < 2; ++b)
#pragma unroll
            for (int m = 0; m < 4; ++m)
#pragma unroll
                for (int n = 0; n < 2; ++n) acc[a][b][m][n] = (f32x4){0.f, 0.f, 0.f, 0.f};
    i32x8 At[4], B0[2], B1[2];
    const int sc8 = 0x7f7f7f7f;
    unsigned vc[2][2], vn[2][2];
    PG8_ROWOFF(vc, cur);
    const char* A0 = PG8_ABASE(cur);
    const char* cB = (const char*)g.Bt + (size_t)cur.pn * tstep + (size_t)cur.k0 * 2;
    PG8_STAGE(PG8_SB(0, 0), cB, voffB); PG8_STAGE(PG8_SB(0, 1), cB + hstep, voffB); PG8_STAGE(PG8_SA(0, 0), A0, vc[0]); PG8_STAGE(PG8_SA(0, 1), A0, vc[1]);
    if (wr == 1) PG8_BAR;
    PG8_WAIT_V(2); PG8_BAR;
    PG8_STAGE(PG8_SB(1, 0), cB + kstep, voffB); PG8_STAGE(PG8_SA(1, 0), A0 + kstep, vc[0]); PG8_STAGE(PG8_SB(1, 1), cB + hstep + kstep, voffB);
    PG8_WAIT_V(6); PG8_BAR;
    for (;;) {
        const bool has_next = S.next(ui + 1, nxt);
        if constexpr (!RowMap::IDENT) { if (has_next) { PG8_ROWOFF(vn, nxt); } else {
#pragma unroll
            for (int _h = 0; _h < 2; ++_h)
#pragma unroll
                for (int _i = 0; _i < 2; ++_i) vn[_h][_i] = vc[_h][_i]; } }
        const char* nB = has_next ? (const char*)g.Bt + (size_t)nxt.pn * tstep + (size_t)nxt.k0 * 2 : cB;
        const char* nA = has_next ? PG8_ABASE(nxt) : A0;
        const int nt = cur.nt;
        for (int t = 0; t < nt; t += 2) {
            const bool last = (t == nt - 2);
            const char* a1 = A0 + (size_t)(t + 1) * kstep;
            const char* a2 = last ? nA : A0 + (size_t)(t + 2) * kstep; const char* b2 = last ? nB : cB + (size_t)(t + 2) * kstep;
            const char* a3 = a2 + kstep; const char* b3 = b2 + kstep;
            unsigned v2h0[2], v2h1[2];
#pragma unroll
            for (int _i = 0; _i < 2; ++_i) { if constexpr (RowMap::IDENT) { v2h0[_i] = vc[0][_i]; v2h1[_i] = vc[1][_i]; } else { v2h0[_i] = last ? vn[0][_i] : vc[0][_i]; v2h1[_i] = last ? vn[1][_i] : vc[1][_i]; } }
            PG8_LDB(B0, 0, 0); PG8_LDB(B1, 0, 1); PG8_SCHED; PG8_LDA(At, 0, 0); PG8_STAGE(PG8_SA(1, 1), a1, vc[1]);
            PG8_WAIT_V(8); PG8_WAIT_L(0); PG8_BAR; PG8_MMA(0, 0, At, B0); PG8_MMA(0, 1, At, B1); PG8_BAR; PG8_SCHED;
            PG8_LDA(At, 0, 1); PG8_STAGE(PG8_SB(0, 0), b2, voffB); PG8_STAGE(PG8_SB(0, 1), b2 + hstep, voffB); PG8_STAGE(PG8_SA(0, 0), a2, v2h0);
            PG8_WAIT_V(8); PG8_WAIT_L(0); PG8_BAR; PG8_MMA(1, 0, At, B0); PG8_MMA(1, 1, At, B1); PG8_BAR; PG8_SCHED;
            PG8_LDB(B0, 1, 0); PG8_LDB(B1, 1, 1); PG8_SCHED; PG8_LDA(At, 1, 0); PG8_STAGE(PG8_SA(0, 1), a2, v2h1);
            PG8_WAIT_V(8); PG8_WAIT_L(0); PG8_BAR; PG8_MMA(0, 0, At, B0); PG8_MMA(0, 1, At, B1); PG8_BAR; PG8_SCHED;
            PG8_LDA(At, 1, 1); PG8_STAGE(PG8_SB(1, 0), b3, voffB); PG8_STAGE(PG8_SB(1, 1), b3 + hstep, voffB); PG8_STAGE(PG8_SA(1, 0), a3, v2h0);
            PG8_WAIT_V(8); PG8_WAIT_L(0); PG8_BAR; PG8_MMA(1, 0, At, B0); PG8_MMA(1, 1, At, B1); PG8_BAR; PG8_SCHED;
        }
        if constexpr (F8) asm volatile("s_nop 7\n\ts_nop 7\n\ts_nop 7" ::: "memory");
        if (wr == 0) PG8_BAR;
        E(acc, cur, wr, wc, fr, fq);
        if (!has_next) break;
#pragma unroll
        for (int a = 0; a < 2; ++a)
#pragma unroll
            for (int b = 0; b < 2; ++b)
#pragma unroll
                for (int m = 0; m < 4; ++m)
#pragma unroll
                    for (int n = 0; n < 2; ++n) acc[a][b][m][n] = (f32x4){0.f, 0.f, 0.f, 0.f};
        cur = nxt; cB = nB; A0 = nA; ++ui;
        if constexpr (!RowMap::IDENT) {
#pragma unroll
        for (int _h = 0; _h < 2; ++_h)
#pragma unroll
            for (int _i = 0; _i < 2; ++_i) vc[_h][_i] = vn[_h][_i]; }
        if (wr == 1) PG8_BAR;
    }
    PG8_WAIT_V(0);
    PG8_BAR;
#undef PG8_SA
#undef PG8_SB
#undef PG8_STAGE
#undef PG8_LDA
#undef PG8_LDB
#undef PG8_LD8
#undef PG8_LOH
#undef PG8_HIH
#undef PG8_MMA
#undef PG8_WAIT_V
#undef PG8_WAIT_L
#undef PG8_BAR
#undef PG8_SCHED
#undef PG8_ROWOFF
#undef PG8_ABASE
}

struct MoeOrder {
    const PG8_LAS int* tab; const PG8_LAS int* cnt; int Ur, nSh, G, c, ntk;
    __device__ __forceinline__ bool next(int i, UnitX& u) const {
        int L = i * G + c; u.k0 = 0; u.nt = ntk;
        if (L < Ur) { const int v = tab[L]; u.e = v & 255; u.pm = v >> 8; u.pn = u.e; u.nrows = cnt[u.e]; return true; }
        L -= Ur;
        if (L < nSh) { u.e = -1; u.pm = L >> 3; u.pn = NE + (L & 7); u.nrows = 0; return true; }
        return false;
    }
};
struct RowList {
    const int* list;
    static constexpr bool IDENT = false;
    __device__ __forceinline__ unsigned base(const UnitX&) const { return 0u; }
    __device__ __forceinline__ unsigned row(const UnitX& u, int r) const {
        if (u.e < 0) return (unsigned)(u.pm * BM + r);
        int i = u.pm * BM + r; i = i < u.nrows ? i : u.nrows - 1;
        return (unsigned)list[(size_t)u.e * T + i];
    }
};
struct EpiSwigluX {
    static constexpr bool PERM = true, AFTER_DRAIN = false;
    unsigned char* H; const float* gates; const int* list; float oscale;
    __device__ __forceinline__ void operator()(const f32x4 (&acc)[2][2][4][2], const UnitX& u, int wr, int wc, int fr, int fq) const {
        const int hc0 = u.pn * 128 + wc * 16 + 4 * fq;
#pragma unroll
        for (int ai = 0; ai < 2; ++ai)
#pragma unroll
            for (int m = 0; m < 4; ++m) { const int rloc = u.pm * BM + wr * 64 + fr + ai * HALF + m * 16; int tok = rloc; float gt = 1.f; bool ok = true;
                if (u.e >= 0) { ok = rloc < u.nrows; tok = ok ? list[(size_t)u.e * T + rloc] : 0; gt = ok ? gates[(size_t)tok * NE + u.e] : 0.f; }
                if (ok) {
#pragma unroll
                for (int bj = 0; bj < 2; ++bj) { const f32x4 v0 = acc[ai][bj][m][0] * oscale, v1 = acc[ai][bj][m][1] * oscale;
                    const float h0 = v0[0] / (1.f + __expf(-v0[0])) * v0[1] * gt, h1 = v0[2] / (1.f + __expf(-v0[2])) * v0[3] * gt;
                    const float h2 = v1[0] / (1.f + __expf(-v1[0])) * v1[1] * gt, h3 = v1[2] / (1.f + __expf(-v1[2])) * v1[3] * gt;
                    int w = __builtin_amdgcn_cvt_pk_fp8_f32(__builtin_amdgcn_fmed3f(h0, -448.f, 448.f), __builtin_amdgcn_fmed3f(h1, -448.f, 448.f), 0, false); w = __builtin_amdgcn_cvt_pk_fp8_f32(__builtin_amdgcn_fmed3f(h2, -448.f, 448.f), __builtin_amdgcn_fmed3f(h3, -448.f, 448.f), w, true);
                    *(int*)(H + (size_t)tok * DN_K + hc0 + bj * 64) = w; } } }
    }
};

struct SplitCtxOrder {
    int nN, G, c, ntk, nlat, nsub, nsplit;
    __device__ __forceinline__ void init(int M, int N, int K, int G_, int c_, int nsplit_) { nN = N / BM; G = G_; c = c_; ntk = K / BK; nsplit = nsplit_; nlat = (NLAT / BM) * nN; nsub = (M > NLAT) ? ((M - NLAT) / BM) * nN * nsplit : 0; }
    __device__ __forceinline__ bool next(int i, UnitX& u) const {
        int L = i * G + c; u.e = -1; u.nrows = 0;
        if (L < nlat) { int wgid = L; { const int q = nlat / NXCD, xcd = wgid % NXCD, off = wgid / NXCD; wgid = xcd * q + off; }
            const int nig = WGM * nN, gid = wgid / nig, fm = gid * WGM; u.pm = fm + ((wgid % nig) % WGM); u.pn = (wgid % nig) / WGM; u.k0 = 0; u.nt = ntk; return true; }
        L -= nlat;
        if (L < nsub) { const int tile = L / nsplit, s = L % nsplit; u.pm = NLAT / BM + tile / nN; u.pn = tile % nN; u.nt = ntk / nsplit; u.k0 = s * (ntk / nsplit) * BK; u.e = -2 - s; return true; }
        return false;
    }
};
struct RowIdent { static constexpr bool IDENT = true;
                  __device__ __forceinline__ unsigned base(const UnitX& u) const { return (unsigned)(u.pm * BM); }
                  __device__ __forceinline__ unsigned row(const UnitX&, int r) const { return (unsigned)r; } };
struct EpiResidX {
    static constexpr bool PERM = false, AFTER_DRAIN = false;
    const float* lat_src; float* lat_dst; const float* gate; float* part; float oscale;
    __device__ __forceinline__ void operator()(const f32x4 (&acc)[2][2][4][2], const UnitX& u, int wr, int wc, int fr, int fq) const {
        const int rowt = u.pm * BM, col0 = u.pn * BM + wc * 32 + 4 * fq;
        if (u.e <= -2) {
            float* pp = part + (size_t)(-2 - u.e) * NCTX * D; const int row0 = rowt - NLAT + wr * 64 + fr;
#pragma unroll
            for (int ai = 0; ai < 2; ++ai)
#pragma unroll
                for (int m = 0; m < 4; ++m) { const size_t off = (size_t)(row0 + ai * HALF + m * 16) * D + col0;
#pragma unroll
                    for (int bj = 0; bj < 2; ++bj)
#pragma unroll
                        for (int n = 0; n < 2; ++n) *(f32x4*)(pp + off + bj * HALF + n * 16) = acc[ai][bj][m][n] * oscale; }
            return; }
        const int c = rowt < SEQ ? 0 : 1; const float* gv = gate + (size_t)c * 6 * D; const int row0 = rowt + wr * 64 + fr;
        f32x4 g[2][2];
#pragma unroll
        for (int bj = 0; bj < 2; ++bj)
#pragma unroll
            for (int n = 0; n < 2; ++n) g[bj][n] = *(const f32x4*)(gv + col0 + bj * HALF + n * 16) * oscale;
#pragma unroll
        for (int ai = 0; ai < 2; ++ai)
#pragma unroll
            for (int m = 0; m < 4; ++m) { const size_t off = (size_t)(row0 + ai * HALF + m * 16) * D + col0;
#pragma unroll
                for (int bj = 0; bj < 2; ++bj)
#pragma unroll
                    for (int n = 0; n < 2; ++n) { const f32x4 s = *(const f32x4*)(lat_src + off + bj * HALF + n * 16); *(f32x4*)(lat_dst + off + bj * HALF + n * 16) = s + g[bj][n] * acc[ai][bj][m][n]; } }
    }
};

struct StaticOrderX {
    int nM, nN, nwg, G, c, ntk;
    __device__ __forceinline__ void init(int M, int N, int K, int G_, int c_) { nM = M / BM; nN = N / BM; nwg = nM * nN; G = G_; c = c_; ntk = K / BK; }
    __device__ __forceinline__ bool next(int i, UnitX& u) const {
        const long L = (long)i * G + c; if (L >= nwg) return false;
        int wgid = (int)L; { const int q = nwg / NXCD, r = nwg % NXCD, xcd = wgid % NXCD, off = wgid / NXCD; wgid = (xcd < r ? xcd * (q + 1) : r * (q + 1) + (xcd - r) * q) + off; }
        const int nig = WGM * nN, gid = wgid / nig, fm = gid * WGM, gsz = (nM - fm) < WGM ? (nM - fm) : WGM;
        u.pm = fm + ((wgid % nig) % gsz); u.pn = (wgid % nig) / gsz; u.e = -1; u.nrows = 0; u.k0 = 0; u.nt = ntk; return true;
    }
};
template <int ACT> struct EpiBf16X {
    static constexpr bool PERM = true, AFTER_DRAIN = false;
    bf16_t* O; int ldc; const float* bias; float oscale;
    __device__ __forceinline__ void operator()(const f32x4 (&acc)[2][2][4][2], const UnitX& u, int wr, int wc, int fr, int fq) const {
        const int row0 = u.pm * BM + wr * 64 + fr, col0 = u.pn * BM + wc * 32 + 8 * fq;
        f32x4 bv[2][2];
#pragma unroll
        for (int bj = 0; bj < 2; ++bj)
#pragma unroll
            for (int n = 0; n < 2; ++n) bv[bj][n] = bias ? *(const f32x4*)(bias + col0 + bj * HALF + 4 * n) : (f32x4){0.f, 0.f, 0.f, 0.f};
#pragma unroll
        for (int ai = 0; ai < 2; ++ai)
#pragma unroll
            for (int m = 0; m < 4; ++m) { bf16_t* rowp = O + (size_t)(row0 + ai * HALF + m * 16) * ldc + col0;
#pragma unroll
                for (int bj = 0; bj < 2; ++bj) { f32x4 v0 = acc[ai][bj][m][0] * oscale + bv[bj][0], v1 = acc[ai][bj][m][1] * oscale + bv[bj][1];
                    if (ACT == 1) { f32x2 a = gelu_pk((f32x2){v0[0], v0[1]}), b = gelu_pk((f32x2){v0[2], v0[3]}), c = gelu_pk((f32x2){v1[0], v1[1]}), d = gelu_pk((f32x2){v1[2], v1[3]});
                        v0 = (f32x4){a.x, a.y, b.x, b.y}; v1 = (f32x4){c.x, c.y, d.x, d.y}; }
                    u32x4 w; w.x = cvt_pk_bf16(v0[0], v0[1]); w.y = cvt_pk_bf16(v0[2], v0[3]); w.z = cvt_pk_bf16(v1[0], v1[1]); w.w = cvt_pk_bf16(v1[2], v1[3]);
                    *(u32x4*)(rowp + bj * HALF) = w; } }
    }
};
}

#ifndef PG8_SP2
#define PG8_SP2 true
#endif
#ifndef PG8_ALIGN
#define PG8_ALIGN true
#endif

#define LAS __attribute__((address_space(3)))
typedef unsigned short bf16_t;
typedef float f32x4 __attribute__((ext_vector_type(4)));
typedef unsigned u32x4 __attribute__((ext_vector_type(4)));
typedef unsigned u32x2 __attribute__((ext_vector_type(2)));

constexpr size_t MiB = 1u << 20;
constexpr size_t WS_CTL = 0, CTL_ZERO_BYTES = 1 * MiB;
constexpr size_t WS_MODS = 1 * MiB;
constexpr size_t WS_RPART = 3 * MiB;
constexpr size_t WS_WR = 4 * MiB;
constexpr size_t WS_RB = 16 * MiB;
constexpr size_t WS_RSTDV = 16 * MiB + 65536;
constexpr size_t WS_GATES = 17 * MiB;
constexpr size_t WS_CX = 22 * MiB;
constexpr size_t WS_WIN = 30 * MiB;
constexpr size_t WS_WOUT = WS_WIN + 96 * MiB;
constexpr size_t WS_WGU = WS_WOUT + 32 * MiB;
constexpr size_t WS_WD = WS_WGU + 144 * MiB;
constexpr size_t WS_H = WS_WD + 72 * MiB;
constexpr size_t WS_P = WS_H + 132 * MiB;
constexpr size_t WS_MIX = WS_P + 396 * MiB;
constexpr size_t WS_UT = WS_MIX + 132 * MiB;
constexpr size_t WS_FILT = WS_UT + 384 * MiB;
constexpr size_t WS_FILTC = WS_FILT + 256 * MiB;
constexpr size_t WS_Z2T = WS_FILTC + 8 * MiB;
constexpr size_t WS_END = WS_Z2T + 128 * MiB;
constexpr size_t WS_WSET2 = WS_END;
constexpr size_t WSET_BYTES = 344 * MiB;
constexpr size_t WS_PART = WS_WSET2 + WSET_BYTES;
constexpr size_t WS_ELIST = WS_PART + 64 * MiB;
constexpr size_t WS_H8E = WS_ELIST + 5 * MiB;
constexpr size_t WS_END2 = WS_H8E + 66 * MiB;
constexpr int CW_BAR = 4096;
constexpr int CW_ECNT = 8192;
constexpr int CW_WQ = 8704;
constexpr int CW_ARR = 8768;
constexpr int TAB_OFF = 131072;

constexpr int LDS_BYTES = 147456;
constexpr int MISC_OFF = 147200;

#define XB_TMO      128
#define XB_XCNT(j)  (256  + 64 * (j))
#define XB_XSUB(j)  (1280 + 64 * (j))
#define XB_XGEN(j)  (2304 + 64 * (j))
#define XB_TOP      3328
#define XB_TOPGEN   3392
#define XCD_BAR_WORDS 3456
#define XB_SPIN_CAP (1u << 21)

__device__ __forceinline__ unsigned xb_ld(unsigned* p)              { return __hip_atomic_load(p, __ATOMIC_RELAXED, __HIP_MEMORY_SCOPE_AGENT); }
__device__ __forceinline__ unsigned xb_add(unsigned* p, unsigned v) { return __hip_atomic_fetch_add(p, v, __ATOMIC_RELAXED, __HIP_MEMORY_SCOPE_AGENT); }
__device__ __forceinline__ unsigned xb_xcc_id() { return (unsigned)__builtin_amdgcn_s_getreg((3 << 11) | 20) & 0xFu; }
#define XB_SPIN(cond, bar) do { unsigned _sp = 0; while (cond) { __builtin_amdgcn_s_sleep(1); \
    if ((++_sp & 255u) == 0u) { if (xb_ld(&(bar)[XB_TMO])) break; if (_sp > XB_SPIN_CAP) { atomicAdd(&(bar)[XB_TMO], 1u); break; } } } } while (0)

struct XcdBarrier { unsigned* bar; unsigned x; volatile LAS unsigned* st; };

__device__ __forceinline__ XcdBarrier xcd_barrier_post(unsigned* bar, volatile LAS unsigned* st) {
    XcdBarrier b; b.bar = bar; b.x = xb_xcc_id(); b.st = st;
    if (threadIdx.x == 0) (void)xb_add(&bar[XB_XCNT(b.x)], 1u);
    return b;
}
__device__ __forceinline__ void xcd_barrier_complete(unsigned* bar, unsigned x, unsigned& nloc, unsigned& nx) {
    const unsigned G = gridDim.x * gridDim.y * gridDim.z;
    unsigned sum, cnt, mine, sp = 0u;
    for (;;) {
        sum = 0u; cnt = 0u; mine = 0u;
#pragma unroll
        for (unsigned j = 0; j < 16; ++j) { const unsigned c = xb_ld(&bar[XB_XCNT(j)]); sum += c; cnt += (c > 0u) ? 1u : 0u; mine = (j == x) ? c : mine; }
        if (sum == G) break;
        __builtin_amdgcn_s_sleep(1);
        if ((++sp & 255u) == 0u) { if (xb_ld(&bar[XB_TMO])) break; if (sp > XB_SPIN_CAP) { atomicAdd(&bar[XB_TMO], 1u); break; } }
    }
    nloc = mine > 0u ? mine : 1u; nx = cnt > 0u ? cnt : 1u;
}
__device__ __forceinline__ void xcd_barrier(const XcdBarrier& b) {
    asm volatile("s_waitcnt vmcnt(0)" ::: "memory");
    __syncthreads();
    if (threadIdx.x == 0) {
        unsigned* bar = b.bar;
        __builtin_amdgcn_s_waitcnt(0);
        unsigned nloc = b.st[0], nx = b.st[1];
        if (nloc == 0u) { xcd_barrier_complete(bar, b.x, nloc, nx); b.st[0] = nloc; b.st[1] = nx; }
        const unsigned old = xb_add(&bar[XB_XSUB(b.x)], 1u);
        const unsigned gen = old / nloc;
        if (old + 1u == (gen + 1u) * nloc) {
            __builtin_amdgcn_fence(__ATOMIC_RELEASE, "agent");
            asm volatile("s_waitcnt vmcnt(0)" ::: "memory");
            const unsigned og = xb_add(&bar[XB_TOP], 1u);
            const unsigned tg = og / nx;
            if (og + 1u == (tg + 1u) * nx) xb_add(&bar[XB_TOPGEN], 1u);
            else XB_SPIN(xb_ld(&bar[XB_TOPGEN]) == tg, bar);
            __builtin_amdgcn_fence(__ATOMIC_ACQUIRE, "agent");
            xb_add(&bar[XB_XGEN(b.x)], 1u);
            asm volatile("s_waitcnt vmcnt(0)" ::: "memory");
        } else {
            XB_SPIN(xb_ld(&bar[XB_XGEN(b.x)]) == gen, bar);
            __builtin_amdgcn_fence(__ATOMIC_ACQUIRE, "agent");
            asm volatile("s_waitcnt vmcnt(0)" ::: "memory");
        }
    }
    __syncthreads();
}

struct Args { const float* in[38]; float* out; unsigned char* ws; int ph_lo, ph_hi; };
enum { I_X = 0, I_C, I_CTX, I_CCTX, I_ADA_A, I_ADA_B, I_ADA_BIAS, I_NORM_MIX, I_NORM_FFN, I_EVEN_WIN, I_QGAIN, I_KGAIN, I_RPB, I_HY_CW, I_HY_CB,
       I_HY_W1, I_HY_B1, I_HY_W2, I_HY_B2, I_HY_W3, I_HY_B3, I_HY_W4, I_HY_FREQ, I_HY_SKIP, I_ODD_WIN, I_ODD_BIN, I_GM_VGAIN, I_GM_WS, I_GM_BS, I_WOUT,
       I_ROUTER, I_MOE_BIAS, I_MOE_WG, I_MOE_WU, I_MOE_WD, I_SH_WG, I_SH_WU, I_SH_WD };

struct Frame { LAS unsigned char* lds; int tid, lane, wave, G, gw, NGW; };

#define LDS_WAIT() asm volatile("s_waitcnt lgkmcnt(0)" ::: "memory")
__device__ __forceinline__ int opaque_zero() { int z; asm volatile("s_mov_b32 %0, 0" : "=s"(z)); return z; }
#define INP(i) (a.in[(i) + Z])
#define WSB(off) (a.ws + ((size_t)(off) + (size_t)Z))
#define AOUT (a.out + (size_t)Z)
#define WSETP(off, l_) ((bf16_t*)(a.ws + (((l_) & 1) ? (WS_WSET2 + ((off) - WS_WIN)) : (off)) + (size_t)Z))
__device__ __forceinline__ unsigned f2bf(float f) { unsigned u = __builtin_bit_cast(unsigned, f); return (u + 0x7fffu + ((u >> 16) & 1u)) >> 16; }
typedef __bf16 bf16x2_t __attribute__((ext_vector_type(2)));
__device__ __forceinline__ unsigned pk2(float lo, float hi) { bf16x2_t v; v.x = (__bf16)lo; v.y = (__bf16)hi; return __builtin_bit_cast(unsigned, v); }
__device__ __forceinline__ float sat8(float v) { return __builtin_amdgcn_fmed3f(v, -448.f, 448.f); }
__device__ __forceinline__ unsigned pk4f8(float a0, float a1, float a2, float a3) { a0 = sat8(a0); a1 = sat8(a1); a2 = sat8(a2); a3 = sat8(a3); int w = __builtin_amdgcn_cvt_pk_fp8_f32(a0, a1, 0, false); w = __builtin_amdgcn_cvt_pk_fp8_f32(a2, a3, w, true); return (unsigned)w; }
__device__ __forceinline__ float bflo(unsigned u) { return __builtin_bit_cast(float, u << 16); }
__device__ __forceinline__ float bfhi(unsigned u) { return __builtin_bit_cast(float, u & 0xffff0000u); }
__device__ __forceinline__ float bf2f(bf16_t b) { return __builtin_bit_cast(float, ((unsigned)b) << 16); }
__device__ __forceinline__ float wave_sum(float v) {
#pragma unroll
    for (int o = 1; o < 64; o <<= 1) v += __shfl_xor(v, o);
    return v;
}
__device__ __forceinline__ float wave_max(float v) {
#pragma unroll
    for (int o = 1; o < 64; o <<= 1) v = fmaxf(v, __shfl_xor(v, o));
    return v;
}
__device__ __forceinline__ float* MODSP_(unsigned char* wsz, int l, int c, int i) { return (float*)(wsz + WS_MODS) + ((size_t)(l * 3 + c) * 6 + i) * D; }
#define MODSP(a_, l_, c_, i_) MODSP_(WSB(0), l_, c_, i_)

__device__ __forceinline__ void ph_mods1(const Args& a, const Frame& F) {
    const int Z = opaque_zero();
    LAS float* red = (LAS float*)F.lds;
    const float* c = INP(I_C); const float* cc = INP(I_CCTX); const float* A = INP(I_ADA_A);
    float* rpart = (float*)WSB(WS_RPART);
    for (int it = blockIdx.x; it < 4 * 64; it += F.G) {
        const int l = it >> 6, kc = it & 63, j = F.tid & 255, half = F.tid >> 8, k0 = kc * 64 + half * 32;
        float s0 = 0.f, s1 = 0.f, s2 = 0.f;
        const float* Ap = A + ((size_t)l * D + k0) * RANK + j;
        for (int k = 0; k < 32; ++k) {
            const float w = Ap[(size_t)k * RANK]; const float x0 = c[k0 + k], x1 = c[D + k0 + k], x2 = cc[k0 + k];
            s0 += x0 / (1.f + expf(-x0)) * w; s1 += x1 / (1.f + expf(-x1)) * w; s2 += x2 / (1.f + expf(-x2)) * w;
        }
        if (half == 1) { red[j] = s0; red[256 + j] = s1; red[512 + j] = s2; }
        __syncthreads();
        if (half == 0) { float* o = rpart + (size_t)(l * 64 + kc) * 768; o[j] = s0 + red[j]; o[256 + j] = s1 + red[256 + j]; o[512 + j] = s2 + red[512 + j]; }
        __syncthreads();
    }
}
__device__ __forceinline__ void ph_mods2(const Args& a, const Frame& F) {
    const int Z = opaque_zero();
    LAS float* r = (LAS float*)F.lds;
    const float* rpart = (const float*)WSB(WS_RPART); const float* B = INP(I_ADA_B); const float* bias = INP(I_ADA_BIAS);
    for (int it = blockIdx.x; it < 4 * 48; it += F.G) {
        const int l = it / 48, nc = it % 48;
        for (int idx = F.tid; idx < 768; idx += 512) { float s = 0.f; for (int kc = 0; kc < 64; ++kc) s += rpart[(size_t)(l * 64 + kc) * 768 + idx]; r[idx] = s; }
        __syncthreads();
        const int n = nc * 512 + F.tid; const float* Bp = B + (size_t)l * RANK * 24576 + n;
        float s0 = bias[l * 24576 + n], s1 = s0, s2 = s0;
        for (int j = 0; j < RANK; ++j) { const float w = Bp[(size_t)j * 24576]; s0 += r[j] * w; s1 += r[256 + j] * w; s2 += r[512 + j] * w; }
        float* M = (float*)WSB(WS_MODS);
        M[(size_t)(l * 3 + 0) * 24576 + n] = s0; M[(size_t)(l * 3 + 1) * 24576 + n] = s1; M[(size_t)(l * 3 + 2) * 24576 + n] = s2;
        __syncthreads();
    }
}
__device__ __forceinline__ void ph_rprep(const Args& a, const Frame& F) {
    const int Z = opaque_zero();
    LAS float* tile = (LAS float*)F.lds;
    bf16_t* WRH = (bf16_t*)WSB(WS_WR); bf16_t* WRL = WRH + (size_t)4 * 3 * NE * D; float* RB = (float*)WSB(WS_RB);
    for (int it = blockIdx.x; it < 4 * 64; it += F.G) {
        const int l = it >> 6, kc = it & 63, k0 = kc * 64;
        const float* Wr = INP(I_ROUTER) + ((size_t)l * D + k0) * NE;
        for (int idx = F.tid; idx < 4096; idx += 512) tile[(idx >> 6) * 65 + (idx & 63)] = Wr[idx];
        __syncthreads();
        const float* g = INP(I_NORM_FFN) + (size_t)l * D;
        for (int c = 0; c < 3; ++c) {
            const float* sc = MODSP(a, l, c, 4); const size_t ob = (size_t)(l * 3 + c) * NE * D;
            for (int idx = F.tid; idx < 4096; idx += 512) { const int e = idx >> 6, kk = idx & 63, k = k0 + kk; const float v = tile[kk * 65 + e] * (g[k] * (1.f + sc[k]));
                const unsigned hb = __builtin_bit_cast(unsigned, v) & 0xffff0000u; const float lo = v - __builtin_bit_cast(float, hb);
                const size_t fo = ob + ((size_t)(((k >> 5) * 4 + (e >> 4)) * 64 + ((k & 31) >> 3) * 16 + (e & 15))) * 8 + (k & 7);
                WRH[fo] = (bf16_t)(hb >> 16); WRL[fo] = (bf16_t)f2bf(lo); }
        }
        __syncthreads();
    }
    for (int task = F.gw; task < 4 * 3 * NE; task += F.NGW) {
        const int l = task / 192, c = (task / 64) % 3, e = task & 63;
        const float* sh = MODSP(a, l, c, 3); const float* Wr = INP(I_ROUTER) + (size_t)l * D * NE + e; float s = 0.f;
        for (int k = F.lane; k < D; k += 64) s += sh[k] * Wr[(size_t)k * NE];
        s = wave_sum(s); if (F.lane == 0) RB[task] = s;
    }
}

__device__ __forceinline__ void transpose_item(const float* W, int N, bf16_t* WT, int ldk, int row_off, int row_mul, int koff, LAS float* scr, int item, int lane) {
    const int nblk = N / 32, kb = item / nblk, nb = item % nblk, k0 = 64 * kb, n0 = 32 * nb;
#pragma unroll 8
    for (int i = 0; i < 32; ++i) { const int kk = 2 * i + (lane >> 5); scr[kk * 33 + (lane & 31)] = W[(size_t)(k0 + kk) * N + n0 + (lane & 31)]; }
    LDS_WAIT();
    const int c = lane & 7;
#pragma unroll
    for (int j = 0; j < 4; ++j) { const int n = (lane >> 3) + 8 * j; const LAS float* s = scr + (8 * c) * 33 + n;
        u32x4 o; o.x = pk2(s[0 * 33], s[1 * 33]); o.y = pk2(s[2 * 33], s[3 * 33]); o.z = pk2(s[4 * 33], s[5 * 33]); o.w = pk2(s[6 * 33], s[7 * 33]);
        *(u32x4*)(WT + (size_t)(row_off + (n0 + n) * row_mul) * ldk + koff + k0 + 8 * c) = o; }
    LDS_WAIT();
}
__device__ __forceinline__ void transpose_item_f8(const float* W, int N, unsigned char* WT, int ldk, int row_off, int row_mul, int koff, float scale, LAS float* scr, int item, int lane) {
    const int nblk = N / 32, kb = item / nblk, nb = item % nblk, k0 = 64 * kb, n0 = 32 * nb;
#pragma unroll 8
    for (int i = 0; i < 32; ++i) { const int kk = 2 * i + (lane >> 5); scr[kk * 33 + (lane & 31)] = W[(size_t)(k0 + kk) * N + n0 + (lane & 31)]; }
    LDS_WAIT();
    const int c = lane & 7;
#pragma unroll
    for (int j = 0; j < 4; ++j) { const int n = (lane >> 3) + 8 * j; const LAS float* s = scr + (8 * c) * 33 + n;
        int lo = __builtin_amdgcn_cvt_pk_fp8_f32(s[0 * 33] * scale, s[1 * 33] * scale, 0, false); lo = __builtin_amdgcn_cvt_pk_fp8_f32(s[2 * 33] * scale, s[3 * 33] * scale, lo, true);
        int hi = __builtin_amdgcn_cvt_pk_fp8_f32(s[4 * 33] * scale, s[5 * 33] * scale, 0, false); hi = __builtin_amdgcn_cvt_pk_fp8_f32(s[6 * 33] * scale, s[7 * 33] * scale, hi, true);
        u32x2 o; o.x = (unsigned)lo; o.y = (unsigned)hi;
        *(u32x2*)(WT + (size_t)(row_off + (n0 + n) * row_mul) * ldk + koff + k0 + 8 * c) = o; }
    LDS_WAIT();
}
constexpr float WD_SCALE = 16.f, WGU_SCALE = 64.f;
__device__ __forceinline__ void conv_mat(const Frame& F, const float* W, int K, int N, bf16_t* WT, int ldk, int row_off, int row_mul, int koff, LAS float* scr) {
    const int nitems = (K / 64) * (N / 32);
    for (int it = F.gw; it < nitems; it += F.NGW) transpose_item(W, N, WT, ldk, row_off, row_mul, koff, scr, it, F.lane);
}
constexpr int WQ_CHUNK = 8;
__device__ __forceinline__ int wq_nitems(int lt) { return (((lt & 1) == 0) ? 24576 : 16384) + 8192 + 16384 + 16384 + 2048 + 2048 + 16384 + 2048; }
__device__ __forceinline__ void wq_item(const Args& a, const Frame& F, int lt, int item, LAS float* scr, int Z) {
    const int j = lt >> 1; const int n0 = ((lt & 1) == 0) ? 24576 : 16384;
    bf16_t* WIN = WSETP(WS_WIN, lt); bf16_t* WOUT = WSETP(WS_WOUT, lt); bf16_t* WGU = WSETP(WS_WGU, lt); bf16_t* WD = WSETP(WS_WD, lt);
    int it = item;
    if (it < n0) { if ((lt & 1) == 0) { if ((it % (EVEN_IN / 32)) * 32 < 6144) transpose_item_f8(INP(I_EVEN_WIN) + (size_t)j * D * EVEN_IN, EVEN_IN, (unsigned char*)WIN, D, 0, 1, 0, WGU_SCALE, scr, it, F.lane);
                                        else transpose_item(INP(I_EVEN_WIN) + (size_t)j * D * EVEN_IN, EVEN_IN, WIN, D, 0, 1, 0, scr, it, F.lane); }
                   else transpose_item_f8(INP(I_ODD_WIN) + (size_t)j * D * ODD_IN, ODD_IN, (unsigned char*)WIN, D, 0, 1, 0, WGU_SCALE, scr, it, F.lane); return; }
    it -= n0;
    if (it < 8192) { if (lt & 1) transpose_item_f8(INP(I_WOUT) + (size_t)lt * D * D, D, (unsigned char*)WOUT, D, 0, 1, 0, WGU_SCALE, scr, it, F.lane);
                     else transpose_item(INP(I_WOUT) + (size_t)lt * D * D, D, WOUT, D, 0, 1, 0, scr, it, F.lane); return; }
    it -= 8192;
    if (it < 16384) { const int e = it >> 8, li = it & 255; transpose_item_f8(INP(I_MOE_WG) + ((size_t)lt * NE + e) * D * ED, ED, (unsigned char*)WGU, D, e * 256, 2, 0, WGU_SCALE, scr, li, F.lane); return; }
    it -= 16384;
    if (it < 16384) { const int e = it >> 8, li = it & 255; transpose_item_f8(INP(I_MOE_WU) + ((size_t)lt * NE + e) * D * ED, ED, (unsigned char*)WGU, D, e * 256 + 1, 2, 0, WGU_SCALE, scr, li, F.lane); return; }
    it -= 16384;
    if (it < 2048) { transpose_item_f8(INP(I_SH_WG) + (size_t)lt * D * SHD, SHD, (unsigned char*)WGU, D, NE * 256, 2, 0, WGU_SCALE, scr, it, F.lane); return; }
    it -= 2048;
    if (it < 2048) { transpose_item_f8(INP(I_SH_WU) + (size_t)lt * D * SHD, SHD, (unsigned char*)WGU, D, NE * 256 + 1, 2, 0, WGU_SCALE, scr, it, F.lane); return; }
    it -= 2048;
    if (it < 16384) { const int e = it >> 8, li = it & 255; transpose_item_f8(INP(I_MOE_WD) + ((size_t)lt * NE + e) * ED * D, D, (unsigned char*)WD, DN_K, 0, 1, e * ED, WD_SCALE, scr, li, F.lane); return; }
    it -= 16384;
    transpose_item_f8(INP(I_SH_WD) + (size_t)lt * SHD * D, D, (unsigned char*)WD, DN_K, 0, 1, NE * ED, WD_SCALE, scr, it, F.lane);
}
__device__ __forceinline__ void wq_pull(const Args& a, const Frame& F, int lt, int arr_word) {
    const int Z = opaque_zero();
    unsigned* ctl = (unsigned*)WSB(WS_CTL);
    volatile LAS unsigned* MISC = (volatile LAS unsigned*)(F.lds + MISC_OFF);
    LAS float* scr = (LAS float*)(F.lds + F.wave * 16384);
    const int nchunks = wq_nitems(lt) / WQ_CHUNK;
    __syncthreads();
    if (arr_word >= 0 && F.tid == 0) __hip_atomic_fetch_add(ctl + arr_word, 1u, __ATOMIC_RELAXED, __HIP_MEMORY_SCOPE_AGENT);
    for (;;) {
        if (F.tid == 0) {
            unsigned c = 0xffffffffu;
            const bool go = (arr_word < 0) || (__hip_atomic_load(ctl + arr_word, __ATOMIC_RELAXED, __HIP_MEMORY_SCOPE_AGENT) < (unsigned)F.G);
            if (go) c = __hip_atomic_fetch_add(ctl + CW_WQ + lt, 1u, __ATOMIC_RELAXED, __HIP_MEMORY_SCOPE_AGENT);
            MISC[16] = c;
        }
        __syncthreads();
        const unsigned c = MISC[16];
        __syncthreads();
        if (c >= (unsigned)nchunks) break;
#pragma unroll 1
        for (int q = 0; q < WQ_CHUNK / 8; ++q) wq_item(a, F, lt, (int)c * WQ_CHUNK + F.wave * (WQ_CHUNK / 8) + q, scr, Z);
    }
}

__device__ __forceinline__ void ph_norm(const Args& a, const Frame& F, int l, int which, int gw0, int ngw, bool zero_hall = false) {
    const int Z = opaque_zero();
    bf16_t* HA = (bf16_t*)WSB(WS_P); unsigned char* H8E = (unsigned char*)WSB(WS_H8E);
    const int M = which ? ((l >= 2) ? NLAT : T) : ((l == 3) ? NLAT : T);
    const float* lat_src = (l == 0 && which == 0) ? INP(I_X) : AOUT;
    const float* cx_src = (l == 0 && which == 0) ? INP(I_CTX) : (const float*)WSB(WS_CX);
    const float* g = (which ? INP(I_NORM_FFN) : INP(I_NORM_MIX)) + (size_t)l * D;
    bf16_t* H = (bf16_t*)WSB(WS_H);
    for (int row = gw0; row < M; row += ngw) {
        const float* src = row < NLAT ? lat_src + (size_t)row * D : cx_src + (size_t)(row - NLAT) * D;
        const int c = row < SEQ ? 0 : (row < NLAT ? 1 : 2);
        const float* sh = MODSP(a, l, c, which ? 3 : 0); const float* sc = MODSP(a, l, c, which ? 4 : 1);
        f32x4 v[16]; float ss = 0.f;
#pragma unroll
        for (int j = 0; j < 16; ++j) { v[j] = ((const f32x4*)src)[F.lane + 64 * j]; ss += (v[j].x * v[j].x + v[j].y * v[j].y) + (v[j].z * v[j].z + v[j].w * v[j].w); }
        ss = wave_sum(ss);
        const float rstd = 1.0f / sqrtf(ss * (1.0f / D) + EPS);
        u32x2* o = (u32x2*)(H + (size_t)row * D);
#pragma unroll
        for (int j = 0; j < 16; ++j) { const int idx = F.lane + 64 * j; const f32x4 gg = ((const f32x4*)g)[idx], s1 = ((const f32x4*)sc)[idx], s0 = ((const f32x4*)sh)[idx];
            const f32x4 y = (v[j] * rstd) * gg; const f32x4 hh = y * (1.f + s1) + s0;
            if (which || (l & 1)) { ((unsigned*)((unsigned char*)H + (size_t)row * D))[idx] = pk4f8(hh.x, hh.y, hh.z, hh.w); }
            else { ((unsigned*)(H8E + (size_t)row * D))[idx] = pk4f8(hh.x, hh.y, hh.z, hh.w);
                   u32x2 w; w.x = pk2(hh.x, hh.y); w.y = pk2(hh.z, hh.w); o[idx] = w; } }
        if (zero_hall) { u32x4* hr = (u32x4*)((unsigned char*)HA + (size_t)row * DN_K); const u32x4 z4 = (u32x4){0u, 0u, 0u, 0u};
#pragma unroll
            for (int q = 0; q < 8; ++q) hr[F.lane + 64 * q] = z4; }
    }
}

__device__ __forceinline__ void ph_e1(const Args& a, const Frame& F, int l, bool do_a = true) {
    const int Z = opaque_zero();
    const int j2 = l >> 1;
    bf16_t* P = (bf16_t*)WSB(WS_P);
    const float* qg = INP(I_QGAIN) + j2 * 128; const float* kg = INP(I_KGAIN) + j2 * 128;
    if (do_a) for (int row = F.gw; row < T; row += F.NGW) {
        u32x4* pr = (u32x4*)(P + (size_t)row * EVEN_IN);
#pragma unroll
        for (int j = 0; j < 8; ++j) {
            const int chunk = F.lane + 64 * j; const u32x4 raw = pr[chunk];
            float x[8] = { bflo(raw.x), bfhi(raw.x), bflo(raw.y), bfhi(raw.y), bflo(raw.z), bfhi(raw.z), bflo(raw.w), bfhi(raw.w) };
            float ss = 0.f;
#pragma unroll
            for (int i = 0; i < 8; ++i) ss += x[i] * x[i];
            ss += __shfl_xor(ss, 1); ss += __shfl_xor(ss, 2); ss += __shfl_xor(ss, 4); ss += __shfl_xor(ss, 8);
            const float rstd = 1.0f / sqrtf(ss * (1.0f / 128.f) + EPS);
            const float* gp = (j < 4 ? qg : kg) + (chunk & 15) * 8;
            u32x4 o; o.x = pk2(x[0] * rstd * gp[0], x[1] * rstd * gp[1]); o.y = pk2(x[2] * rstd * gp[2], x[3] * rstd * gp[3]);
            o.z = pk2(x[4] * rstd * gp[4], x[5] * rstd * gp[5]); o.w = pk2(x[6] * rstd * gp[6], x[7] * rstd * gp[7]);
            pr[chunk] = o;
        }
    }
    LAS float* Q = (LAS float*)F.lds;
    const float* cw = INP(I_HY_CW) + (size_t)j2 * 3 * 6144; const float* cb = INP(I_HY_CB) + (size_t)j2 * 6144;
    bf16_t* UT = (bf16_t*)WSB(WS_UT); float* Z2T = (float*)WSB(WS_Z2T); typedef float f32x2e __attribute__((ext_vector_type(2)));
    __syncthreads();
    for (int it = blockIdx.x; it < 2 * 128 * 24; it += F.G) {
        const int b = it / (128 * 24), rem = it % (128 * 24), t0 = (rem / 24) * 64, ch0 = (rem % 24) * 256;
        for (int idx = F.tid; idx < 66 * 32; idx += 512) { const int rr = idx >> 5, ck = idx & 31, t = t0 - 1 + rr; u32x4 raw = (u32x4){0u, 0u, 0u, 0u};
            if (t >= 0 && t < SEQ) raw = *(const u32x4*)(P + (size_t)(b * SEQ + t) * EVEN_IN + 6144 + ch0 + 8 * ck);
            LAS float* d = Q + (ck * 66 + rr) * 9; d[0] = bflo(raw.x); d[1] = bfhi(raw.x); d[2] = bflo(raw.y); d[3] = bfhi(raw.y); d[4] = bflo(raw.z); d[5] = bfhi(raw.z); d[6] = bflo(raw.w); d[7] = bfhi(raw.w); }
        __syncthreads();
        for (int idx = F.tid; idx < 256 * 32; idx += 512) { const int ch = idx >> 5, t = (idx & 31) * 2, chg = ch0 + ch; const float w0 = cw[chg], w1 = cw[6144 + chg], w2 = cw[2 * 6144 + chg], bb = cb[chg];
            const LAS float* q = Q + ((ch >> 3) * 66 + t) * 9 + (ch & 7); const float p0 = q[0], p1 = q[9], p2 = q[18], p3 = q[27];
            const float v0 = bb + p0 * w0 + p1 * w1 + p2 * w2, v1 = bb + p1 * w0 + p2 * w1 + p3 * w2;
            if (chg < 4096) *(unsigned*)(UT + ((size_t)b * 4096 + chg) * SEQ + t0 + t) = pk2(v0, v1);
            else { f32x2e o2; o2.x = v0; o2.y = v1; *(f32x2e*)(Z2T + ((size_t)b * 2048 + (chg - 4096)) * SEQ + t0 + t) = o2; } }
        __syncthreads();
    }
}

__device__ __forceinline__ void ph_hyf(const Args& a, const Frame& F, int l) {
    const int Z = opaque_zero();
    const int j2 = l >> 1;
    const float* w1 = INP(I_HY_W1) + (size_t)j2 * 33 * 64; const float* b1 = INP(I_HY_B1) + j2 * 64;
    const float* w2 = INP(I_HY_W2) + (size_t)j2 * 4096; const float* b2 = INP(I_HY_B2) + j2 * 64;
    const float* w3 = INP(I_HY_W3) + (size_t)j2 * 4096; const float* b3 = INP(I_HY_B3) + j2 * 64;
    const float* w4 = INP(I_HY_W4) + (size_t)j2 * 64 * 8192; const float* fq = INP(I_HY_FREQ) + j2 * 192;
    float* FILT = (float*)WSB(WS_FILT); float* FILTC = (float*)WSB(WS_FILTC);
    LAS float* feats = (LAS float*)F.lds; LAS float* ha = feats + 1056; LAS float* hb = ha + 2048; LAS float* hT = hb + 2048; LAS float* tn = hT + 2048;
    const float dstart = -15.350567286626969f, dstop = -3.0701134573253945f, dstep = (dstop - dstart) / 2047.f;
    __syncthreads();
    for (int it = blockIdx.x; it < 256 + 128; it += F.G) {
        const int L = it < 256 ? SEQ : LC, t0 = (it < 256 ? it : ((it - 256) >> 4)) * 32;
        const int i_lo = it < 256 ? 0 : ((it - 256) & 15), i_hi = it < 256 ? 16 : i_lo + 1;
        const float c2pi = (float)(6.283185307179586 / (double)L), invLm1 = 1.0f / (float)(L - 1);
        for (int idx = F.tid; idx < 1056; idx += 512) { const int p = idx / 33, f = idx % 33; const float pos = (float)(t0 + p); float val;
            if (f == 0) { val = pos * invLm1; tn[p] = val; }
            else { const int bi = (f - 1) & 15; const float band = 1e-4f + (float)bi * ((15.f - 1e-4f) / 15.f); const float ang = (c2pi * pos) * band; val = (f <= 16) ? cosf(ang) : -sinf(ang); }
            feats[idx] = val; }
        __syncthreads();
        const int p = F.tid >> 4, ug = F.tid & 15;
#pragma unroll 1
        for (int q = 0; q < 4; ++q) { const int u = ug * 4 + q; float s = b1[u];
#pragma unroll 3
            for (int f = 0; f < 33; ++f) s += feats[p * 33 + f] * w1[f * 64 + u];
            ha[p * 64 + u] = sinf(fq[u] * s); }
        __syncthreads();
#pragma unroll 1
        for (int q = 0; q < 4; ++q) { const int u = ug * 4 + q; float s = b2[u];
#pragma unroll 4
            for (int m = 0; m < 64; ++m) s += ha[p * 64 + m] * w2[m * 64 + u];
            hb[p * 64 + u] = sinf(fq[64 + u] * s); }
        __syncthreads();
#pragma unroll 1
        for (int q = 0; q < 4; ++q) { const int u = ug * 4 + q; float s = b3[u];
#pragma unroll 4
            for (int m = 0; m < 64; ++m) s += hb[p * 64 + m] * w3[m * 64 + u];
            hT[(u >> 2) * 128 + (p >> 4) * 64 + (u & 3) * 16 + (p & 15)] = sinf(fq[128 + u] * s); }
        __syncthreads();
        {   const int j = F.lane & 15, kq = F.lane >> 4; const int cb_lo = i_lo * 32, cb_hi = i_hi * 32;
            const float rstep = -invLm1;
            float bvn[16];
            { const float* wp = w4 + (size_t)kq * 8192 + (cb_lo + F.wave) * 16 + j;
#pragma unroll
              for (int sk = 0; sk < 16; ++sk) bvn[sk] = wp[(size_t)sk * 4 * 8192]; }
#pragma unroll 1
            for (int cb = cb_lo + F.wave; cb < cb_hi; cb += 8) {
                const int n = cb * 16 + j;
                float bv[16];
#pragma unroll
                for (int sk = 0; sk < 16; ++sk) bv[sk] = bvn[sk];
                if (cb + 8 < cb_hi) { const float* wp = w4 + (size_t)kq * 8192 + (cb + 8) * 16 + j;
#pragma unroll
                    for (int sk = 0; sk < 16; ++sk) bvn[sk] = wp[(size_t)sk * 4 * 8192]; }
                f32x4 acc0 = (f32x4){0.f, 0.f, 0.f, 0.f}, acc1 = (f32x4){0.f, 0.f, 0.f, 0.f};
#pragma unroll
                for (int sk = 0; sk < 16; ++sk) { const float a0 = hT[sk * 128 + F.lane], a1 = hT[sk * 128 + 64 + F.lane];
                    acc0 = __builtin_amdgcn_mfma_f32_16x16x4f32(a0, bv[sk], acc0, 0, 0, 0); acc1 = __builtin_amdgcn_mfma_f32_16x16x4f32(a1, bv[sk], acc1, 0, 0, 0); }
                const int dir = n >> 12, o = (n >> 11) & 1, c = n & 2047; const float delta = fabsf(dstart + (float)c * dstep);
                const float ratio = expf(rstep * delta), e0 = expf(-tn[4 * kq] * delta), e1 = expf(-tn[16 + 4 * kq] * delta);
                float* dst = (L == SEQ) ? FILT + (((size_t)(c * 2 + o) * 2 + dir) * SEQ + t0) : FILTC + (((size_t)(c * 2 + o) * 2 + dir) * LC + t0);
                f32x4 v0, v1; float d0 = e0, d1 = e1;
                v0.x = acc0.x * d0; v1.x = acc1.x * d1; d0 *= ratio; d1 *= ratio; v0.y = acc0.y * d0; v1.y = acc1.y * d1; d0 *= ratio; d1 *= ratio;
                v0.z = acc0.z * d0; v1.z = acc1.z * d1; d0 *= ratio; d1 *= ratio; v0.w = acc0.w * d0; v1.w = acc1.w * d1;
                *(f32x4*)(dst + 4 * kq) = v0; *(f32x4*)(dst + 16 + 4 * kq) = v1;
            }
        }
        __syncthreads();
    }
}

typedef short bf16x8v __attribute__((ext_vector_type(8)));
#define GAS __attribute__((address_space(1)))
typedef const GAS char* gcp_t;
__device__ __forceinline__ float xmax16_32(float v) {
    const unsigned u = __builtin_bit_cast(unsigned, v);
    const auto r = __builtin_amdgcn_permlane32_swap(u, u, false, false);
    unsigned a0 = r[0], a1 = r[1]; asm volatile("" : "+v"(a0), "+v"(a1));
    const float m = fmaxf(__builtin_bit_cast(float, a0), __builtin_bit_cast(float, a1));
    const unsigned um = __builtin_bit_cast(unsigned, m);
    const auto r2 = __builtin_amdgcn_permlane16_swap(um, um, false, false);
    unsigned b0 = r2[0], b1 = r2[1]; asm volatile("" : "+v"(b0), "+v"(b1));
    return fmaxf(__builtin_bit_cast(float, b0), __builtin_bit_cast(float, b1));
}
__device__ __forceinline__ void ph_attn(const Args& a, const Frame& F, int l) {
    const int Z = opaque_zero();
    const int j2 = l >> 1;
    const bf16_t* P = (const bf16_t*)WSB(WS_P); bf16_t* MIX = (bf16_t*)WSB(WS_MIX);
    const int wv = __builtin_amdgcn_readfirstlane(F.wave);
    LAS unsigned char* KT = F.lds;
    LAS unsigned char* VT = F.lds + 32768;
    LAS float* rp = (LAS float*)(F.lds + 65536);
    const unsigned vt_addr = (unsigned)(size_t)VT;
    const int j = F.lane & 15, kq = F.lane >> 4;
    const float qscale = 0.08838834764831845f * 1.4426950408889634f;
    const unsigned koff = (unsigned)((j * EVEN_IN + 8 * kq) * 2);
    unsigned foff[2];
#pragma unroll
    for (int u = 0; u < 2; ++u) foff[u] = (unsigned)((8 * wv + 4 * u + kq) * (EVEN_IN * 2) + ((j ^ ((kq << 2) | ((2 * wv + u) & 3))) * 16));
    const bool fast = (F.G & 15) == 0;
    const int nst = 128 + (l == 0 ? 4 : 0);
    unsigned gs = 0;
#pragma unroll 1
    for (int h = fast ? ((int)blockIdx.x & 15) : 0; h < 16; h += (fast ? 16 : 1)) {
        const float* rpb = INP(I_RPB) + ((size_t)j2 * 16 + h) * 465;
        __syncthreads();
        for (int idx = F.tid; idx < 465; idx += 512) rp[idx] = rpb[idx] * 1.4426950408889634f;
        __syncthreads();
        const int w0 = fast ? ((int)blockIdx.x >> 4) : (int)blockIdx.x, nw = fast ? (F.G >> 4) : F.G;
#pragma unroll 1
        for (int st = w0; st < nst; st += nw) {
            int b, nwin, c0 = 0, ws_ = 0, rs = 0, r = 0, rsA = 0; size_t qrow0;
            if (st < 128) { const int r0 = (st & 63) * 2; b = st >> 6; r = r0 + (wv >> 2); c0 = (wv & 3) * 16; ws_ = min(max(c0 - 8, 0), 32); rs = min(max(r - 4, 0), 120);
                rsA = min(max(r0 - 4, 0), 120); nwin = min(max(r0 - 3, 0), 120) + 8 - rsA; qrow0 = (size_t)b * SEQ + r * 64 + c0; }
            else { const int t2 = st - 128; b = t2 >> 1; qrow0 = (size_t)NLAT + b * LC + ((t2 & 1) * 8 + wv) * 16; nwin = 0; }
            const int nsteps = nwin + 4;
            bf16x8v qf[4];
            { unsigned long long qbi = (unsigned long long)(P + qrow0 * EVEN_IN + h * 128); asm volatile("" : "+s"(qbi)); const gcp_t qb = (gcp_t)qbi;
              unsigned _ko = koff; asm volatile("" : "+v"(_ko));
#pragma unroll
              for (int s = 0; s < 4; ++s) qf[s] = *(const GAS bf16x8v*)(qb + 64 * s + _ko); }
            u32x4 fr[4];
#define ATT_FETCH(s_) do { const int _s = (s_); const size_t _tok0 = (_s < nwin) ? ((size_t)b * SEQ + (rsA + _s) * 64) : ((size_t)NLAT + b * LC + (_s - nwin) * 64); \
            unsigned long long _kbi = (unsigned long long)(P + _tok0 * EVEN_IN + 2048 + h * 128); asm volatile("" : "+s"(_kbi)); const gcp_t _kb = (gcp_t)_kbi; \
            _Pragma("unroll") for (int u = 0; u < 2; ++u) { unsigned _fo = foff[u]; asm volatile("" : "+v"(_fo)); \
                fr[u] = *(const GAS u32x4*)(_kb + _fo); fr[2 + u] = *(const GAS u32x4*)(_kb + 4096 + _fo); } } while (0)
#define ATT_PUT(bf_) do { _Pragma("unroll") for (int u = 0; u < 2; ++u) { \
                *(LAS u32x4*)(KT + (bf_) * 16384 + (2 * wv + u) * 1024 + F.lane * 16) = fr[u]; *(LAS u32x4*)(VT + (bf_) * 16384 + (2 * wv + u) * 1024 + F.lane * 16) = fr[2 + u]; } } while (0)
            ATT_FETCH(0);
            const int cq = c0 + j, cs = min(max(cq - 8, 0), 48);
            int dcv[8]; float madd[8];
#pragma unroll
            for (int e = 0; e < 8; ++e) { const int kcol = ws_ + 8 * kq + e; dcv[e] = min(max(kcol - cq + 15, 0), 30); madd[e] = ((unsigned)(kcol - cs) < 16u) ? 0.f : -1e30f; asm volatile("" : "+v"(madd[e])); }
            unsigned KBw[2], KBc[2], VBw[2], VBc[2];
#pragma unroll
            for (int t = 0; t < 2; ++t) {
                { const unsigned row = (unsigned)(ws_ + 8 * (j >> 2) + (j & 3) + 4 * t), y = (row >> 2) & 3u; KBw[t] = 256u * row + 16u * ((unsigned)kq ^ y) + 64u * (unsigned)(j & 3); }
                { const unsigned row = (unsigned)(8 * (j >> 2) + (j & 3) + 4 * t), y = (row >> 2) & 3u; KBc[t] = 256u * row + 16u * ((unsigned)kq ^ y) + 64u * (unsigned)(j & 3); }
                const unsigned q = (unsigned)j >> 2, p = (unsigned)j & 3u, bq = p >> 1;
                { const unsigned row = (unsigned)(ws_ + 8 * kq + 4 * t) + q, X = (q << 2) | ((row >> 2) & 3u); VBw[t] = 256u * row + 16u * (bq ^ X) + 8u * (p & 1u); }
                { const unsigned row = (unsigned)(8 * kq + 4 * t) + q, X = (q << 2) | ((row >> 2) & 3u); VBc[t] = 256u * row + 16u * (bq ^ X) + 8u * (p & 1u); }
            }
            f32x4 o[8];
#pragma unroll
            for (int d = 0; d < 8; ++d) o[d] = (f32x4){0.f, 0.f, 0.f, 0.f};
            float mrun = -1e30f, lsum = 0.f;
#define ATT_GROUP(KB0_, KB1_, VB0_, VB1_, XO_, WIN, brow_) do { \
            bf16x8v kf[8]; \
            _Pragma("unroll") for (int s = 0; s < 4; ++s) { kf[s] = *(const LAS bf16x8v*)(KT + (((KB0_) ^ (64u * s)) + (XO_))); kf[4 + s] = *(const LAS bf16x8v*)(KT + (((KB1_) ^ (64u * s)) + (XO_))); } \
            float bias[8]; \
            if (WIN) { const LAS float* rrow = rp + (brow_) * 31; \
                _Pragma("unroll") for (int e = 0; e < 8; ++e) bias[e] = rrow[dcv[e]]; } \
            f32x4 s0 = (f32x4){0.f, 0.f, 0.f, 0.f}, s1 = (f32x4){0.f, 0.f, 0.f, 0.f}; \
            _Pragma("unroll") for (int s = 0; s < 4; ++s) { s0 = __builtin_amdgcn_mfma_f32_16x16x32_bf16(kf[s], qf[s], s0, 0, 0, 0); s1 = __builtin_amdgcn_mfma_f32_16x16x32_bf16(kf[4 + s], qf[s], s1, 0, 0, 0); } \
            if (WIN) asm volatile("" : "+v"(bias[0]), "+v"(bias[1]), "+v"(bias[2]), "+v"(bias[3]), "+v"(bias[4]), "+v"(bias[5]), "+v"(bias[6]), "+v"(bias[7]));     \
            else asm volatile("" : "+v"(s0), "+v"(s1)); \
            u32x2 tr[8][2]; unsigned rd[8][2]; \
            _Pragma("unroll") for (int d = 0; d < 8; ++d) { rd[d][0] = vt_addr + ((VB0_) ^ (32u * d)); rd[d][1] = vt_addr + ((VB1_) ^ (32u * d)); } \
            asm volatile("ds_read_b64_tr_b16 %0, %8 offset:%16\n\tds_read_b64_tr_b16 %1, %9 offset:%16\n\tds_read_b64_tr_b16 %2, %10 offset:%16\n\tds_read_b64_tr_b16 %3, %11 offset:%16\n\t" \
                         "ds_read_b64_tr_b16 %4, %12 offset:%16\n\tds_read_b64_tr_b16 %5, %13 offset:%16\n\tds_read_b64_tr_b16 %6, %14 offset:%16\n\tds_read_b64_tr_b16 %7, %15 offset:%16" \
                : "=&v"(tr[0][0]), "=&v"(tr[0][1]), "=&v"(tr[1][0]), "=&v"(tr[1][1]), "=&v"(tr[2][0]), "=&v"(tr[2][1]), "=&v"(tr[3][0]), "=&v"(tr[3][1]) \
                : "v"(rd[0][0]), "v"(rd[0][1]), "v"(rd[1][0]), "v"(rd[1][1]), "v"(rd[2][0]), "v"(rd[2][1]), "v"(rd[3][0]), "v"(rd[3][1]), "i"(XO_)); \
            asm volatile("ds_read_b64_tr_b16 %0, %8 offset:%16\n\tds_read_b64_tr_b16 %1, %9 offset:%16\n\tds_read_b64_tr_b16 %2, %10 offset:%16\n\tds_read_b64_tr_b16 %3, %11 offset:%16\n\t" \
                         "ds_read_b64_tr_b16 %4, %12 offset:%16\n\tds_read_b64_tr_b16 %5, %13 offset:%16\n\tds_read_b64_tr_b16 %6, %14 offset:%16\n\tds_read_b64_tr_b16 %7, %15 offset:%16" \
                : "=&v"(tr[4][0]), "=&v"(tr[4][1]), "=&v"(tr[5][0]), "=&v"(tr[5][1]), "=&v"(tr[6][0]), "=&v"(tr[6][1]), "=&v"(tr[7][0]), "=&v"(tr[7][1]) \
                : "v"(rd[4][0]), "v"(rd[4][1]), "v"(rd[5][0]), "v"(rd[5][1]), "v"(rd[6][0]), "v"(rd[6][1]), "v"(rd[7][0]), "v"(rd[7][1]), "i"(XO_)); \
            float sv[8]; \
            _Pragma("unroll") for (int e = 0; e < 8; ++e) sv[e] = WIN ? fmaf((e >> 2) ? s1[e & 3] : s0[e & 3], qscale, bias[e]) + madd[e] : ((e >> 2) ? s1[e & 3] : s0[e & 3]) * qscale; \
            float gmax = sv[0]; \
            _Pragma("unroll") for (int e = 1; e < 8; ++e) gmax = fmaxf(gmax, sv[e]); \
            gmax = xmax16_32(gmax); \
            const float mnew = fmaxf(mrun, gmax), alpha = __builtin_amdgcn_exp2f(mrun - mnew); \
            if (__builtin_amdgcn_ballot_w64(mnew > mrun) != 0ull) { _Pragma("unroll") for (int d = 0; d < 8; ++d) o[d] = o[d] * alpha; } \
            mrun = mnew; \
            float p[8], psum = 0.f; \
            _Pragma("unroll") for (int e = 0; e < 8; ++e) { p[e] = __builtin_amdgcn_exp2f(sv[e] - mnew); psum += p[e]; } \
            lsum = lsum * alpha + psum; \
            union { bf16x8v v; unsigned u[4]; } pf; \
            pf.u[0] = pk2(p[0], p[1]); pf.u[1] = pk2(p[2], p[3]); pf.u[2] = pk2(p[4], p[5]); pf.u[3] = pk2(p[6], p[7]); \
            asm volatile("s_waitcnt lgkmcnt(0)" : "+v"(tr[0][0]), "+v"(tr[0][1]), "+v"(tr[1][0]), "+v"(tr[1][1]), "+v"(tr[2][0]), "+v"(tr[2][1]), "+v"(tr[3][0]), "+v"(tr[3][1]), \
                                                  "+v"(tr[4][0]), "+v"(tr[4][1]), "+v"(tr[5][0]), "+v"(tr[5][1]), "+v"(tr[6][0]), "+v"(tr[6][1]), "+v"(tr[7][0]), "+v"(tr[7][1]) :: "memory"); \
            _Pragma("unroll") for (int d = 0; d < 8; ++d) { union { bf16x8v v; unsigned u[4]; } vf; vf.u[0] = tr[d][0].x; vf.u[1] = tr[d][0].y; vf.u[2] = tr[d][1].x; vf.u[3] = tr[d][1].y; \
                o[d] = __builtin_amdgcn_mfma_f32_16x16x32_bf16(vf.v, pf.v, o[d], 0, 0, 0); } } while (0)
#pragma unroll 1
            for (int step = 0; step < nsteps; ++step, ++gs) {
                ATT_PUT(gs & 1u);
                __syncthreads();
                if (step + 1 < nsteps) ATT_FETCH(step + 1);
                const unsigned bo = (gs & 1u) * 16384u;
                if (step < nwin) {
                    const int g = rsA + step - rs;
                    if ((unsigned)g < 8u) { const unsigned k0 = KBw[0] + bo, k1 = KBw[1] + bo, v0 = VBw[0] + bo, v1 = VBw[1] + bo; ATT_GROUP(k0, k1, v0, v1, 0, true, rs + g - r + 7); }
                } else {
                    const unsigned k0 = KBc[0] + bo, k1 = KBc[1] + bo, v0 = VBc[0] + bo, v1 = VBc[1] + bo;
                    ATT_GROUP(k0, k1, v0, v1, 0, false, 0);
                    ATT_GROUP(k0, k1, v0, v1, 8192, false, 0);
                }
            }
#undef ATT_FETCH
#undef ATT_PUT
#undef ATT_GROUP
            lsum += __shfl_xor(lsum, 16); lsum += __shfl_xor(lsum, 32);
            const float inv = 1.0f / lsum;
#pragma unroll
            for (int d = 0; d < 8; ++d) { u32x2 w; w.x = pk2(o[d].x * inv, o[d].y * inv); w.y = pk2(o[d].z * inv, o[d].w * inv);
                *(u32x2*)(MIX + (qrow0 + j) * D + h * 128 + 16 * d + 4 * kq) = w; }
        }
    }
    __syncthreads();
}

__device__ __forceinline__ float wave_sum_o(float v) {
    int ln = (int)__builtin_amdgcn_mbcnt_hi(~0u, __builtin_amdgcn_mbcnt_lo(~0u, 0u)); asm volatile("" : "+v"(ln));
#pragma unroll
    for (int o = 1; o < 64; o <<= 1) v += __builtin_bit_cast(float, __builtin_amdgcn_ds_bpermute((ln ^ o) << 2, __builtin_bit_cast(int, v)));
    return v;
}
__device__ __forceinline__ float block_sum(const Frame& F, float v, LAS float* red) {
    v = wave_sum_o(v);
    __syncthreads();
    if (F.lane == 0) red[F.wave] = v;
    __syncthreads();
    float s = 0.f;
#pragma unroll
    for (int w = 0; w < 8; ++w) s += red[w];
    return s;
}
typedef float f32x2 __attribute__((ext_vector_type(2)));
#define FP(idx) ((idx) + ((idx) >> 5))
__device__ constexpr int BR5[32] = {0,16,8,24,4,20,12,28,2,18,10,26,6,22,14,30,1,17,9,25,5,21,13,29,3,19,11,27,7,23,15,31};
__device__ constexpr int BR4[16] = {0,8,4,12,2,10,6,14,1,9,5,13,3,11,7,15};
#define brevn(s, bits) ((bits) == 5 ? BR5[(s)] : BR4[(s)])
__device__ __forceinline__ f32x2 cswap(f32x2 a) { f32x2 r; r.x = a.y; r.y = -a.x; return r; }
__device__ __forceinline__ f32x2 cmul(f32x2 a, f32x2 w) { f32x2 t; t.x = -a.y; t.y = a.x; return a * w.x + t * w.y; }
__device__ __forceinline__ f32x2 cmulc(f32x2 a, f32x2 w) { f32x2 t; t.x = a.y; t.y = -a.x; f32x2 r = a * w.x + t * w.y; r.y = -r.y; return r; }
template <int R> __device__ __forceinline__ void dif(f32x2 (&x)[R]) {
    constexpr float C32[16] = { 1.f, 0.98078528040323043f, 0.92387953251128674f, 0.83146961230254524f, 0.70710678118654752f, 0.55557023301960218f, 0.38268343236508978f, 0.19509032201612825f,
                                0.f, -0.19509032201612825f, -0.38268343236508978f, -0.55557023301960218f, -0.70710678118654752f, -0.83146961230254524f, -0.92387953251128674f, -0.98078528040323043f };
    constexpr float S32[16] = { 0.f, 0.19509032201612825f, 0.38268343236508978f, 0.55557023301960218f, 0.70710678118654752f, 0.83146961230254524f, 0.92387953251128674f, 0.98078528040323043f,
                                1.f, 0.98078528040323043f, 0.92387953251128674f, 0.83146961230254524f, 0.70710678118654752f, 0.55557023301960218f, 0.38268343236508978f, 0.19509032201612825f };
#pragma unroll
    for (int h = R / 2; h >= 1; h >>= 1) {
#pragma unroll
        for (int b = 0; b < R; b += 2 * h) {
#pragma unroll
            for (int k = 0; k < h; ++k) {
                const int i0 = b + k, i1 = b + k + h, ti = k * (16 / h);
                const f32x2 u = x[i0], v = x[i1];
                x[i0] = u + v;
                const f32x2 d = u - v;
                if (ti == 0) x[i1] = d;
                else if (ti == 8) x[i1] = cswap(d);
                else x[i1] = d * C32[ti] + cswap(d) * S32[ti];
            }
        }
    }
}
struct FftCtx { LAS f32x2* X; const LAS f32x2* TW; int tid; };
__device__ __forceinline__ void fft_fwd_A(const FftCtx& f, f32x2 (&x)[32]) {
    dif<32>(x);
    __builtin_amdgcn_sched_barrier(0);
    const int i = f.tid; const f32x2 w = f.TW[i]; f32x2 cw; cw.x = 1.f; cw.y = 0.f;
    __syncthreads();
    LAS f32x2* XA = f.X + (i + (i >> 5));
    XA[0] = x[0];
#pragma unroll
    for (int r = 1; r < 32; ++r) { __builtin_amdgcn_sched_barrier(0); cw = cmul(cw, w); XA[528 * r] = cmul(x[brevn(r, 5)], cw); }
    __syncthreads();
}
__device__ __forceinline__ void fft_fwd_BC(const FftCtx& f, f32x2 (&x)[32]) {
#pragma unroll 1
    for (int u = 0; u < 2; ++u) {
        const int q = f.tid + 512 * u, r = q >> 5, i2 = q & 31;
        f32x2 y[16]; LAS f32x2* XB = f.X + (528 * r + i2);
#pragma unroll
        for (int j2 = 0; j2 < 16; ++j2) y[j2] = XB[33 * j2];
        dif<16>(y);
        __builtin_amdgcn_sched_barrier(0);
        const f32x2 w = f.TW[32 * i2]; f32x2 cw; cw.x = 1.f; cw.y = 0.f;
        XB[0] = y[0];
#pragma unroll
        for (int r2 = 1; r2 < 16; ++r2) { __builtin_amdgcn_sched_barrier(0); cw = cmul(cw, w); XB[33 * r2] = cmul(y[brevn(r2, 4)], cw); }
    }
    __syncthreads();
    { const LAS f32x2* XC = f.X + 33 * f.tid;
#pragma unroll
      for (int m = 0; m < 32; ++m) x[m] = XC[m]; }
    dif<32>(x);
}
__device__ __forceinline__ void fft_inv(const FftCtx& f, f32x2 (&x)[32]) {
    {   f32x2 t[32];
#pragma unroll
        for (int k = 0; k < 32; ++k) { t[k] = x[brevn(k, 5)]; t[k].y = -t[k].y; }
        dif<32>(t);
        LAS f32x2* XC = f.X + 33 * f.tid;
#pragma unroll
        for (int s = 0; s < 32; ++s) { f32x2 v = t[s]; v.y = -v.y; XC[brevn(s, 5)] = v; }
    }
    __syncthreads();
#pragma unroll 1
    for (int u = 0; u < 2; ++u) {
        const int q = f.tid + 512 * u, r = q >> 5, i2 = q & 31;
        f32x2 y[16];
        const f32x2 w = f.TW[32 * i2]; f32x2 cw; cw.x = 1.f; cw.y = 0.f; LAS f32x2* XB = f.X + (528 * r + i2);
        { f32x2 v = XB[0]; v.y = -v.y; y[0] = v; }
#pragma unroll
        for (int r2 = 1; r2 < 16; ++r2) { __builtin_amdgcn_sched_barrier(0); cw = cmul(cw, w); f32x2 v = XB[33 * r2]; v.y = -v.y; y[r2] = cmul(v, cw); }
        dif<16>(y);
#pragma unroll
        for (int s = 0; s < 16; ++s) { f32x2 v = y[s]; v.y = -v.y; XB[33 * brevn(s, 4)] = v; }
    }
    __syncthreads();
    {   const int i = f.tid; const f32x2 w = f.TW[i]; f32x2 cw; cw.x = 1.f; cw.y = 0.f; const LAS f32x2* XA = f.X + (i + (i >> 5));
        { f32x2 v = XA[0]; v.y = -v.y; x[0] = v; }
#pragma unroll
        for (int r = 1; r < 32; ++r) { __builtin_amdgcn_sched_barrier(0); cw = cmul(cw, w); f32x2 v = XA[528 * r]; v.y = -v.y; x[r] = cmul(v, cw); }
        dif<32>(x);
#pragma unroll
        for (int s = 0; s < 32; ++s) x[s].y = -x[s].y;
    }
}
__device__ __forceinline__ void ph_hyc(const Args& a, const Frame& F, int l) {
    const int Z = opaque_zero();
    const int j2 = l >> 1;
    const float* FILT = (const float*)WSB(WS_FILT); const bf16_t* UT = (const bf16_t*)WSB(WS_UT); float* Z2T = (float*)WSB(WS_Z2T);
    const float* skip = INP(I_HY_SKIP) + (size_t)j2 * 2 * 2048;
    FftCtx f; f.X = (LAS f32x2*)F.lds; f.TW = (const LAS f32x2*)(F.lds + 135168); f.tid = F.tid;
    LAS float* red = (LAS float*)(F.lds + 135168 + 8192);
    { LAS f32x2* tw = (LAS f32x2*)(F.lds + 135168);
      for (int m = F.tid; m < 1024; m += 512) { float sn, cs; sincosf(-6.283185307179586f * (float)m * (1.0f / 16384.f), &sn, &cs); f32x2 v; v.x = cs; v.y = sn; tw[m] = v; } }
    __syncthreads();
    const unsigned tu = (unsigned)F.tid, trv = 511u - (unsigned)F.tid;
    for (int c = blockIdx.x; c < 2048; c += F.G) {
        f32x2 nd[16];
        { const float* z0p = Z2T + ((size_t)0 * 2048 + c) * SEQ; const float* z1p = Z2T + ((size_t)1 * 2048 + c) * SEQ;
#pragma unroll
          for (int j = 0; j < 16; ++j) { unsigned long long a0 = (unsigned long long)(z0p + 512 * j), a1 = (unsigned long long)(z1p + 512 * j); asm volatile("" : "+s"(a0), "+s"(a1)); nd[j].x = ((const GAS float*)a0)[tu]; nd[j].y = ((const GAS float*)a1)[tu]; } }
#pragma unroll 1
        for (int o = 0; o < 2; ++o) {
            const float* fwd = FILT + ((size_t)(c * 2 + o) * 2 + 0) * SEQ; const float* bwd = fwd + SEQ;
            f32x2 kx[32]; float ss = 0.f;
#pragma unroll
            for (int j = 0; j < 32; ++j) { float v;
                if (j < 16) v = (fwd + 512 * j)[tu]; else { v = (bwd + (SEQ - 512 * (j - 16) - 511))[trv]; if (j == 16 && F.tid == 0) v = 0.f; }
                kx[j].x = v; kx[j].y = 0.f; ss += v * v; }
            fft_fwd_A(f, kx); fft_fwd_BC(f, kx);
            const float tot = block_sum(F, ss, red);
            const float sc = (1.0f / sqrtf(tot + EPS)) * (1.0f / 16384.f);
            const float skn = skip[o * 2048 + c] * (1.0f / 16384.f);
#pragma unroll
            for (int s = 0; s < 32; ++s) { kx[s] = kx[s] * sc; kx[s].x += skn; }
            f32x2 dx[32];
#pragma unroll
            for (int j = 0; j < 32; ++j) { if (j < 16) dx[j] = nd[j]; else { dx[j].x = 0.f; dx[j].y = 0.f; } }
            fft_fwd_A(f, dx); fft_fwd_BC(f, dx);
#pragma unroll
            for (int s = 0; s < 32; ++s) dx[s] = cmul(dx[s], kx[s]);
            const bf16_t* g0p = UT + ((size_t)0 * 4096 + o * 2048 + c) * SEQ; const bf16_t* g1p = UT + ((size_t)1 * 4096 + o * 2048 + c) * SEQ;
            unsigned short gt0[16], gt1[16];
#pragma unroll
            for (int j = 0; j < 16; ++j) { unsigned long long a0 = (unsigned long long)(g0p + 512 * j), a1 = (unsigned long long)(g1p + 512 * j); asm volatile("" : "+s"(a0), "+s"(a1));
                gt0[j] = ((const GAS bf16_t*)a0)[tu]; gt1[j] = ((const GAS bf16_t*)a1)[tu]; }
            fft_inv(f, dx);
            float* o0p = Z2T + ((size_t)0 * 2048 + c) * SEQ; float* o1p = Z2T + ((size_t)1 * 2048 + c) * SEQ;
#pragma unroll
            for (int j = 0; j < 16; ++j) { const int s = brevn(j, 5);
                nd[j].x = bf2f(gt0[j]) * dx[s].x; nd[j].y = bf2f(gt1[j]) * dx[s].y; }
            if (o == 1) {
#pragma unroll
                for (int j = 0; j < 16; ++j) { unsigned long long b0 = (unsigned long long)(o0p + 512 * j), b1 = (unsigned long long)(o1p + 512 * j); asm volatile("" : "+s"(b0), "+s"(b1));
                    ((GAS float*)b0)[tu] = nd[j].x; ((GAS float*)b1)[tu] = nd[j].y; }
            }
        }
    }
}

__device__ __forceinline__ void ph_hyx(const Args& a, const Frame& F, int l) {
    const int Z = opaque_zero();
    const int j2 = l >> 1;
    const bf16_t* P = (const bf16_t*)WSB(WS_P); bf16_t* MIX = (bf16_t*)WSB(WS_MIX); const float* FILTC = (const float*)WSB(WS_FILTC);
    const float* cw = INP(I_HY_CW) + (size_t)j2 * 3 * 6144; const float* cb = INP(I_HY_CB) + (size_t)j2 * 6144; const float* skip = INP(I_HY_SKIP) + (size_t)j2 * 2 * 2048;
    LAS float* us = (LAS float*)F.lds;
    LAS float* Hh = us + 3 * 2 * 256 * 8;
    LAS float* red = Hh + 2 * 8 * 512;
    const int b = F.tid >> 8, t = F.tid & 255;
    for (int cg = blockIdx.x; cg < 256; cg += F.G) {
        const int c0 = cg * 8;
        __syncthreads();
#pragma unroll 1
        for (int part = 0; part < 3; ++part) { const int ch0 = part * 2048 + c0; float v[8];
#pragma unroll
            for (int k = 0; k < 8; ++k) v[k] = cb[ch0 + k];
#pragma unroll
            for (int i = 0; i < 3; ++i) { const int tt = t + i - 1; if (tt >= 0 && tt < LC) { const u32x4 raw = *(const u32x4*)(P + (size_t)(NLAT + b * LC + tt) * EVEN_IN + 6144 + ch0); const float* w = cw + i * 6144 + ch0;
                v[0] += bflo(raw.x) * w[0]; v[1] += bfhi(raw.x) * w[1]; v[2] += bflo(raw.y) * w[2]; v[3] += bfhi(raw.y) * w[3]; v[4] += bflo(raw.z) * w[4]; v[5] += bfhi(raw.z) * w[5]; v[6] += bflo(raw.w) * w[6]; v[7] += bfhi(raw.w) * w[7]; } }
            LAS f32x4* d = (LAS f32x4*)(us + ((part * 2 + b) * 256 + t) * 8); d[0] = (f32x4){v[0], v[1], v[2], v[3]}; d[1] = (f32x4){v[4], v[5], v[6], v[7]}; }
#pragma unroll 1
        for (int m = 0; m < 8; ++m) { const int idx = F.tid + 512 * m, ok = idx >> 8, d = idx & 255, o = ok >> 3, k = ok & 7;
            const float* fwd = FILTC + ((size_t)((c0 + k) * 2 + o) * 2 + 0) * LC; const float f = fwd[d]; float ss = f * f; Hh[ok * 512 + 256 + d] = f;
            if (d >= 1) { const float g = fwd[LC + d]; Hh[ok * 512 + 256 - d] = g; ss += g * g; } else Hh[ok * 512] = 0.f;
            ss = wave_sum_o(ss); if (F.lane == 0) red[ok * 4 + (F.wave & 3)] = ss; }
        __syncthreads();
#pragma unroll 1
        for (int o = 0; o < 2; ++o) {
            float acc[8];
#pragma unroll
            for (int k = 0; k < 8; ++k) acc[k] = 0.f;
            const LAS float* zb = us + (2 * 2 + b) * 256 * 8; const LAS float* hb = Hh + (o * 8) * 512 + 256 + t;
            for (int sidx = 0; sidx < LC; ++sidx) { const f32x4 z0 = *(const LAS f32x4*)(zb + sidx * 8), z1 = *(const LAS f32x4*)(zb + sidx * 8 + 4);
                acc[0] += hb[0 * 512 - sidx] * z0.x; acc[1] += hb[1 * 512 - sidx] * z0.y; acc[2] += hb[2 * 512 - sidx] * z0.z; acc[3] += hb[3 * 512 - sidx] * z0.w;
                acc[4] += hb[4 * 512 - sidx] * z1.x; acc[5] += hb[5 * 512 - sidx] * z1.y; acc[6] += hb[6 * 512 - sidx] * z1.z; acc[7] += hb[7 * 512 - sidx] * z1.w; }
            float zn[8];
#pragma unroll
            for (int k = 0; k < 8; ++k) { const int ok = o * 8 + k; const float fscale = 1.0f / sqrtf(red[ok * 4] + red[ok * 4 + 1] + red[ok * 4 + 2] + red[ok * 4 + 3] + EPS);
                const float y = acc[k] * fscale + zb[t * 8 + k] * skip[o * 2048 + c0 + k]; zn[k] = us[((o * 2 + b) * 256 + t) * 8 + k] * y; }
            __syncthreads();
            if (o == 0) { LAS f32x4* d = (LAS f32x4*)(us + ((2 * 2 + b) * 256 + t) * 8); d[0] = (f32x4){zn[0], zn[1], zn[2], zn[3]}; d[1] = (f32x4){zn[4], zn[5], zn[6], zn[7]}; __syncthreads(); }
            else { u32x4 w; w.x = pk2(zn[0], zn[1]); w.y = pk2(zn[2], zn[3]); w.z = pk2(zn[4], zn[5]); w.w = pk2(zn[6], zn[7]); *(u32x4*)(MIX + (size_t)(NLAT + b * LC + t) * D + 2048 + c0) = w; }
        }
    }
}
__device__ __forceinline__ void ph_hyt(const Args& a, const Frame& F) {
    const int Z = opaque_zero();
    const float* Z2T = (const float*)WSB(WS_Z2T); bf16_t* MIX = (bf16_t*)WSB(WS_MIX);
    LAS float* tile = (LAS float*)F.lds;
    for (int it = blockIdx.x; it < 2 * 128 * 32; it += F.G) {
        const int b = it >> 12, t0 = ((it >> 5) & 127) * 64, c0 = (it & 31) * 64;
        for (int idx = F.tid; idx < 4096; idx += 512) { const int cc = idx >> 6, tt = idx & 63; tile[cc * 65 + tt] = Z2T[((size_t)b * 2048 + c0 + cc) * SEQ + t0 + tt]; }
        __syncthreads();
        { const int tt = F.tid >> 3, ck = F.tid & 7; const LAS float* sp = tile + (8 * ck) * 65 + tt;
          u32x4 o; o.x = pk2(sp[0], sp[65]); o.y = pk2(sp[2 * 65], sp[3 * 65]); o.z = pk2(sp[4 * 65], sp[5 * 65]); o.w = pk2(sp[6 * 65], sp[7 * 65]);
          *(u32x4*)(MIX + (size_t)(b * SEQ + t0 + tt) * D + 2048 + c0 + 8 * ck) = o; }
        __syncthreads();
    }
}

__device__ __forceinline__ void ph_r1(const Args& a, const Frame& F, int l) {
    const int Z = opaque_zero();
    const int M = (l == 3) ? NLAT : T; const bf16_t* ZB = (const bf16_t*)WSB(WS_P); float* RS = (float*)WSB(WS_RSTDV);
    for (int row = F.gw; row < M; row += F.NGW) {
        const u32x4* vr = (const u32x4*)(ZB + (size_t)row * ODD_IN + 4096); float ss = 0.f;
#pragma unroll
        for (int j = 0; j < 8; ++j) { const u32x4 r = vr[F.lane + 64 * j];
            ss += bflo(r.x) * bflo(r.x) + bfhi(r.x) * bfhi(r.x) + bflo(r.y) * bflo(r.y) + bfhi(r.y) * bfhi(r.y) + bflo(r.z) * bflo(r.z) + bfhi(r.z) * bfhi(r.z) + bflo(r.w) * bflo(r.w) + bfhi(r.w) * bfhi(r.w); }
        ss = wave_sum(ss);
        if (F.lane == 0) RS[row] = 1.0f / sqrtf(ss * (1.0f / 4096.f) + EPS);
    }
}
__device__ __forceinline__ void ph_sg(const Args& a, const Frame& F, int l) {
    const int Z = opaque_zero();
    const int j2 = l >> 1, M = (l == 3) ? NLAT : T;
    const bf16_t* ZB = (const bf16_t*)WSB(WS_P); bf16_t* MIX = (bf16_t*)WSB(WS_MIX); const float* RS = (const float*)WSB(WS_RSTDV);
    const float* vgain = INP(I_GM_VGAIN) + (size_t)j2 * 4096; const float* ws = INP(I_GM_WS) + (size_t)j2 * 32 * 128 * 128; const float* bs = INP(I_GM_BS) + (size_t)j2 * 32 * 128;
    LAS unsigned char* VT = F.lds;
    const int nunits = (M / 128) * 32;
    const int jl = F.lane & 15, kq = F.lane >> 4;
    for (int un = blockIdx.x; un < nunits; un += F.G) {
        const int chunk = un >> 5, g = un & 31;
        __syncthreads();
#pragma unroll
        for (int it = 0; it < 4; ++it) { const int idx = F.tid + 512 * it, q = idx >> 4, c8 = (idx & 15) * 8; const int row = chunk * 128 + q;
            const u32x4 raw = *(const u32x4*)(ZB + (size_t)row * ODD_IN + 4096 + g * 128 + c8); const float rs = RS[row]; const float* gp = vgain + g * 128 + c8;
            const float v[8] = { bflo(raw.x), bfhi(raw.x), bflo(raw.y), bfhi(raw.y), bflo(raw.z), bfhi(raw.z), bflo(raw.w), bfhi(raw.w) };
#pragma unroll
            for (int i = 0; i < 8; ++i) *(LAS unsigned short*)(VT + (c8 + i) * 272 + q * 2) = (unsigned short)f2bf(v[i] * rs * gp[i]); }
        union { bf16x8v v; unsigned u[4]; } wf[4];
        { const float* wp = ws + (size_t)g * 16384 + (size_t)(16 * F.wave + jl) * 128 + 8 * kq;
#pragma unroll
          for (int s4 = 0; s4 < 4; ++s4) { const f32x4 w0 = *(const f32x4*)(wp + 32 * s4), w1 = *(const f32x4*)(wp + 32 * s4 + 4);
              wf[s4].u[0] = pk2(w0.x, w0.y); wf[s4].u[1] = pk2(w0.z, w0.w); wf[s4].u[2] = pk2(w1.x, w1.y); wf[s4].u[3] = pk2(w1.z, w1.w); } }
        __syncthreads();
        const int p = 16 * F.wave + jl, row = chunk * 128 + p; const float bsp = bs[g * 128 + p];
#pragma unroll
        for (int cb = 0; cb < 8; ++cb) {
            f32x4 acc = (f32x4){0.f, 0.f, 0.f, 0.f};
#pragma unroll
            for (int s4 = 0; s4 < 4; ++s4) { const bf16x8v af = *(const LAS bf16x8v*)(VT + (16 * cb + jl) * 272 + (32 * s4 + 8 * kq) * 2);
                acc = __builtin_amdgcn_mfma_f32_16x16x32_bf16(af, wf[s4].v, acc, 0, 0, 0); }
            const int c0 = g * 128 + 16 * cb + 4 * kq;
            const u32x2 ur = *(const u32x2*)(ZB + (size_t)row * ODD_IN + c0);
            *(unsigned*)((unsigned char*)MIX + (size_t)row * D + c0) = pk4f8(bflo(ur.x) * (acc.x + bsp), bfhi(ur.x) * (acc.y + bsp), bflo(ur.y) * (acc.z + bsp), bfhi(ur.y) * (acc.w + bsp));
        }
    }
}

__device__ __forceinline__ void ph_router(const Args& a, const Frame& F, int l) {
    const int Z = opaque_zero();
    const int M = (l >= 2) ? NLAT : T, ntask = M / 16;
    const bf16_t* WRH = (const bf16_t*)WSB(WS_WR); const bf16_t* WRL = WRH + (size_t)4 * 3 * NE * D; const float* RB = (const float*)WSB(WS_RB); float* GATES = (float*)WSB(WS_GATES);
    const float* CX = (const float*)WSB(WS_CX); const float* rbias = INP(I_MOE_BIAS) + l * NE;
    LAS float* S = (LAS float*)(F.lds + F.wave * 8192);
    unsigned* ECNT = (unsigned*)WSB(WS_CTL) + CW_ECNT; int* ELIST = (int*)WSB(WS_ELIST);
    for (int task = F.wave * F.G + (int)blockIdx.x; task < ntask; task += 4 * F.G) {
        const int t0 = task * 16, c = t0 < SEQ ? 0 : (t0 < NLAT ? 1 : 2), j = F.lane & 15, kq = F.lane >> 4, row = t0 + j;
        const float* xr = (row < NLAT ? AOUT + (size_t)row * D : CX + (size_t)(row - NLAT) * D) + 8 * kq;
        const bf16_t* wh = WRH + (size_t)(l * 3 + c) * NE * D + F.lane * 8; const bf16_t* wl = WRL + (size_t)(l * 3 + c) * NE * D + F.lane * 8;
        f32x4 acc[4]; float ss = 0.f;
#pragma unroll
        for (int blk = 0; blk < 4; ++blk) acc[blk] = (f32x4){0.f, 0.f, 0.f, 0.f};
#pragma unroll 4
        for (int k0 = 0; k0 < D; k0 += 32) {
            const f32x4 x0 = *(const f32x4*)(xr + k0), x1 = *(const f32x4*)(xr + k0 + 4);
            ss += (x0.x * x0.x + x0.y * x0.y) + (x0.z * x0.z + x0.w * x0.w) + (x1.x * x1.x + x1.y * x1.y) + (x1.z * x1.z + x1.w * x1.w);
            const float xs[8] = { x0.x, x0.y, x0.z, x0.w, x1.x, x1.y, x1.z, x1.w };
            union { bf16x8v v; unsigned u[4]; } xh, xl;
#pragma unroll
            for (int q = 0; q < 4; ++q) { const unsigned b0 = __builtin_bit_cast(unsigned, xs[2 * q]), b1 = __builtin_bit_cast(unsigned, xs[2 * q + 1]);
                xh.u[q] = (b0 >> 16) | (b1 & 0xffff0000u);
                xl.u[q] = pk2(xs[2 * q] - __builtin_bit_cast(float, b0 & 0xffff0000u), xs[2 * q + 1] - __builtin_bit_cast(float, b1 & 0xffff0000u)); }
#pragma unroll
            for (int blk = 0; blk < 4; ++blk) { const bf16x8v ah = *(const bf16x8v*)(wh + (size_t)k0 * 64 + blk * 512), al = *(const bf16x8v*)(wl + (size_t)k0 * 64 + blk * 512);
                acc[blk] = __builtin_amdgcn_mfma_f32_16x16x32_bf16(ah, xh.v, acc[blk], 0, 0, 0);
                acc[blk] = __builtin_amdgcn_mfma_f32_16x16x32_bf16(al, xh.v, acc[blk], 0, 0, 0);
                acc[blk] = __builtin_amdgcn_mfma_f32_16x16x32_bf16(ah, xl.v, acc[blk], 0, 0, 0); }
        }
        ss += __shfl_xor(ss, 16); ss += __shfl_xor(ss, 32);
        const float rstd = 1.0f / sqrtf(ss * (1.0f / D) + EPS);
        LDS_WAIT();
#pragma unroll
        for (int blk = 0; blk < 4; ++blk)
#pragma unroll
            for (int r = 0; r < 4; ++r) { const int e = 16 * blk + 4 * kq + r; const float logit = acc[blk][r] * rstd + RB[(l * 3 + c) * NE + e]; S[j * 65 + e] = 1.0f / (1.0f + expf(-logit)); }
        LDS_WAIT();
        unsigned mlo, mhi; float ssum = 0.f;
        { float sc[16], sb[16];
#pragma unroll
          for (int i = 0; i < 16; ++i) { sc[i] = S[j * 65 + 16 * kq + i]; sb[i] = sc[i] + rbias[16 * kq + i]; }
          unsigned taken = 0u;
#pragma unroll 1
          for (int it = 0; it < 8; ++it) { float best = -1e30f, braw = 0.f; int bi = 0;
#pragma unroll
              for (int i = 0; i < 16; ++i) { const bool ok = !((taken >> i) & 1u) && sb[i] > best; best = ok ? sb[i] : best; bi = ok ? i : bi; braw = ok ? sc[i] : braw; }
              int gi = 16 * kq + bi;
#pragma unroll
              for (int off = 16; off <= 32; off <<= 1) { const float ob = __shfl_xor(best, off), orw = __shfl_xor(braw, off); const int oi = __shfl_xor(gi, off);
                  const bool take = (ob > best) || (ob == best && oi < gi); best = take ? ob : best; gi = take ? oi : gi; braw = take ? orw : braw; }
              if ((gi >> 4) == kq) taken |= 1u << (gi & 15);
              ssum += braw; }
          const unsigned t0m = __shfl(taken, j), t1m = __shfl(taken, j + 16), t2m = __shfl(taken, j + 32), t3m = __shfl(taken, j + 48);
          mlo = t0m | (t1m << 16); mhi = t2m | (t3m << 16); }
        unsigned selbits = 0u;
        for (int tok = 0; tok < 16; ++tok) { const unsigned lo = __shfl(mlo, tok), hi = __shfl(mhi, tok); const float sm = __shfl(ssum, tok);
            const bool sel = F.lane < 32 ? ((lo >> F.lane) & 1u) : ((hi >> (F.lane - 32)) & 1u);
            if (sel) selbits |= 1u << tok;
            GATES[(size_t)(t0 + tok) * NE + F.lane] = sel ? S[tok * 65 + F.lane] / sm * 2.5f : 0.f; }
        const int ne = __popc(selbits);
        if (ne) { int pos = (int)__hip_atomic_fetch_add(ECNT + l * NE + F.lane, (unsigned)ne, __ATOMIC_RELAXED, __HIP_MEMORY_SCOPE_AGENT);
            for (int tok = 0; tok < 16; ++tok) if ((selbits >> tok) & 1u) { ELIST[(size_t)F.lane * T + pos] = t0 + tok; ++pos; } }
    }
}

__device__ __forceinline__ void ph_cxfix(const Args& a, const Frame& F, const float* cx_src_in, int l, int gate_idx, int nsplit) {
    const int Z = opaque_zero();
    const float* cx_src = cx_src_in + Z; float* CX = (float*)WSB(WS_CX); const float* part = (const float*)WSB(WS_PART); const float* gv = MODSP(a, l, 2, gate_idx);
    for (int i = blockIdx.x * 512 + F.tid; i < NCTX * (D / 4); i += F.G * 512) {
        f32x4 s = ((const f32x4*)part)[i];
#pragma unroll
        for (int k = 1; k < 8; ++k) if (k < nsplit) s += ((const f32x4*)(part + (size_t)k * NCTX * D))[i];
        ((f32x4*)CX)[i] = ((const f32x4*)cx_src)[i] + ((const f32x4*)gv)[i & (D / 4 - 1)] * s;
    }
}
template <int l> __device__ __forceinline__ void layer_body(const Args& a, const Frame& F, const XcdBarrier& bar, const int lo, const int hi) {
#define IN(k) (lo <= (k) && (k) < hi)
#if (PROBE_DUP & 256)
#define SEAM(k) do { if (IN(k) && IN((k) + 1)) { xcd_barrier(bar); xcd_barrier(bar); } } while (0)
#else
#define SEAM(k) do { if (IN(k) && IN((k) + 1)) xcd_barrier(bar); } while (0)
#endif
        const int base = 3 + 9 * l; const bool even = (l & 1) == 0; const int M = (l == 3) ? NLAT : T; const int M2 = (l >= 2) ? NLAT : T;
        if (IN(base + 0)) { if (l >= 1 && l <= 2) { ph_cxfix(a, F, (const float*)(a.ws + WS_CX), l - 1, 5, 6); xcd_barrier(bar); }
            wq_pull(a, F, l, -1); ph_norm(a, F, l, 0, F.gw, F.NGW); }
        SEAM(base + 0);
        if (IN(base + 1)) {
            const int Z = opaque_zero(); bf16_t* H = (bf16_t*)WSB(WS_H); bf16_t* WIN = WSETP(WS_WIN, l); bf16_t* P = (bf16_t*)WSB(WS_P);
            if (even) { pg8::RowIdent RM;
                { pg8::Gemm g{(bf16_t*)WSB(WS_H8E), WIN, M, 6144, D / 2}; pg8::StaticOrderX S; S.init(M, 6144, D / 2, F.G, (int)blockIdx.x);
                  pg8::EpiBf16X<0> E{P, EVEN_IN, nullptr, 1.f / WGU_SCALE};
                  pg8::gemm_phase_x<pg8::EpiBf16X<0>, pg8::StaticOrderX, pg8::RowIdent, true>(F.lds, g, S, E, RM); }
                __syncthreads();
                { pg8::Gemm g{H, WIN + (size_t)6144 * D, M, 6144, D}; pg8::StaticOrderX S; S.init(M, 6144, D, F.G, F.G - 1 - (int)blockIdx.x);
                  pg8::EpiBf16X<0> E{P + 6144, EVEN_IN, nullptr, 1.f};
                  pg8::gemm_phase_x<pg8::EpiBf16X<0>, pg8::StaticOrderX, pg8::RowIdent, false>(F.lds, g, S, E, RM); } }
            else { pg8::Gemm g{H, WIN, M, ODD_IN, D / 2}; pg8::StaticOrderX S; S.init(M, ODD_IN, D / 2, F.G, (int)blockIdx.x); pg8::RowIdent RM;
                pg8::EpiBf16X<1> E{P, ODD_IN, INP(I_ODD_BIN) + (size_t)(l >> 1) * ODD_IN, 1.f / WGU_SCALE};
                pg8::gemm_phase_x<pg8::EpiBf16X<1>, pg8::StaticOrderX, pg8::RowIdent, true>(F.lds, g, S, E, RM); }
            if (l < 3) wq_pull(a, F, l + 1, CW_ARR + base + 1);
        }
        SEAM(base + 1);
        if (IN(base + 2)) { if (even) { ph_e1(a, F, l); ph_hyf(a, F, l); } else ph_r1(a, F, l);
#if (PROBE_DUP & 1024)
            __syncthreads(); if (even) { ph_hyf(a, F, l); }
#endif
#if (PROBE_DUP & 2)
            __syncthreads(); if (even) { ph_e1(a, F, l, false); ph_hyf(a, F, l); } else ph_r1(a, F, l);
#endif
        }
        SEAM(base + 2);
        if (IN(base + 3)) { if (even) { ph_attn(a, F, l); __syncthreads(); ph_hyc(a, F, l); __syncthreads(); if (l == 0) ph_hyx(a, F, l); } else ph_sg(a, F, l);
#if (PROBE_DUP & 4)
            __syncthreads(); if (even) { ph_attn(a, F, l); __syncthreads(); ph_hyc(a, F, l); __syncthreads(); ph_hyx(a, F, l); } else ph_sg(a, F, l);
#endif
#if (PROBE_DUP & 16)
            __syncthreads(); if (even) { ph_hyc(a, F, l); }
#endif
#if (PROBE_DUP & 32)
            __syncthreads(); if (even) { ph_attn(a, F, l); }
#endif
#if (PROBE_DUP & 64)
            __syncthreads(); if (!even) { ph_sg(a, F, l); }
#endif
        }
        SEAM(base + 3);
        if (IN(base + 4)) { if (even) ph_hyt(a, F);
#if (PROBE_DUP & 8)
            __syncthreads(); if (even) ph_hyt(a, F);
#endif
        }
        SEAM(base + 4);
        if (IN(base + 5)) {
            const int Z = opaque_zero(); bf16_t* MIX = (bf16_t*)WSB(WS_MIX); bf16_t* WOUT = WSETP(WS_WOUT, l); float* CX = (float*)WSB(WS_CX);
            pg8::RowIdent RM;
            if (even) { pg8::Gemm g{MIX, WOUT, M2, D, D}; pg8::SplitCtxOrder S; S.init(M2, D, D, F.G, (int)blockIdx.x, 8);
                pg8::EpiResidX E{l == 0 ? INP(I_X) : AOUT, AOUT, MODSP(a, l, 0, 2), (float*)WSB(WS_PART), 1.f};
                pg8::gemm_phase_x<pg8::EpiResidX, pg8::SplitCtxOrder, pg8::RowIdent>(F.lds, g, S, E, RM); }
            else { pg8::Gemm g{MIX, WOUT, M2, D, D / 2}; pg8::SplitCtxOrder S; S.init(M2, D, D / 2, F.G, (int)blockIdx.x, 8);
                pg8::EpiResidX E{AOUT, AOUT, MODSP(a, l, 0, 2), (float*)WSB(WS_PART), 1.f / WGU_SCALE};
                pg8::gemm_phase_x<pg8::EpiResidX, pg8::SplitCtxOrder, pg8::RowIdent, true>(F.lds, g, S, E, RM); }
            if (l < 3) wq_pull(a, F, l + 1, CW_ARR + base + 5);
        }
        SEAM(base + 5);
        if (IN(base + 6)) { if (M2 > NLAT) { ph_cxfix(a, F, l == 0 ? a.in[I_CTX] : (const float*)(a.ws + WS_CX), l, 2, 8); xcd_barrier(bar); }
            if (F.wave >= 4) ph_norm(a, F, l, 1, (int)blockIdx.x * 4 + F.wave - 4, F.G * 4, true); else ph_router(a, F, l);
#if (PROBE_DUP & 2048)
            __syncthreads(); if (F.wave >= 4) ph_norm(a, F, l, 1, (int)blockIdx.x * 4 + F.wave - 4, F.G * 4, true);
#endif
            }
        SEAM(base + 6);
        if (IN(base + 7)) {
            const int Z = opaque_zero(); bf16_t* H = (bf16_t*)WSB(WS_H); bf16_t* WGU = WSETP(WS_WGU, l); bf16_t* P = (bf16_t*)WSB(WS_P);
            LAS int* tab = (LAS int*)(F.lds + TAB_OFF); LAS int* cntl = tab + 640;
            const unsigned* ECNT = (const unsigned*)WSB(WS_CTL) + CW_ECNT + l * NE;
            if (F.tid < NE) cntl[F.tid] = (int)__hip_atomic_load(ECNT + F.tid, __ATOMIC_RELAXED, __HIP_MEMORY_SCOPE_AGENT);
            __syncthreads();
            if (F.tid == 0) { int n = 0; for (int e = 0; e < NE; ++e) { const int nt_ = (cntl[e] + 255) >> 8; for (int t = 0; t < nt_; ++t) tab[n++] = e | (t << 8); } cntl[NE] = n; }
            __syncthreads();
            pg8::Gemm g{H, WGU, M2, GU_N, D / 2};
            pg8::MoeOrder S{tab, cntl, cntl[NE], (M2 / 256) * 8, F.G, (int)blockIdx.x, D / 128};
            pg8::RowList RM{(const int*)WSB(WS_ELIST)};
            pg8::EpiSwigluX E{(unsigned char*)P, (const float*)WSB(WS_GATES), (const int*)WSB(WS_ELIST), 1.f / WGU_SCALE};
            pg8::gemm_phase_x<pg8::EpiSwigluX, pg8::MoeOrder, pg8::RowList, true>(F.lds, g, S, E, RM);
#if (PROBE_DUP & 512)
            __syncthreads(); pg8::gemm_phase_x<pg8::EpiSwigluX, pg8::MoeOrder, pg8::RowList, true>(F.lds, g, S, E, RM);
#endif
            if (l < 3) wq_pull(a, F, l + 1, CW_ARR + base + 7);
        }
        SEAM(base + 7);
        if (IN(base + 8)) {
            const int Z = opaque_zero(); bf16_t* P = (bf16_t*)WSB(WS_P); bf16_t* WD = WSETP(WS_WD, l); float* CX = (float*)WSB(WS_CX);
            pg8::Gemm g{P, WD, M2, D, DN_K / 2}; pg8::SplitCtxOrder S; S.init(M2, D, DN_K / 2, F.G, (int)blockIdx.x, 6);
            pg8::EpiResidX E{AOUT, AOUT, MODSP(a, l, 0, 5), (float*)WSB(WS_PART), 1.f / WD_SCALE}; pg8::RowIdent RM;
            pg8::gemm_phase_x<pg8::EpiResidX, pg8::SplitCtxOrder, pg8::RowIdent, true>(F.lds, g, S, E, RM);
            if (l < 3) wq_pull(a, F, l + 1, CW_ARR + base + 8);
        }
        if (l < 3) SEAM(base + 8);
#undef IN
#undef SEAM
}

__global__ void __launch_bounds__(512, 2) fwd_kernel(Args a) {
    extern __shared__ __attribute__((aligned(16))) unsigned char lds_raw[];
    Frame F; F.lds = (LAS unsigned char*)lds_raw; F.tid = threadIdx.x; F.lane = F.tid & 63; F.wave = __builtin_amdgcn_readfirstlane(F.tid >> 6);
    F.G = gridDim.x; F.gw = blockIdx.x * 8 + F.wave; F.NGW = F.G * 8;
    volatile LAS unsigned* MISC = (volatile LAS unsigned*)(F.lds + MISC_OFF);
    if (F.tid < 32) MISC[F.tid] = 0u;
    __syncthreads();
    const int lo = a.ph_lo, hi = a.ph_hi;
    unsigned* barw = (unsigned*)(a.ws) + CW_BAR;
    XcdBarrier bar; bar.bar = barw; bar.x = 0; bar.st = MISC + 8;
    if (hi - lo > 1) bar = xcd_barrier_post(barw, MISC + 8);
#define IN(k) (lo <= (k) && (k) < hi)
#if (PROBE_DUP & 256)
#define SEAM(k) do { if (IN(k) && IN((k) + 1)) { xcd_barrier(bar); xcd_barrier(bar); } } while (0)
#else
#define SEAM(k) do { if (IN(k) && IN((k) + 1)) xcd_barrier(bar); } while (0)
#endif

    if (IN(0)) ph_mods1(a, F);
    SEAM(0);
    if (IN(1)) ph_mods2(a, F);
    SEAM(1);
    if (IN(2)) ph_rprep(a, F);
    SEAM(2);
#if (PROBE_DUP & 4096)
    ph_mods1(a, F); xcd_barrier(bar); ph_mods2(a, F); xcd_barrier(bar); ph_rprep(a, F); xcd_barrier(bar);
#endif
    layer_body<0>(a, F, bar, lo, hi);
    layer_body<1>(a, F, bar, lo, hi);
    layer_body<2>(a, F, bar, lo, hi);
    layer_body<3>(a, F, bar, lo, hi);
#undef IN
#undef SEAM
}
constexpr int N_PHASES = 3 + 9 * 4;

extern "C" void kernel_launch(void* const* d_in, const int* in_sizes, int n_in, void* d_out, int out_size, void* d_ws, size_t ws_size, hipStream_t stream) {
    static int grid = 0;
    if (grid == 0) {
        if (n_in != 38 || out_size != NLAT * D || ws_size < WS_END2) { fprintf(stderr, "kernel_launch: unexpected sizes (n_in %d, out %d, ws %zu < %zu)\n", n_in, out_size, ws_size, (size_t)WS_END2); grid = -1; return; }
        int dev = 0, cus = 0, per_cu = 0;
        if (hipGetDevice(&dev) != hipSuccess || hipDeviceGetAttribute(&cus, hipDeviceAttributeMultiprocessorCount, dev) != hipSuccess) { grid = -1; return; }
        if (hipFuncSetAttribute((const void*)fwd_kernel, hipFuncAttributeMaxDynamicSharedMemorySize, LDS_BYTES) != hipSuccess) { fprintf(stderr, "kernel_launch: hipFuncSetAttribute failed\n"); grid = -1; return; }
        if (hipOccupancyMaxActiveBlocksPerMultiprocessor(&per_cu, (const void*)fwd_kernel, 512, LDS_BYTES) != hipSuccess || per_cu < 1) fprintf(stderr, "kernel_launch: occupancy query reports %d\n", per_cu);
        (void)hipGetLastError();
        grid = cus;
    }
    if (grid < 0) return;
    (void)hipMemsetAsync((char*)d_ws + WS_CTL, 0, CTL_ZERO_BYTES, stream);
    Args a{};
    for (int i = 0; i < 38; ++i) a.in[i] = (const float*)d_in[i];
    a.out = (float*)d_out; a.ws = (unsigned char*)d_ws;
#if MK_PER_PHASE
    for (int k = 0; k < N_PHASES; ++k) { a.ph_lo = k; a.ph_hi = k + 1; hipLaunchKernelGGL(fwd_kernel, dim3(grid), dim3(512), LDS_BYTES, stream, a); }
#else
    a.ph_lo = 0; a.ph_hi = N_PHASES;
    hipLaunchKernelGGL(fwd_kernel, dim3(grid), dim3(512), LDS_BYTES, stream, a);
#endif
}
```

```cpp
#include <hip/hip_runtime.h>
#include <cstdio>
#include <cstdint>

#ifndef MK_PER_PHASE
#define MK_PER_PHASE 0
#endif

#ifndef PROBE_DUP
#define PROBE_DUP 0
#endif

constexpr int D = 4096, SEQ = 8192, NLAT = 16384, LC = 256, NCTX = 512, T = NLAT + NCTX;
constexpr int EVEN_IN = 12288, ODD_IN = 8192, NE = 64, ED = 128, SHD = 1024, RANK = 256;
constexpr int GU_N = (NE * ED + SHD) * 2;
constexpr int DN_K = NE * ED + SHD;
constexpr float EPS = 1e-6f;

namespace pg8 {
#define PG8_LAS __attribute__((address_space(3)))
typedef unsigned short bf16_t;
typedef short bf16x8 __attribute__((ext_vector_type(8)));
typedef float f32x4 __attribute__((ext_vector_type(4)));
typedef unsigned u32x4 __attribute__((ext_vector_type(4)));
constexpr int BM = 256, BK = 64, HALF = 128, HTB = HALF * BK * 2  , STAGE_BYTES = 8 * HTB, NXCD = 8, WGM = 8;

__host__ __device__ __forceinline__ int lds_byte(int r, int c) { const int st = (r >> 4) * 2 + (c >> 5), rr = r & 15, cc = c & 31, ob = rr * 64 + cc * 2; return st * 1024 + (ob ^ (((ob >> 9) & 1) << 5)); }
__host__ __device__ __forceinline__ void stage_rc(int b, int& R, int& C) { const int st = b / 1024, sb = b % 1024, swz = sb ^ (((sb >> 9) & 1) << 5); R = (st >> 1) * 16 + swz / 64; C = (st & 1) * 32 + (swz % 64) / 2; }
__host__ __device__ __forceinline__ int perm32(int rho) { const int n = rho >> 4, i = rho & 15; return 8 * (i >> 2) + 4 * n + (i & 3); }

struct Unit { int pm, pn; };
struct Gemm { const bf16_t* A; const bf16_t* Bt; int M, N, K; };

struct StaticOrder {
    int nM, nN, nwg, G, c;
    __host__ __device__ void init(int M, int N, int G_, int c_) { nM = M / BM; nN = N / BM; nwg = nM * nN; G = G_; c = c_; }
    __host__ __device__ bool next(int i, Unit& u) const {
        const long L = (long)i * G + c; if (L >= nwg) return false;
        int wgid = (int)L; { const int q = nwg / NXCD, r = nwg % NXCD, xcd = wgid % NXCD, off = wgid / NXCD; wgid = (xcd < r ? xcd * (q + 1) : r * (q + 1) + (xcd - r) * q) + off; }
        const int nig = WGM * nN, gid = wgid / nig, fm = gid * WGM, gsz = (nM - fm) < WGM ? (nM - fm) : WGM;
        u.pm = fm + ((wgid % nig) % gsz); u.pn = (wgid % nig) / gsz; return true;
    }
    __device__ __forceinline__ void a_ready(const Unit&) const {}
    __device__ __forceinline__ void done(const Unit&) const {}
};

__device__ __forceinline__ unsigned cvt_pk_bf16(float lo, float hi) { unsigned r; asm volatile("v_cvt_pk_bf16_f32 %0, %1, %2" : "=v"(r) : "v"(lo), "v"(hi)); return r; }
typedef float f32x2 __attribute__((ext_vector_type(2)));
__device__ __forceinline__ f32x2 gelu_pk(f32x2 v) {
    const f32x2 av = __builtin_elementwise_abs(v), d = av * 0.2316418882f + 1.0f;
    f32x2 t; t.x = __builtin_amdgcn_rcpf(d.x); t.y = __builtin_amdgcn_rcpf(d.y);
    f32x2 q = t * 0.5307027145f + (-0.7265760135f); q = q * t + 0.7107068705f; q = q * t + (-0.142248368f); q = q * t + 0.127414796f; q = q * t;
    const f32x2 s = (v * v) * (-0.72134752044f);
    f32x2 e; e.x = __builtin_amdgcn_exp2f(s.x); e.y = __builtin_amdgcn_exp2f(s.y);
    const f32x2 m = v * (q * e), r = v - m;
    f32x2 o; o.x = v.x < 0.f ? m.x : r.x; o.y = v.y < 0.f ? m.y : r.y; return o;
}

template <int ACT  > struct EpiBf16 {
    static constexpr bool PERM = true, AFTER_DRAIN = false; static_assert(ACT == 0 || ACT == 1, "EpiBf16: ACT is 0 (none) or 1 (gelu_pk)");
    bf16_t* O; int ldc; const float* bias; int split_cols; size_t split_stride; float scale0;
    __device__ __forceinline__ void operator()(const f32x4 (&acc)[2][2][4][2], const Unit& u, int wr, int wc, int fr, int fq) const {
        const int row0 = u.pm * BM + wr * 64 + fr; int colt = u.pn * BM; bf16_t* base = O;
        float sc = 1.f; if (split_cols) { const int t = colt / split_cols; base += (size_t)t * split_stride; colt -= t * split_cols; if (t == 0) sc = scale0; }
        const int col0 = colt + wc * 32 + 8 * fq, bcol0 = u.pn * BM + wc * 32 + 8 * fq;
        f32x4 bv[2][2];
#pragma unroll
        for (int bj = 0; bj < 2; ++bj)
#pragma unroll
            for (int n = 0; n < 2; ++n) bv[bj][n] = bias ? *(const f32x4*)(bias + bcol0 + bj * HALF + 4 * n) : (f32x4){0.f, 0.f, 0.f, 0.f};
#pragma unroll
        for (int ai = 0; ai < 2; ++ai)
#pragma unroll
            for (int m = 0; m < 4; ++m) { bf16_t* rowp = base + (size_t)(row0 + ai * HALF + m * 16) * ldc + col0;
#pragma unroll
                for (int bj = 0; bj < 2; ++bj) { f32x4 v0 = acc[ai][bj][m][0] + bv[bj][0], v1 = acc[ai][bj][m][1] + bv[bj][1];
                    if (ACT == 1) { f32x2 a = gelu_pk((f32x2){v0[0], v0[1]}), b = gelu_pk((f32x2){v0[2], v0[3]}), c = gelu_pk((f32x2){v1[0], v1[1]}), d = gelu_pk((f32x2){v1[2], v1[3]});
                        v0 = (f32x4){a.x, a.y, b.x, b.y}; v1 = (f32x4){c.x, c.y, d.x, d.y}; }
                    v0 = v0 * sc; v1 = v1 * sc; u32x4 w; w.x = cvt_pk_bf16(v0[0], v0[1]); w.y = cvt_pk_bf16(v0[2], v0[3]); w.z = cvt_pk_bf16(v1[0], v1[1]); w.w = cvt_pk_bf16(v1[2], v1[3]);
                    *(u32x4*)(rowp + bj * HALF) = w; } }
    }
};

struct EpiResid {
    static constexpr bool PERM = false, AFTER_DRAIN = false;
    const float* lat_src; const float* cx_src; float* lat_dst; float* cx_dst; const float* gate;
    __device__ __forceinline__ void operator()(const f32x4 (&acc)[2][2][4][2], const Unit& u, int wr, int wc, int fr, int fq) const {
        const int rowt = u.pm * BM; int c, rbase; const float* src; float* dst;
        if (rowt < NLAT) { c = rowt < SEQ ? 0 : 1; src = lat_src; dst = lat_dst; rbase = 0; } else { c = 2; src = cx_src; dst = cx_dst; rbase = NLAT; }
        const float* gv = gate + (size_t)c * 6 * D;
        const int row0 = rowt - rbase + wr * 64 + fr, col0 = u.pn * BM + wc * 32 + 4 * fq;
        f32x4 g[2][2];
#pragma unroll
        for (int bj = 0; bj < 2; ++bj)
#pragma unroll
            for (int n = 0; n < 2; ++n) g[bj][n] = *(const f32x4*)(gv + col0 + bj * HALF + n * 16);
#pragma unroll
        for (int ai = 0; ai < 2; ++ai)
#pragma unroll
            for (int m = 0; m < 4; ++m) { const size_t off = (size_t)(row0 + ai * HALF + m * 16) * D + col0;
#pragma unroll
                for (int bj = 0; bj < 2; ++bj)
#pragma unroll
                    for (int n = 0; n < 2; ++n) { const f32x4 s = *(const f32x4*)(src + off + bj * HALF + n * 16); *(f32x4*)(dst + off + bj * HALF + n * 16) = s + g[bj][n] * acc[ai][bj][m][n]; } }
    }
};
struct EpiSwiglu {
    static constexpr bool PERM = true, AFTER_DRAIN = false;
    bf16_t* H; const float* gates;
    __device__ __forceinline__ void operator()(const f32x4 (&acc)[2][2][4][2], const Unit& u, int wr, int wc, int fr, int fq) const {
        const int row0 = u.pm * BM + wr * 64 + fr, hc0 = u.pn * 128 + wc * 16 + 4 * fq;
#pragma unroll
        for (int ai = 0; ai < 2; ++ai)
#pragma unroll
            for (int m = 0; m < 4; ++m) { const int row = row0 + ai * HALF + m * 16; const float gt = (u.pn < NE) ? gates[(size_t)row * NE + u.pn] : 1.f;
#pragma unroll
                for (int bj = 0; bj < 2; ++bj) { const f32x4 v0 = acc[ai][bj][m][0], v1 = acc[ai][bj][m][1];
                    const float h0 = v0[0] / (1.f + __expf(-v0[0])) * v0[1] * gt, h1 = v0[2] / (1.f + __expf(-v0[2])) * v0[3] * gt;
                    const float h2 = v1[0] / (1.f + __expf(-v1[0])) * v1[1] * gt, h3 = v1[2] / (1.f + __expf(-v1[2])) * v1[3] * gt;
                    typedef unsigned u32x2v __attribute__((ext_vector_type(2))); u32x2v w; w.x = cvt_pk_bf16(h0, h1); w.y = cvt_pk_bf16(h2, h3);
                    *(u32x2v*)(H + (size_t)row * DN_K + hc0 + bj * 64) = w; } }
    }
};

template <class Epi, class Sched, bool ALIGN_EPI = false, bool SP2 = false>
__device__ __forceinline__ void gemm_phase(PG8_LAS unsigned char* lds, const Gemm g, const Sched& S, const Epi& E) {
    int tid_o = threadIdx.x; asm volatile("" : "+v"(tid_o));
    const int tid = tid_o, wid = __builtin_amdgcn_readfirstlane(tid >> 6), lane = tid & 63, wr = wid >> 2, wc = wid & 3, fr = lane & 15, fq = lane >> 4;
    const int K = g.K, nt = K / BK;
    unsigned voffA[2], voffB[2];
#pragma unroll
    for (int i = 0; i < 2; ++i) { int R, C; stage_rc(tid * 16 + i * 8192, R, C); const int Rb = Epi::PERM ? ((R & ~31) + perm32(R & 31)) : R;
        voffA[i] = (unsigned)(R * K + C) * 2u; voffB[i] = (unsigned)(Rb * K + C) * 2u; }
    const size_t kstep = (size_t)(BK * 2);
    const size_t hstep = (size_t)HALF * K * 2;
    const size_t tstep = 2 * hstep;
    const unsigned ldsw = (unsigned)wid * 1024u;
    const int aoff = lds_byte(wr * 64 + fr, fq * 8), boff = lds_byte(wc * 32 + fr, fq * 8);
#define PG8_SA(b, h) (((b) * 2 + (h)) * HTB)
#define PG8_SB(b, h) ((4 + (b) * 2 + (h)) * HTB)
#define PG8_STAGE(bufoff, gbase, voff) do { _Pragma("unroll") for (int _i = 0; _i < 2; ++_i) \
        __builtin_amdgcn_global_load_lds((const unsigned*)((const char*)(gbase) + (voff)[_i]), (PG8_LAS unsigned*)(lds + (bufoff) + ldsw + _i * 8192), 16, 0, 0); } while (0)
#define PG8_LDA(dst, b, h) do { _Pragma("unroll") for (int m = 0; m < 4; ++m) _Pragma("unroll") for (int k = 0; k < 2; ++k) dst[m][k] = *(const PG8_LAS bf16x8*)(lds + PG8_SA(b, h) + aoff + m * 2048 + k * 1024); } while (0)
#define PG8_LDB(dst, b, h) do { _Pragma("unroll") for (int n = 0; n < 2; ++n) _Pragma("unroll") for (int k = 0; k < 2; ++k) dst[n][k] = *(const PG8_LAS bf16x8*)(lds + PG8_SB(b, h) + boff + n * 2048 + k * 1024); } while (0)
#define PG8_MMA(ai, bj, At, Bt) do { __builtin_amdgcn_s_setprio(1); _Pragma("unroll") for (int m = 0; m < 4; ++m) _Pragma("unroll") for (int n = 0; n < 2; ++n) _Pragma("unroll") for (int k = 0; k < 2; ++k) \
        acc[ai][bj][m][n] = __builtin_amdgcn_mfma_f32_16x16x32_bf16(Bt[n][k], At[m][k], acc[ai][bj][m][n], 0, 0, 0); __builtin_amdgcn_s_setprio(0); } while (0)
#define PG8_WAIT_V(n) asm volatile("s_waitcnt vmcnt(" #n ")" ::: "memory")
#define PG8_WAIT_L(n) asm volatile("s_waitcnt lgkmcnt(" #n ")" ::: "memory")
#define PG8_BAR __builtin_amdgcn_s_barrier()
#define PG8_SCHED __builtin_amdgcn_sched_barrier(0)
    Unit cur, nxt; int ui = 0;
    if (!S.next(0, cur)) return;
    f32x4 acc[2][2][4][2];
#pragma unroll
    for (int a = 0; a < 2; ++a)
#pragma unroll
        for (int b = 0; b < 2; ++b)
#pragma unroll
            for (int m = 0; m < 4; ++m)
#pragma unroll
                for (int n = 0; n < 2; ++n) acc[a][b][m][n] = (f32x4){0.f, 0.f, 0.f, 0.f};
    bf16x8 At[4][2], B0[2][2], B1[2][2];
    const char* cA = (const char*)g.A + (size_t)cur.pm * tstep; const char* cB = (const char*)g.Bt + (size_t)cur.pn * tstep;
    S.a_ready(cur);
    if constexpr (SP2) {
        PG8_STAGE(PG8_SB(0, 0), cB, voffB); PG8_STAGE(PG8_SB(0, 1), cB + hstep, voffB); PG8_STAGE(PG8_SA(0, 0), cA, voffA); PG8_STAGE(PG8_SA(0, 1), cA + hstep, voffA);
        if (wr == 1) PG8_BAR;
        PG8_WAIT_V(2); PG8_BAR;
        PG8_STAGE(PG8_SB(1, 0), cB + kstep, voffB); PG8_STAGE(PG8_SA(1, 0), cA + kstep, voffA); PG8_STAGE(PG8_SB(1, 1), cB + hstep + kstep, voffB);
        PG8_WAIT_V(6); PG8_BAR;
    } else {
        PG8_STAGE(PG8_SB(0, 0), cB, voffB); PG8_STAGE(PG8_SA(0, 0), cA, voffA); PG8_STAGE(PG8_SB(0, 1), cB + hstep, voffB); PG8_STAGE(PG8_SA(0, 1), cA + hstep, voffA);
        if (wr == 1) PG8_BAR;
        PG8_WAIT_V(4); PG8_BAR;
        PG8_STAGE(PG8_SB(1, 0), cB + kstep, voffB); PG8_STAGE(PG8_SA(1, 0), cA + kstep, voffA); PG8_STAGE(PG8_SB(1, 1), cB + hstep + kstep, voffB);
        PG8_WAIT_V(6); PG8_BAR;
    }
    for (;;) {
        const bool has_next = S.next(ui + 1, nxt);
        const char* nA = has_next ? (const char*)g.A + (size_t)nxt.pm * tstep : cA; const char* nB = has_next ? (const char*)g.Bt + (size_t)nxt.pn * tstep : cB;
        for (int t = 0; t < nt; t += 2) {
            const bool last = (t == nt - 2);
            const char* a1 = cA + (size_t)(t + 1) * kstep;
            const char* a2 = last ? nA : cA + (size_t)(t + 2) * kstep; const char* b2 = last ? nB : cB + (size_t)(t + 2) * kstep;
            const char* a3 = a2 + kstep; const char* b3 = b2 + kstep;
            if (last && has_next) S.a_ready(nxt);
            if constexpr (SP2) {
            PG8_LDB(B0, 0, 0); PG8_LDB(B1, 0, 1); PG8_SCHED; PG8_LDA(At, 0, 0); PG8_STAGE(PG8_SA(1, 1), a1 + hstep, voffA);
            PG8_WAIT_V(8); PG8_WAIT_L(0); PG8_BAR; PG8_MMA(0, 0, At, B0); PG8_MMA(0, 1, At, B1); PG8_BAR; PG8_SCHED;
            PG8_LDA(At, 0, 1); PG8_STAGE(PG8_SB(0, 0), b2, voffB); PG8_STAGE(PG8_SB(0, 1), b2 + hstep, voffB); PG8_STAGE(PG8_SA(0, 0), a2, voffA);
            PG8_WAIT_V(8); PG8_WAIT_L(0); PG8_BAR; PG8_MMA(1, 0, At, B0); PG8_MMA(1, 1, At, B1); PG8_BAR; PG8_SCHED;
            PG8_LDB(B0, 1, 0); PG8_LDB(B1, 1, 1); PG8_SCHED; PG8_LDA(At, 1, 0); PG8_STAGE(PG8_SA(0, 1), a2 + hstep, voffA);
            PG8_WAIT_V(8); PG8_WAIT_L(0); PG8_BAR; PG8_MMA(0, 0, At, B0); PG8_MMA(0, 1, At, B1); PG8_BAR; PG8_SCHED;
            PG8_LDA(At, 1, 1); PG8_STAGE(PG8_SB(1, 0), b3, voffB); PG8_STAGE(PG8_SB(1, 1), b3 + hstep, voffB); PG8_STAGE(PG8_SA(1, 0), a3, voffA);
            PG8_WAIT_V(8); PG8_WAIT_L(0); PG8_BAR; PG8_MMA(1, 0, At, B0); PG8_MMA(1, 1, At, B1); PG8_BAR; PG8_SCHED;
            } else {
            PG8_LDB(B0, 0, 0); PG8_SCHED; PG8_LDA(At, 0, 0); PG8_STAGE(PG8_SA(1, 1), a1 + hstep, voffA);
            PG8_WAIT_L(8); PG8_BAR; PG8_WAIT_L(0); PG8_MMA(0, 0, At, B0); PG8_BAR; PG8_SCHED;
            PG8_LDB(B1, 0, 1); PG8_STAGE(PG8_SB(0, 0), b2, voffB);
            PG8_BAR; PG8_WAIT_L(0); PG8_MMA(0, 1, At, B1); PG8_BAR;
            PG8_LDA(At, 0, 1); PG8_STAGE(PG8_SA(0, 0), a2, voffA);
            PG8_BAR; PG8_WAIT_L(0); PG8_MMA(1, 0, At, B0); PG8_BAR; PG8_SCHED;
            PG8_STAGE(PG8_SB(0, 1), b2 + hstep, voffB);
            PG8_WAIT_V(6); PG8_BAR; PG8_MMA(1, 1, At, B1); PG8_BAR;
            PG8_LDB(B0, 1, 0); PG8_SCHED; PG8_LDA(At, 1, 0); PG8_STAGE(PG8_SA(0, 1), a2 + hstep, voffA);
            PG8_WAIT_L(8); PG8_BAR; PG8_WAIT_L(0); PG8_MMA(0, 0, At, B0); PG8_BAR; PG8_SCHED;
            PG8_LDB(B1, 1, 1); PG8_STAGE(PG8_SB(1, 0), b3, voffB);
            PG8_BAR; PG8_WAIT_L(0); PG8_MMA(0, 1, At, B1); PG8_BAR;
            PG8_LDA(At, 1, 1); PG8_STAGE(PG8_SA(1, 0), a3, voffA);
            PG8_BAR; PG8_WAIT_L(0); PG8_MMA(1, 0, At, B0); PG8_BAR; PG8_SCHED;
            PG8_STAGE(PG8_SB(1, 1), b3 + hstep, voffB);
            PG8_WAIT_V(6); PG8_BAR; PG8_MMA(1, 1, At, B1); PG8_BAR;
            }
        }
        if constexpr (ALIGN_EPI) { if (wr == 0) PG8_BAR; }
        if constexpr (!Epi::AFTER_DRAIN) { E(acc, cur, wr, wc, fr, fq); S.done(cur); }
        if (!has_next) break;
#pragma unroll
        for (int a = 0; a < 2; ++a)
#pragma unroll
            for (int b = 0; b < 2; ++b)
#pragma unroll
                for (int m = 0; m < 4; ++m)
#pragma unroll
                    for (int n = 0; n < 2; ++n) acc[a][b][m][n] = (f32x4){0.f, 0.f, 0.f, 0.f};
        cur = nxt; cA = nA; cB = nB; ++ui;
        if constexpr (ALIGN_EPI) { if (wr == 1) PG8_BAR; }
    }
    PG8_WAIT_V(0);
    if constexpr (!ALIGN_EPI) { if (wr == 0) PG8_BAR; }
    PG8_BAR;
    if constexpr (Epi::AFTER_DRAIN) { E.fused(acc, cur, wr, wc, fr, fq, lds, wid, lane); S.done(cur); }
#undef PG8_SA
#undef PG8_SB
#undef PG8_STAGE
#undef PG8_LDA
#undef PG8_LDB
#undef PG8_MMA
#undef PG8_WAIT_V
#undef PG8_WAIT_L
#undef PG8_BAR
#undef PG8_SCHED
}

struct UnitX { int pm, pn, e, nrows, k0, nt; };
typedef int i32x4 __attribute__((ext_vector_type(4)));
typedef int i32x8 __attribute__((ext_vector_type(8)));
template <class Epi, class Sched, class RowMap, bool F8 = false>
__device__ __forceinline__ void gemm_phase_x(PG8_LAS unsigned char* lds, const Gemm g, const Sched& S, const Epi& E, const RowMap& RM) {
    int tid_o = threadIdx.x; asm volatile("" : "+v"(tid_o));
    const int tid = tid_o, wid = __builtin_amdgcn_readfirstlane(tid >> 6), lane = tid & 63, wr = wid >> 2, wc = wid & 3, fr = lane & 15, fq = lane >> 4;
    const int K = g.K;
    int R_[2], C_[2]; unsigned voffB[2];
#pragma unroll
    for (int i = 0; i < 2; ++i) { stage_rc(tid * 16 + i * 8192, R_[i], C_[i]); const int Rb = Epi::PERM ? ((R_[i] & ~31) + perm32(R_[i] & 31)) : R_[i]; voffB[i] = (unsigned)(Rb * K + C_[i]) * 2u; }
    const size_t kstep = (size_t)(BK * 2);
    const size_t hstep = (size_t)HALF * K * 2;
    const size_t tstep = 2 * hstep;
    const unsigned ldsw = (unsigned)wid * 1024u;
    const int aoff = lds_byte(wr * 64 + fr, fq * 8), boff = lds_byte(wc * 32 + fr, fq * 8);
#define PG8_SA(b, h) (((b) * 2 + (h)) * HTB)
#define PG8_SB(b, h) ((4 + (b) * 2 + (h)) * HTB)
#define PG8_STAGE(bufoff, gbase, voff) do { _Pragma("unroll") for (int _i = 0; _i < 2; ++_i) \
        __builtin_amdgcn_global_load_lds((const unsigned*)((const char*)(gbase) + (voff)[_i]), (PG8_LAS unsigned*)(lds + (bufoff) + ldsw + _i * 8192), 16, 0, 0); } while (0)
#define PG8_LD8(dst, addr) do { const i32x4 _lo = *(const PG8_LAS i32x4*)(addr), _hi = *(const PG8_LAS i32x4*)((addr) + 1024); dst = __builtin_shufflevector(_lo, _hi, 0, 1, 2, 3, 4, 5, 6, 7); } while (0)
#define PG8_LDA(dst, b, h) do { _Pragma("unroll") for (int m = 0; m < 4; ++m) PG8_LD8(dst[m], lds + PG8_SA(b, h) + aoff + m * 2048); } while (0)
#define PG8_LDB(dst, b, h) do { _Pragma("unroll") for (int n = 0; n < 2; ++n) PG8_LD8(dst[n], lds + PG8_SB(b, h) + boff + n * 2048); } while (0)
#define PG8_LOH(v) __builtin_bit_cast(bf16x8, __builtin_shufflevector(v, v, 0, 1, 2, 3))
#define PG8_HIH(v) __builtin_bit_cast(bf16x8, __builtin_shufflevector(v, v, 4, 5, 6, 7))
#define PG8_MMA(ai, bj, At, Bt) do { __builtin_amdgcn_s_setprio(1); _Pragma("unroll") for (int m = 0; m < 4; ++m) _Pragma("unroll") for (int n = 0; n < 2; ++n) { \
        if constexpr (F8) asm volatile("v_mfma_scale_f32_16x16x128_f8f6f4 %0, %1, %2, %0, %3, %3 op_sel_hi:[0,0,0]" : "+v"(acc[ai][bj][m][n]) : "v"(Bt[n]), "v"(At[m]), "v"(sc8)); \
        else { acc[ai][bj][m][n] = __builtin_amdgcn_mfma_f32_16x16x32_bf16(PG8_LOH(Bt[n]), PG8_LOH(At[m]), acc[ai][bj][m][n], 0, 0, 0); \
               acc[ai][bj][m][n] = __builtin_amdgcn_mfma_f32_16x16x32_bf16(PG8_HIH(Bt[n]), PG8_HIH(At[m]), acc[ai][bj][m][n], 0, 0, 0); } } \
        __builtin_amdgcn_s_setprio(0); } while (0)
#define PG8_WAIT_V(n) asm volatile("s_waitcnt vmcnt(" #n ")" ::: "memory")
#define PG8_WAIT_L(n) asm volatile("s_waitcnt lgkmcnt(" #n ")" ::: "memory")
#define PG8_BAR __builtin_amdgcn_s_barrier()
#define PG8_SCHED __builtin_amdgcn_sched_barrier(0)
#define PG8_ROWOFF(dst, u) do { _Pragma("unroll") for (int _h = 0; _h < 2; ++_h) _Pragma("unroll") for (int _i = 0; _i < 2; ++_i) \
        dst[_h][_i] = (RM.row(u, _h * HALF + R_[_i]) * (unsigned)K + (unsigned)C_[_i]) * 2u; } while (0)
#define PG8_ABASE(u) ((const char*)g.A + ((size_t)RM.base(u) * K + (size_t)(u).k0) * 2)
    UnitX cur, nxt; int ui = 0;
    if (!S.next(0, cur)) return;
    f32x4 acc[2][2][4][2];
#pragma unroll
    for (int a = 0; a < 2; ++a)
#pragma unroll
        for (int b = 0; b < 2; ++b)
#pragma unroll
            for (int m = 0; m < 4; ++m)
#pragma unroll
                for (int n = 0; n < 2; ++n) acc[a][b][m][n] = (f32x4){0.f, 0.f, 0.f, 0.f};
    i32x8 At[4], B0[2], B1[2];
    const int sc8 = 0x7f7f7f7f;
    unsigned vc[2][2], vn[2][2];
    PG8_ROWOFF(vc, cur);
    const char* A0 = PG8_ABASE(cur);
    const char* cB = (const char*)g.Bt + (size_t)cur.pn * tstep + (size_t)cur.k0 * 2;
    PG8_STAGE(PG8_SB(0, 0), cB, voffB); PG8_STAGE(PG8_SB(0, 1), cB + hstep, voffB); PG8_STAGE(PG8_SA(0, 0), A0, vc[0]); PG8_STAGE(PG8_SA(0, 1), A0, vc[1]);
    if (wr == 1) PG8_BAR;
    PG8_WAIT_V(2); PG8_BAR;
    PG8_STAGE(PG8_SB(1, 0), cB + kstep, voffB); PG8_STAGE(PG8_SA(1, 0), A0 + kstep, vc[0]); PG8_STAGE(PG8_SB(1, 1), cB + hstep + kstep, voffB);
    PG8_WAIT_V(6); PG8_BAR;
    for (;;) {
        const bool has_next = S.next(ui + 1, nxt);
        if constexpr (!RowMap::IDENT) { if (has_next) { PG8_ROWOFF(vn, nxt); } else {
#pragma unroll
            for (int _h = 0; _h < 2; ++_h)
#pragma unroll
                for (int _i = 0; _i < 2; ++_i) vn[_h][_i] = vc[_h][_i]; } }
        const char* nB = has_next ? (const char*)g.Bt + (size_t)nxt.pn * tstep + (size_t)nxt.k0 * 2 : cB;
        const char* nA = has_next ? PG8_ABASE(nxt) : A0;
        const int nt = cur.nt;
        for (int t = 0; t < nt; t += 2) {
            const bool last = (t == nt - 2);
            const char* a1 = A0 + (size_t)(t + 1) * kstep;
            const char* a2 = last ? nA : A0 + (size_t)(t + 2) * kstep; const char* b2 = last ? nB : cB + (size_t)(t + 2) * kstep;
            const char* a3 = a2 + kstep; const char* b3 = b2 + kstep;
            unsigned v2h0[2], v2h1[2];
#pragma unroll
            for (int _i = 0; _i < 2; ++_i) { if constexpr (RowMap::IDENT) { v2h0[_i] = vc[0][_i]; v2h1[_i] = vc[1][_i]; } else { v2h0[_i] = last ? vn[0][_i] : vc[0][_i]; v2h1[_i] = last ? vn[1][_i] : vc[1][_i]; } }
            PG8_LDB(B0, 0, 0); PG8_LDB(B1, 0, 1); PG8_SCHED; PG8_LDA(At, 0, 0); PG8_STAGE(PG8_SA(1, 1), a1, vc[1]);
            PG8_WAIT_V(8); PG8_WAIT_L(0); PG8_BAR; PG8_MMA(0, 0, At, B0); PG8_MMA(0, 1, At, B1); PG8_BAR; PG8_SCHED;
            PG8_LDA(At, 0, 1); PG8_STAGE(PG8_SB(0, 0), b2, voffB); PG8_STAGE(PG8_SB(0, 1), b2 + hstep, voffB); PG8_STAGE(PG8_SA(0, 0), a2, v2h0);
            PG8_WAIT_V(8); PG8_WAIT_L(0); PG8_BAR; PG8_MMA(1, 0, At, B0); PG8_MMA(1, 1, At, B1); PG8_BAR; PG8_SCHED;
            PG8_LDB(B0, 1, 0); PG8_LDB(B1, 1, 1); PG8_SCHED; PG8_LDA(At, 1, 0); PG8_STAGE(PG8_SA(0, 1), a2, v2h1);
            PG8_WAIT_V(8); PG8_WAIT_L(0); PG8_BAR; PG8_MMA(0, 0, At, B0); PG8_MMA(0, 1, At, B1); PG8_BAR; PG8_SCHED;
            PG8_LDA(At, 1, 1); PG8_STAGE(PG8_SB(1, 0), b3, voffB); PG8_STAGE(PG8_SB(1, 1), b3 + hstep, voffB); PG8_STAGE(PG8_SA(1, 0), a3, v2h0);
            PG8_WAIT_V(8); PG8_WAIT_L(0); PG8_BAR; PG8_MMA(1, 0, At, B0); PG8_MMA(1, 1, At, B1); PG8_BAR; PG8_SCHED;
        }
        if constexpr (F8) asm volatile("s_nop 7\n\ts_nop 7\n\ts_nop 7" ::: "memory");
        if (wr == 0) PG8_BAR;
        E(acc, cur, wr, wc, fr, fq);
        if (!has_next) break;
#pragma unroll
        for (int a = 0; a < 2; ++a)
#pragma unroll
            for (int b = 0; b < 2; ++b)
#pragma unroll
                for (int m = 0; m < 4; ++m)
#pragma unroll
                    for (int n = 0; n < 2; ++n) acc[a][b][m][n] = (f32x4){0.f, 0.f, 0.f, 0.f};
        cur = nxt; cB = nB; A0 = nA; ++ui;
        if constexpr (!RowMap::IDENT) {
#pragma unroll
        for (int _h = 0; _h < 2; ++_h)
#pragma unroll
            for (int _i = 0; _i < 2; ++_i) vc[_h][_i] = vn[_h][_i]; }
        if (wr == 1) PG8_BAR;
    }
    PG8_WAIT_V(0);
    PG8_BAR;
#undef PG8_SA
#undef PG8_SB
#undef PG8_STAGE
#undef PG8_LDA
#undef PG8_LDB
#undef PG8_LD8
#undef PG8_LOH
#undef PG8_HIH
#undef PG8_MMA
#undef PG8_WAIT_V
#undef PG8_WAIT_L
#undef PG8_BAR
#undef PG8_SCHED
#undef PG8_ROWOFF
#undef PG8_ABASE
}

struct MoeOrder {
    const PG8_LAS int* tab; const PG8_LAS int* cnt; int Ur, nSh, G, c, ntk;
    __device__ __forceinline__ bool next(int i, UnitX& u) const {
        int L = i * G + c; u.k0 = 0; u.nt = ntk;
        if (L < Ur) { const int v = tab[L]; u.e = v & 255; u.pm = v >> 8; u.pn = u.e; u.nrows = cnt[u.e]; return true; }
        L -= Ur;
        if (L < nSh) { u.e = -1; u.pm = L >> 3; u.pn = NE + (L & 7); u.nrows = 0; return true; }
        return false;
    }
};
struct RowList {
    const int* list;
    static constexpr bool IDENT = false;
    __device__ __forceinline__ unsigned base(const UnitX&) const { return 0u; }
    __device__ __forceinline__ unsigned row(const UnitX& u, int r) const {
        if (u.e < 0) return (unsigned)(u.pm * BM + r);
        int i = u.pm * BM + r; i = i < u.nrows ? i : u.nrows - 1;
        return (unsigned)list[(size_t)u.e * T + i];
    }
};
struct EpiSwigluX {
    static constexpr bool PERM = true, AFTER_DRAIN = false;
    unsigned char* H; const float* gates; const int* list; float oscale;
    __device__ __forceinline__ void operator()(const f32x4 (&acc)[2][2][4][2], const UnitX& u, int wr, int wc, int fr, int fq) const {
        const int hc0 = u.pn * 128 + wc * 16 + 4 * fq;
#pragma unroll
        for (int ai = 0; ai < 2; ++ai)
#pragma unroll
            for (int m = 0; m < 4; ++m) { const int rloc = u.pm * BM + wr * 64 + fr + ai * HALF + m * 16; int tok = rloc; float gt = 1.f; bool ok = true;
                if (u.e >= 0) { ok = rloc < u.nrows; tok = ok ? list[(size_t)u.e * T + rloc] : 0; gt = ok ? gates[(size_t)tok * NE + u.e] : 0.f; }
                if (ok) {
#pragma unroll
                for (int bj = 0; bj < 2; ++bj) { const f32x4 v0 = acc[ai][bj][m][0] * oscale, v1 = acc[ai][bj][m][1] * oscale;
                    const float h0 = v0[0] / (1.f + __expf(-v0[0])) * v0[1] * gt, h1 = v0[2] / (1.f + __expf(-v0[2])) * v0[3] * gt;
                    const float h2 = v1[0] / (1.f + __expf(-v1[0])) * v1[1] * gt, h3 = v1[2] / (1.f + __expf(-v1[2])) * v1[3] * gt;
                    int w = __builtin_amdgcn_cvt_pk_fp8_f32(__builtin_amdgcn_fmed3f(h0, -448.f, 448.f), __builtin_amdgcn_fmed3f(h1, -448.f, 448.f), 0, false); w = __builtin_amdgcn_cvt_pk_fp8_f32(__builtin_amdgcn_fmed3f(h2, -448.f, 448.f), __builtin_amdgcn_fmed3f(h3, -448.f, 448.f), w, true);
                    *(int*)(H + (size_t)tok * DN_K + hc0 + bj * 64) = w; } } }
    }
};

struct SplitCtxOrder {
    int nN, G, c, ntk, nlat, nsub, nsplit;
    __device__ __forceinline__ void init(int M, int N, int K, int G_, int c_, int nsplit_) { nN = N / BM; G = G_; c = c_; ntk = K / BK; nsplit = nsplit_; nlat = (NLAT / BM) * nN; nsub = (M > NLAT) ? ((M - NLAT) / BM) * nN * nsplit : 0; }
    __device__ __forceinline__ bool next(int i, UnitX& u) const {
        int L = i * G + c; u.e = -1; u.nrows = 0;
        if (L < nlat) { int wgid = L; { const int q = nlat / NXCD, xcd = wgid % NXCD, off = wgid / NXCD; wgid = xcd * q + off; }
            const int nig = WGM * nN, gid = wgid / nig, fm = gid * WGM; u.pm = fm + ((wgid % nig) % WGM); u.pn = (wgid % nig) / WGM; u.k0 = 0; u.nt = ntk; return true; }
        L -= nlat;
        if (L < nsub) { const int tile = L / nsplit, s = L % nsplit; u.pm = NLAT / BM + tile / nN; u.pn = tile % nN; u.nt = ntk / nsplit; u.k0 = s * (ntk / nsplit) * BK; u.e = -2 - s; return true; }
        return false;
    }
};
struct RowIdent { static constexpr bool IDENT = true;
                  __device__ __forceinline__ unsigned base(const UnitX& u) const { return (unsigned)(u.pm * BM); }
                  __device__ __forceinline__ unsigned row(const UnitX&, int r) const { return (unsigned)r; } };
struct EpiResidX {
    static constexpr bool PERM = false, AFTER_DRAIN = false;
    const float* lat_src; float* lat_dst; const float* gate; float* part; float oscale;
    __device__ __forceinline__ void operator()(const f32x4 (&acc)[2][2][4][2], const UnitX& u, int wr, int wc, int fr, int fq) const {
        const int rowt = u.pm * BM, col0 = u.pn * BM + wc * 32 + 4 * fq;
        if (u.e <= -2) {
            float* pp = part + (size_t)(-2 - u.e) * NCTX * D; const int row0 = rowt - NLAT + wr * 64 + fr;
#pragma unroll
            for (int ai = 0; ai < 2; ++ai)
#pragma unroll
                for (int m = 0; m < 4; ++m) { const size_t off = (size_t)(row0 + ai * HALF + m * 16) * D + col0;
#pragma unroll
                    for (int bj = 0; bj < 2; ++bj)
#pragma unroll
                        for (int n = 0; n < 2; ++n) *(f32x4*)(pp + off + bj * HALF + n * 16) = acc[ai][bj][m][n] * oscale; }
            return; }
        const int c = rowt < SEQ ? 0 : 1; const float* gv = gate + (size_t)c * 6 * D; const int row0 = rowt + wr * 64 + fr;
        f32x4 g[2][2];
#pragma unroll
        for (int bj = 0; bj < 2; ++bj)
#pragma unroll
            for (int n = 0; n < 2; ++n) g[bj][n] = *(const f32x4*)(gv + col0 + bj * HALF + n * 16) * oscale;
#pragma unroll
        for (int ai = 0; ai < 2; ++ai)
#pragma unroll
            for (int m = 0; m < 4; ++m) { const size_t off = (size_t)(row0 + ai * HALF + m * 16) * D + col0;
#pragma unroll
                for (int bj = 0; bj < 2; ++bj)
#pragma unroll
                    for (int n = 0; n < 2; ++n) { const f32x4 s = *(const f32x4*)(lat_src + off + bj * HALF + n * 16); *(f32x4*)(lat_dst + off + bj * HALF + n * 16) = s + g[bj][n] * acc[ai][bj][m][n]; } }
    }
};

struct StaticOrderX {
    int nM, nN, nwg, G, c, ntk;
    __device__ __forceinline__ void init(int M, int N, int K, int G_, int c_) { nM = M / BM; nN = N / BM; nwg = nM * nN; G = G_; c = c_; ntk = K / BK; }
    __device__ __forceinline__ bool next(int i, UnitX& u) const {
        const long L = (long)i * G + c; if (L >= nwg) return false;
        int wgid = (int)L; { const int q = nwg / NXCD, r = nwg % NXCD, xcd = wgid % NXCD, off = wgid / NXCD; wgid = (xcd < r ? xcd * (q + 1) : r * (q + 1) + (xcd - r) * q) + off; }
        const int nig = WGM * nN, gid = wgid / nig, fm = gid * WGM, gsz = (nM - fm) < WGM ? (nM - fm) : WGM;
        u.pm = fm + ((wgid % nig) % gsz); u.pn = (wgid % nig) / gsz; u.e = -1; u.nrows = 0; u.k0 = 0; u.nt = ntk; return true;
    }
};
template <int ACT> struct EpiBf16X {
    static constexpr bool PERM = true, AFTER_DRAIN = false;
    bf16_t* O; int ldc; const float* bias; float oscale;
    __device__ __forceinline__ void operator()(const f32x4 (&acc)[2][2][4][2], const UnitX& u, int wr, int wc, int fr, int fq) const {
        const int row0 = u.pm * BM + wr * 64 + fr, col0 = u.pn * BM + wc * 32 + 8 * fq;
        f32x4 bv[2][2];
#pragma unroll
        for (int bj = 0; bj < 2; ++bj)
#pragma unroll
            for (int n = 0; n < 2; ++n) bv[bj][n] = bias ? *(const f32x4*)(bias + col0 + bj * HALF + 4 * n) : (f32x4){0.f, 0.f, 0.f, 0.f};
#pragma unroll
        for (int ai = 0; ai < 2; ++ai)
#pragma unroll
            for (int m = 0; m < 4; ++m) { bf16_t* rowp = O + (size_t)(row0 + ai * HALF + m * 16) * ldc + col0;
#pragma unroll
                for (int bj = 0; bj < 2; ++bj) { f32x4 v0 = acc[ai][bj][m][0] * oscale + bv[bj][0], v1 = acc[ai][bj][m][1] * oscale + bv[bj][1];
                    if (ACT == 1) { f32x2 a = gelu_pk((f32x2){v0[0], v0[1]}), b = gelu_pk((f32x2){v0[2], v0[3]}), c = gelu_pk((f32x2){v1[0], v1[1]}), d = gelu_pk((f32x2){v1[2], v1[3]});
                        v0 = (f32x4){a.x, a.y, b.x, b.y}; v1 = (f32x4){c.x, c.y, d.x, d.y}; }
                    u32x4 w; w.x = cvt_pk_bf16(v0[0], v0[1]); w.y = cvt_pk_bf16(v0[2], v0[3]); w.z = cvt_pk_bf16(v1[0], v1[1]); w.w = cvt_pk_bf16(v1[2], v1[3]);
                    *(u32x4*)(rowp + bj * HALF) = w; } }
    }
};
}

#ifndef PG8_SP2
#define PG8_SP2 true
#endif
#ifndef PG8_ALIGN
#define PG8_ALIGN true
#endif

#define LAS __attribute__((address_space(3)))
typedef unsigned short bf16_t;
typedef float f32x4 __attribute__((ext_vector_type(4)));
typedef unsigned u32x4 __attribute__((ext_vector_type(4)));
typedef unsigned u32x2 __attribute__((ext_vector_type(2)));

constexpr size_t MiB = 1u << 20;
constexpr size_t WS_CTL = 0, CTL_ZERO_BYTES = 1 * MiB;
constexpr size_t WS_MODS = 1 * MiB;
constexpr size_t WS_RPART = 3 * MiB;
constexpr size_t WS_WR = 4 * MiB;
constexpr size_t WS_RB = 16 * MiB;
constexpr size_t WS_RSTDV = 16 * MiB + 65536;
constexpr size_t WS_GATES = 17 * MiB;
constexpr size_t WS_CX = 22 * MiB;
constexpr size_t WS_WIN = 30 * MiB;
constexpr size_t WS_WOUT = WS_WIN + 96 * MiB;
constexpr size_t WS_WGU = WS_WOUT + 32 * MiB;
constexpr size_t WS_WD = WS_WGU + 144 * MiB;
constexpr size_t WS_H = WS_WD + 72 * MiB;
constexpr size_t WS_P = WS_H + 132 * MiB;
constexpr size_t WS_MIX = WS_P + 396 * MiB;
constexpr size_t WS_UT = WS_MIX + 132 * MiB;
constexpr size_t WS_FILT = WS_UT + 384 * MiB;
constexpr size_t WS_FILTC = WS_FILT + 256 * MiB;
constexpr size_t WS_Z2T = WS_FILTC + 8 * MiB;
constexpr size_t WS_END = WS_Z2T + 128 * MiB;
constexpr size_t WS_WSET2 = WS_END;
constexpr size_t WSET_BYTES = 344 * MiB;
constexpr size_t WS_PART = WS_WSET2 + WSET_BYTES;
constexpr size_t WS_ELIST = WS_PART + 64 * MiB;
constexpr size_t WS_H8E = WS_ELIST + 5 * MiB;
constexpr size_t WS_END2 = WS_H8E + 66 * MiB;
constexpr int CW_BAR = 4096;
constexpr int CW_ECNT = 8192;
constexpr int CW_WQ = 8704;
constexpr int CW_ARR = 8768;
constexpr int TAB_OFF = 131072;

constexpr int LDS_BYTES = 147456;
constexpr int MISC_OFF = 147200;

#define XB_TMO      128
#define XB_XCNT(j)  (256  + 64 * (j))
#define XB_XSUB(j)  (1280 + 64 * (j))
#define XB_XGEN(j)  (2304 + 64 * (j))
#define XB_TOP      3328
#define XB_TOPGEN   3392
#define XCD_BAR_WORDS 3456
#define XB_SPIN_CAP (1u << 21)

__device__ __forceinline__ unsigned xb_ld(unsigned* p)              { return __hip_atomic_load(p, __ATOMIC_RELAXED, __HIP_MEMORY_SCOPE_AGENT); }
__device__ __forceinline__ unsigned xb_add(unsigned* p, unsigned v) { return __hip_atomic_fetch_add(p, v, __ATOMIC_RELAXED, __HIP_MEMORY_SCOPE_AGENT); }
__device__ __forceinline__ unsigned xb_xcc_id() { return (unsigned)__builtin_amdgcn_s_getreg((3 << 11) | 20) & 0xFu; }
#define XB_SPIN(cond, bar) do { unsigned _sp = 0; while (cond) { __builtin_amdgcn_s_sleep(1); \
    if ((++_sp & 255u) == 0u) { if (xb_ld(&(bar)[XB_TMO])) break; if (_sp > XB_SPIN_CAP) { atomicAdd(&(bar)[XB_TMO], 1u); break; } } } } while (0)

struct XcdBarrier { unsigned* bar; unsigned x; volatile LAS unsigned* st; };

__device__ __forceinline__ XcdBarrier xcd_barrier_post(unsigned* bar, volatile LAS unsigned* st) {
    XcdBarrier b; b.bar = bar; b.x = xb_xcc_id(); b.st = st;
    if (threadIdx.x == 0) (void)xb_add(&bar[XB_XCNT(b.x)], 1u);
    return b;
}
__device__ __forceinline__ void xcd_barrier_complete(unsigned* bar, unsigned x, unsigned& nloc, unsigned& nx) {
    const unsigned G = gridDim.x * gridDim.y * gridDim.z;
    unsigned sum, cnt, mine, sp = 0u;
    for (;;) {
        sum = 0u; cnt = 0u; mine = 0u;
#pragma unroll
        for (unsigned j = 0; j < 16; ++j) { const unsigned c = xb_ld(&bar[XB_XCNT(j)]); sum += c; cnt += (c > 0u) ? 1u : 0u; mine = (j == x) ? c : mine; }
        if (sum == G) break;
        __builtin_amdgcn_s_sleep(1);
        if ((++sp & 255u) == 0u) { if (xb_ld(&bar[XB_TMO])) break; if (sp > XB_SPIN_CAP) { atomicAdd(&bar[XB_TMO], 1u); break; } }
    }
    nloc = mine > 0u ? mine : 1u; nx = cnt > 0u ? cnt : 1u;
}
__device__ __forceinline__ void xcd_barrier(const XcdBarrier& b) {
    asm volatile("s_waitcnt vmcnt(0)" ::: "memory");
    __syncthreads();
    if (threadIdx.x == 0) {
        unsigned* bar = b.bar;
        __builtin_amdgcn_s_waitcnt(0);
        unsigned nloc = b.st[0], nx = b.st[1];
        if (nloc == 0u) { xcd_barrier_complete(bar, b.x, nloc, nx); b.st[0] = nloc; b.st[1] = nx; }
        const unsigned old = xb_add(&bar[XB_XSUB(b.x)], 1u);
        const unsigned gen = old / nloc;
        if (old + 1u == (gen + 1u) * nloc) {
            __builtin_amdgcn_fence(__ATOMIC_RELEASE, "agent");
            asm volatile("s_waitcnt vmcnt(0)" ::: "memory");
            const unsigned og = xb_add(&bar[XB_TOP], 1u);
            const unsigned tg = og / nx;
            if (og + 1u == (tg + 1u) * nx) xb_add(&bar[XB_TOPGEN], 1u);
            else XB_SPIN(xb_ld(&bar[XB_TOPGEN]) == tg, bar);
            __builtin_amdgcn_fence(__ATOMIC_ACQUIRE, "agent");
            xb_add(&bar[XB_XGEN(b.x)], 1u);
            asm volatile("s_waitcnt vmcnt(0)" ::: "memory");
        } else {
            XB_SPIN(xb_ld(&bar[XB_XGEN(b.x)]) == gen, bar);
            __builtin_amdgcn_fence(__ATOMIC_ACQUIRE, "agent");
            asm volatile("s_waitcnt vmcnt(0)" ::: "memory");
        }
    }
    __syncthreads();
}

struct Args { const float* in[38]; float* out; unsigned char* ws; int ph_lo, ph_hi; };
enum { I_X = 0, I_C, I_CTX, I_CCTX, I_ADA_A, I_ADA_B, I_ADA_BIAS, I_NORM_MIX, I_NORM_FFN, I_EVEN_WIN, I_QGAIN, I_KGAIN, I_RPB, I_HY_CW, I_HY_CB,
       I_HY_W1, I_HY_B1, I_HY_W2, I_HY_B2, I_HY_W3, I_HY_B3, I_HY_W4, I_HY_FREQ, I_HY_SKIP, I_ODD_WIN, I_ODD_BIN, I_GM_VGAIN, I_GM_WS, I_GM_BS, I_WOUT,
       I_ROUTER, I_MOE_BIAS, I_MOE_WG, I_MOE_WU, I_MOE_WD, I_SH_WG, I_SH_WU, I_SH_WD };

struct Frame { LAS unsigned char* lds; int tid, lane, wave, G, gw, NGW; };

#define LDS_WAIT() asm volatile("s_waitcnt lgkmcnt(0)" ::: "memory")
__device__ __forceinline__ int opaque_zero() { int z; asm volatile("s_mov_b32 %0, 0" : "=s"(z)); return z; }
#define INP(i) (a.in[(i) + Z])
#define WSB(off) (a.ws + ((size_t)(off) + (size_t)Z))
#define AOUT (a.out + (size_t)Z)
#define WSETP(off, l_) ((bf16_t*)(a.ws + (((l_) & 1) ? (WS_WSET2 + ((off) - WS_WIN)) : (off)) + (size_t)Z))
__device__ __forceinline__ unsigned f2bf(float f) { unsigned u = __builtin_bit_cast(unsigned, f); return (u + 0x7fffu + ((u >> 16) & 1u)) >> 16; }
typedef __bf16 bf16x2_t __attribute__((ext_vector_type(2)));
__device__ __forceinline__ unsigned pk2(float lo, float hi) { bf16x2_t v; v.x = (__bf16)lo; v.y = (__bf16)hi; return __builtin_bit_cast(unsigned, v); }
__device__ __forceinline__ float sat8(float v) { return __builtin_amdgcn_fmed3f(v, -448.f, 448.f); }
__device__ __forceinline__ unsigned pk4f8(float a0, float a1, float a2, float a3) { a0 = sat8(a0); a1 = sat8(a1); a2 = sat8(a2); a3 = sat8(a3); int w = __builtin_amdgcn_cvt_pk_fp8_f32(a0, a1, 0, false); w = __builtin_amdgcn_cvt_pk_fp8_f32(a2, a3, w, true); return (unsigned)w; }
__device__ __forceinline__ float bflo(unsigned u) { return __builtin_bit_cast(float, u << 16); }
__device__ __forceinline__ float bfhi(unsigned u) { return __builtin_bit_cast(float, u & 0xffff0000u); }
__device__ __forceinline__ float bf2f(bf16_t b) { return __builtin_bit_cast(float, ((unsigned)b) << 16); }
__device__ __forceinline__ float wave_sum(float v) {
#pragma unroll
    for (int o = 1; o < 64; o <<= 1) v += __shfl_xor(v, o);
    return v;
}
__device__ __forceinline__ float wave_max(float v) {
#pragma unroll
    for (int o = 1; o < 64; o <<= 1) v = fmaxf(v, __shfl_xor(v, o));
    return v;
}
__device__ __forceinline__ float* MODSP_(unsigned char* wsz, int l, int c, int i) { return (float*)(wsz + WS_MODS) + ((size_t)(l * 3 + c) * 6 + i) * D; }
#define MODSP(a_, l_, c_, i_) MODSP_(WSB(0), l_, c_, i_)

__device__ __forceinline__ void ph_mods1(const Args& a, const Frame& F) {
    const int Z = opaque_zero();
    LAS float* red = (LAS float*)F.lds;
    const float* c = INP(I_C); const float* cc = INP(I_CCTX); const float* A = INP(I_ADA_A);
    float* rpart = (float*)WSB(WS_RPART);
    for (int it = blockIdx.x; it < 4 * 64; it += F.G) {
        const int l = it >> 6, kc = it & 63, j = F.tid & 255, half = F.tid >> 8, k0 = kc * 64 + half * 32;
        float s0 = 0.f, s1 = 0.f, s2 = 0.f;
        const float* Ap = A + ((size_t)l * D + k0) * RANK + j;
        for (int k = 0; k < 32; ++k) {
            const float w = Ap[(size_t)k * RANK]; const float x0 = c[k0 + k], x1 = c[D + k0 + k], x2 = cc[k0 + k];
            s0 += x0 / (1.f + expf(-x0)) * w; s1 += x1 / (1.f + expf(-x1)) * w; s2 += x2 / (1.f + expf(-x2)) * w;
        }
        if (half == 1) { red[j] = s0; red[256 + j] = s1; red[512 + j] = s2; }
        __syncthreads();
        if (half == 0) { float* o = rpart + (size_t)(l * 64 + kc) * 768; o[j] = s0 + red[j]; o[256 + j] = s1 + red[256 + j]; o[512 + j] = s2 + red[512 + j]; }
        __syncthreads();
    }
}
__device__ __forceinline__ void ph_mods2(const Args& a, const Frame& F) {
    const int Z = opaque_zero();
    LAS float* r = (LAS float*)F.lds;
    const float* rpart = (const float*)WSB(WS_RPART); const float* B = INP(I_ADA_B); const float* bias = INP(I_ADA_BIAS);
    for (int it = blockIdx.x; it < 4 * 48; it += F.G) {
        const int l = it / 48, nc = it % 48;
        for (int idx = F.tid; idx < 768; idx += 512) { float s = 0.f; for (int kc = 0; kc < 64; ++kc) s += rpart[(size_t)(l * 64 + kc) * 768 + idx]; r[idx] = s; }
        __syncthreads();
        const int n = nc * 512 + F.tid; const float* Bp = B + (size_t)l * RANK * 24576 + n;
        float s0 = bias[l * 24576 + n], s1 = s0, s2 = s0;
        for (int j = 0; j < RANK; ++j) { const float w = Bp[(size_t)j * 24576]; s0 += r[j] * w; s1 += r[256 + j] * w; s2 += r[512 + j] * w; }
        float* M = (float*)WSB(WS_MODS);
        M[(size_t)(l * 3 + 0) * 24576 + n] = s0; M[(size_t)(l * 3 + 1) * 24576 + n] = s1; M[(size_t)(l * 3 + 2) * 24576 + n] = s2;
        __syncthreads();
    }
}
__device__ __forceinline__ void ph_rprep(const Args& a, const Frame& F) {
    const int Z = opaque_zero();
    LAS float* tile = (LAS float*)F.lds;
    bf16_t* WRH = (bf16_t*)WSB(WS_WR); bf16_t* WRL = WRH + (size_t)4 * 3 * NE * D; float* RB = (float*)WSB(WS_RB);
    for (int it = blockIdx.x; it < 4 * 64; it += F.G) {
        const int l = it >> 6, kc = it & 63, k0 = kc * 64;
        const float* Wr = INP(I_ROUTER) + ((size_t)l * D + k0) * NE;
        for (int idx = F.tid; idx < 4096; idx += 512) tile[(idx >> 6) * 65 + (idx & 63)] = Wr[idx];
        __syncthreads();
        const float* g = INP(I_NORM_FFN) + (size_t)l * D;
        for (int c = 0; c < 3; ++c) {
            const float* sc = MODSP(a, l, c, 4); const size_t ob = (size_t)(l * 3 + c) * NE * D;
            for (int idx = F.tid; idx < 4096; idx += 512) { const int e = idx >> 6, kk = idx & 63, k = k0 + kk; const float v = tile[kk * 65 + e] * (g[k] * (1.f + sc[k]));
                const unsigned hb = __builtin_bit_cast(unsigned, v) & 0xffff0000u; const float lo = v - __builtin_bit_cast(float, hb);
                const size_t fo = ob + ((size_t)(((k >> 5) * 4 + (e >> 4)) * 64 + ((k & 31) >> 3) * 16 + (e & 15))) * 8 + (k & 7);
                WRH[fo] = (bf16_t)(hb >> 16); WRL[fo] = (bf16_t)f2bf(lo); }
        }
        __syncthreads();
    }
    for (int task = F.gw; task < 4 * 3 * NE; task += F.NGW) {
        const int l = task / 192, c = (task / 64) % 3, e = task & 63;
        const float* sh = MODSP(a, l, c, 3); const float* Wr = INP(I_ROUTER) + (size_t)l * D * NE + e; float s = 0.f;
        for (int k = F.lane; k < D; k += 64) s += sh[k] * Wr[(size_t)k * NE];
        s = wave_sum(s); if (F.lane == 0) RB[task] = s;
    }
}

__device__ __forceinline__ void transpose_item(const float* W, int N, bf16_t* WT, int ldk, int row_off, int row_mul, int koff, LAS float* scr, int item, int lane) {
    const int nblk = N / 32, kb = item / nblk, nb = item % nblk, k0 = 64 * kb, n0 = 32 * nb;
#pragma unroll 8
    for (int i = 0; i < 32; ++i) { const int kk = 2 * i + (lane >> 5); scr[kk * 33 + (lane & 31)] = W[(size_t)(k0 + kk) * N + n0 + (lane & 31)]; }
    LDS_WAIT();
    const int c = lane & 7;
#pragma unroll
    for (int j = 0; j < 4; ++j) { const int n = (lane >> 3) + 8 * j; const LAS float* s = scr + (8 * c) * 33 + n;
        u32x4 o; o.x = pk2(s[0 * 33], s[1 * 33]); o.y = pk2(s[2 * 33], s[3 * 33]); o.z = pk2(s[4 * 33], s[5 * 33]); o.w = pk2(s[6 * 33], s[7 * 33]);
        *(u32x4*)(WT + (size_t)(row_off + (n0 + n) * row_mul) * ldk + koff + k0 + 8 * c) = o; }
    LDS_WAIT();
}
__device__ __forceinline__ void transpose_item_f8(const float* W, int N, unsigned char* WT, int ldk, int row_off, int row_mul, int koff, float scale, LAS float* scr, int item, int lane) {
    const int nblk = N / 32, kb = item / nblk, nb = item % nblk, k0 = 64 * kb, n0 = 32 * nb;
#pragma unroll 8
    for (int i = 0; i < 32; ++i) { const int kk = 2 * i + (lane >> 5); scr[kk * 33 + (lane & 31)] = W[(size_t)(k0 + kk) * N + n0 + (lane & 31)]; }
    LDS_WAIT();
    const int c = lane & 7;
#pragma unroll
    for (int j = 0; j < 4; ++j) { const int n = (lane >> 3) + 8 * j; const LAS float* s = scr + (8 * c) * 33 + n;
        int lo = __builtin_amdgcn_cvt_pk_fp8_f32(s[0 * 33] * scale, s[1 * 33] * scale, 0, false); lo = __builtin_amdgcn_cvt_pk_fp8_f32(s[2 * 33] * scale, s[3 * 33] * scale, lo, true);
        int hi = __builtin_amdgcn_cvt_pk_fp8_f32(s[4 * 33] * scale, s[5 * 33] * scale, 0, false); hi = __builtin_amdgcn_cvt_pk_fp8_f32(s[6 * 33] * scale, s[7 * 33] * scale, hi, true);
        u32x2 o; o.x = (unsigned)lo; o.y = (unsigned)hi;
        *(u32x2*)(WT + (size_t)(row_off + (n0 + n) * row_mul) * ldk + koff + k0 + 8 * c) = o; }
    LDS_WAIT();
}
constexpr float WD_SCALE = 16.f, WGU_SCALE = 64.f;
__device__ __forceinline__ void conv_mat(const Frame& F, const float* W, int K, int N, bf16_t* WT, int ldk, int row_off, int row_mul, int koff, LAS float* scr) {
    const int nitems = (K / 64) * (N / 32);
    for (int it = F.gw; it < nitems; it += F.NGW) transpose_item(W, N, WT, ldk, row_off, row_mul, koff, scr, it, F.lane);
}
constexpr int WQ_CHUNK = 8;
__device__ __forceinline__ int wq_nitems(int lt) { return (((lt & 1) == 0) ? 24576 : 16384) + 8192 + 16384 + 16384 + 2048 + 2048 + 16384 + 2048; }
__device__ __forceinline__ void wq_item(const Args& a, const Frame& F, int lt, int item, LAS float* scr, int Z) {
    const int j = lt >> 1; const int n0 = ((lt & 1) == 0) ? 24576 : 16384;
    bf16_t* WIN = WSETP(WS_WIN, lt); bf16_t* WOUT = WSETP(WS_WOUT, lt); bf16_t* WGU = WSETP(WS_WGU, lt); bf16_t* WD = WSETP(WS_WD, lt);
    int it = item;
    if (it < n0) { if ((lt & 1) == 0) { if ((it % (EVEN_IN / 32)) * 32 < 6144) transpose_item_f8(INP(I_EVEN_WIN) + (size_t)j * D * EVEN_IN, EVEN_IN, (unsigned char*)WIN, D, 0, 1, 0, WGU_SCALE, scr, it, F.lane);
                                        else transpose_item(INP(I_EVEN_WIN) + (size_t)j * D * EVEN_IN, EVEN_IN, WIN, D, 0, 1, 0, scr, it, F.lane); }
                   else transpose_item_f8(INP(I_ODD_WIN) + (size_t)j * D * ODD_IN, ODD_IN, (unsigned char*)WIN, D, 0, 1, 0, WGU_SCALE, scr, it, F.lane); return; }
    it -= n0;
    if (it < 8192) { if (lt & 1) transpose_item_f8(INP(I_WOUT) + (size_t)lt * D * D, D, (unsigned char*)WOUT, D, 0, 1, 0, WGU_SCALE, scr, it, F.lane);
                     else transpose_item(INP(I_WOUT) + (size_t)lt * D * D, D, WOUT, D, 0, 1, 0, scr, it, F.lane); return; }
    it -= 8192;
    if (it < 16384) { const int e = it >> 8, li = it & 255; transpose_item_f8(INP(I_MOE_WG) + ((size_t)lt * NE + e) * D * ED, ED, (unsigned char*)WGU, D, e * 256, 2, 0, WGU_SCALE, scr, li, F.lane); return; }
    it -= 16384;
    if (it < 16384) { const int e = it >> 8, li = it & 255; transpose_item_f8(INP(I_MOE_WU) + ((size_t)lt * NE + e) * D * ED, ED, (unsigned char*)WGU, D, e * 256 + 1, 2, 0, WGU_SCALE, scr, li, F.lane); return; }
    it -= 16384;
    if (it < 2048) { transpose_item_f8(INP(I_SH_WG) + (size_t)lt * D * SHD, SHD, (unsigned char*)WGU, D, NE * 256, 2, 0, WGU_SCALE, scr, it, F.lane); return; }
    it -= 2048;
    if (it < 2048) { transpose_item_f8(INP(I_SH_WU) + (size_t)lt * D * SHD, SHD, (unsigned char*)WGU, D, NE * 256 + 1, 2, 0, WGU_SCALE, scr, it, F.lane); return; }
    it -= 2048;
    if (it < 16384) { const int e = it >> 8, li = it & 255; transpose_item_f8(INP(I_MOE_WD) + ((size_t)lt * NE + e) * ED * D, D, (unsigned char*)WD, DN_K, 0, 1, e * ED, WD_SCALE, scr, li, F.lane); return; }
    it -= 16384;
    transpose_item_f8(INP(I_SH_WD) + (size_t)lt * SHD * D, D, (unsigned char*)WD, DN_K, 0, 1, NE * ED, WD_SCALE, scr, it, F.lane);
}
__device__ __forceinline__ void wq_pull(const Args& a, const Frame& F, int lt, int arr_word) {
    const int Z = opaque_zero();
    unsigned* ctl = (unsigned*)WSB(WS_CTL);
    volatile LAS unsigned* MISC = (volatile LAS unsigned*)(F.lds + MISC_OFF);
    LAS float* scr = (LAS float*)(F.lds + F.wave * 16384);
    const int nchunks = wq_nitems(lt) / WQ_CHUNK;
    __syncthreads();
    if (arr_word >= 0 && F.tid == 0) __hip_atomic_fetch_add(ctl + arr_word, 1u, __ATOMIC_RELAXED, __HIP_MEMORY_SCOPE_AGENT);
    for (;;) {
        if (F.tid == 0) {
            unsigned c = 0xffffffffu;
            const bool go = (arr_word < 0) || (__hip_atomic_load(ctl + arr_word, __ATOMIC_RELAXED, __HIP_MEMORY_SCOPE_AGENT) < (unsigned)F.G);
            if (go) c = __hip_atomic_fetch_add(ctl + CW_WQ + lt, 1u, __ATOMIC_RELAXED, __HIP_MEMORY_SCOPE_AGENT);
            MISC[16] = c;
        }
        __syncthreads();
        const unsigned c = MISC[16];
        __syncthreads();
        if (c >= (unsigned)nchunks) break;
#pragma unroll 1
        for (int q = 0; q < WQ_CHUNK / 8; ++q) wq_item(a, F, lt, (int)c * WQ_CHUNK + F.wave * (WQ_CHUNK / 8) + q, scr, Z);
    }
}

__device__ __forceinline__ void ph_norm(const Args& a, const Frame& F, int l, int which, int gw0, int ngw, bool zero_hall = false) {
    const int Z = opaque_zero();
    bf16_t* HA = (bf16_t*)WSB(WS_P); unsigned char* H8E = (unsigned char*)WSB(WS_H8E);
    const int M = which ? ((l >= 2) ? NLAT : T) : ((l == 3) ? NLAT : T);
    const float* lat_src = (l == 0 && which == 0) ? INP(I_X) : AOUT;
    const float* cx_src = (l == 0 && which == 0) ? INP(I_CTX) : (const float*)WSB(WS_CX);
    const float* g = (which ? INP(I_NORM_FFN) : INP(I_NORM_MIX)) + (size_t)l * D;
    bf16_t* H = (bf16_t*)WSB(WS_H);
    for (int row = gw0; row < M; row += ngw) {
        const float* src = row < NLAT ? lat_src + (size_t)row * D : cx_src + (size_t)(row - NLAT) * D;
        const int c = row < SEQ ? 0 : (row < NLAT ? 1 : 2);
        const float* sh = MODSP(a, l, c, which ? 3 : 0); const float* sc = MODSP(a, l, c, which ? 4 : 1);
        f32x4 v[16]; float ss = 0.f;
#pragma unroll
        for (int j = 0; j < 16; ++j) { v[j] = ((const f32x4*)src)[F.lane + 64 * j]; ss += (v[j].x * v[j].x + v[j].y * v[j].y) + (v[j].z * v[j].z + v[j].w * v[j].w); }
        ss = wave_sum(ss);
        const float rstd = 1.0f / sqrtf(ss * (1.0f / D) + EPS);
        u32x2* o = (u32x2*)(H + (size_t)row * D);
#pragma unroll
        for (int j = 0; j < 16; ++j) { const int idx = F.lane + 64 * j; const f32x4 gg = ((const f32x4*)g)[idx], s1 = ((const f32x4*)sc)[idx], s0 = ((const f32x4*)sh)[idx];
            const f32x4 y = (v[j] * rstd) * gg; const f32x4 hh = y * (1.f + s1) + s0;
            if (which || (l & 1)) { ((unsigned*)((unsigned char*)H + (size_t)row * D))[idx] = pk4f8(hh.x, hh.y, hh.z, hh.w); }
            else { ((unsigned*)(H8E + (size_t)row * D))[idx] = pk4f8(hh.x, hh.y, hh.z, hh.w);
                   u32x2 w; w.x = pk2(hh.x, hh.y); w.y = pk2(hh.z, hh.w); o[idx] = w; } }
        if (zero_hall) { u32x4* hr = (u32x4*)((unsigned char*)HA + (size_t)row * DN_K); const u32x4 z4 = (u32x4){0u, 0u, 0u, 0u};
#pragma unroll
            for (int q = 0; q < 8; ++q) hr[F.lane + 64 * q] = z4; }
    }
}

__device__ __forceinline__ void ph_e1(const Args& a, const Frame& F, int l, bool do_a = true) {
    const int Z = opaque_zero();
    const int j2 = l >> 1;
    bf16_t* P = (bf16_t*)WSB(WS_P);
    const float* qg = INP(I_QGAIN) + j2 * 128; const float* kg = INP(I_KGAIN) + j2 * 128;
    if (do_a) for (int row = F.gw; row < T; row += F.NGW) {
        u32x4* pr = (u32x4*)(P + (size_t)row * EVEN_IN);
#pragma unroll
        for (int j = 0; j < 8; ++j) {
            const int chunk = F.lane + 64 * j; const u32x4 raw = pr[chunk];
            float x[8] = { bflo(raw.x), bfhi(raw.x), bflo(raw.y), bfhi(raw.y), bflo(raw.z), bfhi(raw.z), bflo(raw.w), bfhi(raw.w) };
            float ss = 0.f;
#pragma unroll
            for (int i = 0; i < 8; ++i) ss += x[i] * x[i];
            ss += __shfl_xor(ss, 1); ss += __shfl_xor(ss, 2); ss += __shfl_xor(ss, 4); ss += __shfl_xor(ss, 8);
            const float rstd = 1.0f / sqrtf(ss * (1.0f / 128.f) + EPS);
            const float* gp = (j < 4 ? qg : kg) + (chunk & 15) * 8;
            u32x4 o; o.x = pk2(x[0] * rstd * gp[0], x[1] * rstd * gp[1]); o.y = pk2(x[2] * rstd * gp[2], x[3] * rstd * gp[3]);
            o.z = pk2(x[4] * rstd * gp[4], x[5] * rstd * gp[5]); o.w = pk2(x[6] * rstd * gp[6], x[7] * rstd * gp[7]);
            pr[chunk] = o;
        }
    }
    LAS float* Q = (LAS float*)F.lds;
    const float* cw = INP(I_HY_CW) + (size_t)j2 * 3 * 6144; const float* cb = INP(I_HY_CB) + (size_t)j2 * 6144;
    bf16_t* UT = (bf16_t*)WSB(WS_UT); float* Z2T = (float*)WSB(WS_Z2T); typedef float f32x2e __attribute__((ext_vector_type(2)));
    __syncthreads();
    for (int it = blockIdx.x; it < 2 * 128 * 24; it += F.G) {
        const int b = it / (128 * 24), rem = it % (128 * 24), t0 = (rem / 24) * 64, ch0 = (rem % 24) * 256;
        for (int idx = F.tid; idx < 66 * 32; idx += 512) { const int rr = idx >> 5, ck = idx & 31, t = t0 - 1 + rr; u32x4 raw = (u32x4){0u, 0u, 0u, 0u};
            if (t >= 0 && t < SEQ) raw = *(const u32x4*)(P + (size_t)(b * SEQ + t) * EVEN_IN + 6144 + ch0 + 8 * ck);
            LAS float* d = Q + (ck * 66 + rr) * 9; d[0] = bflo(raw.x); d[1] = bfhi(raw.x); d[2] = bflo(raw.y); d[3] = bfhi(raw.y); d[4] = bflo(raw.z); d[5] = bfhi(raw.z); d[6] = bflo(raw.w); d[7] = bfhi(raw.w); }
        __syncthreads();
        for (int idx = F.tid; idx < 256 * 32; idx += 512) { const int ch = idx >> 5, t = (idx & 31) * 2, chg = ch0 + ch; const float w0 = cw[chg], w1 = cw[6144 + chg], w2 = cw[2 * 6144 + chg], bb = cb[chg];
            const LAS float* q = Q + ((ch >> 3) * 66 + t) * 9 + (ch & 7); const float p0 = q[0], p1 = q[9], p2 = q[18], p3 = q[27];
            const float v0 = bb + p0 * w0 + p1 * w1 + p2 * w2, v1 = bb + p1 * w0 + p2 * w1 + p3 * w2;
            if (chg < 4096) *(unsigned*)(UT + ((size_t)b * 4096 + chg) * SEQ + t0 + t) = pk2(v0, v1);
            else { f32x2e o2; o2.x = v0; o2.y = v1; *(f32x2e*)(Z2T + ((size_t)b * 2048 + (chg - 4096)) * SEQ + t0 + t) = o2; } }
        __syncthreads();
    }
}

__device__ __forceinline__ void ph_hyf(const Args& a, const Frame& F, int l) {
    const int Z = opaque_zero();
    const int j2 = l >> 1;
    const float* w1 = INP(I_HY_W1) + (size_t)j2 * 33 * 64; const float* b1 = INP(I_HY_B1) + j2 * 64;
    const float* w2 = INP(I_HY_W2) + (size_t)j2 * 4096; const float* b2 = INP(I_HY_B2) + j2 * 64;
    const float* w3 = INP(I_HY_W3) + (size_t)j2 * 4096; const float* b3 = INP(I_HY_B3) + j2 * 64;
    const float* w4 = INP(I_HY_W4) + (size_t)j2 * 64 * 8192; const float* fq = INP(I_HY_FREQ) + j2 * 192;
    float* FILT = (float*)WSB(WS_FILT); float* FILTC = (float*)WSB(WS_FILTC);
    LAS float* feats = (LAS float*)F.lds; LAS float* ha = feats + 1056; LAS float* hb = ha + 2048; LAS float* hT = hb + 2048; LAS float* tn = hT + 2048;
    const float dstart = -15.350567286626969f, dstop = -3.0701134573253945f, dstep = (dstop - dstart) / 2047.f;
    __syncthreads();
    for (int it = blockIdx.x; it < 256 + 128; it += F.G) {
        const int L = it < 256 ? SEQ : LC, t0 = (it < 256 ? it : ((it - 256) >> 4)) * 32;
        const int i_lo = it < 256 ? 0 : ((it - 256) & 15), i_hi = it < 256 ? 16 : i_lo + 1;
        const float c2pi = (float)(6.283185307179586 / (double)L), invLm1 = 1.0f / (float)(L - 1);
        for (int idx = F.tid; idx < 1056; idx += 512) { const int p = idx / 33, f = idx % 33; const float pos = (float)(t0 + p); float val;
            if (f == 0) { val = pos * invLm1; tn[p] = val; }
            else { const int bi = (f - 1) & 15; const float band = 1e-4f + (float)bi * ((15.f - 1e-4f) / 15.f); const float ang = (c2pi * pos) * band; val = (f <= 16) ? cosf(ang) : -sinf(ang); }
            feats[idx] = val; }
        __syncthreads();
        const int p = F.tid >> 4, ug = F.tid & 15;
#pragma unroll 1
        for (int q = 0; q < 4; ++q) { const int u = ug * 4 + q; float s = b1[u];
#pragma unroll 3
            for (int f = 0; f < 33; ++f) s += feats[p * 33 + f] * w1[f * 64 + u];
            ha[p * 64 + u] = sinf(fq[u] * s); }
        __syncthreads();
#pragma unroll 1
        for (int q = 0; q < 4; ++q) { const int u = ug * 4 + q; float s = b2[u];
#pragma unroll 4
            for (int m = 0; m < 64; ++m) s += ha[p * 64 + m] * w2[m * 64 + u];
            hb[p * 64 + u] = sinf(fq[64 + u] * s); }
        __syncthreads();
#pragma unroll 1
        for (int q = 0; q < 4; ++q) { const int u = ug * 4 + q; float s = b3[u];
#pragma unroll 4
            for (int m = 0; m < 64; ++m) s += hb[p * 64 + m] * w3[m * 64 + u];
            hT[(u >> 2) * 128 + (p >> 4) * 64 + (u & 3) * 16 + (p & 15)] = sinf(fq[128 + u] * s); }
        __syncthreads();
        {   const int j = F.lane & 15, kq = F.lane >> 4; const int cb_lo = i_lo * 32, cb_hi = i_hi * 32;
            const float rstep = -invLm1;
            float bvn[16];
            { const float* wp = w4 + (size_t)kq * 8192 + (cb_lo + F.wave) * 16 + j;
#pragma unroll
              for (int sk = 0; sk < 16; ++sk) bvn[sk] = wp[(size_t)sk * 4 * 8192]; }
#pragma unroll 1
            for (int cb = cb_lo + F.wave; cb < cb_hi; cb += 8) {
                const int n = cb * 16 + j;
                float bv[16];
#pragma unroll
                for (int sk = 0; sk < 16; ++sk) bv[sk] = bvn[sk];
                if (cb + 8 < cb_hi) { const float* wp = w4 + (size_t)kq * 8192 + (cb + 8) * 16 + j;
#pragma unroll
                    for (int sk = 0; sk < 16; ++sk) bvn[sk] = wp[(size_t)sk * 4 * 8192]; }
                f32x4 acc0 = (f32x4){0.f, 0.f, 0.f, 0.f}, acc1 = (f32x4){0.f, 0.f, 0.f, 0.f};
#pragma unroll
                for (int sk = 0; sk < 16; ++sk) { const float a0 = hT[sk * 128 + F.lane], a1 = hT[sk * 128 + 64 + F.lane];
                    acc0 = __builtin_amdgcn_mfma_f32_16x16x4f32(a0, bv[sk], acc0, 0, 0, 0); acc1 = __builtin_amdgcn_mfma_f32_16x16x4f32(a1, bv[sk], acc1, 0, 0, 0); }
                const int dir = n >> 12, o = (n >> 11) & 1, c = n & 2047; const float delta = fabsf(dstart + (float)c * dstep);
                const float ratio = expf(rstep * delta), e0 = expf(-tn[4 * kq] * delta), e1 = expf(-tn[16 + 4 * kq] * delta);
                float* dst = (L == SEQ) ? FILT + (((size_t)(c * 2 + o) * 2 + dir) * SEQ + t0) : FILTC + (((size_t)(c * 2 + o) * 2 + dir) * LC + t0);
                f32x4 v0, v1; float d0 = e0, d1 = e1;
                v0.x = acc0.x * d0; v1.x = acc1.x * d1; d0 *= ratio; d1 *= ratio; v0.y = acc0.y * d0; v1.y = acc1.y * d1; d0 *= ratio; d1 *= ratio;
                v0.z = acc0.z * d0; v1.z = acc1.z * d1; d0 *= ratio; d1 *= ratio; v0.w = acc0.w * d0; v1.w = acc1.w * d1;
                *(f32x4*)(dst + 4 * kq) = v0; *(f32x4*)(dst + 16 + 4 * kq) = v1;
            }
        }
        __syncthreads();
    }
}

typedef short bf16x8v __attribute__((ext_vector_type(8)));
#define GAS __attribute__((address_space(1)))
typedef const GAS char* gcp_t;
__device__ __forceinline__ float xmax16_32(float v) {
    const unsigned u = __builtin_bit_cast(unsigned, v);
    const auto r = __builtin_amdgcn_permlane32_swap(u, u, false, false);
    unsigned a0 = r[0], a1 = r[1]; asm volatile("" : "+v"(a0), "+v"(a1));
    const float m = fmaxf(__builtin_bit_cast(float, a0), __builtin_bit_cast(float, a1));
    const unsigned um = __builtin_bit_cast(unsigned, m);
    const auto r2 = __builtin_amdgcn_permlane16_swap(um, um, false, false);
    unsigned b0 = r2[0], b1 = r2[1]; asm volatile("" : "+v"(b0), "+v"(b1));
    return fmaxf(__builtin_bit_cast(float, b0), __builtin_bit_cast(float, b1));
}
__device__ __forceinline__ void ph_attn(const Args& a, const Frame& F, int l) {
    const int Z = opaque_zero();
    const int j2 = l >> 1;
    const bf16_t* P = (const bf16_t*)WSB(WS_P); bf16_t* MIX = (bf16_t*)WSB(WS_MIX);
    const int wv = __builtin_amdgcn_readfirstlane(F.wave);
    LAS unsigned char* KT = F.lds;
    LAS unsigned char* VT = F.lds + 32768;
    LAS float* rp = (LAS float*)(F.lds + 65536);
    const unsigned vt_addr = (unsigned)(size_t)VT;
    const int j = F.lane & 15, kq = F.lane >> 4;
    const float qscale = 0.08838834764831845f * 1.4426950408889634f;
    const unsigned koff = (unsigned)((j * EVEN_IN + 8 * kq) * 2);
    unsigned foff[2];
#pragma unroll
    for (int u = 0; u < 2; ++u) foff[u] = (unsigned)((8 * wv + 4 * u + kq) * (EVEN_IN * 2) + ((j ^ ((kq << 2) | ((2 * wv + u) & 3))) * 16));
    const bool fast = (F.G & 15) == 0;
    const int nst = 128 + (l == 0 ? 4 : 0);
    unsigned gs = 0;
#pragma unroll 1
    for (int h = fast ? ((int)blockIdx.x & 15) : 0; h < 16; h += (fast ? 16 : 1)) {
        const float* rpb = INP(I_RPB) + ((size_t)j2 * 16 + h) * 465;
        __syncthreads();
        for (int idx = F.tid; idx < 465; idx += 512) rp[idx] = rpb[idx] * 1.4426950408889634f;
        __syncthreads();
        const int w0 = fast ? ((int)blockIdx.x >> 4) : (int)blockIdx.x, nw = fast ? (F.G >> 4) : F.G;
#pragma unroll 1
        for (int st = w0; st < nst; st += nw) {
            int b, nwin, c0 = 0, ws_ = 0, rs = 0, r = 0, rsA = 0; size_t qrow0;
            if (st < 128) { const int r0 = (st & 63) * 2; b = st >> 6; r = r0 + (wv >> 2); c0 = (wv & 3) * 16; ws_ = min(max(c0 - 8, 0), 32); rs = min(max(r - 4, 0), 120);
                rsA = min(max(r0 - 4, 0), 120); nwin = min(max(r0 - 3, 0), 120) + 8 - rsA; qrow0 = (size_t)b * SEQ + r * 64 + c0; }
            else { const int t2 = st - 128; b = t2 >> 1; qrow0 = (size_t)NLAT + b * LC + ((t2 & 1) * 8 + wv) * 16; nwin = 0; }
            const int nsteps = nwin + 4;
            bf16x8v qf[4];
            { unsigned long long qbi = (unsigned long long)(P + qrow0 * EVEN_IN + h * 128); asm volatile("" : "+s"(qbi)); const gcp_t qb = (gcp_t)qbi;
              unsigned _ko = koff; asm volatile("" : "+v"(_ko));
#pragma unroll
              for (int s = 0; s < 4; ++s) qf[s] = *(const GAS bf16x8v*)(qb + 64 * s + _ko); }
            u32x4 fr[4];
#define ATT_FETCH(s_) do { const int _s = (s_); const size_t _tok0 = (_s < nwin) ? ((size_t)b * SEQ + (rsA + _s) * 64) : ((size_t)NLAT + b * LC + (_s - nwin) * 64); \
            unsigned long long _kbi = (unsigned long long)(P + _tok0 * EVEN_IN + 2048 + h * 128); asm volatile("" : "+s"(_kbi)); const gcp_t _kb = (gcp_t)_kbi; \
            _Pragma("unroll") for (int u = 0; u < 2; ++u) { unsigned _fo = foff[u]; asm volatile("" : "+v"(_fo)); \
                fr[u] = *(const GAS u32x4*)(_kb + _fo); fr[2 + u] = *(const GAS u32x4*)(_kb + 4096 + _fo); } } while (0)
#define ATT_PUT(bf_) do { _Pragma("unroll") for (int u = 0; u < 2; ++u) { \
                *(LAS u32x4*)(KT + (bf_) * 16384 + (2 * wv + u) * 1024 + F.lane * 16) = fr[u]; *(LAS u32x4*)(VT + (bf_) * 16384 + (2 * wv + u) * 1024 + F.lane * 16) = fr[2 + u]; } } while (0)
            ATT_FETCH(0);
            const int cq = c0 + j, cs = min(max(cq - 8, 0), 48);
            int dcv[8]; float madd[8];
#pragma unroll
            for (int e = 0; e < 8; ++e) { const int kcol = ws_ + 8 * kq + e; dcv[e] = min(max(kcol - cq + 15, 0), 30); madd[e] = ((unsigned)(kcol - cs) < 16u) ? 0.f : -1e30f; asm volatile("" : "+v"(madd[e])); }
            unsigned KBw[2], KBc[2], VBw[2], VBc[2];
#pragma unroll
            for (int t = 0; t < 2; ++t) {
                { const unsigned row = (unsigned)(ws_ + 8 * (j >> 2) + (j & 3) + 4 * t), y = (row >> 2) & 3u; KBw[t] = 256u * row + 16u * ((unsigned)kq ^ y) + 64u * (unsigned)(j & 3); }
                { const unsigned row = (unsigned)(8 * (j >> 2) + (j & 3) + 4 * t), y = (row >> 2) & 3u; KBc[t] = 256u * row + 16u * ((unsigned)kq ^ y) + 64u * (unsigned)(j & 3); }
                const unsigned q = (unsigned)j >> 2, p = (unsigned)j & 3u, bq = p >> 1;
                { const unsigned row = (unsigned)(ws_ + 8 * kq + 4 * t) + q, X = (q << 2) | ((row >> 2) & 3u); VBw[t] = 256u * row + 16u * (bq ^ X) + 8u * (p & 1u); }
                { const unsigned row = (unsigned)(8 * kq + 4 * t) + q, X = (q << 2) | ((row >> 2) & 3u); VBc[t] = 256u * row + 16u * (bq ^ X) + 8u * (p & 1u); }
            }
            f32x4 o[8];
#pragma unroll
            for (int d = 0; d < 8; ++d) o[d] = (f32x4){0.f, 0.f, 0.f, 0.f};
            float mrun = -1e30f, lsum = 0.f;
#define ATT_GROUP(KB0_, KB1_, VB0_, VB1_, XO_, WIN, brow_) do { \
            bf16x8v kf[8]; \
            _Pragma("unroll") for (int s = 0; s < 4; ++s) { kf[s] = *(const LAS bf16x8v*)(KT + (((KB0_) ^ (64u * s)) + (XO_))); kf[4 + s] = *(const LAS bf16x8v*)(KT + (((KB1_) ^ (64u * s)) + (XO_))); } \
            float bias[8]; \
            if (WIN) { const LAS float* rrow = rp + (brow_) * 31; \
                _Pragma("unroll") for (int e = 0; e < 8; ++e) bias[e] = rrow[dcv[e]]; } \
            f32x4 s0 = (f32x4){0.f, 0.f, 0.f, 0.f}, s1 = (f32x4){0.f, 0.f, 0.f, 0.f}; \
            _Pragma("unroll") for (int s = 0; s < 4; ++s) { s0 = __builtin_amdgcn_mfma_f32_16x16x32_bf16(kf[s], qf[s], s0, 0, 0, 0); s1 = __builtin_amdgcn_mfma_f32_16x16x32_bf16(kf[4 + s], qf[s], s1, 0, 0, 0); } \
            if (WIN) asm volatile("" : "+v"(bias[0]), "+v"(bias[1]), "+v"(bias[2]), "+v"(bias[3]), "+v"(bias[4]), "+v"(bias[5]), "+v"(bias[6]), "+v"(bias[7]));     \
            else asm volatile("" : "+v"(s0), "+v"(s1)); \
            u32x2 tr[8][2]; unsigned rd[8][2]; \
            _Pragma("unroll") for (int d = 0; d < 8; ++d) { rd[d][0] = vt_addr + ((VB0_) ^ (32u * d)); rd[d][1] = vt_addr + ((VB1_) ^ (32u * d)); } \
            asm volatile("ds_read_b64_tr_b16 %0, %8 offset:%16\n\tds_read_b64_tr_b16 %1, %9 offset:%16\n\tds_read_b64_tr_b16 %2, %10 offset:%16\n\tds_read_b64_tr_b16 %3, %11 offset:%16\n\t" \
                         "ds_read_b64_tr_b16 %4, %12 offset:%16\n\tds_read_b64_tr_b16 %5, %13 offset:%16\n\tds_read_b64_tr_b16 %6, %14 offset:%16\n\tds_read_b64_tr_b16 %7, %15 offset:%16" \
                : "=&v"(tr[0][0]), "=&v"(tr[0][1]), "=&v"(tr[1][0]), "=&v"(tr[1][1]), "=&v"(tr[2][0]), "=&v"(tr[2][1]), "=&v"(tr[3][0]), "=&v"(tr[3][1]) \
                : "v"(rd[0][0]), "v"(rd[0][1]), "v"(rd[1][0]), "v"(rd[1][1]), "v"(rd[2][0]), "v"(rd[2][1]), "v"(rd[3][0]), "v"(rd[3][1]), "i"(XO_)); \
            asm volatile("ds_read_b64_tr_b16 %0, %8 offset:%16\n\tds_read_b64_tr_b16 %1, %9 offset:%16\n\tds_read_b64_tr_b16 %2, %10 offset:%16\n\tds_read_b64_tr_b16 %3, %11 offset:%16\n\t" \
                         "ds_read_b64_tr_b16 %4, %12 offset:%16\n\tds_read_b64_tr_b16 %5, %13 offset:%16\n\tds_read_b64_tr_b16 %6, %14 offset:%16\n\tds_read_b64_tr_b16 %7, %15 offset:%16" \
                : "=&v"(tr[4][0]), "=&v"(tr[4][1]), "=&v"(tr[5][0]), "=&v"(tr[5][1]), "=&v"(tr[6][0]), "=&v"(tr[6][1]), "=&v"(tr[7][0]), "=&v"(tr[7][1]) \
                : "v"(rd[4][0]), "v"(rd[4][1]), "v"(rd[5][0]), "v"(rd[5][1]), "v"(rd[6][0]), "v"(rd[6][1]), "v"(rd[7][0]), "v"(rd[7][1]), "i"(XO_)); \
            float sv[8]; \
            _Pragma("unroll") for (int e = 0; e < 8; ++e) sv[e] = WIN ? fmaf((e >> 2) ? s1[e & 3] : s0[e & 3], qscale, bias[e]) + madd[e] : ((e >> 2) ? s1[e & 3] : s0[e & 3]) * qscale; \
            float gmax = sv[0]; \
            _Pragma("unroll") for (int e = 1; e < 8; ++e) gmax = fmaxf(gmax, sv[e]); \
            gmax = xmax16_32(gmax); \
            const float mnew = fmaxf(mrun, gmax), alpha = __builtin_amdgcn_exp2f(mrun - mnew); \
            if (__builtin_amdgcn_ballot_w64(mnew > mrun) != 0ull) { _Pragma("unroll") for (int d = 0; d < 8; ++d) o[d] = o[d] * alpha; } \
            mrun = mnew; \
            float p[8], psum = 0.f; \
            _Pragma("unroll") for (int e = 0; e < 8; ++e) { p[e] = __builtin_amdgcn_exp2f(sv[e] - mnew); psum += p[e]; } \
            lsum = lsum * alpha + psum; \
            union { bf16x8v v; unsigned u[4]; } pf; \
            pf.u[0] = pk2(p[0], p[1]); pf.u[1] = pk2(p[2], p[3]); pf.u[2] = pk2(p[4], p[5]); pf.u[3] = pk2(p[6], p[7]); \
            asm volatile("s_waitcnt lgkmcnt(0)" : "+v"(tr[0][0]), "+v"(tr[0][1]), "+v"(tr[1][0]), "+v"(tr[1][1]), "+v"(tr[2][0]), "+v"(tr[2][1]), "+v"(tr[3][0]), "+v"(tr[3][1]), \
                                                  "+v"(tr[4][0]), "+v"(tr[4][1]), "+v"(tr[5][0]), "+v"(tr[5][1]), "+v"(tr[6][0]), "+v"(tr[6][1]), "+v"(tr[7][0]), "+v"(tr[7][1]) :: "memory"); \
            _Pragma("unroll") for (int d = 0; d < 8; ++d) { union { bf16x8v v; unsigned u[4]; } vf; vf.u[0] = tr[d][0].x; vf.u[1] = tr[d][0].y; vf.u[2] = tr[d][1].x; vf.u[3] = tr[d][1].y; \
                o[d] = __builtin_amdgcn_mfma_f32_16x16x32_bf16(vf.v, pf.v, o[d], 0, 0, 0); } } while (0)
#pragma unroll 1
            for (int step = 0; step < nsteps; ++step, ++gs) {
                ATT_PUT(gs & 1u);
                __syncthreads();
                if (step + 1 < nsteps) ATT_FETCH(step + 1);
                const unsigned bo = (gs & 1u) * 16384u;
                if (step < nwin) {
                    const int g = rsA + step - rs;
                    if ((unsigned)g < 8u) { const unsigned k0 = KBw[0] + bo, k1 = KBw[1] + bo, v0 = VBw[0] + bo, v1 = VBw[1] + bo; ATT_GROUP(k0, k1, v0, v1, 0, true, rs + g - r + 7); }
                } else {
                    const unsigned k0 = KBc[0] + bo, k1 = KBc[1] + bo, v0 = VBc[0] + bo, v1 = VBc[1] + bo;
                    ATT_GROUP(k0, k1, v0, v1, 0, false, 0);
                    ATT_GROUP(k0, k1, v0, v1, 8192, false, 0);
                }
            }
#undef ATT_FETCH
#undef ATT_PUT
#undef ATT_GROUP
            lsum += __shfl_xor(lsum, 16); lsum += __shfl_xor(lsum, 32);
            const float inv = 1.0f / lsum;
#pragma unroll
            for (int d = 0; d < 8; ++d) { u32x2 w; w.x = pk2(o[d].x * inv, o[d].y * inv); w.y = pk2(o[d].z * inv, o[d].w * inv);
                *(u32x2*)(MIX + (qrow0 + j) * D + h * 128 + 16 * d + 4 * kq) = w; }
        }
    }
    __syncthreads();
}

__device__ __forceinline__ float wave_sum_o(float v) {
    int ln = (int)__builtin_amdgcn_mbcnt_hi(~0u, __builtin_amdgcn_mbcnt_lo(~0u, 0u)); asm volatile("" : "+v"(ln));
#pragma unroll
    for (int o = 1; o < 64; o <<= 1) v += __builtin_bit_cast(float, __builtin_amdgcn_ds_bpermute((ln ^ o) << 2, __builtin_bit_cast(int, v)));
    return v;
}
__device__ __forceinline__ float block_sum(const Frame& F, float v, LAS float* red) {
    v = wave_sum_o(v);
    __syncthreads();
    if (F.lane == 0) red[F.wave] = v;
    __syncthreads();
    float s = 0.f;
#pragma unroll
    for (int w = 0; w < 8; ++w) s += red[w];
    return s;
}
typedef float f32x2 __attribute__((ext_vector_type(2)));
#define FP(idx) ((idx) + ((idx) >> 5))
__device__ constexpr int BR5[32] = {0,16,8,24,4,20,12,28,2,18,10,26,6,22,14,30,1,17,9,25,5,21,13,29,3,19,11,27,7,23,15,31};
__device__ constexpr int BR4[16] = {0,8,4,12,2,10,6,14,1,9,5,13,3,11,7,15};
#define brevn(s, bits) ((bits) == 5 ? BR5[(s)] : BR4[(s)])
__device__ __forceinline__ f32x2 cswap(f32x2 a) { f32x2 r; r.x = a.y; r.y = -a.x; return r; }
__device__ __forceinline__ f32x2 cmul(f32x2 a, f32x2 w) { f32x2 t; t.x = -a.y; t.y = a.x; return a * w.x + t * w.y; }
__device__ __forceinline__ f32x2 cmulc(f32x2 a, f32x2 w) { f32x2 t; t.x = a.y; t.y = -a.x; f32x2 r = a * w.x + t * w.y; r.y = -r.y; return r; }
template <int R> __device__ __forceinline__ void dif(f32x2 (&x)[R]) {
    constexpr float C32[16] = { 1.f, 0.98078528040323043f, 0.92387953251128674f, 0.83146961230254524f, 0.70710678118654752f, 0.55557023301960218f, 0.38268343236508978f, 0.19509032201612825f,
                                0.f, -0.19509032201612825f, -0.38268343236508978f, -0.55557023301960218f, -0.70710678118654752f, -0.83146961230254524f, -0.92387953251128674f, -0.98078528040323043f };
    constexpr float S32[16] = { 0.f, 0.19509032201612825f, 0.38268343236508978f, 0.55557023301960218f, 0.70710678118654752f, 0.83146961230254524f, 0.92387953251128674f, 0.98078528040323043f,
                                1.f, 0.98078528040323043f, 0.92387953251128674f, 0.83146961230254524f, 0.70710678118654752f, 0.55557023301960218f, 0.38268343236508978f, 0.19509032201612825f };
#pragma unroll
    for (int h = R / 2; h >= 1; h >>= 1) {
#pragma unroll
        for (int b = 0; b < R; b += 2 * h) {
#pragma unroll
            for (int k = 0; k < h; ++k) {
                const int i0 = b + k, i1 = b + k + h, ti = k * (16 / h);
                const f32x2 u = x[i0], v = x[i1];
                x[i0] = u + v;
                const f32x2 d = u - v;
                if (ti == 0) x[i1] = d;
                else if (ti == 8) x[i1] = cswap(d);
                else x[i1] = d * C32[ti] + cswap(d) * S32[ti];
            }
        }
    }
}
struct FftCtx { LAS f32x2* X; const LAS f32x2* TW; int tid; };
__device__ __forceinline__ void fft_fwd_A(const FftCtx& f, f32x2 (&x)[32]) {
    dif<32>(x);
    __builtin_amdgcn_sched_barrier(0);
    const int i = f.tid; const f32x2 w = f.TW[i]; f32x2 cw; cw.x = 1.f; cw.y = 0.f;
    __syncthreads();
    LAS f32x2* XA = f.X + (i + (i >> 5));
    XA[0] = x[0];
#pragma unroll
    for (int r = 1; r < 32; ++r) { __builtin_amdgcn_sched_barrier(0); cw = cmul(cw, w); XA[528 * r] = cmul(x[brevn(r, 5)], cw); }
    __syncthreads();
}
__device__ __forceinline__ void fft_fwd_BC(const FftCtx& f, f32x2 (&x)[32]) {
#pragma unroll 1
    for (int u = 0; u < 2; ++u) {
        const int q = f.tid + 512 * u, r = q >> 5, i2 = q & 31;
        f32x2 y[16]; LAS f32x2* XB = f.X + (528 * r + i2);
#pragma unroll
        for (int j2 = 0; j2 < 16; ++j2) y[j2] = XB[33 * j2];
        dif<16>(y);
        __builtin_amdgcn_sched_barrier(0);
        const f32x2 w = f.TW[32 * i2]; f32x2 cw; cw.x = 1.f; cw.y = 0.f;
        XB[0] = y[0];
#pragma unroll
        for (int r2 = 1; r2 < 16; ++r2) { __builtin_amdgcn_sched_barrier(0); cw = cmul(cw, w); XB[33 * r2] = cmul(y[brevn(r2, 4)], cw); }
    }
    __syncthreads();
    { const LAS f32x2* XC = f.X + 33 * f.tid;
#pragma unroll
      for (int m = 0; m < 32; ++m) x[m] = XC[m]; }
    dif<32>(x);
}
__device__ __forceinline__ void fft_inv(const FftCtx& f, f32x2 (&x)[32]) {
    {   f32x2 t[32];
#pragma unroll
        for (int k = 0; k < 32; ++k) { t[k] = x[brevn(k, 5)]; t[k].y = -t[k].y; }
        dif<32>(t);
        LAS f32x2* XC = f.X + 33 * f.tid;
#pragma unroll
        for (int s = 0; s < 32; ++s) { f32x2 v = t[s]; v.y = -v.y; XC[brevn(s, 5)] = v; }
    }
    __syncthreads();
#pragma unroll 1
    for (int u = 0; u < 2; ++u) {
        const int q = f.tid + 512 * u, r = q >> 5, i2 = q & 31;
        f32x2 y[16];
        const f32x2 w = f.TW[32 * i2]; f32x2 cw; cw.x = 1.f; cw.y = 0.f; LAS f32x2* XB = f.X + (528 * r + i2);
        { f32x2 v = XB[0]; v.y = -v.y; y[0] = v; }
#pragma unroll
        for (int r2 = 1; r2 < 16; ++r2) { __builtin_amdgcn_sched_barrier(0); cw = cmul(cw, w); f32x2 v = XB[33 * r2]; v.y = -v.y; y[r2] = cmul(v, cw); }
        dif<16>(y);
#pragma unroll
        for (int s = 0; s < 16; ++s) { f32x2 v = y[s]; v.y = -v.y; XB[33 * brevn(s, 4)] = v; }
    }
    __syncthreads();
    {   const int i = f.tid; const f32x2 w = f.TW[i]; f32x2 cw; cw.x = 1.f; cw.y = 0.f; const LAS f32x2* XA = f.X + (i + (i >> 5));
        { f32x2 v = XA[0]; v.y = -v.y; x[0] = v; }
#pragma unroll
        for (int r = 1; r < 32; ++r) { __builtin_amdgcn_sched_barrier(0); cw = cmul(cw, w); f32x2 v = XA[528 * r]; v.y = -v.y; x[r] = cmul(v, cw); }
        dif<32>(x);
#pragma unroll
        for (int s = 0; s < 32; ++s) x[s].y = -x[s].y;
    }
}
__device__ __forceinline__ void ph_hyc(const Args& a, const Frame& F, int l) {
    const int Z = opaque_zero();
    const int j2 = l >> 1;
    const float* FILT = (const float*)WSB(WS_FILT); const bf16_t* UT = (const bf16_t*)WSB(WS_UT); float* Z2T = (float*)WSB(WS_Z2T);
    const float* skip = INP(I_HY_SKIP) + (size_t)j2 * 2 * 2048;
    FftCtx f; f.X = (LAS f32x2*)F.lds; f.TW = (const LAS f32x2*)(F.lds + 135168); f.tid = F.tid;
    LAS float* red = (LAS float*)(F.lds + 135168 + 8192);
    { LAS f32x2* tw = (LAS f32x2*)(F.lds + 135168);
      for (int m = F.tid; m < 1024; m += 512) { float sn, cs; sincosf(-6.283185307179586f * (float)m * (1.0f / 16384.f), &sn, &cs); f32x2 v; v.x = cs; v.y = sn; tw[m] = v; } }
    __syncthreads();
    const unsigned tu = (unsigned)F.tid, trv = 511u - (unsigned)F.tid;
    for (int c = blockIdx.x; c < 2048; c += F.G) {
        f32x2 nd[16];
        { const float* z0p = Z2T + ((size_t)0 * 2048 + c) * SEQ; const float* z1p = Z2T + ((size_t)1 * 2048 + c) * SEQ;
#pragma unroll
          for (int j = 0; j < 16; ++j) { unsigned long long a0 = (unsigned long long)(z0p + 512 * j), a1 = (unsigned long long)(z1p + 512 * j); asm volatile("" : "+s"(a0), "+s"(a1)); nd[j].x = ((const GAS float*)a0)[tu]; nd[j].y = ((const GAS float*)a1)[tu]; } }
#pragma unroll 1
        for (int o = 0; o < 2; ++o) {
            const float* fwd = FILT + ((size_t)(c * 2 + o) * 2 + 0) * SEQ; const float* bwd = fwd + SEQ;
            f32x2 kx[32]; float ss = 0.f;
#pragma unroll
            for (int j = 0; j < 32; ++j) { float v;
                if (j < 16) v = (fwd + 512 * j)[tu]; else { v = (bwd + (SEQ - 512 * (j - 16) - 511))[trv]; if (j == 16 && F.tid == 0) v = 0.f; }
                kx[j].x = v; kx[j].y = 0.f; ss += v * v; }
            fft_fwd_A(f, kx); fft_fwd_BC(f, kx);
            const float tot = block_sum(F, ss, red);
            const float sc = (1.0f / sqrtf(tot + EPS)) * (1.0f / 16384.f);
            const float skn = skip[o * 2048 + c] * (1.0f / 16384.f);
#pragma unroll
            for (int s = 0; s < 32; ++s) { kx[s] = kx[s] * sc; kx[s].x += skn; }
            f32x2 dx[32];
#pragma unroll
            for (int j = 0; j < 32; ++j) { if (j < 16) dx[j] = nd[j]; else { dx[j].x = 0.f; dx[j].y = 0.f; } }
            fft_fwd_A(f, dx); fft_fwd_BC(f, dx);
#pragma unroll
            for (int s = 0; s < 32; ++s) dx[s] = cmul(dx[s], kx[s]);
            const bf16_t* g0p = UT + ((size_t)0 * 4096 + o * 2048 + c) * SEQ; const bf16_t* g1p = UT + ((size_t)1 * 4096 + o * 2048 + c) * SEQ;
            unsigned short gt0[16], gt1[16];
#pragma unroll
            for (int j = 0; j < 16; ++j) { unsigned long long a0 = (unsigned long long)(g0p + 512 * j), a1 = (unsigned long long)(g1p + 512 * j); asm volatile("" : "+s"(a0), "+s"(a1));
                gt0[j] = ((const GAS bf16_t*)a0)[tu]; gt1[j] = ((const GAS bf16_t*)a1)[tu]; }
            fft_inv(f, dx);
            float* o0p = Z2T + ((size_t)0 * 2048 + c) * SEQ; float* o1p = Z2T + ((size_t)1 * 2048 + c) * SEQ;
#pragma unroll
            for (int j = 0; j < 16; ++j) { const int s = brevn(j, 5);
                nd[j].x = bf2f(gt0[j]) * dx[s].x; nd[j].y = bf2f(gt1[j]) * dx[s].y; }
            if (o == 1) {
#pragma unroll
                for (int j = 0; j < 16; ++j) { unsigned long long b0 = (unsigned long long)(o0p + 512 * j), b1 = (unsigned long long)(o1p + 512 * j); asm volatile("" : "+s"(b0), "+s"(b1));
                    ((GAS float*)b0)[tu] = nd[j].x; ((GAS float*)b1)[tu] = nd[j].y; }
            }
        }
    }
}

__device__ __forceinline__ void ph_hyx(const Args& a, const Frame& F, int l) {
    const int Z = opaque_zero();
    const int j2 = l >> 1;
    const bf16_t* P = (const bf16_t*)WSB(WS_P); bf16_t* MIX = (bf16_t*)WSB(WS_MIX); const float* FILTC = (const float*)WSB(WS_FILTC);
    const float* cw = INP(I_HY_CW) + (size_t)j2 * 3 * 6144; const float* cb = INP(I_HY_CB) + (size_t)j2 * 6144; const float* skip = INP(I_HY_SKIP) + (size_t)j2 * 2 * 2048;
    LAS float* us = (LAS float*)F.lds;
    LAS float* Hh = us + 3 * 2 * 256 * 8;
    LAS float* red = Hh + 2 * 8 * 512;
    const int b = F.tid >> 8, t = F.tid & 255;
    for (int cg = blockIdx.x; cg < 256; cg += F.G) {
        const int c0 = cg * 8;
        __syncthreads();
#pragma unroll 1
        for (int part = 0; part < 3; ++part) { const int ch0 = part * 2048 + c0; float v[8];
#pragma unroll
            for (int k = 0; k < 8; ++k) v[k] = cb[ch0 + k];
#pragma unroll
            for (int i = 0; i < 3; ++i) { const int tt = t + i - 1; if (tt >= 0 && tt < LC) { const u32x4 raw = *(const u32x4*)(P + (size_t)(NLAT + b * LC + tt) * EVEN_IN + 6144 + ch0); const float* w = cw + i * 6144 + ch0;
                v[0] += bflo(raw.x) * w[0]; v[1] += bfhi(raw.x) * w[1]; v[2] += bflo(raw.y) * w[2]; v[3] += bfhi(raw.y) * w[3]; v[4] += bflo(raw.z) * w[4]; v[5] += bfhi(raw.z) * w[5]; v[6] += bflo(raw.w) * w[6]; v[7] += bfhi(raw.w) * w[7]; } }
            LAS f32x4* d = (LAS f32x4*)(us + ((part * 2 + b) * 256 + t) * 8); d[0] = (f32x4){v[0], v[1], v[2], v[3]}; d[1] = (f32x4){v[4], v[5], v[6], v[7]}; }
#pragma unroll 1
        for (int m = 0; m < 8; ++m) { const int idx = F.tid + 512 * m, ok = idx >> 8, d = idx & 255, o = ok >> 3, k = ok & 7;
            const float* fwd = FILTC + ((size_t)((c0 + k) * 2 + o) * 2 + 0) * LC; const float f = fwd[d]; float ss = f * f; Hh[ok * 512 + 256 + d] = f;
            if (d >= 1) { const float g = fwd[LC + d]; Hh[ok * 512 + 256 - d] = g; ss += g * g; } else Hh[ok * 512] = 0.f;
            ss = wave_sum_o(ss); if (F.lane == 0) red[ok * 4 + (F.wave & 3)] = ss; }
        __syncthreads();
#pragma unroll 1
        for (int o = 0; o < 2; ++o) {
            float acc[8];
#pragma unroll
            for (int k = 0; k < 8; ++k) acc[k] = 0.f;
            const LAS float* zb = us + (2 * 2 + b) * 256 * 8; const LAS float* hb = Hh + (o * 8) * 512 + 256 + t;
            for (int sidx = 0; sidx < LC; ++sidx) { const f32x4 z0 = *(const LAS f32x4*)(zb + sidx * 8), z1 = *(const LAS f32x4*)(zb + sidx * 8 + 4);
                acc[0] += hb[0 * 512 - sidx] * z0.x; acc[1] += hb[1 * 512 - sidx] * z0.y; acc[2] += hb[2 * 512 - sidx] * z0.z; acc[3] += hb[3 * 512 - sidx] * z0.w;
                acc[4] += hb[4 * 512 - sidx] * z1.x; acc[5] += hb[5 * 512 - sidx] * z1.y; acc[6] += hb[6 * 512 - sidx] * z1.z; acc[7] += hb[7 * 512 - sidx] * z1.w; }
            float zn[8];
#pragma unroll
            for (int k = 0; k < 8; ++k) { const int ok = o * 8 + k; const float fscale = 1.0f / sqrtf(red[ok * 4] + red[ok * 4 + 1] + red[ok * 4 + 2] + red[ok * 4 + 3] + EPS);
                const float y = acc[k] * fscale + zb[t * 8 + k] * skip[o * 2048 + c0 + k]; zn[k] = us[((o * 2 + b) * 256 + t) * 8 + k] * y; }
            __syncthreads();
            if (o == 0) { LAS f32x4* d = (LAS f32x4*)(us + ((2 * 2 + b) * 256 + t) * 8); d[0] = (f32x4){zn[0], zn[1], zn[2], zn[3]}; d[1] = (f32x4){zn[4], zn[5], zn[6], zn[7]}; __syncthreads(); }
            else { u32x4 w; w.x = pk2(zn[0], zn[1]); w.y = pk2(zn[2], zn[3]); w.z = pk2(zn[4], zn[5]); w.w = pk2(zn[6], zn[7]); *(u32x4*)(MIX + (size_t)(NLAT + b * LC + t) * D + 2048 + c0) = w; }
        }
    }
}
__device__ __forceinline__ void ph_hyt(const Args& a, const Frame& F) {
    const int Z = opaque_zero();
    const float* Z2T = (const float*)WSB(WS_Z2T); bf16_t* MIX = (bf16_t*)WSB(WS_MIX);
    LAS float* tile = (LAS float*)F.lds;
    for (int it = blockIdx.x; it < 2 * 128 * 32; it += F.G) {
        const int b = it >> 12, t0 = ((it >> 5) & 127) * 64, c0 = (it & 31) * 64;
        for (int idx = F.tid; idx < 4096; idx += 512) { const int cc = idx >> 6, tt = idx & 63; tile[cc * 65 + tt] = Z2T[((size_t)b * 2048 + c0 + cc) * SEQ + t0 + tt]; }
        __syncthreads();
        { const int tt = F.tid >> 3, ck = F.tid & 7; const LAS float* sp = tile + (8 * ck) * 65 + tt;
          u32x4 o; o.x = pk2(sp[0], sp[65]); o.y = pk2(sp[2 * 65], sp[3 * 65]); o.z = pk2(sp[4 * 65], sp[5 * 65]); o.w = pk2(sp[6 * 65], sp[7 * 65]);
          *(u32x4*)(MIX + (size_t)(b * SEQ + t0 + tt) * D + 2048 + c0 + 8 * ck) = o; }
        __syncthreads();
    }
}

__device__ __forceinline__ void ph_r1(const Args& a, const Frame& F, int l) {
    const int Z = opaque_zero();
    const int M = (l == 3) ? NLAT : T; const bf16_t* ZB = (const bf16_t*)WSB(WS_P); float* RS = (float*)WSB(WS_RSTDV);
    for (int row = F.gw; row < M; row += F.NGW) {
        const u32x4* vr = (const u32x4*)(ZB + (size_t)row * ODD_IN + 4096); float ss = 0.f;
#pragma unroll
        for (int j = 0; j < 8; ++j) { const u32x4 r = vr[F.lane + 64 * j];
            ss += bflo(r.x) * bflo(r.x) + bfhi(r.x) * bfhi(r.x) + bflo(r.y) * bflo(r.y) + bfhi(r.y) * bfhi(r.y) + bflo(r.z) * bflo(r.z) + bfhi(r.z) * bfhi(r.z) + bflo(r.w) * bflo(r.w) + bfhi(r.w) * bfhi(r.w); }
        ss = wave_sum(ss);
        if (F.lane == 0) RS[row] = 1.0f / sqrtf(ss * (1.0f / 4096.f) + EPS);
    }
}
__device__ __forceinline__ void ph_sg(const Args& a, const Frame& F, int l) {
    const int Z = opaque_zero();
    const int j2 = l >> 1, M = (l == 3) ? NLAT : T;
    const bf16_t* ZB = (const bf16_t*)WSB(WS_P); bf16_t* MIX = (bf16_t*)WSB(WS_MIX); const float* RS = (const float*)WSB(WS_RSTDV);
    const float* vgain = INP(I_GM_VGAIN) + (size_t)j2 * 4096; const float* ws = INP(I_GM_WS) + (size_t)j2 * 32 * 128 * 128; const float* bs = INP(I_GM_BS) + (size_t)j2 * 32 * 128;
    LAS unsigned char* VT = F.lds;
    const int nunits = (M / 128) * 32;
    const int jl = F.lane & 15, kq = F.lane >> 4;
    for (int un = blockIdx.x; un < nunits; un += F.G) {
        const int chunk = un >> 5, g = un & 31;
        __syncthreads();
#pragma unroll
        for (int it = 0; it < 4; ++it) { const int idx = F.tid + 512 * it, q = idx >> 4, c8 = (idx & 15) * 8; const int row = chunk * 128 + q;
            const u32x4 raw = *(const u32x4*)(ZB + (size_t)row * ODD_IN + 4096 + g * 128 + c8); const float rs = RS[row]; const float* gp = vgain + g * 128 + c8;
            const float v[8] = { bflo(raw.x), bfhi(raw.x), bflo(raw.y), bfhi(raw.y), bflo(raw.z), bfhi(raw.z), bflo(raw.w), bfhi(raw.w) };
#pragma unroll
            for (int i = 0; i < 8; ++i) *(LAS unsigned short*)(VT + (c8 + i) * 272 + q * 2) = (unsigned short)f2bf(v[i] * rs * gp[i]); }
        union { bf16x8v v; unsigned u[4]; } wf[4];
        { const float* wp = ws + (size_t)g * 16384 + (size_t)(16 * F.wave + jl) * 128 + 8 * kq;
#pragma unroll
          for (int s4 = 0; s4 < 4; ++s4) { const f32x4 w0 = *(const f32x4*)(wp + 32 * s4), w1 = *(const f32x4*)(wp + 32 * s4 + 4);
              wf[s4].u[0] = pk2(w0.x, w0.y); wf[s4].u[1] = pk2(w0.z, w0.w); wf[s4].u[2] = pk2(w1.x, w1.y); wf[s4].u[3] = pk2(w1.z, w1.w); } }
        __syncthreads();
        const int p = 16 * F.wave + jl, row = chunk * 128 + p; const float bsp = bs[g * 128 + p];
#pragma unroll
        for (int cb = 0; cb < 8; ++cb) {
            f32x4 acc = (f32x4){0.f, 0.f, 0.f, 0.f};
#pragma unroll
            for (int s4 = 0; s4 < 4; ++s4) { const bf16x8v af = *(const LAS bf16x8v*)(VT + (16 * cb + jl) * 272 + (32 * s4 + 8 * kq) * 2);
                acc = __builtin_amdgcn_mfma_f32_16x16x32_bf16(af, wf[s4].v, acc, 0, 0, 0); }
            const int c0 = g * 128 + 16 * cb + 4 * kq;
            const u32x2 ur = *(const u32x2*)(ZB + (size_t)row * ODD_IN + c0);
            *(unsigned*)((unsigned char*)MIX + (size_t)row * D + c0) = pk4f8(bflo(ur.x) * (acc.x + bsp), bfhi(ur.x) * (acc.y + bsp), bflo(ur.y) * (acc.z + bsp), bfhi(ur.y) * (acc.w + bsp));
        }
    }
}

__device__ __forceinline__ void ph_router(const Args& a, const Frame& F, int l) {
    const int Z = opaque_zero();
    const int M = (l >= 2) ? NLAT : T, ntask = M / 16;
    const bf16_t* WRH = (const bf16_t*)WSB(WS_WR); const bf16_t* WRL = WRH + (size_t)4 * 3 * NE * D; const float* RB = (const float*)WSB(WS_RB); float* GATES = (float*)WSB(WS_GATES);
    const float* CX = (const float*)WSB(WS_CX); const float* rbias = INP(I_MOE_BIAS) + l * NE;
    LAS float* S = (LAS float*)(F.lds + F.wave * 8192);
    unsigned* ECNT = (unsigned*)WSB(WS_CTL) + CW_ECNT; int* ELIST = (int*)WSB(WS_ELIST);
    for (int task = F.wave * F.G + (int)blockIdx.x; task < ntask; task += 4 * F.G) {
        const int t0 = task * 16, c = t0 < SEQ ? 0 : (t0 < NLAT ? 1 : 2), j = F.lane & 15, kq = F.lane >> 4, row = t0 + j;
        const float* xr = (row < NLAT ? AOUT + (size_t)row * D : CX + (size_t)(row - NLAT) * D) + 8 * kq;
        const bf16_t* wh = WRH + (size_t)(l * 3 + c) * NE * D + F.lane * 8; const bf16_t* wl = WRL + (size_t)(l * 3 + c) * NE * D + F.lane * 8;
        f32x4 acc[4]; float ss = 0.f;
#pragma unroll
        for (int blk = 0; blk < 4; ++blk) acc[blk] = (f32x4){0.f, 0.f, 0.f, 0.f};
#pragma unroll 4
        for (int k0 = 0; k0 < D; k0 += 32) {
            const f32x4 x0 = *(const f32x4*)(xr + k0), x1 = *(const f32x4*)(xr + k0 + 4);
            ss += (x0.x * x0.x + x0.y * x0.y) + (x0.z * x0.z + x0.w * x0.w) + (x1.x * x1.x + x1.y * x1.y) + (x1.z * x1.z + x1.w * x1.w);
            const float xs[8] = { x0.x, x0.y, x0.z, x0.w, x1.x, x1.y, x1.z, x1.w };
            union { bf16x8v v; unsigned u[4]; } xh, xl;
#pragma unroll
            for (int q = 0; q < 4; ++q) { const unsigned b0 = __builtin_bit_cast(unsigned, xs[2 * q]), b1 = __builtin_bit_cast(unsigned, xs[2 * q + 1]);
                xh.u[q] = (b0 >> 16) | (b1 & 0xffff0000u);
                xl.u[q] = pk2(xs[2 * q] - __builtin_bit_cast(float, b0 & 0xffff0000u), xs[2 * q + 1] - __builtin_bit_cast(float, b1 & 0xffff0000u)); }
#pragma unroll
            for (int blk = 0; blk < 4; ++blk) { const bf16x8v ah = *(const bf16x8v*)(wh + (size_t)k0 * 64 + blk * 512), al = *(const bf16x8v*)(wl + (size_t)k0 * 64 + blk * 512);
                acc[blk] = __builtin_amdgcn_mfma_f32_16x16x32_bf16(ah, xh.v, acc[blk], 0, 0, 0);
                acc[blk] = __builtin_amdgcn_mfma_f32_16x16x32_bf16(al, xh.v, acc[blk], 0, 0, 0);
                acc[blk] = __builtin_amdgcn_mfma_f32_16x16x32_bf16(ah, xl.v, acc[blk], 0, 0, 0); }
        }
        ss += __shfl_xor(ss, 16); ss += __shfl_xor(ss, 32);
        const float rstd = 1.0f / sqrtf(ss * (1.0f / D) + EPS);
        LDS_WAIT();
#pragma unroll
        for (int blk = 0; blk < 4; ++blk)
#pragma unroll
            for (int r = 0; r < 4; ++r) { const int e = 16 * blk + 4 * kq + r; const float logit = acc[blk][r] * rstd + RB[(l * 3 + c) * NE + e]; S[j * 65 + e] = 1.0f / (1.0f + expf(-logit)); }
        LDS_WAIT();
        unsigned mlo, mhi; float ssum = 0.f;
        { float sc[16], sb[16];
#pragma unroll
          for (int i = 0; i < 16; ++i) { sc[i] = S[j * 65 + 16 * kq + i]; sb[i] = sc[i] + rbias[16 * kq + i]; }
          unsigned taken = 0u;
#pragma unroll 1
          for (int it = 0; it < 8; ++it) { float best = -1e30f, braw = 0.f; int bi = 0;
#pragma unroll
              for (int i = 0; i < 16; ++i) { const bool ok = !((taken >> i) & 1u) && sb[i] > best; best = ok ? sb[i] : best; bi = ok ? i : bi; braw = ok ? sc[i] : braw; }
              int gi = 16 * kq + bi;
#pragma unroll
              for (int off = 16; off <= 32; off <<= 1) { const float ob = __shfl_xor(best, off), orw = __shfl_xor(braw, off); const int oi = __shfl_xor(gi, off);
                  const bool take = (ob > best) || (ob == best && oi < gi); best = take ? ob : best; gi = take ? oi : gi; braw = take ? orw : braw; }
              if ((gi >> 4) == kq) taken |= 1u << (gi & 15);
              ssum += braw; }
          const unsigned t0m = __shfl(taken, j), t1m = __shfl(taken, j + 16), t2m = __shfl(taken, j + 32), t3m = __shfl(taken, j + 48);
          mlo = t0m | (t1m << 16); mhi = t2m | (t3m << 16); }
        unsigned selbits = 0u;
        const float ginv = 2.5f / ssum;
        for (int tok = 0; tok < 16; ++tok) { const unsigned lo = __shfl(mlo, tok), hi = __shfl(mhi, tok); const float sm = __shfl(ginv, tok);
            const bool sel = F.lane < 32 ? ((lo >> F.lane) & 1u) : ((hi >> (F.lane - 32)) & 1u);
            if (sel) selbits |= 1u << tok;
            GATES[(size_t)(t0 + tok) * NE + F.lane] = sel ? S[tok * 65 + F.lane] * sm : 0.f; }
        const int ne = __popc(selbits);
        if (ne) { int pos = (int)__hip_atomic_fetch_add(ECNT + l * NE + F.lane, (unsigned)ne, __ATOMIC_RELAXED, __HIP_MEMORY_SCOPE_AGENT);
            for (int tok = 0; tok < 16; ++tok) if ((selbits >> tok) & 1u) { ELIST[(size_t)F.lane * T + pos] = t0 + tok; ++pos; } }
    }
}

__device__ __forceinline__ void ph_cxfix(const Args& a, const Frame& F, const float* cx_src_in, int l, int gate_idx, int nsplit) {
    const int Z = opaque_zero();
    const float* cx_src = cx_src_in + Z; float* CX = (float*)WSB(WS_CX); const float* part = (const float*)WSB(WS_PART); const float* gv = MODSP(a, l, 2, gate_idx);
    for (int i = blockIdx.x * 512 + F.tid; i < NCTX * (D / 4); i += F.G * 512) {
        f32x4 s = ((const f32x4*)part)[i];
#pragma unroll
        for (int k = 1; k < 8; ++k) if (k < nsplit) s += ((const f32x4*)(part + (size_t)k * NCTX * D))[i];
        ((f32x4*)CX)[i] = ((const f32x4*)cx_src)[i] + ((const f32x4*)gv)[i & (D / 4 - 1)] * s;
    }
}
template <int l> __device__ __forceinline__ void layer_body(const Args& a, const Frame& F, const XcdBarrier& bar, const int lo, const int hi) {
#define IN(k) (lo <= (k) && (k) < hi)
#if (PROBE_DUP & 256)
#define SEAM(k) do { if (IN(k) && IN((k) + 1)) { xcd_barrier(bar); xcd_barrier(bar); } } while (0)
#else
#define SEAM(k) do { if (IN(k) && IN((k) + 1)) xcd_barrier(bar); } while (0)
#endif
        const int base = 3 + 9 * l; const bool even = (l & 1) == 0; const int M = (l == 3) ? NLAT : T; const int M2 = (l >= 2) ? NLAT : T;
        if (IN(base + 0)) { if (l >= 1 && l <= 2) { ph_cxfix(a, F, (const float*)(a.ws + WS_CX), l - 1, 5, 6); xcd_barrier(bar); }
            wq_pull(a, F, l, -1); ph_norm(a, F, l, 0, F.gw, F.NGW); }
        SEAM(base + 0);
        if (IN(base + 1)) {
            const int Z = opaque_zero(); bf16_t* H = (bf16_t*)WSB(WS_H); bf16_t* WIN = WSETP(WS_WIN, l); bf16_t* P = (bf16_t*)WSB(WS_P);
            if (even) { pg8::RowIdent RM;
                { pg8::Gemm g{(bf16_t*)WSB(WS_H8E), WIN, M, 6144, D / 2}; pg8::StaticOrderX S; S.init(M, 6144, D / 2, F.G, (int)blockIdx.x);
                  pg8::EpiBf16X<0> E{P, EVEN_IN, nullptr, 1.f / WGU_SCALE};
                  pg8::gemm_phase_x<pg8::EpiBf16X<0>, pg8::StaticOrderX, pg8::RowIdent, true>(F.lds, g, S, E, RM); }
                __syncthreads();
                { pg8::Gemm g{H, WIN + (size_t)6144 * D, M, 6144, D}; pg8::StaticOrderX S; S.init(M, 6144, D, F.G, F.G - 1 - (int)blockIdx.x);
                  pg8::EpiBf16X<0> E{P + 6144, EVEN_IN, nullptr, 1.f};
                  pg8::gemm_phase_x<pg8::EpiBf16X<0>, pg8::StaticOrderX, pg8::RowIdent, false>(F.lds, g, S, E, RM); } }
            else { pg8::Gemm g{H, WIN, M, ODD_IN, D / 2}; pg8::StaticOrderX S; S.init(M, ODD_IN, D / 2, F.G, (int)blockIdx.x); pg8::RowIdent RM;
                pg8::EpiBf16X<1> E{P, ODD_IN, INP(I_ODD_BIN) + (size_t)(l >> 1) * ODD_IN, 1.f / WGU_SCALE};
                pg8::gemm_phase_x<pg8::EpiBf16X<1>, pg8::StaticOrderX, pg8::RowIdent, true>(F.lds, g, S, E, RM); }
            if (l < 3) wq_pull(a, F, l + 1, CW_ARR + base + 1);
        }
        SEAM(base + 1);
        if (IN(base + 2)) { if (even) { ph_e1(a, F, l); ph_hyf(a, F, l); } else ph_r1(a, F, l);
#if (PROBE_DUP & 1024)
            __syncthreads(); if (even) { ph_hyf(a, F, l); }
#endif
#if (PROBE_DUP & 2)
            __syncthreads(); if (even) { ph_e1(a, F, l, false); ph_hyf(a, F, l); } else ph_r1(a, F, l);
#endif
        }
        SEAM(base + 2);
        if (IN(base + 3)) { if (even) { ph_attn(a, F, l); __syncthreads(); ph_hyc(a, F, l); __syncthreads(); if (l == 0) ph_hyx(a, F, l); } else ph_sg(a, F, l);
#if (PROBE_DUP & 4)
            __syncthreads(); if (even) { ph_attn(a, F, l); __syncthreads(); ph_hyc(a, F, l); __syncthreads(); ph_hyx(a, F, l); } else ph_sg(a, F, l);
#endif
#if (PROBE_DUP & 16)
            __syncthreads(); if (even) { ph_hyc(a, F, l); }
#endif
#if (PROBE_DUP & 32)
            __syncthreads(); if (even) { ph_attn(a, F, l); }
#endif
#if (PROBE_DUP & 64)
            __syncthreads(); if (!even) { ph_sg(a, F, l); }
#endif
        }
        SEAM(base + 3);
        if (IN(base + 4)) { if (even) ph_hyt(a, F);
#if (PROBE_DUP & 8)
            __syncthreads(); if (even) ph_hyt(a, F);
#endif
        }
        SEAM(base + 4);
        if (IN(base + 5)) {
            const int Z = opaque_zero(); bf16_t* MIX = (bf16_t*)WSB(WS_MIX); bf16_t* WOUT = WSETP(WS_WOUT, l); float* CX = (float*)WSB(WS_CX);
            pg8::RowIdent RM;
            if (even) { pg8::Gemm g{MIX, WOUT, M2, D, D}; pg8::SplitCtxOrder S; S.init(M2, D, D, F.G, (int)blockIdx.x, 8);
                pg8::EpiResidX E{l == 0 ? INP(I_X) : AOUT, AOUT, MODSP(a, l, 0, 2), (float*)WSB(WS_PART), 1.f};
                pg8::gemm_phase_x<pg8::EpiResidX, pg8::SplitCtxOrder, pg8::RowIdent>(F.lds, g, S, E, RM); }
            else { pg8::Gemm g{MIX, WOUT, M2, D, D / 2}; pg8::SplitCtxOrder S; S.init(M2, D, D / 2, F.G, (int)blockIdx.x, 8);
                pg8::EpiResidX E{AOUT, AOUT, MODSP(a, l, 0, 2), (float*)WSB(WS_PART), 1.f / WGU_SCALE};
                pg8::gemm_phase_x<pg8::EpiResidX, pg8::SplitCtxOrder, pg8::RowIdent, true>(F.lds, g, S, E, RM); }
            if (l < 3) wq_pull(a, F, l + 1, CW_ARR + base + 5);
        }
        SEAM(base + 5);
        if (IN(base + 6)) { if (M2 > NLAT) { ph_cxfix(a, F, l == 0 ? a.in[I_CTX] : (const float*)(a.ws + WS_CX), l, 2, 8); xcd_barrier(bar); }
            if (F.wave >= 4) ph_norm(a, F, l, 1, (int)blockIdx.x * 4 + F.wave - 4, F.G * 4, true); else ph_router(a, F, l);
#if (PROBE_DUP & 2048)
            __syncthreads(); if (F.wave >= 4) ph_norm(a, F, l, 1, (int)blockIdx.x * 4 + F.wave - 4, F.G * 4, true);
#endif
            }
        SEAM(base + 6);
        if (IN(base + 7)) {
            const int Z = opaque_zero(); bf16_t* H = (bf16_t*)WSB(WS_H); bf16_t* WGU = WSETP(WS_WGU, l); bf16_t* P = (bf16_t*)WSB(WS_P);
            LAS int* tab = (LAS int*)(F.lds + TAB_OFF); LAS int* cntl = tab + 640;
            const unsigned* ECNT = (const unsigned*)WSB(WS_CTL) + CW_ECNT + l * NE;
            if (F.tid < NE) cntl[F.tid] = (int)__hip_atomic_load(ECNT + F.tid, __ATOMIC_RELAXED, __HIP_MEMORY_SCOPE_AGENT);
            __syncthreads();
            if (F.tid == 0) { int n = 0; for (int e = 0; e < NE; ++e) { const int nt_ = (cntl[e] + 255) >> 8; for (int t = 0; t < nt_; ++t) tab[n++] = e | (t << 8); } cntl[NE] = n; }
            __syncthreads();
            pg8::Gemm g{H, WGU, M2, GU_N, D / 2};
            pg8::MoeOrder S{tab, cntl, cntl[NE], (M2 / 256) * 8, F.G, (int)blockIdx.x, D / 128};
            pg8::RowList RM{(const int*)WSB(WS_ELIST)};
            pg8::EpiSwigluX E{(unsigned char*)P, (const float*)WSB(WS_GATES), (const int*)WSB(WS_ELIST), 1.f / WGU_SCALE};
            pg8::gemm_phase_x<pg8::EpiSwigluX, pg8::MoeOrder, pg8::RowList, true>(F.lds, g, S, E, RM);
#if (PROBE_DUP & 512)
            __syncthreads(); pg8::gemm_phase_x<pg8::EpiSwigluX, pg8::MoeOrder, pg8::RowList, true>(F.lds, g, S, E, RM);
#endif
            if (l < 3) wq_pull(a, F, l + 1, CW_ARR + base + 7);
        }
        SEAM(base + 7);
        if (IN(base + 8)) {
            const int Z = opaque_zero(); bf16_t* P = (bf16_t*)WSB(WS_P); bf16_t* WD = WSETP(WS_WD, l); float* CX = (float*)WSB(WS_CX);
            pg8::Gemm g{P, WD, M2, D, DN_K / 2}; pg8::SplitCtxOrder S; S.init(M2, D, DN_K / 2, F.G, (int)blockIdx.x, 6);
            pg8::EpiResidX E{AOUT, AOUT, MODSP(a, l, 0, 5), (float*)WSB(WS_PART), 1.f / WD_SCALE}; pg8::RowIdent RM;
            pg8::gemm_phase_x<pg8::EpiResidX, pg8::SplitCtxOrder, pg8::RowIdent, true>(F.lds, g, S, E, RM);
            if (l < 3) wq_pull(a, F, l + 1, CW_ARR + base + 8);
        }
        if (l < 3) SEAM(base + 8);
#undef IN
#undef SEAM
}

__global__ void __launch_bounds__(512, 2) fwd_kernel(Args a) {
    extern __shared__ __attribute__((aligned(16))) unsigned char lds_raw[];
    Frame F; F.lds = (LAS unsigned char*)lds_raw; F.tid = threadIdx.x; F.lane = F.tid & 63; F.wave = __builtin_amdgcn_readfirstlane(F.tid >> 6);
    F.G = gridDim.x; F.gw = blockIdx.x * 8 + F.wave; F.NGW = F.G * 8;
    volatile LAS unsigned* MISC = (volatile LAS unsigned*)(F.lds + MISC_OFF);
    if (F.tid < 32) MISC[F.tid] = 0u;
    __syncthreads();
    const int lo = a.ph_lo, hi = a.ph_hi;
    unsigned* barw = (unsigned*)(a.ws) + CW_BAR;
    XcdBarrier bar; bar.bar = barw; bar.x = 0; bar.st = MISC + 8;
    if (hi - lo > 1) bar = xcd_barrier_post(barw, MISC + 8);
#define IN(k) (lo <= (k) && (k) < hi)
#if (PROBE_DUP & 256)
#define SEAM(k) do { if (IN(k) && IN((k) + 1)) { xcd_barrier(bar); xcd_barrier(bar); } } while (0)
#else
#define SEAM(k) do { if (IN(k) && IN((k) + 1)) xcd_barrier(bar); } while (0)
#endif

    if (IN(0)) ph_mods1(a, F);
    SEAM(0);
    if (IN(1)) ph_mods2(a, F);
    SEAM(1);
    if (IN(2)) ph_rprep(a, F);
    SEAM(2);
#if (PROBE_DUP & 4096)
    ph_mods1(a, F); xcd_barrier(bar); ph_mods2(a, F); xcd_barrier(bar); ph_rprep(a, F); xcd_barrier(bar);
#endif
    layer_body<0>(a, F, bar, lo, hi);
    layer_body<1>(a, F, bar, lo, hi);
    layer_body<2>(a, F, bar, lo, hi);
    layer_body<3>(a, F, bar, lo, hi);
#undef IN
#undef SEAM
}
constexpr int N_PHASES = 3 + 9 * 4;

extern "C" void kernel_launch(void* const* d_in, const int* in_sizes, int n_in, void* d_out, int out_size, void* d_ws, size_t ws_size, hipStream_t stream) {
    static int grid = 0;
    if (grid == 0) {
        if (n_in != 38 || out_size != NLAT * D || ws_size < WS_END2) { fprintf(stderr, "kernel_launch: unexpected sizes (n_in %d, out %d, ws %zu < %zu)\n", n_in, out_size, ws_size, (size_t)WS_END2); grid = -1; return; }
        int dev = 0, cus = 0, per_cu = 0;
        if (hipGetDevice(&dev) != hipSuccess || hipDeviceGetAttribute(&cus, hipDeviceAttributeMultiprocessorCount, dev) != hipSuccess) { grid = -1; return; }
        if (hipFuncSetAttribute((const void*)fwd_kernel, hipFuncAttributeMaxDynamicSharedMemorySize, LDS_BYTES) != hipSuccess) { fprintf(stderr, "kernel_launch: hipFuncSetAttribute failed\n"); grid = -1; return; }
        if (hipOccupancyMaxActiveBlocksPerMultiprocessor(&per_cu, (const void*)fwd_kernel, 512, LDS_BYTES) != hipSuccess || per_cu < 1) fprintf(stderr, "kernel_launch: occupancy query reports %d\n", per_cu);
        (void)hipGetLastError();
        grid = cus;
    }
    if (grid < 0) return;
    (void)hipMemsetAsync((char*)d_ws + WS_CTL, 0, CTL_ZERO_BYTES, stream);
    Args a{};
    for (int i = 0; i < 38; ++i) a.in[i] = (const float*)d_in[i];
    a.out = (float*)d_out; a.ws = (unsigned char*)d_ws;
#if MK_PER_PHASE
    for (int k = 0; k < N_PHASES; ++k) { a.ph_lo = k; a.ph_hi = k + 1; hipLaunchKernelGGL(fwd_kernel, dim3(grid), dim3(512), LDS_BYTES, stream, a); }
#else
    a.ph_lo = 0; a.ph_hi = N_PHASES;
    hipLaunchKernelGGL(fwd_kernel, dim3(grid), dim3(512), LDS_BYTES, stream, a);
#endif
}
```
